# Optimizing an MI355X kernel written in HIP

```python
import jax, jax.numpy as jnp
from jax import lax
import numpy as np

D_MODEL = 1024
BATCH = 4
SEQ = 4096
DEPTH = 1

GRID_W = 64
CTX_LEN = 256
MLA_HEADS = 8
QK_NOPE = 64
QK_ROPE = 32
V_HEAD = 64
Q_LORA = 384
KV_LORA = 256
Q_BLOCK = 128
ROPE_THETA = 10000.0
MLA_SCALE = (QK_NOPE + QK_ROPE) ** -0.5
M_HEADS = 4
M_DQK = 64
M_DV = 128
CHUNK = 128
N_EXPERTS = 32
TOP_K = 4
D_FF = 1024
SWIGLU_LIMIT = 7.0
SWIGLU_ALPHA = 1.702
MOE_BLOCK = 128
EPS = 1e-6

MLA_WIDTH = MLA_HEADS * V_HEAD
MLSTM_WIDTH = M_HEADS * M_DV
MIX_WIDTH = MLA_WIDTH + MLSTM_WIDTH
IN_SPLITS = (Q_LORA, KV_LORA, QK_ROPE, M_HEADS * M_DQK, M_HEADS * M_DQK, MLSTM_WIDTH, MLSTM_WIDTH, 4 * M_HEADS)
IN_WIDTH = sum(IN_SPLITS)

kernel_name = "hybrid_mla_mlstm_moe_dit_block"


def rms_norm(x, g):
    xf = x.astype(jnp.float32)
    y = xf * lax.rsqrt(jnp.mean(xf * xf, axis=-1, keepdims=True) + EPS)
    return (y * g.astype(jnp.float32)).astype(x.dtype)


def modulate(h, shift, scale):
    return h * (1 + scale) + shift


def split_cols(a, sizes):
    out, start = [], 0
    for s in sizes:
        out.append(a[..., start:start + s])
        start += s
    return out


def rope_tables(n_tokens):
    rows = n_tokens // GRID_W
    row = jnp.repeat(jnp.arange(rows, dtype=jnp.float32), GRID_W)
    col = jnp.tile(jnp.arange(GRID_W, dtype=jnp.float32), rows)
    pairs = QK_ROPE // 4
    inv = ROPE_THETA ** (-jnp.arange(pairs, dtype=jnp.float32) / pairs)
    ang = jnp.concatenate([row[:, None] * inv, col[:, None] * inv], axis=-1)
    return jnp.cos(ang), jnp.sin(ang)


def apply_rope(x, cos, sin):
    half = x.shape[-1] // 2
    xf = x.astype(jnp.float32)
    x1, x2 = xf[..., :half], xf[..., half:]
    return jnp.concatenate([x1 * cos - x2 * sin, x1 * sin + x2 * cos], axis=-1).astype(x.dtype)


def mla_q(cq, q_norm_g, w_uq, cos, sin):
    B, S = cq.shape[:2]
    q = (rms_norm(cq, q_norm_g) @ w_uq).reshape(B, S, MLA_HEADS, QK_NOPE + QK_ROPE)
    q_nope, q_rope = q[..., :QK_NOPE], q[..., QK_NOPE:]
    if cos is not None:
        q_rope = apply_rope(q_rope, cos[:, None, :], sin[:, None, :])
    return q_nope, q_rope


def mla_kv(ckv, k_rope, kv_norm_g, w_ukv, cos, sin):
    B, S = ckv.shape[:2]
    kv = (rms_norm(ckv, kv_norm_g) @ w_ukv).reshape(B, S, MLA_HEADS, QK_NOPE + V_HEAD)
    k_nope, v = kv[..., :QK_NOPE], kv[..., QK_NOPE:]
    if cos is not None:
        k_rope = apply_rope(k_rope, cos, sin)
    return k_nope, k_rope, v


def attend(q_nope, q_rope, k_nope, k_rope, v):
    s = jnp.einsum('bqhd,bkhd->bhqk', q_nope, k_nope) + jnp.einsum('bqhr,bkr->bhqk', q_rope, k_rope)
    p = jax.nn.softmax(s.astype(jnp.float32) * MLA_SCALE, axis=-1).astype(v.dtype)
    return jnp.einsum('bhqk,bkhd->bqhd', p, v)


def blocked_attention(q_nope, q_rope, k_nope, k_rope, v):
    B, S, H, _ = q_nope.shape
    nb = S // Q_BLOCK
    blk = lambda a: jnp.moveaxis(a.reshape(B, nb, Q_BLOCK, *a.shape[2:]), 1, 0)
    out = lax.map(lambda qs: attend(qs[0], qs[1], k_nope, k_rope, v), (blk(q_nope), blk(q_rope)))
    return jnp.moveaxis(out, 0, 1).reshape(B, S, H * V_HEAD)


def mlstm_heads(mq, mk, mv, mg, b_gates):
    B, S = mq.shape[:2]
    to_h = lambda a, d: jnp.moveaxis(a.astype(jnp.float32).reshape(B, S, M_HEADS, d), 1, 2)
    q = to_h(mq, M_DQK) * M_DQK ** -0.5
    k = to_h(mk, M_DQK)
    v = to_h(mv, M_DV)
    g = (mg.astype(jnp.float32) + b_gates.astype(jnp.float32)).reshape(B, S, 4, M_HEADS)
    g = jnp.moveaxis(g, 1, 3)
    return q, k, v, g


def mlstm_chunked(q, k, v, log_i, log_f, state):
    B, NH, S, _ = q.shape
    nc = S // CHUNK
    chunks = lambda a: jnp.moveaxis(a.reshape(B, NH, nc, CHUNK, *a.shape[3:]), 2, 0)
    tril = jnp.tril(jnp.ones((CHUNK, CHUNK), dtype=bool))

    def step(carry, inp):
        C, n, m = carry
        qc, kc, vc, li, lf = inp
        b = jnp.cumsum(lf, axis=-1)
        d_intra = jnp.where(tril, b[..., :, None] - b[..., None, :] + li[..., None, :], -jnp.inf)
        d_inter = b + m[..., None]
        m_t = jnp.maximum(d_inter, d_intra.max(-1))
        s = jnp.einsum('bhtd,bhsd->bhts', qc, kc) * jnp.exp(d_intra - m_t[..., None])
        w_inter = jnp.exp(d_inter - m_t)
        num = jnp.einsum('bhts,bhsv->bhtv', s, vc) + w_inter[..., None] * jnp.einsum('bhvd,bhtd->bhtv', C, qc)
        den = s.sum(-1) + w_inter * jnp.einsum('bhd,bhtd->bht', n, qc)
        h = num / jnp.maximum(jnp.abs(den), jnp.exp(-m_t))[..., None]
        b_last = b[..., -1]
        w_src = b_last[..., None] - b + li
        m_new = jnp.maximum(b_last + m, w_src.max(-1))
        decay = jnp.exp(b_last + m - m_new)
        w_src = jnp.exp(w_src - m_new[..., None])
        C_new = decay[..., None, None] * C + jnp.einsum('bhs,bhsv,bhsd->bhvd', w_src, vc, kc)
        n_new = decay[..., None] * n + jnp.einsum('bhs,bhsd->bhd', w_src, kc)
        return (C_new, n_new, m_new), h

    state, h = lax.scan(step, state, (chunks(q), chunks(k), chunks(v), chunks(log_i), chunks(log_f)))
    return state, jnp.moveaxis(h, 0, 2).reshape(B, NH, S, -1)


def rev(a, d):
    return jnp.flip(a, axis=2) if d == 1 else a


def mlstm_bidirectional(lat, ctxh):
    q, k, v, g = lat
    qc, kc, vc, gc = ctxh
    B = q.shape[0]
    h_lat, h_ctx = 0.0, 0.0
    for d in range(2):
        state0 = (jnp.zeros((B, M_HEADS, M_DV, M_DQK), jnp.float32),
                  jnp.zeros((B, M_HEADS, M_DQK), jnp.float32),
                  jnp.zeros((B, M_HEADS), jnp.float32))
        i_c, f_c = gc[:, 2 * d], jax.nn.log_sigmoid(gc[:, 2 * d + 1])
        i_x, f_x = g[:, 2 * d], jax.nn.log_sigmoid(g[:, 2 * d + 1])
        state_c, hc = mlstm_chunked(rev(qc, d), rev(kc, d), rev(vc, d), rev(i_c, d), rev(f_c, d), state0)
        _, hx = mlstm_chunked(rev(q, d), rev(k, d), rev(v, d), rev(i_x, d), rev(f_x, d), state_c)
        h_lat = h_lat + rev(hx, d)
        h_ctx = h_ctx + rev(hc, d)
    return h_lat, h_ctx


def mlstm_out(h, o, m_norm_g):
    B, NH, S, DV = h.shape
    h = h * lax.rsqrt(jnp.mean(h * h, axis=-1, keepdims=True) + EPS)
    h = jnp.moveaxis(h, 1, 2).reshape(B, S, NH * DV) * m_norm_g.astype(jnp.float32)
    return (h * jax.nn.sigmoid(o.astype(jnp.float32))).astype(o.dtype)


def token_mixer(hx, hc, w_in, b_gates, q_norm_g, w_uq, kv_norm_g, w_ukv, m_norm_g, w_out, cos, sin, want_ctx):
    B, S = hx.shape[:2]
    px = split_cols(hx @ w_in, IN_SPLITS)
    pc = split_cols(hc @ w_in, IN_SPLITS)
    qn, qr = mla_q(px[0], q_norm_g, w_uq, cos, sin)
    kn, kr, v = mla_kv(px[1], px[2], kv_norm_g, w_ukv, cos, sin)
    kn_c, kr_c, v_c = mla_kv(pc[1], pc[2], kv_norm_g, w_ukv, None, None)
    attn_x = blocked_attention(qn, qr, jnp.concatenate([kn_c, kn], axis=1),
                               jnp.concatenate([kr_c, kr], axis=1), jnp.concatenate([v_c, v], axis=1))
    lat = mlstm_heads(px[3], px[4], px[5], px[7], b_gates)
    ctxh = mlstm_heads(pc[3], pc[4], pc[5], pc[7], b_gates)
    h_lat, h_ctx = mlstm_bidirectional(lat, ctxh)
    out_x = jnp.concatenate([attn_x, mlstm_out(h_lat, px[6], m_norm_g)], axis=-1) @ w_out
    out_c = None
    if want_ctx:
        qn_c, qr_c = mla_q(pc[0], q_norm_g, w_uq, None, None)
        attn_c = attend(qn_c, qr_c, kn_c, kr_c, v_c).reshape(B, hc.shape[1], MLA_WIDTH)
        out_c = jnp.concatenate([attn_c, mlstm_out(h_ctx, pc[6], m_norm_g)], axis=-1) @ w_out
    return out_x, out_c


def routed_ffn(h, router_w, router_b, w_gu, b_gu, w_down, b_down):
    shp = h.shape
    t = h.reshape(-1, shp[-1])
    T = t.shape[0]
    TK = T * TOP_K
    logits = (t @ router_w + router_b).astype(jnp.float32)
    top_logit, top_idx = lax.top_k(logits, TOP_K)
    gates = jax.nn.softmax(top_logit, axis=-1)
    flat_e = top_idx.reshape(-1)
    order = jnp.argsort(flat_e)
    sorted_e = flat_e[order]
    counts = jnp.bincount(flat_e, length=N_EXPERTS)
    padded = (counts + MOE_BLOCK - 1) // MOE_BLOCK * MOE_BLOCK
    pad_end = jnp.cumsum(padded)
    rank = jnp.arange(TK) - (jnp.cumsum(counts) - counts)[sorted_e]
    dest = ((pad_end - padded)[sorted_e] + rank).astype(jnp.int32)
    n_blocks = -(-TK // MOE_BLOCK) + N_EXPERTS
    rows_tok = jnp.zeros(n_blocks * MOE_BLOCK, jnp.int32).at[dest].set((order // TOP_K).astype(jnp.int32))
    block_e = jnp.minimum(jnp.searchsorted(pad_end, jnp.arange(n_blocks) * MOE_BLOCK, side='right'), N_EXPERTS - 1)
    x_blocks = t[rows_tok].reshape(n_blocks, MOE_BLOCK, shp[-1])

    def expert_block(args):
        xb, e = args
        gu = xb @ w_gu[e] + b_gu[e]
        glu = jnp.minimum(gu[:, :D_FF], SWIGLU_LIMIT)
        lin = jnp.clip(gu[:, D_FF:], -SWIGLU_LIMIT, SWIGLU_LIMIT)
        return (glu * jax.nn.sigmoid(SWIGLU_ALPHA * glu) * (lin + 1)) @ w_down[e] + b_down[e]

    y_rows = lax.map(expert_block, (x_blocks, block_e)).reshape(n_blocks * MOE_BLOCK, shp[-1])
    slot = jnp.zeros(TK, jnp.int32).at[order].set(dest)
    y = jnp.einsum('tkd,tk->td', y_rows[slot].reshape(T, TOP_K, shp[-1]), gates.astype(h.dtype))
    return y.reshape(shp)


def setup_inputs(seed: int = 0) -> dict:
    key = jax.random.key(seed)
    ks = jax.random.split(key, 24)
    L, D = DEPTH, D_MODEL
    nrm = lambda k, shape, scale: jax.random.normal(k, shape, jnp.float32) * scale
    gain = lambda k, shape: 1.0 + nrm(k, shape, 0.05)
    b_gates = (nrm(ks[9], (L, 4, M_HEADS), 0.3) + jnp.array([0.0, 3.0, 0.0, 3.0], jnp.float32)[None, :, None]).reshape(L, 4 * M_HEADS)
    return {
        "x": nrm(ks[0], (BATCH, SEQ, D), 1.0),
        "c": nrm(ks[1], (BATCH, D), 1.0),
        "ctx": nrm(ks[2], (BATCH, CTX_LEN, D), 1.0),
        "c_ctx": nrm(ks[3], (D,), 1.0),
        "w_mod": nrm(ks[4], (L, D, 6 * D), D ** -0.5),
        "b_mod": nrm(ks[5], (L, 6 * D), 0.01),
        "norm1_g": gain(ks[6], (L, D)),
        "w_in": nrm(ks[7], (L, D, IN_WIDTH), D ** -0.5),
        "b_gates": b_gates,
        "q_norm_g": gain(ks[8], (L, Q_LORA)),
        "w_uq": nrm(ks[10], (L, Q_LORA, MLA_HEADS * (QK_NOPE + QK_ROPE)), Q_LORA ** -0.5),
        "kv_norm_g": gain(ks[11], (L, KV_LORA)),
        "w_ukv": nrm(ks[12], (L, KV_LORA, MLA_HEADS * (QK_NOPE + V_HEAD)), KV_LORA ** -0.5),
        "m_norm_g": gain(ks[13], (L, MLSTM_WIDTH)),
        "w_out": nrm(ks[14], (L, MIX_WIDTH, D), MIX_WIDTH ** -0.5),
        "norm2_g": gain(ks[15], (L, D)),
        "router_w": nrm(ks[16], (L, D, N_EXPERTS), D ** -0.5),
        "router_b": nrm(ks[17], (L, N_EXPERTS), 0.01),
        "w_gu": nrm(ks[18], (L, N_EXPERTS, D, 2 * D_FF), D ** -0.5),
        "b_gu": nrm(ks[19], (L, N_EXPERTS, 2 * D_FF), 0.01),
        "w_down": nrm(ks[20], (L, N_EXPERTS, D_FF, D), D_FF ** -0.5),
        "b_down": nrm(ks[21], (L, N_EXPERTS, D), 0.01),
        "final_norm_g": gain(ks[22], (D,)),
    }


def reference(x, c, ctx, c_ctx, w_mod, b_mod, norm1_g, w_in, b_gates, q_norm_g, w_uq, kv_norm_g, w_ukv,
              m_norm_g, w_out, norm2_g, router_w, router_b, w_gu, b_gu, w_down, b_down, final_norm_g):
    cos, sin = rope_tables(x.shape[1])
    for l in range(DEPTH):
        want_ctx = l < DEPTH - 1
        mod_x = (jax.nn.silu(c) @ w_mod[l] + b_mod[l])[:, None, :]
        mod_c = (jax.nn.silu(c_ctx) @ w_mod[l] + b_mod[l])[None, None, :]
        sh1, sc1, g1, sh2, sc2, g2 = jnp.split(mod_x, 6, axis=-1)
        csh1, csc1, cg1, csh2, csc2, cg2 = jnp.split(mod_c, 6, axis=-1)
        hx = modulate(rms_norm(x, norm1_g[l]), sh1, sc1)
        hc = modulate(rms_norm(ctx, norm1_g[l]), csh1, csc1)
        mix_x, mix_c = token_mixer(hx, hc, w_in[l], b_gates[l], q_norm_g[l], w_uq[l], kv_norm_g[l], w_ukv[l],
                                   m_norm_g[l], w_out[l], cos, sin, want_ctx)
        x = x + g1 * mix_x
        x = x + g2 * routed_ffn(modulate(rms_norm(x, norm2_g[l]), sh2, sc2),
                                router_w[l], router_b[l], w_gu[l], b_gu[l], w_down[l], b_down[l])
        if want_ctx:
            ctx = ctx + cg1 * mix_c
            ctx = ctx + cg2 * routed_ffn(modulate(rms_norm(ctx, norm2_g[l]), csh2, csc2),
                                         router_w[l], router_b[l], w_gu[l], b_gu[l], w_down[l], b_down[l])
    return rms_norm(x, final_norm_g)
```

```cpp
#include <hip/hip_runtime.h>
#include <cstdio>
#include <cstdint>

#define LAS __attribute__((address_space(3)))

#define XB_TMO      128
#define XB_XCNT(j)  (256  + 64 * (j))
#define XB_XSUB(j)  (1280 + 64 * (j))
#define XB_XGEN(j)  (2304 + 64 * (j))
#define XB_TOP      3328
#define XB_TOPGEN   3392
#define XCD_BAR_WORDS 3456
#define XB_SPIN_CAP (1u << 22)

__device__ __forceinline__ unsigned xb_ld(unsigned* p)              { return __hip_atomic_load(p, __ATOMIC_RELAXED, __HIP_MEMORY_SCOPE_AGENT); }
__device__ __forceinline__ unsigned xb_add(unsigned* p, unsigned v) { return __hip_atomic_fetch_add(p, v, __ATOMIC_RELAXED, __HIP_MEMORY_SCOPE_AGENT); }
__device__ __forceinline__ unsigned xb_xcc_id() { return (unsigned)__builtin_amdgcn_s_getreg((3 << 11) | 20) & 0xFu; }
#define XB_SPIN(cond, bar) do { unsigned _sp = 0; while (cond) { __builtin_amdgcn_s_sleep(1); \
    if ((++_sp & 255u) == 0u) { if (xb_ld(&(bar)[XB_TMO])) break; if (_sp > XB_SPIN_CAP) { atomicAdd(&(bar)[XB_TMO], 1u); break; } } } } while (0)

struct XcdBarrier { unsigned* bar; unsigned x; volatile LAS unsigned* st; };

__device__ __forceinline__ XcdBarrier xcd_barrier_post(unsigned* bar, volatile LAS unsigned* st) {
    XcdBarrier b; b.bar = bar; b.x = xb_xcc_id(); b.st = st;
    if (threadIdx.x == 0) (void)xb_add(&bar[XB_XCNT(b.x)], 1u);
    return b;
}
__device__ __forceinline__ void xcd_barrier_complete(unsigned* bar, unsigned x, unsigned& nloc, unsigned& nx) {
    const unsigned G = gridDim.x * gridDim.y * gridDim.z;
    unsigned sum, cnt, mine, sp = 0u;
    for (;;) {
        sum = 0u; cnt = 0u; mine = 0u;
#pragma unroll
        for (unsigned j = 0; j < 16; ++j) { const unsigned c = xb_ld(&bar[XB_XCNT(j)]); sum += c; cnt += (c > 0u) ? 1u : 0u; mine = (j == x) ? c : mine; }
        if (sum == G) break;
        __builtin_amdgcn_s_sleep(1);
        if ((++sp & 255u) == 0u) { if (xb_ld(&bar[XB_TMO])) break; if (sp > XB_SPIN_CAP) { atomicAdd(&bar[XB_TMO], 1u); break; } }
    }
    nloc = mine > 0u ? mine : 1u; nx = cnt > 0u ? cnt : 1u;
}
__device__ __forceinline__ void xcd_barrier(const XcdBarrier& b) {
    asm volatile("s_waitcnt vmcnt(0)" ::: "memory");
    __syncthreads();
    if (threadIdx.x == 0) {
        unsigned* bar = b.bar;
        __builtin_amdgcn_s_waitcnt(0);
        unsigned nloc = b.st[0], nx = b.st[1];
        if (nloc == 0u) { xcd_barrier_complete(bar, b.x, nloc, nx); b.st[0] = nloc; b.st[1] = nx; }
        const unsigned old = xb_add(&bar[XB_XSUB(b.x)], 1u);
        const unsigned gen = old / nloc;
        if (old + 1u == (gen + 1u) * nloc) {
            __builtin_amdgcn_fence(__ATOMIC_RELEASE, "agent");
            asm volatile("s_waitcnt vmcnt(0)" ::: "memory");
            const unsigned og = xb_add(&bar[XB_TOP], 1u);
            const unsigned tg = og / nx;
            if (og + 1u == (tg + 1u) * nx) xb_add(&bar[XB_TOPGEN], 1u);
            else XB_SPIN(xb_ld(&bar[XB_TOPGEN]) == tg, bar);
            __builtin_amdgcn_fence(__ATOMIC_ACQUIRE, "agent");
            xb_add(&bar[XB_XGEN(b.x)], 1u);
            asm volatile("s_waitcnt vmcnt(0)" ::: "memory");
        } else {
            XB_SPIN(xb_ld(&bar[XB_XGEN(b.x)]) == gen, bar);
            __builtin_amdgcn_fence(__ATOMIC_ACQUIRE, "agent");
            asm volatile("s_waitcnt vmcnt(0)" ::: "memory");
        }
    }
    __syncthreads();
}

constexpr int D = 1024, NB = 4, S = 4096, CTX = 256, SKV = S + CTX;
constexpr int MX = NB * S, MC = NB * CTX, MT = MX + MC;
constexpr int INW = 2224;
constexpr int O_CQ = 0, O_CKV = 384, O_KR = 640, O_MQ = 672, O_MK = 928, O_MV = 1184, O_MO = 1696, O_G = 2208;
constexpr int QL = 384, KVL = 256, HA = 8, DN = 64, DR = 32, DQK = 96, DVH = 64;
constexpr int NH = 4, MDQK = 64, MDV = 128;
constexpr int NE = 32, TOPK = 4, DFF = 1024;
constexpr float EPS = 1e-6f;
constexpr int NT = 512;
constexpr int NSEQ = NB * NH * 2;
constexpr int RCAP = MX * TOPK + NE * 128;

constexpr size_t MiB = 1u << 20;
constexpr size_t WS_CTL = 0, CTL_BYTES = 1 * MiB;
constexpr size_t WS_MOD = 1 * MiB;
constexpr size_t WS_FA = 2 * MiB;
constexpr size_t WS_KR = 5 * MiB;
constexpr size_t WS_TOPE = 8 * MiB;
constexpr size_t WS_TOPG = 9 * MiB;
constexpr size_t WS_SLOT = 10 * MiB;
constexpr size_t WS_LIST = 11 * MiB;
constexpr size_t WS_H = 16 * MiB;
constexpr size_t WS_P = WS_H + (size_t)MT * D * 4;
constexpr size_t WS_Q = WS_P + (size_t)MT * INW * 4;
constexpr size_t WS_KV = WS_Q + (size_t)MX * 768 * 4;
constexpr size_t WS_HM = WS_KV + (size_t)MT * 1024 * 4;
constexpr size_t WS_MIX = WS_HM + (size_t)2 * MX * 512 * 4;
constexpr size_t WS_X1 = WS_MIX + (size_t)MX * D * 4;
constexpr size_t WS_H2 = WS_X1 + (size_t)MX * D * 4;
constexpr size_t WS_YG = WS_H2 + (size_t)MX * D * 4;
constexpr size_t WS_ACT = WS_H;
constexpr size_t WS_END = WS_YG + (size_t)RCAP * D * 4;
static_assert(WS_ACT + (size_t)RCAP * DFF * 4 <= WS_HM, "ACT overlay");

constexpr int CW_BAR = 4096;
constexpr int CW_CNT = 16384;

struct Params {
    const float* in[23];
    float* out;
    unsigned char* ws;
    int ph_lo, ph_hi;
};
enum { I_X = 0, I_C, I_CTX, I_CCTX, I_WMOD, I_BMOD, I_N1G, I_WIN, I_BG, I_QNG, I_WUQ, I_KVNG, I_WUKV, I_MNG, I_WOUT, I_N2G, I_RW, I_RB, I_WGU, I_BGU, I_WDN, I_BDN, I_FNG };

__device__ __forceinline__ float wave_sum(float v) {
#pragma unroll
    for (int o = 1; o < 64; o <<= 1) v += __shfl_xor(v, o);
    return v;
}
__device__ __forceinline__ float sigmoidf_(float x) { return 1.f / (1.f + __expf(-x)); }
__device__ __forceinline__ float siluf_(float x) { return x / (1.f + expf(-x)); }
__device__ __forceinline__ float logsigmoidf_(float x) { return fminf(x, 0.f) - log1pf(expf(-fabsf(x))); }

__device__ __forceinline__ int krow(int b, int key) { return key < CTX ? MX + b * CTX + key : b * S + (key - CTX); }
__device__ __forceinline__ int srow(int b, int dir, int u) {
    if (u < CTX) { const int c = dir ? (CTX - 1 - u) : u; return MX + b * CTX + c; }
    const int tt = u - CTX; const int s = dir ? (S - 1 - tt) : tt; return b * S + s;
}
__device__ __forceinline__ void rope_angles(int s, int j, float& cs, float& sn) {
    const int jj = j & 7; const float pos = (j < 8) ? (float)(s / 64) : (float)(s % 64);
    const float inv = powf(10000.f, -(float)jj / 8.f);
    const float ang = pos * inv; cs = cosf(ang); sn = sinf(ang);
}

struct GemmDesc { const float* A; int lda; const int* arow; int M; const float* B; int ldb; int N; int K; };
template <class Epi>
__device__ __forceinline__ void sgemm_tile(float* lds, const GemmDesc g, int tm, int tn, const Epi& epi) {
    float* As = lds;
    float* Bs = lds + 16 * 132;
    const int tid = threadIdx.x, tx = tid & 15, ty = tid >> 4;
    float acc[4][8];
#pragma unroll
    for (int i = 0; i < 4; ++i)
#pragma unroll
        for (int j = 0; j < 8; ++j) acc[i][j] = 0.f;
    const int ar = tid >> 2, ak = (tid & 3) * 4;
    const int grow = tm * 128 + ar;
    const float* aptr = nullptr;
    if (grow < g.M) { const int r = g.arow ? g.arow[grow] : grow; aptr = g.A + (size_t)r * g.lda + ak; }
    const int bk = tid >> 5, bc = (tid & 31) * 4;
    const int gcol = tn * 128 + bc;
    for (int k0 = 0; k0 < g.K; k0 += 16) {
        float4 av = make_float4(0.f, 0.f, 0.f, 0.f), bv = make_float4(0.f, 0.f, 0.f, 0.f);
        if (aptr) av = *(const float4*)(aptr + k0);
        if (gcol < g.N) bv = *(const float4*)(g.B + (size_t)(k0 + bk) * g.ldb + gcol);
        __syncthreads();
        As[(ak + 0) * 132 + ar] = av.x; As[(ak + 1) * 132 + ar] = av.y; As[(ak + 2) * 132 + ar] = av.z; As[(ak + 3) * 132 + ar] = av.w;
        *(float4*)(Bs + bk * 128 + bc) = bv;
        __syncthreads();
#pragma unroll
        for (int k = 0; k < 16; ++k) {
            const float4 a4 = *(const float4*)(As + k * 132 + ty * 4);
            const float4 b0 = *(const float4*)(Bs + k * 128 + tx * 8), b1 = *(const float4*)(Bs + k * 128 + tx * 8 + 4);
            const float a[4] = {a4.x, a4.y, a4.z, a4.w};
            const float b[8] = {b0.x, b0.y, b0.z, b0.w, b1.x, b1.y, b1.z, b1.w};
#pragma unroll
            for (int i = 0; i < 4; ++i)
#pragma unroll
                for (int j = 0; j < 8; ++j) acc[i][j] = fmaf(a[i], b[j], acc[i][j]);
        }
    }
#pragma unroll
    for (int i = 0; i < 4; ++i) {
        const int r = tm * 128 + ty * 4 + i;
        if (r < g.M) {
#pragma unroll
            for (int j = 0; j < 8; ++j) { const int c = tn * 128 + tx * 8 + j; if (c < g.N) epi(r, c, acc[i][j]); }
        }
    }
}
template <class Epi>
__device__ __forceinline__ void sgemm_phase(float* lds, const GemmDesc g, const Epi& epi, int u0 = 0, int ustride = 0) {
    const int ntm = (g.M + 127) / 128, ntn = (g.N + 127) / 128;
    for (int u = blockIdx.x; u < ntm * ntn; u += gridDim.x) sgemm_tile(lds, g, u / ntn, u % ntn, epi);
}

constexpr int LDS_BYTES = 147456;
constexpr int N_PHASES = 12;

__global__ void __launch_bounds__(NT, 2) fwd_kernel(Params p) {
    extern __shared__ __attribute__((aligned(16))) unsigned char lds_raw[];
    float* lds = (float*)lds_raw;
    LAS unsigned* misc = (LAS unsigned*)(lds_raw + 131072 + 4096);
    const int tid = threadIdx.x, lane = tid & 63, wave = tid >> 6;
    const int bid = blockIdx.x, G = gridDim.x;
    unsigned char* ws = p.ws;
    unsigned* ctl = (unsigned*)(ws + WS_CTL);
    if (tid < 4) misc[tid] = 0u;
    __syncthreads();
    const bool single = (p.ph_hi - p.ph_lo) > 1;
    XcdBarrier bar; bar.bar = ctl + CW_BAR; bar.x = 0; bar.st = nullptr;
    if (single) bar = xcd_barrier_post(ctl + CW_BAR, (volatile LAS unsigned*)misc);
#ifndef PH_MASK
#define PH_MASK 0xFFFF
#endif
#define IN(k) ((((PH_MASK) >> (k)) & 1) && p.ph_lo <= (k) && (k) < p.ph_hi)
#define SEAM(k) do { if (IN(k) && IN((k) + 1)) xcd_barrier(bar); } while (0)

    float* MOD = (float*)(ws + WS_MOD);
    float* Fb = (float*)(ws + WS_FA); float* Ab = Fb + NSEQ * SKV;
    float* KR = (float*)(ws + WS_KR);
    int* TOPE = (int*)(ws + WS_TOPE); float* TOPG = (float*)(ws + WS_TOPG); int* SLOT = (int*)(ws + WS_SLOT); int* LIST = (int*)(ws + WS_LIST);
    float* Hb = (float*)(ws + WS_H); float* Pb = (float*)(ws + WS_P); float* Qb = (float*)(ws + WS_Q); float* KVb = (float*)(ws + WS_KV);
    float* HM = (float*)(ws + WS_HM); float* MIX = (float*)(ws + WS_MIX); float* X1 = (float*)(ws + WS_X1); float* H2 = (float*)(ws + WS_H2);
    float* YG = (float*)(ws + WS_YG); float* ACT = (float*)(ws + WS_ACT);
    unsigned* CNT = ctl + CW_CNT;

    if (IN(0)) {
        const float* wmod = p.in[I_WMOD]; const float* bmod = p.in[I_BMOD];
        for (int idx = bid * NT + tid; idx < 5 * 6144; idx += G * NT) {
            const int r = idx / 6144, col = idx % 6144;
            const float* cv = (r < 4) ? p.in[I_C] + r * D : p.in[I_CCTX];
            float acc = 0.f;
            for (int k = 0; k < D; ++k) acc = fmaf(siluf_(cv[k]), wmod[(size_t)k * 6144 + col], acc);
            MOD[idx] = acc + bmod[col];
        }
    }
    SEAM(0);
    if (IN(1)) {
        const float* g1n = p.in[I_N1G];
        for (int r = bid * 8 + wave; r < MT; r += G * 8) {
            const float* src = (r < MX) ? p.in[I_X] + (size_t)r * D : p.in[I_CTX] + (size_t)(r - MX) * D;
            const int mb = (r < MX) ? r / S : 4;
            const float* sh = MOD + mb * 6144, *sc = sh + D;
            float v[16]; float ss = 0.f;
#pragma unroll
            for (int j = 0; j < 4; ++j) { const float4 t = *(const float4*)(src + j * 256 + lane * 4); v[4 * j] = t.x; v[4 * j + 1] = t.y; v[4 * j + 2] = t.z; v[4 * j + 3] = t.w; ss += t.x * t.x + t.y * t.y + t.z * t.z + t.w * t.w; }
            const float rstd = rsqrtf(wave_sum(ss) * (1.f / D) + EPS);
#pragma unroll
            for (int j = 0; j < 4; ++j) {
                const int c = j * 256 + lane * 4; float4 o;
                o.x = v[4 * j] * rstd * g1n[c] * (1.f + sc[c]) + sh[c];
                o.y = v[4 * j + 1] * rstd * g1n[c + 1] * (1.f + sc[c + 1]) + sh[c + 1];
                o.z = v[4 * j + 2] * rstd * g1n[c + 2] * (1.f + sc[c + 2]) + sh[c + 2];
                o.w = v[4 * j + 3] * rstd * g1n[c + 3] * (1.f + sc[c + 3]) + sh[c + 3];
                *(float4*)(Hb + (size_t)r * D + c) = o;
            }
        }
    }
    SEAM(1);
    if (IN(2)) {
        GemmDesc g{Hb, D, nullptr, MT, p.in[I_WIN], INW, INW, D};
        sgemm_phase(lds, g, [=](int r, int c, float v) { Pb[(size_t)r * INW + c] = v; });
    }
    SEAM(2);
    if (IN(3)) {
        const float* qg = p.in[I_QNG]; const float* kvg = p.in[I_KVNG];
        for (int r = bid * 8 + wave; r < MT; r += G * 8) {
            float* pr = Pb + (size_t)r * INW;
            {
                float v[6]; float ss = 0.f;
#pragma unroll
                for (int j = 0; j < 6; ++j) { v[j] = pr[O_CQ + j * 64 + lane]; ss += v[j] * v[j]; }
                const float rstd = rsqrtf(wave_sum(ss) * (1.f / QL) + EPS);
#pragma unroll
                for (int j = 0; j < 6; ++j) pr[O_CQ + j * 64 + lane] = v[j] * rstd * qg[j * 64 + lane];
            }
            {
                float v[4]; float ss = 0.f;
#pragma unroll
                for (int j = 0; j < 4; ++j) { v[j] = pr[O_CKV + j * 64 + lane]; ss += v[j] * v[j]; }
                const float rstd = rsqrtf(wave_sum(ss) * (1.f / KVL) + EPS);
#pragma unroll
                for (int j = 0; j < 4; ++j) pr[O_CKV + j * 64 + lane] = v[j] * rstd * kvg[j * 64 + lane];
            }
            {
                int b, key; if (r < MX) { b = r / S; key = CTX + (r % S); } else { b = (r - MX) / CTX; key = (r - MX) % CTX; }
                float* dst = KR + (size_t)(b * SKV + key) * DR;
                if (lane < 16) {
                    const float x1 = pr[O_KR + lane], x2 = pr[O_KR + 16 + lane];
                    if (r < MX) { float cs, sn; rope_angles(r % S, lane, cs, sn); dst[lane] = x1 * cs - x2 * sn; dst[16 + lane] = x1 * sn + x2 * cs; }
                    else { dst[lane] = x1; dst[16 + lane] = x2; }
                }
            }
        }
        const float* bg = p.in[I_BG];
        for (int sq = bid * 8 + wave; sq < NSEQ; sq += G * 8) {
            const int dir = sq & 1, h = (sq >> 1) & 3, b = sq >> 3;
            const float bi = bg[(2 * dir) * 4 + h], bf = bg[(2 * dir + 1) * 4 + h];
            float carry = 0.f;
            for (int u0 = 0; u0 < SKV; u0 += 64) {
                const int u = u0 + lane; const int r = srow(b, dir, u);
                const float li = Pb[(size_t)r * INW + O_G + (2 * dir) * 4 + h] + bi;
                const float f = Pb[(size_t)r * INW + O_G + (2 * dir + 1) * 4 + h] + bf;
                float x = logsigmoidf_(f);
#pragma unroll
                for (int o = 1; o < 64; o <<= 1) { const float y = __shfl_up(x, o); if (lane >= o) x += y; }
                const float F = carry + x;
                Fb[sq * SKV + u] = F; Ab[sq * SKV + u] = li - F;
                carry = __shfl(F, 63);
            }
        }
    }
    SEAM(3);
    if (IN(4)) {
        { GemmDesc g{Pb + O_CQ, INW, nullptr, MX, p.in[I_WUQ], 768, 768, QL};
          sgemm_phase(lds, g, [=](int r, int c, float v) { Qb[(size_t)r * 768 + c] = v; }); }
        { GemmDesc g{Pb + O_CKV, INW, nullptr, MT, p.in[I_WUKV], 1024, 1024, KVL};
          sgemm_phase(lds, g, [=](int r, int c, float v) { KVb[(size_t)r * 1024 + c] = v; }); }
    }
    SEAM(4);
    if (IN(5)) {
#ifndef NO_ATT
        {
            float* Ks = lds;
            float* Vs = lds + 64 * 96;
            float* CS = Vs + 64 * 64;
            const float scale = 0.10206207261596577f;
            for (int u = bid; u < NB * HA * (S / 256); u += G) {
                const int qb = u % (S / 256), h = (u / (S / 256)) % HA, b = u / ((S / 256) * HA);
                const int half = tid & 1;
                const int s = qb * 256 + (tid >> 1); const int r = b * S + s;
                __syncthreads();
                for (int e = tid; e < 256 * 16; e += NT) { float cs, sn; rope_angles(qb * 256 + e / 16, e % 16, cs, sn); CS[e] = cs; CS[256 * 16 + e] = sn; }
                __syncthreads();
                float q[96], o[32];
#pragma unroll
                for (int d = 0; d < 96; d += 4) { const float4 t = *(const float4*)(Qb + (size_t)r * 768 + h * 96 + d); q[d] = t.x; q[d + 1] = t.y; q[d + 2] = t.z; q[d + 3] = t.w; }
#pragma unroll
                for (int j = 0; j < 16; ++j) { const float cs = CS[(tid >> 1) * 16 + j], sn = CS[256 * 16 + (tid >> 1) * 16 + j]; const float x1 = q[64 + j], x2 = q[80 + j]; q[64 + j] = x1 * cs - x2 * sn; q[80 + j] = x1 * sn + x2 * cs; }
#pragma unroll
                for (int d = 0; d < 96; ++d) q[d] *= scale;
#pragma unroll
                for (int d = 0; d < 32; ++d) o[d] = 0.f;
                float m = -1e30f, l = 0.f;
                for (int kt = 0; kt < SKV / 64; ++kt) {
                    __syncthreads();
                    for (int e = tid; e < 64 * 96; e += NT) { const int kk = e / 96, d = e % 96; const int key = kt * 64 + kk; const int rr = krow(b, key);
                        Ks[e] = (d < 64) ? KVb[(size_t)rr * 1024 + h * 128 + d] : KR[(size_t)(b * SKV + key) * DR + (d - 64)]; }
                    for (int e = tid; e < 64 * 64; e += NT) { const int kk = e / 64, d = e % 64; const int rr = krow(b, kt * 64 + kk); Vs[e] = KVb[(size_t)rr * 1024 + h * 128 + 64 + d]; }
                    __syncthreads();
#pragma unroll 1
                    for (int k0 = 0; k0 < 64; k0 += 4) {
                        float sc[4]; float mx = m;
#pragma unroll
                        for (int i = 0; i < 4; ++i) { float a = 0.f; const float* kp = Ks + (k0 + i) * 96;
#pragma unroll
                            for (int d = 0; d < 96; d += 4) { const float4 t = *(const float4*)(kp + d); a = fmaf(q[d], t.x, a); a = fmaf(q[d + 1], t.y, a); a = fmaf(q[d + 2], t.z, a); a = fmaf(q[d + 3], t.w, a); }
                            sc[i] = a; mx = fmaxf(mx, a); }
                        const float alpha = __expf(m - mx); m = mx; l *= alpha;
#pragma unroll
                        for (int d = 0; d < 32; ++d) o[d] *= alpha;
#pragma unroll
                        for (int i = 0; i < 4; ++i) { const float pw = __expf(sc[i] - m); l += pw; const float* vp = Vs + (k0 + i) * 64 + half * 32;
#pragma unroll
                            for (int d = 0; d < 32; d += 4) { const float4 t = *(const float4*)(vp + d); o[d] = fmaf(pw, t.x, o[d]); o[d + 1] = fmaf(pw, t.y, o[d + 1]); o[d + 2] = fmaf(pw, t.z, o[d + 2]); o[d + 3] = fmaf(pw, t.w, o[d + 3]); } }
                    }
                }
                const float il = 1.f / l;
#pragma unroll
                for (int d = 0; d < 32; d += 4) *(float4*)(MIX + (size_t)r * D + h * 64 + half * 32 + d) = make_float4(o[d] * il, o[d + 1] * il, o[d + 2] * il, o[d + 3] * il);
            }
        }
#endif
#ifndef NO_ML
        {
            float* Ks = lds;
            float* Vs = lds + 64 * 64;
            float* As2 = Vs + 64 * 128;
            for (int u = bid; u < NSEQ * (S / 128); u += G) {
                const int tb = u % (S / 128), sq = u / (S / 128); const int dir = sq & 1, h = (sq >> 1) & 3, b = sq >> 3;
                const int tl = tid >> 2, qr = tid & 3; const int tt = tb * 128 + tl; const int ut = CTX + tt;
                const int rt = srow(b, dir, ut);
                float q[64], num[32];
#pragma unroll
                for (int d = 0; d < 64; d += 4) { const float4 t = *(const float4*)(Pb + (size_t)rt * INW + O_MQ + h * 64 + d); q[d] = t.x * 0.125f; q[d + 1] = t.y * 0.125f; q[d + 2] = t.z * 0.125f; q[d + 3] = t.w * 0.125f; }
#pragma unroll
                for (int d = 0; d < 32; ++d) num[d] = 0.f;
                const float Ft = Fb[sq * SKV + ut];
                float den = 0.f, M = -1e30f;
                const int umax = CTX + tb * 128 + 127;
                for (int s0 = 0; s0 <= umax; s0 += 64) {
                    __syncthreads();
#pragma unroll 1
                    for (int e = tid; e < 64 * 64; e += NT) { const int kk = e / 64, d = e % 64; const int rr = srow(b, dir, s0 + kk); Ks[e] = Pb[(size_t)rr * INW + O_MK + h * 64 + d]; }
#pragma unroll 1
                    for (int e = tid; e < 64 * 128; e += NT) { const int kk = e / 128, d = e % 128; const int rr = srow(b, dir, s0 + kk); Vs[e] = Pb[(size_t)rr * INW + O_MV + h * 128 + d]; }
                    if (tid < 64) As2[tid] = Ab[sq * SKV + s0 + tid];
                    __syncthreads();
                    const int kend = min(64, ut - s0 + 1);
#pragma unroll 1
                    for (int k0 = 0; k0 < kend; ++k0) {
                        const float lw = Ft + As2[k0];
                        float a = 0.f; const float* kp = Ks + k0 * 64;
#pragma unroll
                        for (int d = 0; d < 64; d += 4) { const float4 t = *(const float4*)(kp + d); a = fmaf(q[d], t.x, a); a = fmaf(q[d + 1], t.y, a); a = fmaf(q[d + 2], t.z, a); a = fmaf(q[d + 3], t.w, a); }
                        const float mx = fmaxf(M, lw);
                        const float alpha = __expf(M - mx); M = mx;
                        const float w = __expf(lw - mx) * a;
                        den = den * alpha + w;
                        const float* vp = Vs + k0 * 128 + qr * 32;
#pragma unroll
                        for (int d = 0; d < 32; d += 4) { const float4 t = *(const float4*)(vp + d); num[d] = fmaf(w, t.x, num[d] * alpha); num[d + 1] = fmaf(w, t.y, num[d + 1] * alpha); num[d + 2] = fmaf(w, t.z, num[d + 2] * alpha); num[d + 3] = fmaf(w, t.w, num[d + 3] * alpha); }
                    }
                }
                const float dn = 1.f / fmaxf(fabsf(den), __expf(-M));
                const int so = dir ? (S - 1 - tt) : tt;
                float* dst = HM + ((size_t)dir * MX + (size_t)b * S + so) * 512 + h * 128 + qr * 32;
#pragma unroll
                for (int d = 0; d < 32; d += 4) *(float4*)(dst + d) = make_float4(num[d] * dn, num[d + 1] * dn, num[d + 2] * dn, num[d + 3] * dn);
            }
        }
#endif
    }
    SEAM(5);
    if (IN(6)) {
        const float* mng = p.in[I_MNG];
        for (int it = bid * 8 + wave; it < MX * NH; it += G * 8) {
            const int r = it >> 2, h = it & 3;
            const float* h0 = HM + (size_t)r * 512 + h * 128; const float* h1 = HM + ((size_t)MX + r) * 512 + h * 128;
            const float a0 = h0[lane] + h1[lane], a1 = h0[64 + lane] + h1[64 + lane];
            const float rstd = rsqrtf(wave_sum(a0 * a0 + a1 * a1) * (1.f / 128.f) + EPS);
            const float* orow = Pb + (size_t)r * INW + O_MO + h * 128;
            MIX[(size_t)r * D + 512 + h * 128 + lane] = a0 * rstd * mng[h * 128 + lane] * sigmoidf_(orow[lane]);
            MIX[(size_t)r * D + 512 + h * 128 + 64 + lane] = a1 * rstd * mng[h * 128 + 64 + lane] * sigmoidf_(orow[64 + lane]);
        }
    }
    SEAM(6);
    if (IN(7)) {
        const float* xin = p.in[I_X];
        GemmDesc g{MIX, D, nullptr, MX, p.in[I_WOUT], D, D, D};
        sgemm_phase(lds, g, [=](int r, int c, float v) { const float g1 = MOD[(r / S) * 6144 + 2 * D + c]; X1[(size_t)r * D + c] = xin[(size_t)r * D + c] + g1 * v; });
    }
    SEAM(7);
    if (IN(8)) {
        const float* g2n = p.in[I_N2G]; const float* rw = p.in[I_RW]; const float* rb = p.in[I_RB];
        for (int r = bid * 8 + wave; r < MX; r += G * 8) {
            const float* src = X1 + (size_t)r * D; const int mb = r / S;
            const float* sh = MOD + mb * 6144 + 3 * D, *sc = MOD + mb * 6144 + 4 * D;
            float v[16]; float ss = 0.f;
#pragma unroll
            for (int j = 0; j < 4; ++j) { const float4 t = *(const float4*)(src + j * 256 + lane * 4); v[4 * j] = t.x; v[4 * j + 1] = t.y; v[4 * j + 2] = t.z; v[4 * j + 3] = t.w; ss += t.x * t.x + t.y * t.y + t.z * t.z + t.w * t.w; }
            const float rstd = rsqrtf(wave_sum(ss) * (1.f / D) + EPS);
#pragma unroll
            for (int j = 0; j < 4; ++j) {
#pragma unroll
                for (int i = 0; i < 4; ++i) { const int c = j * 256 + lane * 4 + i; v[4 * j + i] = v[4 * j + i] * rstd * g2n[c] * (1.f + sc[c]) + sh[c]; }
                *(float4*)(H2 + (size_t)r * D + j * 256 + lane * 4) = make_float4(v[4 * j], v[4 * j + 1], v[4 * j + 2], v[4 * j + 3]);
            }
            float mylg = 0.f;
#pragma unroll 1
            for (int e = 0; e < 32; ++e) {
                float a = 0.f;
#pragma unroll
                for (int j = 0; j < 4; ++j)
#pragma unroll
                    for (int i = 0; i < 4; ++i) a = fmaf(v[4 * j + i], rw[(size_t)(j * 256 + lane * 4 + i) * NE + e], a);
                const float tot = wave_sum(a) + rb[e];
                if ((lane & 31) == e) mylg = tot;
            }
            int ti[4]; float tv[4];
#pragma unroll
            for (int k = 0; k < 4; ++k) {
                float val = mylg; int idx = lane & 31;
#pragma unroll
                for (int o = 1; o < 64; o <<= 1) { const float ov = __shfl_xor(val, o); const int oi = __shfl_xor(idx, o); if (ov > val || (ov == val && oi < idx)) { val = ov; idx = oi; } }
                ti[k] = idx; tv[k] = val;
                if ((lane & 31) == idx) mylg = -3.0e38f;
            }
            const float e0 = 1.f, e1 = expf(tv[1] - tv[0]), e2 = expf(tv[2] - tv[0]), e3 = expf(tv[3] - tv[0]);
            const float inv = 1.f / (e0 + e1 + e2 + e3);
            if (lane < 4) {
                const int e = lane == 0 ? ti[0] : lane == 1 ? ti[1] : lane == 2 ? ti[2] : ti[3];
                const float gv = (lane == 0 ? e0 : lane == 1 ? e1 : lane == 2 ? e2 : e3) * inv;
                const unsigned pos = atomicAdd(&CNT[e], 1u);
                TOPE[r * 4 + lane] = e; TOPG[r * 4 + lane] = gv; SLOT[r * 4 + lane] = (int)pos; LIST[e * MX + pos] = r;
            }
        }
    }
    SEAM(8);
    if (IN(9)) {
        int off = 0, ubase = 0;
        for (int e = 0; e < NE; ++e) {
            const int cnt = (int)__hip_atomic_load(&CNT[e], __ATOMIC_RELAXED, __HIP_MEMORY_SCOPE_AGENT);
            const int ntm = (cnt + 127) / 128;
            const float* wgu = p.in[I_WGU] + (size_t)e * D * 2 * DFF; const float* bgu = p.in[I_BGU] + (size_t)e * 2 * DFF;
            GemmDesc g{H2, D, LIST + e * MX, cnt, wgu, 2 * DFF, 2 * DFF, D};
            float* actb = ACT + (size_t)off * DFF;
            const int nun = ntm * (DFF / 128);
            for (int uu = 0; uu < nun; ++uu) {
                const int gidx = ubase + uu; if (gidx % G != bid) continue;
                const int tm = uu / (DFF / 128), tn = uu % (DFF / 128);
                sgemm_tile(lds, g, tm, tn, [=](int r, int c, float v) { const float gl = fminf(v + bgu[c], 7.f); actb[(size_t)r * DFF + c] = gl * sigmoidf_(1.702f * gl); });
                sgemm_tile(lds, g, tm, tn + DFF / 128, [=](int r, int c, float v) { const float ln = fminf(fmaxf(v + bgu[c], -7.f), 7.f); actb[(size_t)r * DFF + (c - DFF)] *= (ln + 1.f); });
            }
            ubase += nun; off += ntm * 128;
        }
    }
    SEAM(9);
    if (IN(10)) {
        int off = 0, ubase = 0;
        for (int e = 0; e < NE; ++e) {
            const int cnt = (int)__hip_atomic_load(&CNT[e], __ATOMIC_RELAXED, __HIP_MEMORY_SCOPE_AGENT);
            const int ntm = (cnt + 127) / 128;
            const float* wdn = p.in[I_WDN] + (size_t)e * DFF * D; const float* bdn = p.in[I_BDN] + (size_t)e * D;
            GemmDesc g{ACT + (size_t)off * DFF, DFF, nullptr, cnt, wdn, D, D, DFF};
            float* yb = YG + (size_t)off * D;
            const int nun = ntm * (D / 128);
            for (int uu = 0; uu < nun; ++uu) {
                const int gidx = ubase + uu; if (gidx % G != bid) continue;
                sgemm_tile(lds, g, uu / (D / 128), uu % (D / 128), [=](int r, int c, float v) { yb[(size_t)r * D + c] = v + bdn[c]; });
            }
            ubase += nun; off += ntm * 128;
        }
    }
    SEAM(10);
    if (IN(11)) {
        LAS int* offs = (LAS int*)(lds_raw + 65536);
        if (tid == 0) { int off = 0; for (int e = 0; e < NE; ++e) { offs[e] = off; const int cnt = (int)__hip_atomic_load(&CNT[e], __ATOMIC_RELAXED, __HIP_MEMORY_SCOPE_AGENT); off += ((cnt + 127) / 128) * 128; } }
        __syncthreads();
        const float* fng = p.in[I_FNG];
        for (int r = bid * 8 + wave; r < MX; r += G * 8) {
            const int mb = r / S; const float* g2 = MOD + mb * 6144 + 5 * D;
            float acc[16];
#pragma unroll
            for (int i = 0; i < 16; ++i) acc[i] = 0.f;
#pragma unroll
            for (int k = 0; k < 4; ++k) {
                const int e = TOPE[r * 4 + k]; const float gv = TOPG[r * 4 + k]; const int row = offs[e] + SLOT[r * 4 + k];
                const float* yr = YG + (size_t)row * D;
#pragma unroll
                for (int j = 0; j < 4; ++j) { const float4 t = *(const float4*)(yr + j * 256 + lane * 4); acc[4 * j] += gv * t.x; acc[4 * j + 1] += gv * t.y; acc[4 * j + 2] += gv * t.z; acc[4 * j + 3] += gv * t.w; }
            }
            float v[16]; float ss = 0.f;
#pragma unroll
            for (int j = 0; j < 4; ++j) { const float4 t = *(const float4*)(X1 + (size_t)r * D + j * 256 + lane * 4); const int c = j * 256 + lane * 4;
                v[4 * j] = t.x + g2[c] * acc[4 * j]; v[4 * j + 1] = t.y + g2[c + 1] * acc[4 * j + 1]; v[4 * j + 2] = t.z + g2[c + 2] * acc[4 * j + 2]; v[4 * j + 3] = t.w + g2[c + 3] * acc[4 * j + 3];
                ss += v[4 * j] * v[4 * j] + v[4 * j + 1] * v[4 * j + 1] + v[4 * j + 2] * v[4 * j + 2] + v[4 * j + 3] * v[4 * j + 3]; }
            const float rstd = rsqrtf(wave_sum(ss) * (1.f / D) + EPS);
#pragma unroll
            for (int j = 0; j < 4; ++j) { const int c = j * 256 + lane * 4;
                *(float4*)(p.out + (size_t)r * D + c) = make_float4(v[4 * j] * rstd * fng[c], v[4 * j + 1] * rstd * fng[c + 1], v[4 * j + 2] * rstd * fng[c + 2], v[4 * j + 3] * rstd * fng[c + 3]); }
        }
    }
#undef IN
#undef SEAM
}

#ifndef N_LAUNCH_SPLIT
#define N_LAUNCH_SPLIT 0
#endif

extern "C" void kernel_launch(void* const* d_in, const int* in_sizes, int n_in, void* d_out, int out_size, void* d_ws, size_t ws_size, hipStream_t stream) {
    static int grid = 0;
    if (grid == 0) {
        if (n_in != 23 || out_size != MX * D || ws_size < WS_END) { fprintf(stderr, "kernel_launch: unexpected shapes n_in %d out %d ws %zu (need %zu)\n", n_in, out_size, ws_size, (size_t)WS_END); grid = -1; return; }
        int dev = 0, cus = 0, per_cu = 0;
        hipGetDevice(&dev); hipDeviceGetAttribute(&cus, hipDeviceAttributeMultiprocessorCount, dev);
        if (hipFuncSetAttribute((const void*)fwd_kernel, hipFuncAttributeMaxDynamicSharedMemorySize, LDS_BYTES) != hipSuccess) { fprintf(stderr, "kernel_launch: hipFuncSetAttribute failed\n"); grid = -1; return; }
        hipOccupancyMaxActiveBlocksPerMultiprocessor(&per_cu, (const void*)fwd_kernel, NT, LDS_BYTES);
        if (per_cu < 1) fprintf(stderr, "kernel_launch: occupancy query says %d\n", per_cu);
        (void)hipGetLastError();
        grid = cus > 0 ? cus : 256;
    }
    if (grid < 0) return;
    hipMemsetAsync((char*)d_ws + WS_CTL, 0, CTL_BYTES, stream);
    Params p{};
    for (int i = 0; i < 23; ++i) p.in[i] = (const float*)d_in[i];
    p.out = (float*)d_out; p.ws = (unsigned char*)d_ws;
#if N_LAUNCH_SPLIT
    for (int k = 0; k < N_PHASES; ++k) { p.ph_lo = k; p.ph_hi = k + 1; hipLaunchKernelGGL(fwd_kernel, dim3(grid), dim3(NT), LDS_BYTES, stream, p); }
#else
    p.ph_lo = 0; p.ph_hi = N_PHASES;
    hipLaunchKernelGGL(fwd_kernel, dim3(grid), dim3(NT), LDS_BYTES, stream, p);
#endif
}
```

```cpp
#include <hip/hip_runtime.h>
#include <cstdio>
#include <cstdint>

#define LAS __attribute__((address_space(3)))

#define XB_TMO      128
#define XB_XCNT(j)  (256  + 64 * (j))
#define XB_XSUB(j)  (1280 + 64 * (j))
#define XB_XGEN(j)  (2304 + 64 * (j))
#define XB_TOP      3328
#define XB_TOPGEN   3392
#define XCD_BAR_WORDS 3456
#define XB_SPIN_CAP (1u << 22)

__device__ __forceinline__ unsigned xb_ld(unsigned* p)              { return __hip_atomic_load(p, __ATOMIC_RELAXED, __HIP_MEMORY_SCOPE_AGENT); }
__device__ __forceinline__ unsigned xb_add(unsigned* p, unsigned v) { return __hip_atomic_fetch_add(p, v, __ATOMIC_RELAXED, __HIP_MEMORY_SCOPE_AGENT); }
__device__ __forceinline__ unsigned xb_xcc_id() { return (unsigned)__builtin_amdgcn_s_getreg((3 << 11) | 20) & 0xFu; }
#define XB_SPIN(cond, bar) do { unsigned _sp = 0; while (cond) { __builtin_amdgcn_s_sleep(1); \
    if ((++_sp & 255u) == 0u) { if (xb_ld(&(bar)[XB_TMO])) break; if (_sp > XB_SPIN_CAP) { atomicAdd(&(bar)[XB_TMO], 1u); break; } } } } while (0)

struct XcdBarrier { unsigned* bar; unsigned x; volatile LAS unsigned* st; };

__device__ __forceinline__ XcdBarrier xcd_barrier_post(unsigned* bar, volatile LAS unsigned* st) {
    XcdBarrier b; b.bar = bar; b.x = xb_xcc_id(); b.st = st;
    if (threadIdx.x == 0) (void)xb_add(&bar[XB_XCNT(b.x)], 1u);
    return b;
}
__device__ __forceinline__ void xcd_barrier_complete(unsigned* bar, unsigned x, unsigned& nloc, unsigned& nx) {
    const unsigned G = gridDim.x * gridDim.y * gridDim.z;
    unsigned sum, cnt, mine, sp = 0u;
    for (;;) {
        sum = 0u; cnt = 0u; mine = 0u;
#pragma unroll
        for (unsigned j = 0; j < 16; ++j) { const unsigned c = xb_ld(&bar[XB_XCNT(j)]); sum += c; cnt += (c > 0u) ? 1u : 0u; mine = (j == x) ? c : mine; }
        if (sum == G) break;
        __builtin_amdgcn_s_sleep(1);
        if ((++sp & 255u) == 0u) { if (xb_ld(&bar[XB_TMO])) break; if (sp > XB_SPIN_CAP) { atomicAdd(&bar[XB_TMO], 1u); break; } }
    }
    nloc = mine > 0u ? mine : 1u; nx = cnt > 0u ? cnt : 1u;
}
__device__ __forceinline__ void xcd_barrier(const XcdBarrier& b) {
    asm volatile("s_waitcnt vmcnt(0)" ::: "memory");
    __syncthreads();
    if (threadIdx.x == 0) {
        unsigned* bar = b.bar;
        __builtin_amdgcn_s_waitcnt(0);
        unsigned nloc = b.st[0], nx = b.st[1];
        if (nloc == 0u) { xcd_barrier_complete(bar, b.x, nloc, nx); b.st[0] = nloc; b.st[1] = nx; }
        const unsigned old = xb_add(&bar[XB_XSUB(b.x)], 1u);
        const unsigned gen = old / nloc;
        if (old + 1u == (gen + 1u) * nloc) {
            __builtin_amdgcn_fence(__ATOMIC_RELEASE, "agent");
            asm volatile("s_waitcnt vmcnt(0)" ::: "memory");
            const unsigned og = xb_add(&bar[XB_TOP], 1u);
            const unsigned tg = og / nx;
            if (og + 1u == (tg + 1u) * nx) xb_add(&bar[XB_TOPGEN], 1u);
            else XB_SPIN(xb_ld(&bar[XB_TOPGEN]) == tg, bar);
            __builtin_amdgcn_fence(__ATOMIC_ACQUIRE, "agent");
            xb_add(&bar[XB_XGEN(b.x)], 1u);
            asm volatile("s_waitcnt vmcnt(0)" ::: "memory");
        } else {
            XB_SPIN(xb_ld(&bar[XB_XGEN(b.x)]) == gen, bar);
            __builtin_amdgcn_fence(__ATOMIC_ACQUIRE, "agent");
            asm volatile("s_waitcnt vmcnt(0)" ::: "memory");
        }
    }
    __syncthreads();
}

constexpr int D = 1024, NB = 4, S = 4096, CTX = 256, SKV = S + CTX;
constexpr int MX = NB * S, MC = NB * CTX, MT = MX + MC;
constexpr int INW = 2224, PW = 2304;
constexpr int O_CQ = 0, O_CKV = 384, O_KR = 640, O_MQ = 672, O_MK = 928, O_MV = 1184, O_MO = 1696, O_G = 2208;
constexpr int QL = 384, KVL = 256, HA = 8, DN = 64, DR = 32, DQK = 96, DVH = 64;
constexpr int NH = 4, MDQK = 64, MDV = 128;
constexpr int NE = 32, TOPK = 4, DFF = 1024;
constexpr float EPS = 1e-6f;
constexpr int NT = 512;
constexpr int NSEQ = NB * NH * 2;
constexpr int RCAP = MX * TOPK + NE * 256;

constexpr size_t MiB = 1u << 20;
constexpr size_t WS_CTL = 0, CTL_BYTES = 1 * MiB;
constexpr size_t WS_MOD = 1 * MiB;
constexpr size_t WS_MLS = 2 * MiB;
constexpr size_t WS_ROPE = 5 * MiB;
constexpr size_t WS_TOPE = 8 * MiB;
constexpr size_t WS_SLOT = 9 * MiB;
constexpr size_t WS_LIST = 10 * MiB;
constexpr size_t WS_RGATE = 12 * MiB;
constexpr size_t WS_H = 16 * MiB;
constexpr size_t WS_P = 52 * MiB;
constexpr size_t WS_ACT = WS_P;
constexpr size_t WS_Q = 206 * MiB;
constexpr size_t WS_KV = 254 * MiB;
constexpr size_t WS_CLOC = 322 * MiB;
constexpr size_t WS_CIN = 386 * MiB;
constexpr size_t WS_X1 = 450 * MiB;
constexpr size_t WS_H2 = 514 * MiB;
constexpr size_t WS_YG = 546 * MiB;
constexpr size_t WS_WGUT = 690 * MiB;
constexpr size_t WS_WDNT = 818 * MiB;
constexpr size_t WS_WINT = 882 * MiB;
constexpr size_t WS_WUQT = 887 * MiB;
constexpr size_t WS_WUKVT = 888 * MiB;
constexpr size_t WS_WOUTT = 889 * MiB;
constexpr size_t WS_GATES = 891 * MiB;
constexpr size_t WS_STAT = 893 * MiB;
constexpr size_t WS_RSTD = 895 * MiB;
constexpr size_t WS_MIX16 = 896 * MiB;
constexpr size_t WS_END = 928 * MiB;
static_assert((size_t)MT * PW * 2 <= 153 * MiB && (size_t)RCAP * DFF * 2 <= 144 * MiB, "map");

constexpr int CW_BAR = 4096;
constexpr int CW_CNT = 16384;

struct Params {
    const float* in[23];
    float* out;
    unsigned char* ws;
    int ph_lo, ph_hi;
};
enum { I_X = 0, I_C, I_CTX, I_CCTX, I_WMOD, I_BMOD, I_N1G, I_WIN, I_BG, I_QNG, I_WUQ, I_KVNG, I_WUKV, I_MNG, I_WOUT, I_N2G, I_RW, I_RB, I_WGU, I_BGU, I_WDN, I_BDN, I_FNG };

__device__ __forceinline__ float wave_sum(float v) {
#pragma unroll
    for (int o = 1; o < 64; o <<= 1) v += __shfl_xor(v, o);
    return v;
}
__device__ __forceinline__ float bf2f(unsigned short v) { return __uint_as_float(((unsigned)v) << 16); }
__device__ __forceinline__ float sigmoidf_(float x) { return 1.f / (1.f + __expf(-x)); }
__device__ __forceinline__ float siluf_(float x) { return x / (1.f + expf(-x)); }
__device__ __forceinline__ float logsigmoidf_(float x) { return fminf(x, 0.f) - log1pf(expf(-fabsf(x))); }

__device__ __forceinline__ int krow(int b, int key) { return key < CTX ? MX + b * CTX + key : b * S + (key - CTX); }
__device__ __forceinline__ int srow(int b, int dir, int u) {
    if (u < CTX) { const int c = dir ? (CTX - 1 - u) : u; return MX + b * CTX + c; }
    const int tt = u - CTX; const int s = dir ? (S - 1 - tt) : tt; return b * S + s;
}
__device__ __forceinline__ void rope_angles(int s, int j, float& cs, float& sn) {
    const int jj = j & 7; const float pos = (j < 8) ? (float)(s / 64) : (float)(s % 64);
    const float inv = powf(10000.f, -(float)jj / 8.f);
    const float ang = pos * inv; cs = cosf(ang); sn = sinf(ang);
}

struct GemmDesc { const float* A; int lda; const int* arow; int M; const float* B; int ldb; int N; int K; };
template <class Epi>
__device__ __forceinline__ void sgemm_tile(float* lds, const GemmDesc g, int tm, int tn, const Epi& epi) {
    float* As = lds;
    float* Bs = lds + 16 * 132;
    const int tid = threadIdx.x, tx = tid & 15, ty = tid >> 4;
    float acc[4][8];
#pragma unroll
    for (int i = 0; i < 4; ++i)
#pragma unroll
        for (int j = 0; j < 8; ++j) acc[i][j] = 0.f;
    const int ar = tid >> 2, ak = (tid & 3) * 4;
    const int grow = tm * 128 + ar;
    const float* aptr = nullptr;
    if (grow < g.M) { const int r = g.arow ? g.arow[grow] : grow; aptr = g.A + (size_t)r * g.lda + ak; }
    const int bk = tid >> 5, bc = (tid & 31) * 4;
    const int gcol = tn * 128 + bc;
    for (int k0 = 0; k0 < g.K; k0 += 16) {
        float4 av = make_float4(0.f, 0.f, 0.f, 0.f), bv = make_float4(0.f, 0.f, 0.f, 0.f);
        if (aptr) av = *(const float4*)(aptr + k0);
        if (gcol < g.N) bv = *(const float4*)(g.B + (size_t)(k0 + bk) * g.ldb + gcol);
        __syncthreads();
        As[(ak + 0) * 132 + ar] = av.x; As[(ak + 1) * 132 + ar] = av.y; As[(ak + 2) * 132 + ar] = av.z; As[(ak + 3) * 132 + ar] = av.w;
        *(float4*)(Bs + bk * 128 + bc) = bv;
        __syncthreads();
#pragma unroll
        for (int k = 0; k < 16; ++k) {
            const float4 a4 = *(const float4*)(As + k * 132 + ty * 4);
            const float4 b0 = *(const float4*)(Bs + k * 128 + tx * 8), b1 = *(const float4*)(Bs + k * 128 + tx * 8 + 4);
            const float a[4] = {a4.x, a4.y, a4.z, a4.w};
            const float b[8] = {b0.x, b0.y, b0.z, b0.w, b1.x, b1.y, b1.z, b1.w};
#pragma unroll
            for (int i = 0; i < 4; ++i)
#pragma unroll
                for (int j = 0; j < 8; ++j) acc[i][j] = fmaf(a[i], b[j], acc[i][j]);
        }
    }
#pragma unroll
    for (int i = 0; i < 4; ++i) {
        const int r = tm * 128 + ty * 4 + i;
        if (r < g.M) {
#pragma unroll
            for (int j = 0; j < 8; ++j) { const int c = tn * 128 + tx * 8 + j; if (c < g.N) epi(r, c, acc[i][j]); }
        }
    }
}
template <class Epi>
__device__ __forceinline__ void sgemm_phase(float* lds, const GemmDesc g, const Epi& epi, int u0 = 0, int ustride = 0) {
    const int ntm = (g.M + 127) / 128, ntn = (g.N + 127) / 128;
    for (int u = blockIdx.x; u < ntm * ntn; u += gridDim.x) sgemm_tile(lds, g, u / ntn, u % ntn, epi);
}


namespace pg8 {
#define PG8_LAS __attribute__((address_space(3)))
typedef unsigned short bf16_t;
typedef short bf16x8 __attribute__((ext_vector_type(8)));
typedef float f32x4 __attribute__((ext_vector_type(4)));
typedef unsigned u32x4 __attribute__((ext_vector_type(4)));
typedef unsigned u32x2 __attribute__((ext_vector_type(2)));
constexpr int BM = 256, BK = 64, HALF = 128, HTB = HALF * BK * 2, STAGE_BYTES = 8 * HTB, NXCD = 8, WGM = 8;
__host__ __device__ __forceinline__ int lds_byte(int r, int c) { const int st = (r >> 4) * 2 + (c >> 5), rr = r & 15, cc = c & 31, ob = rr * 64 + cc * 2; return st * 1024 + (ob ^ (((ob >> 9) & 1) << 5)); }
__host__ __device__ __forceinline__ void stage_rc(int b, int& R, int& C) { const int st = b / 1024, sb = b % 1024, swz = sb ^ (((sb >> 9) & 1) << 5); R = (st >> 1) * 16 + swz / 64; C = (st & 1) * 32 + (swz % 64) / 2; }
__host__ __device__ __forceinline__ int perm32(int rho) { const int n = rho >> 4, i = rho & 15; return 8 * (i >> 2) + 4 * n + (i & 3); }
__device__ __forceinline__ unsigned cvt_pk_bf16(float lo, float hi) { unsigned r; asm volatile("v_cvt_pk_bf16_f32 %0, %1, %2" : "=v"(r) : "v"(lo), "v"(hi)); return r; }

struct Unit { int pm, pn, g, row0; };

struct PlainSched {
    int nM, nN, nwg, G, c, lda, K; const char* Bt;
    __device__ void init(int M, int N, int K_, int lda_, const void* Bt_, int G_, int c_) { nM = M / BM; nN = N / BM; nwg = nM * nN; G = G_; c = c_; lda = lda_; K = K_; Bt = (const char*)Bt_; }
    __device__ __forceinline__ bool next(int i, Unit& u) const {
        const long L = (long)i * G + c; if (L >= nwg) return false;
        int wgid = (int)L; { const int q = nwg / NXCD, r = nwg % NXCD, xcd = wgid % NXCD, off = wgid / NXCD; wgid = (xcd < r ? xcd * (q + 1) : r * (q + 1) + (xcd - r) * q) + off; }
        const int nig = WGM * nN, gid = wgid / nig, fm = gid * WGM, gsz = (nM - fm) < WGM ? (nM - fm) : WGM;
        u.pm = fm + ((wgid % nig) % gsz); u.pn = (wgid % nig) / gsz; u.g = 0; u.row0 = u.pm * BM; return true;
    }
    __device__ __forceinline__ unsigned a_rowoff(const Unit& u, int r) const { return (unsigned)(u.pm * BM + r) * (unsigned)(lda * 2); }
    __device__ __forceinline__ const char* b_base(const Unit& u) const { return Bt + (size_t)u.pn * BM * K * 2; }
};

template <class Epi, class Sched, bool ALIGN_EPI>
__device__ __forceinline__ void gemm_phase(PG8_LAS unsigned char* lds, const bf16_t* Aptr, const int K, const Sched& S, const Epi& E) {
    const int tid = threadIdx.x, wid = __builtin_amdgcn_readfirstlane(tid >> 6), lane = tid & 63, wr = wid >> 2, wc = wid & 3, fr = lane & 15, fq = lane >> 4;
    const int nt = K / BK;
    unsigned voffB[2];
#pragma unroll
    for (int i = 0; i < 2; ++i) { int R, C; stage_rc(tid * 16 + i * 8192, R, C); const int Rb = Epi::PERM ? ((R & ~31) + perm32(R & 31)) : R;
        voffB[i] = (unsigned)(Rb * K + C) * 2u; }
    const size_t kstep = (size_t)(BK * 2);
    const size_t hstepB = (size_t)HALF * K * 2;
    const unsigned ldsw = (unsigned)wid * 1024u;
    const int aoff = lds_byte(wr * 64 + fr, fq * 8), boff = lds_byte(wc * 32 + fr, fq * 8);
#define PG8_SA(b, h) (((b) * 2 + (h)) * HTB)
#define PG8_SB(b, h) ((4 + (b) * 2 + (h)) * HTB)
#define PG8_STAGE(bufoff, gbase, voff) do { _Pragma("unroll") for (int _i = 0; _i < 2; ++_i) \
        __builtin_amdgcn_global_load_lds((const unsigned*)((const char*)(gbase) + (voff)[_i]), (PG8_LAS unsigned*)(lds + (bufoff) + ldsw + _i * 8192), 16, 0, 0); } while (0)
#define PG8_LDA(dst, b, h) do { _Pragma("unroll") for (int m = 0; m < 4; ++m) _Pragma("unroll") for (int k = 0; k < 2; ++k) dst[m][k] = *(const PG8_LAS bf16x8*)(lds + PG8_SA(b, h) + aoff + m * 2048 + k * 1024); } while (0)
#define PG8_LDB(dst, b, h) do { _Pragma("unroll") for (int n = 0; n < 2; ++n) _Pragma("unroll") for (int k = 0; k < 2; ++k) dst[n][k] = *(const PG8_LAS bf16x8*)(lds + PG8_SB(b, h) + boff + n * 2048 + k * 1024); } while (0)
#define PG8_MMA(ai, bj, At, Bt) do { __builtin_amdgcn_s_setprio(1); _Pragma("unroll") for (int m = 0; m < 4; ++m) _Pragma("unroll") for (int n = 0; n < 2; ++n) _Pragma("unroll") for (int k = 0; k < 2; ++k) \
        acc[ai][bj][m][n] = __builtin_amdgcn_mfma_f32_16x16x32_bf16(Bt[n][k], At[m][k], acc[ai][bj][m][n], 0, 0, 0); __builtin_amdgcn_s_setprio(0); } while (0)
#define PG8_WAIT_V(n) asm volatile("s_waitcnt vmcnt(" #n ")" ::: "memory")
#define PG8_WAIT_L(n) asm volatile("s_waitcnt lgkmcnt(" #n ")" ::: "memory")
#define PG8_BAR __builtin_amdgcn_s_barrier()
#define PG8_SCHED __builtin_amdgcn_sched_barrier(0)
    Unit cur, nxt; int ui = 0;
    if (!S.next(0, cur)) return;
    f32x4 acc[2][2][4][2];
#pragma unroll
    for (int a = 0; a < 2; ++a)
#pragma unroll
        for (int b = 0; b < 2; ++b)
#pragma unroll
            for (int m = 0; m < 4; ++m)
#pragma unroll
                for (int n = 0; n < 2; ++n) acc[a][b][m][n] = (f32x4){0.f, 0.f, 0.f, 0.f};
    bf16x8 At[4][2], B0[2][2], B1[2][2];
    unsigned oA0[2], oA1[2];
#pragma unroll
    for (int i = 0; i < 2; ++i) { int R, C; stage_rc(tid * 16 + i * 8192, R, C); oA0[i] = S.a_rowoff(cur, R) + (unsigned)C * 2u; oA1[i] = S.a_rowoff(cur, HALF + R) + (unsigned)C * 2u; }
    const char* const cA = (const char*)Aptr;
    const char* cB = S.b_base(cur);
    PG8_STAGE(PG8_SB(0, 0), cB, voffB); PG8_STAGE(PG8_SB(0, 1), cB + hstepB, voffB); PG8_STAGE(PG8_SA(0, 0), cA, oA0); PG8_STAGE(PG8_SA(0, 1), cA, oA1);
    if (wr == 1) PG8_BAR;
    PG8_WAIT_V(2); PG8_BAR;
    PG8_STAGE(PG8_SB(1, 0), cB + kstep, voffB); PG8_STAGE(PG8_SA(1, 0), cA + kstep, oA0); PG8_STAGE(PG8_SB(1, 1), cB + hstepB + kstep, voffB);
    PG8_WAIT_V(6); PG8_BAR;
    for (;;) {
        const bool has_next = S.next(ui + 1, nxt);
        const char* nB = has_next ? S.b_base(nxt) : cB;
#pragma unroll 1
        for (int t = 0; t < nt; t += 2) {
            const bool last = (t == nt - 2);
            const char* a1 = cA + (size_t)(t + 1) * kstep;
            const char* a2 = last ? cA : cA + (size_t)(t + 2) * kstep; const char* b2 = last ? nB : cB + (size_t)(t + 2) * kstep;
            const char* a3 = a2 + kstep; const char* b3 = b2 + kstep;
            PG8_LDB(B0, 0, 0); PG8_LDB(B1, 0, 1); PG8_SCHED; PG8_LDA(At, 0, 0); PG8_STAGE(PG8_SA(1, 1), a1, oA1);
            if (last && has_next) {
#pragma unroll
                for (int i = 0; i < 2; ++i) { int R, C; stage_rc((int)threadIdx.x * 16 + i * 8192, R, C); oA0[i] = S.a_rowoff(nxt, R) + (unsigned)C * 2u; oA1[i] = S.a_rowoff(nxt, HALF + R) + (unsigned)C * 2u; }
            }
            PG8_WAIT_V(8); PG8_WAIT_L(0); PG8_BAR; PG8_MMA(0, 0, At, B0); PG8_MMA(0, 1, At, B1); PG8_BAR; PG8_SCHED;
            PG8_LDA(At, 0, 1); PG8_STAGE(PG8_SB(0, 0), b2, voffB); PG8_STAGE(PG8_SB(0, 1), b2 + hstepB, voffB); PG8_STAGE(PG8_SA(0, 0), a2, oA0);
            PG8_WAIT_V(8); PG8_WAIT_L(0); PG8_BAR; PG8_MMA(1, 0, At, B0); PG8_MMA(1, 1, At, B1); PG8_BAR; PG8_SCHED;
            PG8_LDB(B0, 1, 0); PG8_LDB(B1, 1, 1); PG8_SCHED; PG8_LDA(At, 1, 0); PG8_STAGE(PG8_SA(0, 1), a2, oA1);
            PG8_WAIT_V(8); PG8_WAIT_L(0); PG8_BAR; PG8_MMA(0, 0, At, B0); PG8_MMA(0, 1, At, B1); PG8_BAR; PG8_SCHED;
            PG8_LDA(At, 1, 1); PG8_STAGE(PG8_SB(1, 0), b3, voffB); PG8_STAGE(PG8_SB(1, 1), b3 + hstepB, voffB); PG8_STAGE(PG8_SA(1, 0), a3, oA0);
            PG8_WAIT_V(8); PG8_WAIT_L(0); PG8_BAR; PG8_MMA(1, 0, At, B0); PG8_MMA(1, 1, At, B1); PG8_BAR; PG8_SCHED;
        }
        if constexpr (ALIGN_EPI) { if (wr == 0) PG8_BAR; }
        E(acc, cur, wr, wc, fr, fq);
        if (!has_next) break;
#pragma unroll
        for (int a = 0; a < 2; ++a)
#pragma unroll
            for (int b = 0; b < 2; ++b)
#pragma unroll
                for (int m = 0; m < 4; ++m)
#pragma unroll
                    for (int n = 0; n < 2; ++n) acc[a][b][m][n] = (f32x4){0.f, 0.f, 0.f, 0.f};
        cur = nxt; cB = nB; ++ui;
        if constexpr (ALIGN_EPI) { if (wr == 1) PG8_BAR; }
    }
    PG8_WAIT_V(0);
    if constexpr (!ALIGN_EPI) { if (wr == 0) PG8_BAR; }
    PG8_BAR;
#undef PG8_SA
#undef PG8_SB
#undef PG8_STAGE
#undef PG8_LDA
#undef PG8_LDB
#undef PG8_MMA
#undef PG8_WAIT_V
#undef PG8_WAIT_L
#undef PG8_BAR
#undef PG8_SCHED
}

struct EpiF32 {
    static constexpr bool PERM = false;
    float* C; int ldc; int ncols;
    __device__ __forceinline__ void operator()(const f32x4 (&acc)[2][2][4][2], const Unit& u, int wr, int wc, int fr, int fq) const {
        const int row0 = u.row0 + wr * 64 + fr, col0 = u.pn * BM + wc * 32 + 4 * fq;
#pragma unroll
        for (int ai = 0; ai < 2; ++ai)
#pragma unroll
            for (int m = 0; m < 4; ++m) { float* rowp = C + (size_t)(row0 + ai * HALF + m * 16) * ldc + col0;
#pragma unroll
                for (int bj = 0; bj < 2; ++bj)
#pragma unroll
                    for (int n = 0; n < 2; ++n) if (col0 + bj * HALF + n * 16 < ncols) *(f32x4*)(rowp + bj * HALF + n * 16) = acc[ai][bj][m][n]; }
    }
};
struct MoeSched {
    const PG8_LAS int* tp; const PG8_LAS int* ro; const PG8_LAS int* cn; int nN, G, c, K, lda, gather; const int* list; const char* Bt; size_t bstride;
    __device__ __forceinline__ bool next(int i, Unit& u) const {
        const int nwg = tp[32] * nN; const long L = (long)i * G + c; if (L >= nwg) return false;
        int wgid = (int)L; { const int q = nwg / NXCD, r = nwg % NXCD, xcd = wgid % NXCD, off = wgid / NXCD; wgid = (xcd < r ? xcd * (q + 1) : r * (q + 1) + (xcd - r) * q) + off; }
        const int tile = wgid / nN; int g = 0;
#pragma unroll 1
        for (int e = 1; e < 32; ++e) g = (tp[e] <= tile) ? e : g;
        const int ntm = tp[g + 1] - tp[g]; const int rem = wgid - tp[g] * nN;
        u.g = g; u.pm = rem % ntm; u.pn = rem / ntm; u.row0 = ro[g] + u.pm * BM; return true;
    }
    __device__ __forceinline__ unsigned a_rowoff(const Unit& u, int r) const {
        const int rr = u.pm * BM + r;
        if (gather) { const int tok = (rr < cn[u.g]) ? list[u.g * 16384 + rr] : 0; return (unsigned)tok * (unsigned)(lda * 2); }
        return (unsigned)(u.row0 + r) * (unsigned)(lda * 2);
    }
    __device__ __forceinline__ const char* b_base(const Unit& u) const { return Bt + (size_t)u.g * bstride + (size_t)u.pn * BM * K * 2; }
};
struct EpiSwiglu {
    static constexpr bool PERM = true;
    bf16_t* O; const float* bias;
    __device__ __forceinline__ void operator()(const f32x4 (&acc)[2][2][4][2], const Unit& u, int wr, int wc, int fr, int fq) const {
        const int row0 = u.row0 + wr * 64 + fr, col0 = u.pn * 128 + wc * 32 + 8 * fq;
        const float* bg = bias + (size_t)u.g * 2048 + col0;
        f32x4 bgl[2], bln[2];
#pragma unroll
        for (int n = 0; n < 2; ++n) { bgl[n] = *(const f32x4*)(bg + 4 * n); bln[n] = *(const f32x4*)(bg + 1024 + 4 * n); }
#pragma unroll
        for (int ai = 0; ai < 2; ++ai)
#pragma unroll
            for (int m = 0; m < 4; ++m) {
                float o[8];
#pragma unroll
                for (int n = 0; n < 2; ++n)
#pragma unroll
                    for (int j = 0; j < 4; ++j) {
                        const float gl = fminf(acc[ai][0][m][n][j] + bgl[n][j], 7.f);
                        const float ln = fminf(fmaxf(acc[ai][1][m][n][j] + bln[n][j], -7.f), 7.f);
                        o[4 * n + j] = gl * __builtin_amdgcn_rcpf(1.f + __expf(-1.702f * gl)) * (ln + 1.f);
                    }
                u32x4 w; w.x = cvt_pk_bf16(o[0], o[1]); w.y = cvt_pk_bf16(o[2], o[3]); w.z = cvt_pk_bf16(o[4], o[5]); w.w = cvt_pk_bf16(o[6], o[7]);
                *(u32x4*)(O + (size_t)(row0 + ai * HALF + m * 16) * 1024 + col0) = w;
            }
    }
};
struct EpiDown {
    static constexpr bool PERM = true;
    bf16_t* O; const float* bias; const float* rgate; const PG8_LAS int* ro;
    __device__ __forceinline__ void operator()(const f32x4 (&acc)[2][2][4][2], const Unit& u, int wr, int wc, int fr, int fq) const {
        const int row0 = u.row0 + wr * 64 + fr, col0 = u.pn * BM + wc * 32 + 8 * fq;
        const float* bd = bias + (size_t)u.g * 1024 + col0;
        const float* gt = rgate + (size_t)u.g * 16384 + (row0 - ro[u.g]);
        f32x4 bv[2][2];
#pragma unroll
        for (int bj = 0; bj < 2; ++bj)
#pragma unroll
            for (int n = 0; n < 2; ++n) bv[bj][n] = *(const f32x4*)(bd + bj * HALF + 4 * n);
#pragma unroll
        for (int ai = 0; ai < 2; ++ai)
#pragma unroll
            for (int m = 0; m < 4; ++m) {
                const float gv = gt[ai * HALF + m * 16];
                bf16_t* rowp = O + (size_t)(row0 + ai * HALF + m * 16) * 1024 + col0;
#pragma unroll
                for (int bj = 0; bj < 2; ++bj) { const f32x4 v0 = (acc[ai][bj][m][0] + bv[bj][0]) * gv, v1 = (acc[ai][bj][m][1] + bv[bj][1]) * gv;
                    u32x4 w; w.x = cvt_pk_bf16(v0[0], v0[1]); w.y = cvt_pk_bf16(v0[2], v0[3]); w.z = cvt_pk_bf16(v1[0], v1[1]); w.w = cvt_pk_bf16(v1[2], v1[3]);
                    *(u32x4*)(rowp + bj * HALF) = w; }
            }
    }
};
struct EpiInproj {
    static constexpr bool PERM = true;
    bf16_t* P; float* gates; float* stat; bf16_t* Kb; const float* cs; const float* sn;
    __device__ __forceinline__ void operator()(const f32x4 (&acc)[2][2][4][2], const Unit& u, int wr, int wc, int fr, int fq) const {
        const int row0 = u.row0 + wr * 64 + fr, colb = u.pn * BM + wc * 32 + 8 * fq;
#pragma unroll
        for (int ai = 0; ai < 2; ++ai)
#pragma unroll
            for (int m = 0; m < 4; ++m) { const int row = row0 + ai * HALF + m * 16;
#pragma unroll
                for (int bj = 0; bj < 2; ++bj) { const f32x4 v0 = acc[ai][bj][m][0], v1 = acc[ai][bj][m][1];
                    u32x4 w; w.x = cvt_pk_bf16(v0[0], v0[1]); w.y = cvt_pk_bf16(v0[2], v0[3]); w.z = cvt_pk_bf16(v1[0], v1[1]); w.w = cvt_pk_bf16(v1[2], v1[3]);
                    *(u32x4*)(P + (size_t)row * 2304 + colb + bj * HALF) = w;
                    if (u.pn <= 2) { float sq = (v0[0] * v0[0] + v0[1] * v0[1]) + (v0[2] * v0[2] + v0[3] * v0[3]) + (v1[0] * v1[0] + v1[1] * v1[1]) + (v1[2] * v1[2] + v1[3] * v1[3]);
                        sq += __shfl_xor(sq, 16); sq += __shfl_xor(sq, 32);
                        if (fq == 0) stat[(size_t)row * 24 + (u.pn * 2 + bj) * 4 + wc] = sq; }
                    if (u.pn == 8 && bj == 1 && wc == 1 && fq < 2) { *(f32x4*)(gates + (size_t)row * 16 + fq * 8) = v0; *(f32x4*)(gates + (size_t)row * 16 + fq * 8 + 4) = v1; }
                    if (u.pn == 2 && bj == 1 && wc == 0) {
                        f32x4 r0 = v0, r1 = v1;
                        f32x4 o0, o1;
#pragma unroll
                        for (int j = 0; j < 4; ++j) { o0[j] = __shfl_xor(v0[j], 32); o1[j] = __shfl_xor(v1[j], 32); }
                        int krow;
                        if (row < 16384) { const int pos = row & 4095; const int jb = 8 * (fq & 1);
                            const f32x4 c0 = *(const f32x4*)(cs + pos * 16 + jb), c1 = *(const f32x4*)(cs + pos * 16 + jb + 4), s0 = *(const f32x4*)(sn + pos * 16 + jb), s1 = *(const f32x4*)(sn + pos * 16 + jb + 4);
                            if (fq < 2) { r0 = v0 * c0 - o0 * s0; r1 = v1 * c1 - o1 * s1; } else { r0 = o0 * s0 + v0 * c0; r1 = o1 * s1 + v1 * c1; }
                            krow = (row >> 12) * 4352 + 256 + pos; }
                        else krow = ((row - 16384) >> 8) * 4352 + ((row - 16384) & 255);
                        u32x4 kw; kw.x = cvt_pk_bf16(r0[0], r0[1]); kw.y = cvt_pk_bf16(r0[2], r0[3]); kw.z = cvt_pk_bf16(r1[0], r1[1]); kw.w = cvt_pk_bf16(r1[2], r1[3]);
#pragma unroll
                        for (int hh = 0; hh < 8; ++hh) *(u32x4*)(Kb + (size_t)krow * 768 + hh * 96 + 64 + 8 * fq) = kw;
                    }
                } }
    }
};
struct EpiF32RowScale {
    static constexpr bool PERM = false;
    float* C; int ldc; const float* rs;
    __device__ __forceinline__ void operator()(const f32x4 (&acc)[2][2][4][2], const Unit& u, int wr, int wc, int fr, int fq) const {
        const int row0 = u.row0 + wr * 64 + fr, col0 = u.pn * BM + wc * 32 + 4 * fq;
#pragma unroll
        for (int ai = 0; ai < 2; ++ai)
#pragma unroll
            for (int m = 0; m < 4; ++m) { const int row = row0 + ai * HALF + m * 16; const float sc = rs[row]; float* rowp = C + (size_t)row * ldc + col0;
#pragma unroll
                for (int bj = 0; bj < 2; ++bj)
#pragma unroll
                    for (int n = 0; n < 2; ++n) *(f32x4*)(rowp + bj * HALF + n * 16) = acc[ai][bj][m][n] * sc; }
    }
};
struct EpiResid {
    static constexpr bool PERM = false;
    float* C; const float* X; const float* mod;
    __device__ __forceinline__ void operator()(const f32x4 (&acc)[2][2][4][2], const Unit& u, int wr, int wc, int fr, int fq) const {
        const int row0 = u.row0 + wr * 64 + fr, col0 = u.pn * BM + wc * 32 + 4 * fq;
        const float* g1 = mod + (size_t)(u.row0 / 4096) * 6144 + 2048 + col0;
        f32x4 gv[2][2];
#pragma unroll
        for (int bj = 0; bj < 2; ++bj)
#pragma unroll
            for (int n = 0; n < 2; ++n) gv[bj][n] = *(const f32x4*)(g1 + bj * HALF + n * 16);
#pragma unroll
        for (int ai = 0; ai < 2; ++ai)
#pragma unroll
            for (int m = 0; m < 4; ++m) { const size_t off = (size_t)(row0 + ai * HALF + m * 16) * 1024 + col0;
#pragma unroll
                for (int bj = 0; bj < 2; ++bj)
#pragma unroll
                    for (int n = 0; n < 2; ++n) { const f32x4 xv = *(const f32x4*)(X + off + bj * HALF + n * 16); *(f32x4*)(C + off + bj * HALF + n * 16) = xv + gv[bj][n] * acc[ai][bj][m][n]; } }
    }
};
struct EpiQ {
    static constexpr bool PERM = false;
    bf16_t* Q; const float* stat; const float* cs; const float* sn;
    __device__ __forceinline__ void operator()(const f32x4 (&acc)[2][2][4][2], const Unit& u, int wr, int wc, int fr, int fq) const {
        const int row0 = u.row0 + wr * 64 + fr;
#pragma unroll
        for (int ai = 0; ai < 2; ++ai)
#pragma unroll
            for (int m = 0; m < 4; ++m) { const int row = row0 + ai * HALF + m * 16; const int pos = row & 4095;
                float sc; { const f32x4* sp = (const f32x4*)(stat + (size_t)row * 24); const f32x4 a0 = sp[0], a1 = sp[1], a2 = sp[2];
                    sc = rsqrtf((((a0[0] + a0[1]) + (a0[2] + a0[3])) + ((a1[0] + a1[1]) + (a1[2] + a1[3])) + ((a2[0] + a2[1]) + (a2[2] + a2[3]))) * (1.f / 384.f) + 1e-6f); }
                const f32x4 cv = *(const f32x4*)(cs + pos * 16 + 4 * fq), sv = *(const f32x4*)(sn + pos * 16 + 4 * fq);
#pragma unroll
                for (int bj = 0; bj < 2; ++bj) { const int c32 = u.pn * BM + bj * HALF + wc * 32; const bool rope = ((c32 % 96) == 64);
                    f32x4 v0 = acc[ai][bj][m][0], v1 = acc[ai][bj][m][1];
                    if (rope) { const f32x4 a = v0 * cv - v1 * sv, b = v0 * sv + v1 * cv; v0 = a; v1 = b; }
                    v0 = v0 * sc; v1 = v1 * sc;
                    u32x2 w0, w1; w0.x = cvt_pk_bf16(v0[0], v0[1]); w0.y = cvt_pk_bf16(v0[2], v0[3]); w1.x = cvt_pk_bf16(v1[0], v1[1]); w1.y = cvt_pk_bf16(v1[2], v1[3]);
                    bf16_t* dst = Q + (size_t)row * 768 + c32 + 4 * fq;
                    *(u32x2*)dst = w0; *(u32x2*)(dst + 16) = w1; }
                asm volatile("" ::: "memory"); }
    }
};
struct EpiKV {
    static constexpr bool PERM = true;
    bf16_t* K; bf16_t* V; const float* stat;
    __device__ __forceinline__ void operator()(const f32x4 (&acc)[2][2][4][2], const Unit& u, int wr, int wc, int fr, int fq) const {
        const int row0 = u.row0 + wr * 64 + fr;
#pragma unroll
        for (int ai = 0; ai < 2; ++ai)
#pragma unroll
            for (int m = 0; m < 4; ++m) { const int row = row0 + ai * HALF + m * 16;
                float sc; { const f32x4* sp = (const f32x4*)(stat + (size_t)row * 24); const f32x4 a3 = sp[3], a4 = sp[4];
                    sc = rsqrtf((((a3[0] + a3[1]) + (a3[2] + a3[3])) + ((a4[0] + a4[1]) + (a4[2] + a4[3]))) * (1.f / 256.f) + 1e-6f); }
                const int krow = (row < 16384) ? ((row >> 12) * 4352 + 256 + (row & 4095)) : (((row - 16384) >> 8) * 4352 + ((row - 16384) & 255));
#pragma unroll
                for (int bj = 0; bj < 2; ++bj) { const int head = 2 * u.pn + bj; const f32x4 v0 = acc[ai][bj][m][0] * sc, v1 = acc[ai][bj][m][1] * sc;
                    u32x4 w; w.x = cvt_pk_bf16(v0[0], v0[1]); w.y = cvt_pk_bf16(v0[2], v0[3]); w.z = cvt_pk_bf16(v1[0], v1[1]); w.w = cvt_pk_bf16(v1[2], v1[3]);
                    if (wc < 2) *(u32x4*)(K + (size_t)krow * 768 + head * 96 + wc * 32 + 8 * fq) = w;
                    else *(u32x4*)(V + (size_t)krow * 512 + head * 64 + (wc - 2) * 32 + 8 * fq) = w; }
                asm volatile("" ::: "memory"); }
    }
};
}

template <class RowMap>
__device__ __forceinline__ void transpose_item(const float* W, int K, int N, int nblk, unsigned short* WT, const RowMap& rowmap, LAS float* scr, int item, int lane, const float* kscale = nullptr) {
    const int kb = item / nblk, nb = item % nblk, k0 = 64 * kb, n0 = 32 * nb;
    const int ncol = n0 + (lane & 31);
#pragma unroll 8
    for (int i = 0; i < 32; ++i) { const int kk = 2 * i + (lane >> 5); scr[kk * 33 + (lane & 31)] = (ncol < N) ? W[(size_t)(k0 + kk) * N + ncol] * (kscale ? kscale[k0 + kk] : 1.f) : 0.f; }
    asm volatile("s_waitcnt lgkmcnt(0)" ::: "memory");
    const int c = lane & 7;
    const int r0 = rowmap(n0);
#pragma unroll
    for (int j = 0; j < 4; ++j) { const int n = (lane >> 3) + 8 * j; const LAS float* sp = scr + (8 * c) * 33 + n;
        pg8::u32x4 o; o.x = pg8::cvt_pk_bf16(sp[0 * 33], sp[1 * 33]); o.y = pg8::cvt_pk_bf16(sp[2 * 33], sp[3 * 33]); o.z = pg8::cvt_pk_bf16(sp[4 * 33], sp[5 * 33]); o.w = pg8::cvt_pk_bf16(sp[6 * 33], sp[7 * 33]);
        *(pg8::u32x4*)(WT + (size_t)(r0 + n) * K + k0 + 8 * c) = o; }
    asm volatile("s_waitcnt lgkmcnt(0)" ::: "memory");
}


namespace att {
using bf16x8 = __attribute__((ext_vector_type(8))) short;
using s16x4  = __attribute__((ext_vector_type(4))) short;
using f32x16 = __attribute__((ext_vector_type(16))) float;
using u32x4  = __attribute__((ext_vector_type(4))) unsigned;
constexpr int NW = 8, QBLK = 32, KVBLK = 64;
constexpr float SCALE = 0.10206207261596577f;
constexpr float THR = 8.f;
constexpr int LDQ = 768, LDK = 768, LDV = 512, LDO = 1024;
constexpr int SHM_V = KVBLK * 64 * 2, SHM_K = KVBLK * 256;
constexpr int SHM_ATTN = 2 * SHM_V + 2 * SHM_K + NW * 64 * 4;
#define KSWZ(row, colB) ((row) * 256 + ((colB) ^ (((row) & 7) << 4)))
#define SBAR() __builtin_amdgcn_sched_barrier(0)
__device__ __forceinline__ int crow(int r, int hi) { return (r & 3) + 8 * (r >> 2) + 4 * hi; }
__device__ __forceinline__ unsigned cvtpk(float lo, float hi) { unsigned r; asm volatile("v_cvt_pk_bf16_f32 %0, %1, %2" : "=v"(r) : "v"(lo), "v"(hi)); return r; }

__device__ __forceinline__ void partialSM(f32x16& p0, f32x16& p1, float& m_reg, float& mn, float& alpha) {
  constexpr float C = SCALE * 1.4426950408889634f;
  float pmax = p0[0]; for (int r = 1; r < 16; ++r) pmax = fmaxf(pmax, p0[r]); for (int r = 0; r < 16; ++r) pmax = fmaxf(pmax, p1[r]);
  { auto rr = __builtin_amdgcn_permlane32_swap(__float_as_uint(pmax), __float_as_uint(pmax), false, false);
    pmax = fmaxf(__uint_as_float(rr[0]), __uint_as_float(rr[1])); }
  if (__builtin_expect(__all(pmax - m_reg <= THR / SCALE), 1)) { mn = m_reg; alpha = 1.f; }
  else { mn = fmaxf(m_reg, pmax); alpha = __builtin_amdgcn_exp2f((m_reg - mn) * C); m_reg = mn; }
  float mnC = -mn * C;
  for (int r = 0; r < 16; ++r) p0[r] = fmaf(p0[r], C, mnC); for (int r = 0; r < 16; ++r) p1[r] = fmaf(p1[r], C, mnC);
  for (int r = 0; r < 16; ++r) p0[r] = __builtin_amdgcn_exp2f(p0[r]);
}
__device__ __forceinline__ void finishSM(f32x16& p0, f32x16& p1, float alpha, float& l_reg, bf16x8& pa0, bf16x8& pa1, bf16x8& pa2, bf16x8& pa3) {
  for (int r = 0; r < 16; ++r) p1[r] = __builtin_amdgcn_exp2f(p1[r]);
  float ps = 0; for (int r = 0; r < 16; ++r) ps += p0[r]; for (int r = 0; r < 16; ++r) ps += p1[r];
  { auto rr = __builtin_amdgcn_permlane32_swap(__float_as_uint(ps), __float_as_uint(ps), false, false);
    ps = __uint_as_float(rr[0]) + __uint_as_float(rr[1]); }
  l_reg = l_reg * alpha + ps;
#define PK4(P, BASE, OUT) do { unsigned a0 = cvtpk(P[BASE + 0], P[BASE + 1]), a1 = cvtpk(P[BASE + 2], P[BASE + 3]);   \
    unsigned b0 = cvtpk(P[BASE + 4], P[BASE + 5]), b1 = cvtpk(P[BASE + 6], P[BASE + 7]);                              \
    auto r0 = __builtin_amdgcn_permlane32_swap(a0, b0, false, false); auto r1 = __builtin_amdgcn_permlane32_swap(a1, b1, false, false); \
    u32x4 w = {r0[0], r1[0], r0[1], r1[1]}; OUT = *reinterpret_cast<bf16x8*>(&w); } while (0)
  PK4(p0, 0, pa0); PK4(p0, 8, pa1); PK4(p1, 0, pa2); PK4(p1, 8, pa3);
#undef PK4
}
__device__ __forceinline__ void qkt(f32x16& p0, f32x16& p1, const char* Ks, const bf16x8* qr, int r32, int hi) {
  p0 = f32x16{}; p1 = f32x16{};
#pragma unroll
  for (int d0 = 0; d0 < 6; ++d0) { int cb = (d0 * 16 + hi * 8) * 2;
    bf16x8 b0 = *reinterpret_cast<const bf16x8*>(Ks + KSWZ(r32, cb));
    bf16x8 b1 = *reinterpret_cast<const bf16x8*>(Ks + KSWZ(32 + r32, cb));
    p0 = __builtin_amdgcn_mfma_f32_32x32x16_bf16(b0, qr[d0], p0, 0, 0, 0);
    p1 = __builtin_amdgcn_mfma_f32_32x32x16_bf16(b1, qr[d0], p1, 0, 0, 0); }
}
__device__ __forceinline__ int v_st(int k, int c) { const int kk = (k & ~0xC) | ((k & 4) << 1) | ((k & 8) >> 1); return ((kk >> 3) * 2 + (c >> 5)) * 512 + ((kk & 7) * 32 + (c & 31)) * 2; }
__device__ __forceinline__ int v_rd_base(int lane) { return ((lane & 3) << 3) | (((lane >> 2) & 3) << 6) | (((lane >> 4) & 1) << 5) | (((lane >> 5) & 1) << 8); }
constexpr int v_rd_off(int d0, int ks, int half) { return d0 * 512 + ks * 2048 + half * 1024; }
template <int OFF> __device__ __forceinline__ s16x4 tr_read(int vb) {
  s16x4 r; asm volatile("ds_read_b64_tr_b16 %0, %1 offset:%2" : "=&v"(r) : "v"(vb), "i"(OFF) : "memory"); return r;
}
template <int D0> __device__ __forceinline__ void pv_one(f32x16& od, int vb, bf16x8 pa0, bf16x8 pa1, bf16x8 pa2, bf16x8 pa3) {
  const s16x4 l0 = tr_read<v_rd_off(D0, 0, 0)>(vb), h0 = tr_read<v_rd_off(D0, 0, 1)>(vb), l1 = tr_read<v_rd_off(D0, 1, 0)>(vb), h1 = tr_read<v_rd_off(D0, 1, 1)>(vb);
  const s16x4 l2 = tr_read<v_rd_off(D0, 2, 0)>(vb), h2 = tr_read<v_rd_off(D0, 2, 1)>(vb), l3 = tr_read<v_rd_off(D0, 3, 0)>(vb), h3 = tr_read<v_rd_off(D0, 3, 1)>(vb);
  asm volatile("s_waitcnt lgkmcnt(0)" ::: "memory"); SBAR();
#define PK(L, H) (bf16x8){L[0], L[1], L[2], L[3], H[0], H[1], H[2], H[3]}
  od = __builtin_amdgcn_mfma_f32_32x32x16_bf16(pa0, PK(l0, h0), od, 0, 0, 0);
  od = __builtin_amdgcn_mfma_f32_32x32x16_bf16(pa1, PK(l1, h1), od, 0, 0, 0);
  od = __builtin_amdgcn_mfma_f32_32x32x16_bf16(pa2, PK(l2, h2), od, 0, 0, 0);
  od = __builtin_amdgcn_mfma_f32_32x32x16_bf16(pa3, PK(l3, h3), od, 0, 0, 0);
#undef PK
}
__device__ __forceinline__ void pv_d0(f32x16* o, int vb, bf16x8 pa0, bf16x8 pa1, bf16x8 pa2, bf16x8 pa3) {
  pv_one<0>(o[0], vb, pa0, pa1, pa2, pa3); pv_one<1>(o[1], vb, pa0, pa1, pa2, pa3);
}
__device__ __forceinline__ void attn_body(const unsigned short* __restrict__ Qb, const unsigned short* __restrict__ Kh, const unsigned short* __restrict__ Vh,
                                          unsigned short* __restrict__ Ob, int seq, char* lds) {
  const int tid = threadIdx.x, wid = tid >> 6, lane = tid & 63, r32 = lane & 31, hi = lane >> 5;
  char* V_lds = lds; char* K_lds = lds + 2 * SHM_V;
  float* ws = (float*)(lds + 2 * SHM_V + 2 * SHM_K) + wid * 64; float* li_l = ws; float* al_l = ws + 32;
  float m_reg = -1e30f, l_reg = 0; f32x16 o[2] = {}; bf16x8 qr[6];
  const unsigned short* Qw = Qb + (long)(wid * QBLK + r32) * LDQ + hi * 8;
#pragma unroll
  for (int d0 = 0; d0 < 6; ++d0) qr[d0] = *reinterpret_cast<const bf16x8*>(Qw + d0 * 16);
  const int vr = tid >> 3, vc = (tid & 7) * 8, vst = v_st(vr, vc);
  const int k0r = tid / 12, k0c = tid % 12, id1 = 512 + (tid & 255), k1r = id1 / 12, k1c = id1 % 12;
  const int kst0 = KSWZ(k0r, k0c * 16), kst1 = KSWZ(k1r, k1c * 16);
  const long vg = (long)vr * LDV + vc, kg0 = (long)k0r * LDK + k0c * 8, kg1 = (long)k1r * LDK + k1c * 8;
  const int vb0 = (int)(uintptr_t)V_lds + v_rd_base(lane);
  struct { bf16x8 vs, ks0, ks1; } sr_[2];
#define SLOAD(i, kk0) do { sr_[i].vs = *reinterpret_cast<const bf16x8*>(Vh + (long)(kk0) * LDV + vg); \
    sr_[i].ks0 = *reinterpret_cast<const bf16x8*>(Kh + (long)(kk0) * LDK + kg0); sr_[i].ks1 = *reinterpret_cast<const bf16x8*>(Kh + (long)(kk0) * LDK + kg1); } while (0)
#define SWRITE(b, i) do { *(bf16x8*)(V_lds + (b) * SHM_V + vst) = sr_[i].vs; \
    *(bf16x8*)(K_lds + (b) * SHM_K + kst0) = sr_[i].ks0; *(bf16x8*)(K_lds + (b) * SHM_K + kst1) = sr_[i].ks1; } while (0)
#define SWAIT() asm volatile("s_waitcnt vmcnt(3)" ::: "memory")
#define RESC(a) do { if (__any((a) < 1.f)) { if (hi == 0) al_l[r32] = (a); asm volatile("s_waitcnt lgkmcnt(0)" ::: "memory"); \
    for (int d = 0; d < 2; ++d) for (int r = 0; r < 16; ++r) o[d][r] *= al_l[crow(r, hi)]; } } while (0)
  f32x16 pA0, pA1, pB0, pB1; float mnA, mnB, alA, alB; bf16x8 pa0, pa1, pa2, pa3; const int NT = seq / KVBLK;
  constexpr int SE = 0, SO = 1;
  SLOAD(SE, 0); asm volatile("s_waitcnt vmcnt(0)" ::: "memory"); SWRITE(0, SE); __syncthreads();
  qkt(pA0, pA1, K_lds, qr, r32, hi); partialSM(pA0, pA1, m_reg, mnA, alA);
  SLOAD(SO, KVBLK); if (2 < NT) SLOAD(SE, 2 * KVBLK);
  SWAIT(); SWRITE(1, SO); __syncthreads();
  for (int j = 1; j + 1 < NT; j += 2) {
    SBAR(); qkt(pB0, pB1, K_lds + SHM_K, qr, r32, hi);
    finishSM(pA0, pA1, alA, l_reg, pa0, pa1, pa2, pa3); SBAR();
    SLOAD(SO, (j + 2) * KVBLK); SBAR();
    pv_d0(o, vb0, pa0, pa1, pa2, pa3); partialSM(pB0, pB1, m_reg, mnB, alB);
    __syncthreads(); SWAIT(); SWRITE(0, SE);
    RESC(alB); __syncthreads();
    SBAR(); qkt(pA0, pA1, K_lds, qr, r32, hi);
    finishSM(pB0, pB1, alB, l_reg, pa0, pa1, pa2, pa3); SBAR();
    if (j + 3 < NT) SLOAD(SE, (j + 3) * KVBLK); SBAR();
    pv_d0(o, vb0 + SHM_V, pa0, pa1, pa2, pa3); partialSM(pA0, pA1, m_reg, mnA, alA);
    __syncthreads(); SWAIT(); SWRITE(1, SO);
    RESC(alA); __syncthreads();
  }
  SBAR(); qkt(pB0, pB1, K_lds + SHM_K, qr, r32, hi);
  finishSM(pA0, pA1, alA, l_reg, pa0, pa1, pa2, pa3); SBAR();
  pv_d0(o, vb0, pa0, pa1, pa2, pa3); partialSM(pB0, pB1, m_reg, mnB, alB);
  __syncthreads(); RESC(alB);
  finishSM(pB0, pB1, alB, l_reg, pa0, pa1, pa2, pa3); SBAR();
  pv_d0(o, vb0 + SHM_V, pa0, pa1, pa2, pa3);
  if (hi == 0) li_l[r32] = l_reg; asm volatile("s_waitcnt lgkmcnt(0)" ::: "memory");
  float rli[16];
#pragma unroll
  for (int r = 0; r < 16; ++r) rli[r] = __builtin_amdgcn_rcpf(li_l[crow(r, hi)]);
  unsigned short* Ow = Ob + (long)(wid * QBLK) * LDO;
#pragma unroll
  for (int r = 0; r < 16; ++r) { int orow = crow(r, hi);
#pragma unroll
    for (int d0 = 0; d0 < 2; ++d0) Ow[(long)orow * LDO + d0 * 32 + r32] = (unsigned short)(cvtpk(o[d0][r] * rli[r], 0.f) & 0xffffu); }
  __syncthreads();
#undef SLOAD
#undef SWRITE
#undef SWAIT
#undef RESC
}
#undef KSWZ
#undef SBAR
}


namespace ml {
using bf16x8 = __attribute__((ext_vector_type(8))) short;
using s16x4  = __attribute__((ext_vector_type(4))) short;
using f32x16 = __attribute__((ext_vector_type(16))) float;
using f32x4  = __attribute__((ext_vector_type(4))) float;
using u32x4  = __attribute__((ext_vector_type(4))) unsigned;
constexpr float L2E = 1.4426950408889634f;
constexpr int NXC = 34;
__device__ __forceinline__ int crow(int r, int hi) { return (r & 3) + 8 * (r >> 2) + 4 * hi; }
__device__ __forceinline__ unsigned cvtpk(float lo, float hi) { unsigned r; asm volatile("v_cvt_pk_bf16_f32 %0, %1, %2" : "=v"(r) : "v"(lo), "v"(hi)); return r; }
template <int NC> __device__ __forceinline__ int t_st(int k, int c) { const int kk = (k & ~0xC) | ((k & 4) << 1) | ((k & 8) >> 1); return ((kk >> 3) * NC + (c >> 5)) * 512 + ((kk & 7) * 32 + (c & 31)) * 2; }
__device__ __forceinline__ int t_rd_base(int lane) { return ((lane & 3) << 3) | (((lane >> 2) & 3) << 6) | (((lane >> 4) & 1) << 5) | (((lane >> 5) & 1) << 8); }
template <int NC> constexpr int t_rd_off(int d0, int ks, int half) { return d0 * 512 + ks * (NC * 1024) + half * (NC * 512); }
template <int OFF> __device__ __forceinline__ s16x4 tr_read(int vb) { s16x4 r; asm volatile("ds_read_b64_tr_b16 %0, %1 offset:%2" : "=&v"(r) : "v"(vb), "i"(OFF) : "memory"); return r; }
#define ML_PK(L, H) (bf16x8){L[0], L[1], L[2], L[3], H[0], H[1], H[2], H[3]}
#define ML_KS(row, colB) ((row) * 128 + ((colB) ^ (((row) & 7) << 4)))
__device__ __forceinline__ int chunk_row(int b, int X, int i) { return X < 2 ? (16384 + b * 256 + X * 128 + i) : (b * 4096 + (X - 2) * 128 + i); }
__device__ __forceinline__ float lsig(float x) { return fminf(x, 0.f) - __logf(1.f + __expf(-fabsf(x))); }

__device__ __forceinline__ void gate_prep(const float* GATES, const float* bg, int b, int h, int X, LAS float* cum, LAS float* av, LAS float* pm, LAS float* wsr, LAS float* tot, int wave, int lane) {
    if (wave < 2) {
        const int dir = wave;
        const int e0 = dir ? (127 - 2 * lane) : (2 * lane), e1 = dir ? (126 - 2 * lane) : (2 * lane + 1);
        const int r0 = chunk_row(b, X, e0), r1 = chunk_row(b, X, e1);
        const float bi = bg[(2 * dir) * 4 + h], bf = bg[(2 * dir + 1) * 4 + h];
        const float li0 = GATES[(size_t)r0 * 16 + (2 * dir) * 4 + h] + bi, li1 = GATES[(size_t)r1 * 16 + (2 * dir) * 4 + h] + bi;
        const float x0 = lsig(GATES[(size_t)r0 * 16 + (2 * dir + 1) * 4 + h] + bf), x1 = lsig(GATES[(size_t)r1 * 16 + (2 * dir + 1) * 4 + h] + bf);
        float sc = x0 + x1;
#pragma unroll
        for (int o = 1; o < 64; o <<= 1) { const float y = __shfl_up(sc, o); if (lane >= o) sc += y; }
        const float c1 = sc, c0 = sc - x1; const float total = __shfl(sc, 63);
        const float a0 = li0 - c0, a1 = li1 - c1;
        float mx = fmaxf(a0, a1);
#pragma unroll
        for (int o = 1; o < 64; o <<= 1) { const float y = __shfl_up(mx, o); if (lane >= o) mx = fmaxf(mx, y); }
        float prev = __shfl_up(mx, 1); if (lane == 0) prev = -3.0e38f;
        cum[dir * 128 + e0] = c0; cum[dir * 128 + e1] = c1; av[dir * 128 + e0] = a0; av[dir * 128 + e1] = a1;
        pm[dir * 128 + e0] = fmaxf(prev, a0); pm[dir * 128 + e1] = mx;
        wsr[dir * 128 + e0] = total - c0 + li0; wsr[dir * 128 + e1] = total - c1 + li1;
        if (lane == 0) tot[dir] = total;
    }
}

__device__ __forceinline__ void stepA_unit(const unsigned short* P16, const float* GATES, const float* bg, int bh, int X, float* CLOC, float* NLOC, float* MLOC, float* TOT, char* lds) {
    const int tid = threadIdx.x, wave = __builtin_amdgcn_readfirstlane(tid >> 6), lane = tid & 63, r32 = lane & 31, hi = lane >> 5;
    const int b = bh >> 2, h = bh & 3;
    LAS float* fa = (LAS float*)(lds + 65536);
    LAS float* cum = fa, *av = fa + 256, *pm = fa + 512, *wsr = fa + 768, *tot = fa + 1024, *wl = fa + 1040, *mlo = fa + 1296, *npart = fa + 1312;
    gate_prep(GATES, bg, b, h, X, cum, av, pm, wsr, tot, wave, lane);
    __syncthreads();
    if (wave < 2) {
        const int dir = wave; const float w0 = wsr[dir * 128 + lane], w1 = wsr[dir * 128 + 64 + lane];
        float mx = fmaxf(w0, w1);
#pragma unroll
        for (int o = 1; o < 64; o <<= 1) mx = fmaxf(mx, __shfl_xor(mx, o));
        wl[dir * 128 + lane] = __expf(w0 - mx); wl[dir * 128 + 64 + lane] = __expf(w1 - mx);
        if (lane == 0) { mlo[dir] = mx; MLOC[(bh * NXC + X) * 2 + dir] = mx; TOT[(bh * NXC + X) * 2 + dir] = tot[dir]; }
    }
    __syncthreads();
#pragma unroll
    for (int j = 0; j < 4; ++j) { const int id = tid + 512 * j, row = id >> 4, ch = id & 15;
        const bf16x8 v = *reinterpret_cast<const bf16x8*>(P16 + (size_t)chunk_row(b, X, row) * 2304 + 1184 + h * 128 + ch * 8);
        *(bf16x8*)(lds + t_st<4>(row, ch * 8)) = v; }
#pragma unroll
    for (int j = 0; j < 2; ++j) { const int id = tid + 512 * j, row = id >> 3, ch = id & 7;
        const u32x4 kv = *reinterpret_cast<const u32x4*>(P16 + (size_t)chunk_row(b, X, row) * 2304 + 928 + h * 64 + ch * 8);
        const float wf = wl[row], wb = wl[128 + row];
        u32x4 of, ob;
#pragma unroll
        for (int q = 0; q < 4; ++q) { const float lo = __uint_as_float(kv[q] << 16), hi2 = __uint_as_float(kv[q] & 0xffff0000u); of[q] = cvtpk(lo * wf, hi2 * wf); ob[q] = cvtpk(lo * wb, hi2 * wb); }
        *(u32x4*)(lds + 32768 + t_st<2>(row, ch * 8)) = of; *(u32x4*)(lds + 49152 + t_st<2>(row, ch * 8)) = ob; }
    __syncthreads();
    {
        const int dir = wave >> 2, mb = wave & 3;
        const int vb = (int)(uintptr_t)lds + t_rd_base(lane) + mb * 512;
        const int kb = (int)(uintptr_t)lds + 32768 + dir * 16384 + t_rd_base(lane);
        f32x16 acc0 = {}, acc1 = {};
#define ML_A_STEP(KS) do { \
        const s16x4 vl = tr_read<t_rd_off<4>(0, KS, 0)>(vb), vh = tr_read<t_rd_off<4>(0, KS, 1)>(vb); \
        const s16x4 k0l = tr_read<t_rd_off<2>(0, KS, 0)>(kb), k0h = tr_read<t_rd_off<2>(0, KS, 1)>(kb), k1l = tr_read<t_rd_off<2>(1, KS, 0)>(kb), k1h = tr_read<t_rd_off<2>(1, KS, 1)>(kb); \
        asm volatile("s_waitcnt lgkmcnt(0)" ::: "memory"); __builtin_amdgcn_sched_barrier(0); \
        acc0 = __builtin_amdgcn_mfma_f32_32x32x16_bf16(ML_PK(vl, vh), ML_PK(k0l, k0h), acc0, 0, 0, 0); \
        acc1 = __builtin_amdgcn_mfma_f32_32x32x16_bf16(ML_PK(vl, vh), ML_PK(k1l, k1h), acc1, 0, 0, 0); } while (0)
        ML_A_STEP(0); ML_A_STEP(1); ML_A_STEP(2); ML_A_STEP(3); ML_A_STEP(4); ML_A_STEP(5); ML_A_STEP(6); ML_A_STEP(7);
#undef ML_A_STEP
        float* dst = CLOC + ((size_t)(bh * NXC + X) * 2 + dir) * 8192;
#pragma unroll
        for (int r = 0; r < 16; ++r) { const int dv = 32 * mb + crow(r, hi); dst[dv * 64 + r32] = acc0[r]; dst[dv * 64 + 32 + r32] = acc1[r]; }
    }
    {
        const int dir = tid >> 8, part = (tid >> 6) & 3, d = tid & 63; float a = 0.f;
        for (int i = 0; i < 32; ++i) { const int row = part * 32 + i; a = fmaf(wl[dir * 128 + row], bf2f(P16[(size_t)chunk_row(b, X, row) * 2304 + 928 + h * 64 + d]), a); }
        npart[(dir * 4 + part) * 64 + d] = a;
    }
    __syncthreads();
    if (tid < 128) { const int dir = tid >> 6, d = tid & 63; NLOC[((size_t)(bh * NXC + X) * 2 + dir) * 64 + d] = (npart[(dir * 4 + 0) * 64 + d] + npart[(dir * 4 + 1) * 64 + d]) + (npart[(dir * 4 + 2) * 64 + d] + npart[(dir * 4 + 3) * 64 + d]); }
    __syncthreads();
}

__device__ __forceinline__ int scanX(int dir, int j) { return dir ? (j == 0 ? 1 : (j == 1 ? 0 : 35 - j)) : j; }
__device__ __forceinline__ void stepB(const float* CLOC, const float* NLOC, const float* MLOC, const float* TOT, unsigned* CIN, float* NIN, float* MIN, int gtid, int gthreads) {
    for (int it = gtid; it < 32 * 4096 + 32 * 64; it += gthreads) {
        const bool isn = it >= 32 * 4096;
        const int sq = isn ? (it - 32 * 4096) >> 6 : it >> 12, e = isn ? (it - 32 * 4096) & 63 : it & 4095;
        const int bh = sq >> 1, dir = sq & 1;
        float c0 = 0.f, c1 = 0.f, m = 0.f;
#pragma unroll 2
        for (int j = 0; j < NXC; ++j) {
            const int X = scanX(dir, j);
            if (X >= 2) {
                const size_t ci = (size_t)(bh * 32 + (X - 2)) * 2 + dir;
                if (isn) { NIN[ci * 64 + e] = c0; if (e == 0) MIN[ci] = m; }
                else CIN[ci * 4096 + e] = cvtpk(c0, c1);
            }
            const size_t li = (size_t)(bh * NXC + X) * 2 + dir;
            const float tot = TOT[li], mloc = MLOC[li];
            const float mn = fmaxf(tot + m, mloc), dec = __expf(tot + m - mn), scl = __expf(mloc - mn);
            if (isn) c0 = dec * c0 + scl * NLOC[li * 64 + e];
            else { const float2 v = *(const float2*)(CLOC + li * 8192 + 2 * e); c0 = dec * c0 + scl * v.x; c1 = dec * c1 + scl * v.y; }
            m = mn;
        }
    }
}

__device__ __forceinline__ void stepC_unit(const unsigned short* P16, const float* GATES, const float* bg, const unsigned short* CIN, const float* NIN, const float* MIN, const float* mng,
                                           unsigned short* MIX16, int bh, int c, char* lds) {
    const int tid = threadIdx.x, wave = __builtin_amdgcn_readfirstlane(tid >> 6), lane = tid & 63, r32 = lane & 31, hi = lane >> 5;
    const int b = bh >> 2, h = bh & 3, X = c + 2;
    LAS float* fa = (LAS float*)(lds + 114688);
    LAS float* cum = fa, *av = fa + 256, *pm = fa + 512, *wsr = fa + 768, *tot = fa + 1024, *scl = fa + 1040;
    LAS float* hb = (LAS float*)(lds + 49152);
    gate_prep(GATES, bg, b, h, X, cum, av, pm, wsr, tot, wave, lane);
#pragma unroll
    for (int j = 0; j < 2; ++j) { const int id = tid + 512 * j, row = id >> 3, ch = id & 7;
        const bf16x8 kv = *reinterpret_cast<const bf16x8*>(P16 + (size_t)chunk_row(b, X, row) * 2304 + 928 + h * 64 + ch * 8);
        *(bf16x8*)(lds + ML_KS(row, ch * 16)) = kv; }
#pragma unroll
    for (int j = 0; j < 4; ++j) { const int id = tid + 512 * j, row = id >> 4, ch = id & 15;
        const bf16x8 v = *reinterpret_cast<const bf16x8*>(P16 + (size_t)chunk_row(b, X, row) * 2304 + 1184 + h * 128 + ch * 8);
        *(bf16x8*)(lds + 16384 + t_st<4>(row, ch * 8)) = v; }
    __syncthreads();
    const int dir = wave >> 2, tb = wave & 3;
    const int t = 32 * tb + r32;
    const size_t ci = (size_t)(bh * 32 + c) * 2 + dir;
    const float min2 = MIN[ci] * L2E;
    const float el2 = fmaxf(min2, pm[dir * 128 + t] * L2E);
    const float wint = __builtin_amdgcn_exp2f(min2 - el2);
    bf16x8 qr[4];
    {
        const unsigned short* qp = P16 + (size_t)chunk_row(b, X, t) * 2304 + 672 + h * 64 + hi * 8;
#pragma unroll
        for (int ks = 0; ks < 4; ++ks) qr[ks] = *reinterpret_cast<const bf16x8*>(qp + ks * 16);
    }
    f32x16 o[4] = {}; float den = 0.f;
    const int vb = (int)(uintptr_t)lds + 16384 + t_rd_base(lane);
    const char* Kl = lds;
#define ML_C_BLOCK(SB) do { if (dir ? (SB >= tb) : (SB <= tb)) { \
        f32x16 p = {}; \
        _Pragma("unroll") for (int ks = 0; ks < 4; ++ks) { const bf16x8 kf = *reinterpret_cast<const bf16x8*>(Kl + ML_KS(32 * SB + r32, (ks * 16 + hi * 8) * 2)); p = __builtin_amdgcn_mfma_f32_32x32x16_bf16(kf, qr[ks], p, 0, 0, 0); } \
        _Pragma("unroll") for (int g = 0; g < 4; ++g) { const f32x4 a4 = *(const LAS f32x4*)(av + dir * 128 + 32 * SB + 8 * g + 4 * hi); \
            _Pragma("unroll") for (int i = 0; i < 4; ++i) { const int sidx = 32 * SB + 8 * g + 4 * hi + i; const bool ok = dir ? (sidx >= t) : (sidx <= t); \
                const float f = __builtin_amdgcn_exp2f(a4[i] * L2E - el2) * 0.125f; p[4 * g + i] = ok ? p[4 * g + i] * f : 0.f; den += p[4 * g + i]; } } \
        bf16x8 pa0, pa1; \
        { unsigned a0 = cvtpk(p[0], p[1]), a1 = cvtpk(p[2], p[3]), b0 = cvtpk(p[4], p[5]), b1 = cvtpk(p[6], p[7]); \
          auto r0 = __builtin_amdgcn_permlane32_swap(a0, b0, false, false); auto r1 = __builtin_amdgcn_permlane32_swap(a1, b1, false, false); u32x4 w = {r0[0], r1[0], r0[1], r1[1]}; pa0 = *reinterpret_cast<bf16x8*>(&w); } \
        { unsigned a0 = cvtpk(p[8], p[9]), a1 = cvtpk(p[10], p[11]), b0 = cvtpk(p[12], p[13]), b1 = cvtpk(p[14], p[15]); \
          auto r0 = __builtin_amdgcn_permlane32_swap(a0, b0, false, false); auto r1 = __builtin_amdgcn_permlane32_swap(a1, b1, false, false); u32x4 w = {r0[0], r1[0], r0[1], r1[1]}; pa1 = *reinterpret_cast<bf16x8*>(&w); } \
        ML_C_PV(0, SB, pa0, pa1); ML_C_PV(1, SB, pa0, pa1); ML_C_PV(2, SB, pa0, pa1); ML_C_PV(3, SB, pa0, pa1); } } while (0)
#define ML_C_PV(D0, SB, PA0, PA1) do { \
        const s16x4 l0 = tr_read<t_rd_off<4>(D0, 2 * SB, 0)>(vb), h0 = tr_read<t_rd_off<4>(D0, 2 * SB, 1)>(vb), l1 = tr_read<t_rd_off<4>(D0, 2 * SB + 1, 0)>(vb), h1 = tr_read<t_rd_off<4>(D0, 2 * SB + 1, 1)>(vb); \
        asm volatile("s_waitcnt lgkmcnt(0)" ::: "memory"); __builtin_amdgcn_sched_barrier(0); \
        o[D0] = __builtin_amdgcn_mfma_f32_32x32x16_bf16(PA0, ML_PK(l0, h0), o[D0], 0, 0, 0); \
        o[D0] = __builtin_amdgcn_mfma_f32_32x32x16_bf16(PA1, ML_PK(l1, h1), o[D0], 0, 0, 0); } while (0)
    ML_C_BLOCK(0); ML_C_BLOCK(1); ML_C_BLOCK(2); ML_C_BLOCK(3);
#undef ML_C_BLOCK
#undef ML_C_PV
    float ndot = 0.f;
    {
        bf16x8 qw[4];
        const float* np = NIN + ci * 64 + hi * 8;
#pragma unroll
        for (int ks = 0; ks < 4; ++ks) { const u32x4 q4 = *reinterpret_cast<const u32x4*>(&qr[ks]);
            const f32x4 n0 = *(const f32x4*)(np + ks * 16), n1 = *(const f32x4*)(np + ks * 16 + 4);
            u32x4 w4;
#pragma unroll
            for (int q = 0; q < 4; ++q) { const float lo = __uint_as_float(q4[q] << 16), hi2 = __uint_as_float(q4[q] & 0xffff0000u);
                const float nl = (q < 2) ? n0[2 * q] : n1[2 * q - 4], nh = (q < 2) ? n0[2 * q + 1] : n1[2 * q - 3];
                ndot = fmaf(lo, nl, ndot); ndot = fmaf(hi2, nh, ndot);
                w4[q] = cvtpk(lo * (0.125f * wint), hi2 * (0.125f * wint)); }
            qw[ks] = *reinterpret_cast<const bf16x8*>(&w4); }
        const unsigned short* cp = CIN + ci * 8192 + (size_t)r32 * 64 + hi * 8;
#pragma unroll
        for (int d0 = 0; d0 < 4; ++d0)
#pragma unroll
            for (int ks = 0; ks < 4; ++ks) { const bf16x8 cf = *reinterpret_cast<const bf16x8*>(cp + (size_t)d0 * 32 * 64 + ks * 16); o[d0] = __builtin_amdgcn_mfma_f32_32x32x16_bf16(qw[ks], cf, o[d0], 0, 0, 0); }
    }
    { auto rr = __builtin_amdgcn_permlane32_swap(__float_as_uint(den), __float_as_uint(den), false, false); den = __uint_as_float(rr[0]) + __uint_as_float(rr[1]); }
    { auto rr = __builtin_amdgcn_permlane32_swap(__float_as_uint(ndot), __float_as_uint(ndot), false, false); ndot = __uint_as_float(rr[0]) + __uint_as_float(rr[1]); }
    den += wint * 0.125f * ndot;
    const float sct = 1.f / fmaxf(fabsf(den), __builtin_amdgcn_exp2f(-cum[dir * 128 + t] * L2E - el2));
    if (hi == 0) scl[wave * 32 + r32] = sct;
    asm volatile("s_waitcnt lgkmcnt(0)" ::: "memory");
    if (dir == 1) {
#pragma unroll
        for (int r = 0; r < 16; ++r)
#pragma unroll
            for (int d0 = 0; d0 < 4; ++d0) hb[(32 * tb + crow(r, hi)) * 128 + 32 * d0 + r32] = o[d0][r] * scl[wave * 32 + crow(r, hi)];
    }
    __syncthreads();
    if (dir == 0) {
        const float* gn = mng + h * 128;
        const float g0 = gn[r32], g1 = gn[32 + r32], g2 = gn[64 + r32], g3 = gn[96 + r32];
#pragma unroll
        for (int r = 0; r < 16; ++r) { const int tt = 32 * tb + crow(r, hi);
            const float rsr = scl[wave * 32 + crow(r, hi)];
            const float v0 = o[0][r] * rsr + hb[tt * 128 + r32], v1 = o[1][r] * rsr + hb[tt * 128 + 32 + r32], v2 = o[2][r] * rsr + hb[tt * 128 + 64 + r32], v3 = o[3][r] * rsr + hb[tt * 128 + 96 + r32];
            float ss = (v0 * v0 + v1 * v1) + (v2 * v2 + v3 * v3);
#pragma unroll
            for (int of = 1; of < 32; of <<= 1) ss += __shfl_xor(ss, of);
            const float rstd = rsqrtf(ss * (1.f / 128.f) + 1e-6f);
            const size_t grow = (size_t)chunk_row(b, X, tt);
            const unsigned short* og = P16 + grow * 2304 + 1696 + h * 128 + r32;
            unsigned short* dst = MIX16 + grow * 1024 + 512 + h * 128 + r32;
            dst[0]  = (unsigned short)(cvtpk(v0 * rstd * g0 * __builtin_amdgcn_rcpf(1.f + __expf(-bf2f(og[0]))), 0.f) & 0xffffu);
            dst[32] = (unsigned short)(cvtpk(v1 * rstd * g1 * __builtin_amdgcn_rcpf(1.f + __expf(-bf2f(og[32]))), 0.f) & 0xffffu);
            dst[64] = (unsigned short)(cvtpk(v2 * rstd * g2 * __builtin_amdgcn_rcpf(1.f + __expf(-bf2f(og[64]))), 0.f) & 0xffffu);
            dst[96] = (unsigned short)(cvtpk(v3 * rstd * g3 * __builtin_amdgcn_rcpf(1.f + __expf(-bf2f(og[96]))), 0.f) & 0xffffu);
        }
    }
    __syncthreads();
}
#undef ML_PK
#undef ML_KS
}

constexpr int LDS_BYTES = 147456;
constexpr int N_PHASES = 12;

__global__ void __launch_bounds__(NT, 2) fwd_kernel(Params p) {
    extern __shared__ __attribute__((aligned(16))) unsigned char lds_raw[];
    float* lds = (float*)lds_raw;
    LAS unsigned* misc = (LAS unsigned*)(lds_raw + 131072 + 4096);
    const int tid = threadIdx.x, lane = tid & 63, wave = tid >> 6;
    const int bid = blockIdx.x, G = gridDim.x;
    unsigned char* ws = p.ws;
    unsigned* ctl = (unsigned*)(ws + WS_CTL);
    if (tid < 4) misc[tid] = 0u;
    __syncthreads();
    const bool single = (p.ph_hi - p.ph_lo) > 1;
    XcdBarrier bar; bar.bar = ctl + CW_BAR; bar.x = 0; bar.st = nullptr;
    if (single) bar = xcd_barrier_post(ctl + CW_BAR, (volatile LAS unsigned*)misc);
#ifndef PH_MASK
#define PH_MASK 0xFFFF
#endif
#define IN(k) ((((PH_MASK) >> (k)) & 1) && p.ph_lo <= (k) && (k) < p.ph_hi)
#define SEAM(k) do { if (IN(k) && IN((k) + 1)) xcd_barrier(bar); } while (0)
#define SEAM2(k) do { if (IN(k) && IN((k) + 2)) xcd_barrier(bar); } while (0)

    float* MOD = (float*)(ws + WS_MOD);
    float* NLOC = (float*)(ws + WS_MLS); float* MLOC = (float*)(ws + WS_MLS + 512 * 1024); float* TOT = (float*)(ws + WS_MLS + 576 * 1024); float* NIN = (float*)(ws + WS_MLS + 1 * MiB); float* MIN_ = (float*)(ws + WS_MLS + 1536 * 1024);
    float* CLOC = (float*)(ws + WS_CLOC); unsigned short* CIN = (unsigned short*)(ws + WS_CIN);
    float* ROPEC = (float*)(ws + WS_ROPE); float* ROPES = ROPEC + S * 16;
    int* TOPE = (int*)(ws + WS_TOPE); int* SLOT = (int*)(ws + WS_SLOT); int* LIST = (int*)(ws + WS_LIST); float* RGATE = (float*)(ws + WS_RGATE);
    unsigned short* Hb16 = (unsigned short*)(ws + WS_H); unsigned short* WinT = (unsigned short*)(ws + WS_WINT);
 unsigned short* Q16 = (unsigned short*)(ws + WS_Q); unsigned short* K16 = (unsigned short*)(ws + WS_KV); unsigned short* V16 = (unsigned short*)(ws + WS_KV + 32 * MiB);
    float* X1 = (float*)(ws + WS_X1); unsigned short* H2 = (unsigned short*)(ws + WS_H2);
    unsigned short* YG = (unsigned short*)(ws + WS_YG); unsigned short* ACT = (unsigned short*)(ws + WS_ACT);
    unsigned short* WguT = (unsigned short*)(ws + WS_WGUT); unsigned short* WdnT = (unsigned short*)(ws + WS_WDNT);
    unsigned short* WuqT = (unsigned short*)(ws + WS_WUQT); unsigned short* WukvT = (unsigned short*)(ws + WS_WUKVT); unsigned short* WoutT = (unsigned short*)(ws + WS_WOUTT);
    float* GATES = (float*)(ws + WS_GATES); float* STAT = (float*)(ws + WS_STAT); float* RSTD = (float*)(ws + WS_RSTD); unsigned short* MIX16 = (unsigned short*)(ws + WS_MIX16);
    unsigned short* P16 = (unsigned short*)(ws + WS_P);
    unsigned* CNT = ctl + CW_CNT;

    if (IN(0)) {
        const float* wmod = p.in[I_WMOD]; const float* bmod = p.in[I_BMOD];
        for (int idx = bid * NT + tid; idx < 5 * 6144; idx += G * NT) {
            const int r = idx / 6144, col = idx % 6144;
            const float* cv = (r < 4) ? p.in[I_C] + r * D : p.in[I_CCTX];
            float acc = 0.f;
            for (int k = 0; k < D; ++k) acc = fmaf(siluf_(cv[k]), wmod[(size_t)k * 6144 + col], acc);
            MOD[idx] = acc + bmod[col];
        }
        for (int e = bid * NT + tid; e < S * 16; e += G * NT) { float cs, sn; rope_angles(e >> 4, e & 15, cs, sn); ROPEC[e] = cs; ROPES[e] = sn; }
        {
            LAS float* scr = (LAS float*)(lds_raw + wave * 16384);
            const int gw = bid * 8 + wave, NGW = G * 8;
            for (int it = gw; it < (D / 64) * (PW / 32); it += NGW) transpose_item(p.in[I_WIN], D, INW, PW / 32, WinT, [](int n0) { return n0; }, scr, it, lane);
            for (int it = gw; it < (QL / 64) * (768 / 32); it += NGW) transpose_item(p.in[I_WUQ], QL, 768, 768 / 32, WuqT, [](int n0) { return n0; }, scr, it, lane, p.in[I_QNG]);
            for (int it = gw; it < (KVL / 64) * (1024 / 32); it += NGW) transpose_item(p.in[I_WUKV], KVL, 1024, 1024 / 32, WukvT, [](int n0) { return n0; }, scr, it, lane, p.in[I_KVNG]);
            for (int it = gw; it < (D / 64) * (D / 32); it += NGW) transpose_item(p.in[I_WOUT], D, D, D / 32, WoutT, [](int n0) { return n0; }, scr, it, lane);
            constexpr int IGU = (D / 64) * (2 * DFF / 32), IDN = (DFF / 64) * (D / 32);
            for (int it = gw; it < NE * (IGU + IDN); it += NGW) {
                const int e = it / (IGU + IDN), r = it % (IGU + IDN);
                if (r < IGU) transpose_item(p.in[I_WGU] + (size_t)e * D * 2 * DFF, D, 2 * DFF, 2 * DFF / 32, WguT + (size_t)e * 2 * DFF * D,
                                            [](int n0) { return n0 < DFF ? (n0 >> 7) * 256 + (n0 & 127) : ((n0 - DFF) >> 7) * 256 + 128 + ((n0 - DFF) & 127); }, scr, r, lane);
                else transpose_item(p.in[I_WDN] + (size_t)e * DFF * D, DFF, D, D / 32, WdnT + (size_t)e * D * DFF, [](int n0) { return n0; }, scr, r - IGU, lane);
            }
        }
    }
    SEAM(0);
    if (IN(1)) {
        const float* g1n = p.in[I_N1G];
        for (int r = bid * 8 + wave; r < MT; r += G * 8) {
            const float* src = (r < MX) ? p.in[I_X] + (size_t)r * D : p.in[I_CTX] + (size_t)(r - MX) * D;
            const int mb = (r < MX) ? r / S : 4;
            const float* sh = MOD + mb * 6144, *sc = sh + D;
            float v[16]; float ss = 0.f;
#pragma unroll
            for (int j = 0; j < 4; ++j) { const float4 t = *(const float4*)(src + j * 256 + lane * 4); v[4 * j] = t.x; v[4 * j + 1] = t.y; v[4 * j + 2] = t.z; v[4 * j + 3] = t.w; ss += t.x * t.x + t.y * t.y + t.z * t.z + t.w * t.w; }
            const float rstd = rsqrtf(wave_sum(ss) * (1.f / D) + EPS);
#pragma unroll
            for (int j = 0; j < 4; ++j) {
                const int c = j * 256 + lane * 4; float4 o;
                o.x = v[4 * j] * rstd * g1n[c] * (1.f + sc[c]) + sh[c];
                o.y = v[4 * j + 1] * rstd * g1n[c + 1] * (1.f + sc[c + 1]) + sh[c + 1];
                o.z = v[4 * j + 2] * rstd * g1n[c + 2] * (1.f + sc[c + 2]) + sh[c + 2];
                o.w = v[4 * j + 3] * rstd * g1n[c + 3] * (1.f + sc[c + 3]) + sh[c + 3];
                pg8::u32x2 w; w.x = pg8::cvt_pk_bf16(o.x, o.y); w.y = pg8::cvt_pk_bf16(o.z, o.w);
                *(pg8::u32x2*)(Hb16 + (size_t)r * D + c) = w;
            }
        }
    }
    SEAM(1);
    if (IN(2)) {
        pg8::PlainSched Sd; Sd.init(MT, PW, D, D, WinT, G, bid);
        pg8::EpiInproj E{P16, GATES, STAT, K16, ROPEC, ROPES};
        pg8::gemm_phase<pg8::EpiInproj, pg8::PlainSched, true>((LAS unsigned char*)lds_raw, Hb16, D, Sd, E);
    }
    SEAM2(2);
    if (IN(4)) {
#ifndef NO_QG
        { pg8::PlainSched Sd; Sd.init(MX, 768, QL, PW, WuqT, G, bid);
          pg8::EpiQ E{Q16, STAT, ROPEC, ROPES};
          pg8::gemm_phase<pg8::EpiQ, pg8::PlainSched, true>((LAS unsigned char*)lds_raw, P16 + O_CQ, QL, Sd, E); }
#endif
#ifndef NO_KVG
        { pg8::PlainSched Sd; Sd.init(MT, 1024, KVL, PW, WukvT, G, bid);
          pg8::EpiKV E{K16, V16, STAT};
          pg8::gemm_phase<pg8::EpiKV, pg8::PlainSched, true>((LAS unsigned char*)lds_raw, P16 + O_CKV, KVL, Sd, E); }
#endif
        for (int u = bid; u < 16 * ml::NXC; u += G) ml::stepA_unit(P16, GATES, p.in[I_BG], u / ml::NXC, u % ml::NXC, CLOC, NLOC, MLOC, TOT, (char*)lds_raw);
    }
    SEAM(4);
    if (IN(5)) {
        ml::stepB(CLOC, NLOC, MLOC, TOT, (unsigned*)CIN, NIN, MIN_, bid * NT + tid, G * NT);
        {
            const int nun = NB * HA * (S / 256);
            for (int i = 0; i * G < nun; ++i) {
                int bh, qb;
                if (G == 256) { const int x = bid & 7, slot = bid >> 3; bh = i * 16 + x * 2 + (slot >> 4); qb = slot & 15; }
                else { const int u = i * G + bid; if (u >= nun) break; bh = u >> 4; qb = u & 15; }
                const int b = bh >> 3, h = bh & 7;
                att::attn_body(Q16 + (size_t)(b * S + qb * 256) * 768 + h * 96, K16 + (size_t)(b * SKV) * 768 + h * 96, V16 + (size_t)(b * SKV) * 512 + h * 64,
                               MIX16 + (size_t)(b * S + qb * 256) * D + h * 64, SKV, (char*)lds_raw);
            }
        }
    }
    SEAM(5);
    if (IN(6)) {
        for (int u = bid; u < 16 * 32; u += G) ml::stepC_unit(P16, GATES, p.in[I_BG], CIN, NIN, MIN_, p.in[I_MNG], MIX16, u >> 5, u & 31, (char*)lds_raw);
    }
    SEAM(6);
    if (IN(7)) {
        pg8::PlainSched Sd; Sd.init(MX, D, D, D, WoutT, G, bid);
        pg8::EpiResid E{X1, p.in[I_X], MOD};
        pg8::gemm_phase<pg8::EpiResid, pg8::PlainSched, true>((LAS unsigned char*)lds_raw, MIX16, D, Sd, E);
    }
    SEAM(7);
    if (IN(8)) {
        const float* g2n = p.in[I_N2G]; const float* rw = p.in[I_RW]; const float* rb = p.in[I_RB];
        for (int r = bid * 8 + wave; r < MX; r += G * 8) {
            const float* src = X1 + (size_t)r * D; const int mb = r / S;
            const float* sh = MOD + mb * 6144 + 3 * D, *sc = MOD + mb * 6144 + 4 * D;
            float v[16]; float ss = 0.f;
#pragma unroll
            for (int j = 0; j < 4; ++j) { const float4 t = *(const float4*)(src + j * 256 + lane * 4); v[4 * j] = t.x; v[4 * j + 1] = t.y; v[4 * j + 2] = t.z; v[4 * j + 3] = t.w; ss += t.x * t.x + t.y * t.y + t.z * t.z + t.w * t.w; }
            const float rstd = rsqrtf(wave_sum(ss) * (1.f / D) + EPS);
#pragma unroll
            for (int j = 0; j < 4; ++j) {
#pragma unroll
                for (int i = 0; i < 4; ++i) { const int c = j * 256 + lane * 4 + i; v[4 * j + i] = v[4 * j + i] * rstd * g2n[c] * (1.f + sc[c]) + sh[c]; }
                { pg8::u32x2 w; w.x = pg8::cvt_pk_bf16(v[4 * j], v[4 * j + 1]); w.y = pg8::cvt_pk_bf16(v[4 * j + 2], v[4 * j + 3]); *(pg8::u32x2*)(H2 + (size_t)r * D + j * 256 + lane * 4) = w; }
            }
            float mylg = 0.f;
#pragma unroll 1
            for (int e = 0; e < 32; ++e) {
                float a = 0.f;
#pragma unroll
                for (int j = 0; j < 4; ++j)
#pragma unroll
                    for (int i = 0; i < 4; ++i) a = fmaf(v[4 * j + i], rw[(size_t)(j * 256 + lane * 4 + i) * NE + e], a);
                const float tot = wave_sum(a) + rb[e];
                if ((lane & 31) == e) mylg = tot;
            }
            int ti[4]; float tv[4];
#pragma unroll
            for (int k = 0; k < 4; ++k) {
                float val = mylg; int idx = lane & 31;
#pragma unroll
                for (int o = 1; o < 64; o <<= 1) { const float ov = __shfl_xor(val, o); const int oi = __shfl_xor(idx, o); if (ov > val || (ov == val && oi < idx)) { val = ov; idx = oi; } }
                ti[k] = idx; tv[k] = val;
                if ((lane & 31) == idx) mylg = -3.0e38f;
            }
            const float e0 = 1.f, e1 = expf(tv[1] - tv[0]), e2 = expf(tv[2] - tv[0]), e3 = expf(tv[3] - tv[0]);
            const float inv = 1.f / (e0 + e1 + e2 + e3);
            if (lane < 4) {
                const int e = lane == 0 ? ti[0] : lane == 1 ? ti[1] : lane == 2 ? ti[2] : ti[3];
                const float gv = (lane == 0 ? e0 : lane == 1 ? e1 : lane == 2 ? e2 : e3) * inv;
                const unsigned pos = atomicAdd(&CNT[e], 1u);
                TOPE[r * 4 + lane] = e; SLOT[r * 4 + lane] = (int)pos; LIST[e * MX + pos] = r; RGATE[e * MX + pos] = gv;
            }
        }
    }
    SEAM(8);
    LAS int* mtp = (LAS int*)(lds_raw + 131072); LAS int* mro = mtp + 40; LAS int* mcn = mro + 40;
    if (IN(9) || IN(10) || IN(11)) {
        __syncthreads();
        if (tid == 0) { int tp = 0; for (int e = 0; e < NE; ++e) { const int cnt = (int)__hip_atomic_load(&CNT[e], __ATOMIC_RELAXED, __HIP_MEMORY_SCOPE_AGENT); mcn[e] = cnt; mtp[e] = tp; mro[e] = tp * 256; tp += (cnt + 255) / 256; } mtp[NE] = tp; mro[NE] = tp * 256; }
        __syncthreads();
    }
    if (IN(9)) {
        pg8::MoeSched Sd{mtp, mro, mcn, DFF / 128, G, bid, D, D, 1, LIST, (const char*)WguT, (size_t)2 * DFF * D * 2};
        pg8::EpiSwiglu E{ACT, p.in[I_BGU]};
        pg8::gemm_phase<pg8::EpiSwiglu, pg8::MoeSched, true>((LAS unsigned char*)lds_raw, H2, D, Sd, E);
    }
    SEAM(9);
    if (IN(10)) {
        pg8::MoeSched Sd{mtp, mro, mcn, D / 256, G, bid, DFF, DFF, 0, LIST, (const char*)WdnT, (size_t)D * DFF * 2};
        pg8::EpiDown E{YG, p.in[I_BDN], RGATE, mro};
        pg8::gemm_phase<pg8::EpiDown, pg8::MoeSched, true>((LAS unsigned char*)lds_raw, ACT, DFF, Sd, E);
    }
    SEAM(10);
    if (IN(11)) {
        const float* fng = p.in[I_FNG];
        for (int r = bid * 8 + wave; r < MX; r += G * 8) {
            const int mb = r / S; const float* g2 = MOD + mb * 6144 + 5 * D;
            float acc[16];
#pragma unroll
            for (int i = 0; i < 16; ++i) acc[i] = 0.f;
#pragma unroll
            for (int k = 0; k < 4; ++k) {
                const int e = TOPE[r * 4 + k]; const int row = mro[e] + SLOT[r * 4 + k];
                const unsigned short* yr = YG + (size_t)row * D;
#pragma unroll
                for (int j = 0; j < 4; ++j) { const pg8::u32x2 t = *(const pg8::u32x2*)(yr + j * 256 + lane * 4);
                    acc[4 * j] += __uint_as_float(t.x << 16); acc[4 * j + 1] += __uint_as_float(t.x & 0xffff0000u); acc[4 * j + 2] += __uint_as_float(t.y << 16); acc[4 * j + 3] += __uint_as_float(t.y & 0xffff0000u); }
            }
            float v[16]; float ss = 0.f;
#pragma unroll
            for (int j = 0; j < 4; ++j) { const float4 t = *(const float4*)(X1 + (size_t)r * D + j * 256 + lane * 4); const int c = j * 256 + lane * 4;
                v[4 * j] = t.x + g2[c] * acc[4 * j]; v[4 * j + 1] = t.y + g2[c + 1] * acc[4 * j + 1]; v[4 * j + 2] = t.z + g2[c + 2] * acc[4 * j + 2]; v[4 * j + 3] = t.w + g2[c + 3] * acc[4 * j + 3];
                ss += v[4 * j] * v[4 * j] + v[4 * j + 1] * v[4 * j + 1] + v[4 * j + 2] * v[4 * j + 2] + v[4 * j + 3] * v[4 * j + 3]; }
            const float rstd = rsqrtf(wave_sum(ss) * (1.f / D) + EPS);
#pragma unroll
            for (int j = 0; j < 4; ++j) { const int c = j * 256 + lane * 4;
                *(float4*)(p.out + (size_t)r * D + c) = make_float4(v[4 * j] * rstd * fng[c], v[4 * j + 1] * rstd * fng[c + 1], v[4 * j + 2] * rstd * fng[c + 2], v[4 * j + 3] * rstd * fng[c + 3]); }
        }
    }
#undef IN
#undef SEAM
}

#ifndef N_LAUNCH_SPLIT
#define N_LAUNCH_SPLIT 0
#endif

extern "C" void kernel_launch(void* const* d_in, const int* in_sizes, int n_in, void* d_out, int out_size, void* d_ws, size_t ws_size, hipStream_t stream) {
    static int grid = 0;
    if (grid == 0) {
        if (n_in != 23 || out_size != MX * D || ws_size < WS_END) { fprintf(stderr, "kernel_launch: unexpected shapes n_in %d out %d ws %zu (need %zu)\n", n_in, out_size, ws_size, (size_t)WS_END); grid = -1; return; }
        int dev = 0, cus = 0, per_cu = 0;
        hipGetDevice(&dev); hipDeviceGetAttribute(&cus, hipDeviceAttributeMultiprocessorCount, dev);
        if (hipFuncSetAttribute((const void*)fwd_kernel, hipFuncAttributeMaxDynamicSharedMemorySize, LDS_BYTES) != hipSuccess) { fprintf(stderr, "kernel_launch: hipFuncSetAttribute failed\n"); grid = -1; return; }
        hipOccupancyMaxActiveBlocksPerMultiprocessor(&per_cu, (const void*)fwd_kernel, NT, LDS_BYTES);
        if (per_cu < 1) fprintf(stderr, "kernel_launch: occupancy query says %d\n", per_cu);
        (void)hipGetLastError();
        grid = cus > 0 ? cus : 256;
    }
    if (grid < 0) return;
    hipMemsetAsync((char*)d_ws + WS_CTL, 0, CTL_BYTES, stream);
    Params p{};
    for (int i = 0; i < 23; ++i) p.in[i] = (const float*)d_in[i];
    p.out = (float*)d_out; p.ws = (unsigned char*)d_ws;
#if N_LAUNCH_SPLIT
    for (int k = 0; k < N_PHASES; ++k) { p.ph_lo = k; p.ph_hi = k + 1; hipLaunchKernelGGL(fwd_kernel, dim3(grid), dim3(NT), LDS_BYTES, stream, p); }
#else
    p.ph_lo = 0; p.ph_hi = N_PHASES;
    hipLaunchKernelGGL(fwd_kernel, dim3(grid), dim3(NT), LDS_BYTES, stream, p);
#endif
}
```

```cpp
#include <hip/hip_runtime.h>
#include <cstdio>
#include <cstdint>

#define LAS __attribute__((address_space(3)))

#define XB_TMO      128
#define XB_XCNT(j)  (256  + 64 * (j))
#define XB_XSUB(j)  (1280 + 64 * (j))
#define XB_XGEN(j)  (2304 + 64 * (j))
#define XB_TOP      3328
#define XB_TOPGEN   3392
#define XCD_BAR_WORDS 3456
#define XB_SPIN_CAP (1u << 22)

__device__ __forceinline__ unsigned xb_ld(unsigned* p)              { return __hip_atomic_load(p, __ATOMIC_RELAXED, __HIP_MEMORY_SCOPE_AGENT); }
__device__ __forceinline__ unsigned xb_add(unsigned* p, unsigned v) { return __hip_atomic_fetch_add(p, v, __ATOMIC_RELAXED, __HIP_MEMORY_SCOPE_AGENT); }
__device__ __forceinline__ unsigned xb_xcc_id() { return (unsigned)__builtin_amdgcn_s_getreg((3 << 11) | 20) & 0xFu; }
#define XB_SPIN(cond, bar) do { unsigned _sp = 0; while (cond) { __builtin_amdgcn_s_sleep(1); \
    if ((++_sp & 255u) == 0u) { if (xb_ld(&(bar)[XB_TMO])) break; if (_sp > XB_SPIN_CAP) { atomicAdd(&(bar)[XB_TMO], 1u); break; } } } } while (0)

struct XcdBarrier { unsigned* bar; unsigned x; volatile LAS unsigned* st; };

__device__ __forceinline__ XcdBarrier xcd_barrier_post(unsigned* bar, volatile LAS unsigned* st) {
    XcdBarrier b; b.bar = bar; b.x = xb_xcc_id(); b.st = st;
    if (threadIdx.x == 0) (void)xb_add(&bar[XB_XCNT(b.x)], 1u);
    return b;
}
__device__ __forceinline__ void xcd_barrier_complete(unsigned* bar, unsigned x, unsigned& nloc, unsigned& nx) {
    const unsigned G = gridDim.x * gridDim.y * gridDim.z;
    unsigned sum, cnt, mine, sp = 0u;
    for (;;) {
        sum = 0u; cnt = 0u; mine = 0u;
#pragma unroll
        for (unsigned j = 0; j < 16; ++j) { const unsigned c = xb_ld(&bar[XB_XCNT(j)]); sum += c; cnt += (c > 0u) ? 1u : 0u; mine = (j == x) ? c : mine; }
        if (sum == G) break;
        __builtin_amdgcn_s_sleep(1);
        if ((++sp & 255u) == 0u) { if (xb_ld(&bar[XB_TMO])) break; if (sp > XB_SPIN_CAP) { atomicAdd(&bar[XB_TMO], 1u); break; } }
    }
    nloc = mine > 0u ? mine : 1u; nx = cnt > 0u ? cnt : 1u;
}
__device__ __forceinline__ void xcd_barrier(const XcdBarrier& b) {
    asm volatile("s_waitcnt vmcnt(0)" ::: "memory");
    __syncthreads();
    if (threadIdx.x == 0) {
        unsigned* bar = b.bar;
        __builtin_amdgcn_s_waitcnt(0);
        unsigned nloc = b.st[0], nx = b.st[1];
        if (nloc == 0u) { xcd_barrier_complete(bar, b.x, nloc, nx); b.st[0] = nloc; b.st[1] = nx; }
        const unsigned old = xb_add(&bar[XB_XSUB(b.x)], 1u);
        const unsigned gen = old / nloc;
        if (old + 1u == (gen + 1u) * nloc) {
            __builtin_amdgcn_fence(__ATOMIC_RELEASE, "agent");
            asm volatile("s_waitcnt vmcnt(0)" ::: "memory");
            const unsigned og = xb_add(&bar[XB_TOP], 1u);
            const unsigned tg = og / nx;
            if (og + 1u == (tg + 1u) * nx) xb_add(&bar[XB_TOPGEN], 1u);
            else XB_SPIN(xb_ld(&bar[XB_TOPGEN]) == tg, bar);
            __builtin_amdgcn_fence(__ATOMIC_ACQUIRE, "agent");
            xb_add(&bar[XB_XGEN(b.x)], 1u);
            asm volatile("s_waitcnt vmcnt(0)" ::: "memory");
        } else {
            XB_SPIN(xb_ld(&bar[XB_XGEN(b.x)]) == gen, bar);
            __builtin_amdgcn_fence(__ATOMIC_ACQUIRE, "agent");
            asm volatile("s_waitcnt vmcnt(0)" ::: "memory");
        }
    }
    __syncthreads();
}

constexpr int D = 1024, NB = 4, S = 4096, CTX = 256, SKV = S + CTX;
constexpr int MX = NB * S, MC = NB * CTX, MT = MX + MC;
constexpr int INW = 2224, PW = 2304;
constexpr int O_CQ = 0, O_CKV = 384, O_KR = 640, O_MQ = 672, O_MK = 928, O_MV = 1184, O_MO = 1696, O_G = 2208;
constexpr int QL = 384, KVL = 256, HA = 8, DN = 64, DR = 32, DQK = 96, DVH = 64;
constexpr int NH = 4, MDQK = 64, MDV = 128;
constexpr int NE = 32, TOPK = 4, DFF = 1024;
constexpr float EPS = 1e-6f;
constexpr int NT = 512;
constexpr int NSEQ = NB * NH * 2;
constexpr int RCAP = MX * TOPK + NE * 256;

constexpr size_t MiB = 1u << 20;
constexpr size_t WS_CTL = 0, CTL_BYTES = 1 * MiB;
constexpr size_t WS_MOD = 1 * MiB;
constexpr size_t WS_MLS = 2 * MiB;
constexpr size_t WS_ROPE = 5 * MiB;
constexpr size_t WS_STAT2 = 6 * MiB;
constexpr size_t WS_TOPE = 8 * MiB;
constexpr size_t WS_SLOT = 9 * MiB;
constexpr size_t WS_LIST = 10 * MiB;
constexpr size_t WS_RGATE = 12 * MiB;
constexpr size_t WS_H = 16 * MiB;
constexpr size_t WS_P = 52 * MiB;
constexpr size_t WS_ACT = WS_P;
constexpr size_t WS_Q = 206 * MiB;
constexpr size_t WS_KV = 254 * MiB;
constexpr size_t WS_CLOC = 322 * MiB;
constexpr size_t WS_CIN = 386 * MiB;
constexpr size_t WS_X1 = 450 * MiB;
constexpr size_t WS_H2 = 514 * MiB;
constexpr size_t WS_YG = 546 * MiB;
constexpr size_t WS_WGUT = 690 * MiB;
constexpr size_t WS_WDNT = 818 * MiB;
constexpr size_t WS_WINT = 882 * MiB;
constexpr size_t WS_WUQT = 887 * MiB;
constexpr size_t WS_WUKVT = 888 * MiB;
constexpr size_t WS_WOUTT = 889 * MiB;
constexpr size_t WS_GATES = 891 * MiB;
constexpr size_t WS_STAT = 893 * MiB;
constexpr size_t WS_RSTD = 895 * MiB;
constexpr size_t WS_MIX16 = 896 * MiB;
constexpr size_t WS_END = 928 * MiB;
static_assert((size_t)MT * PW * 2 <= 153 * MiB && (size_t)RCAP * DFF * 2 <= 144 * MiB, "map");

constexpr int CW_BAR = 4096;
constexpr int CW_CNT = 16384;
constexpr int CW_QGU = 16384 + 64, CW_QDN = 16384 + 128;
constexpr int GU_CHUNKS = 512, DN_CHUNKS = 256;
#ifndef GU_STATIC
#define GU_STATIC 312
#endif

struct Params {
    const float* in[23];
    float* out;
    unsigned char* ws;
    int ph_lo, ph_hi;
};
enum { I_X = 0, I_C, I_CTX, I_CCTX, I_WMOD, I_BMOD, I_N1G, I_WIN, I_BG, I_QNG, I_WUQ, I_KVNG, I_WUKV, I_MNG, I_WOUT, I_N2G, I_RW, I_RB, I_WGU, I_BGU, I_WDN, I_BDN, I_FNG };

__device__ __forceinline__ float wave_sum(float v) {
#pragma unroll
    for (int o = 1; o < 64; o <<= 1) v += __shfl_xor(v, o);
    return v;
}
__device__ __forceinline__ float bf2f(unsigned short v) { return __uint_as_float(((unsigned)v) << 16); }
__device__ __forceinline__ float sigmoidf_(float x) { return 1.f / (1.f + __expf(-x)); }
__device__ __forceinline__ float siluf_(float x) { return x / (1.f + expf(-x)); }
__device__ __forceinline__ float logsigmoidf_(float x) { return fminf(x, 0.f) - log1pf(expf(-fabsf(x))); }

__device__ __forceinline__ int krow(int b, int key) { return key < CTX ? MX + b * CTX + key : b * S + (key - CTX); }
__device__ __forceinline__ int srow(int b, int dir, int u) {
    if (u < CTX) { const int c = dir ? (CTX - 1 - u) : u; return MX + b * CTX + c; }
    const int tt = u - CTX; const int s = dir ? (S - 1 - tt) : tt; return b * S + s;
}
__device__ __forceinline__ void rope_angles(int s, int j, float& cs, float& sn) {
    const int jj = j & 7; const float pos = (j < 8) ? (float)(s / 64) : (float)(s % 64);
    const float inv = powf(10000.f, -(float)jj / 8.f);
    const float ang = pos * inv; cs = cosf(ang); sn = sinf(ang);
}

struct GemmDesc { const float* A; int lda; const int* arow; int M; const float* B; int ldb; int N; int K; };
template <class Epi>
__device__ __forceinline__ void sgemm_tile(float* lds, const GemmDesc g, int tm, int tn, const Epi& epi) {
    float* As = lds;
    float* Bs = lds + 16 * 132;
    const int tid = threadIdx.x, tx = tid & 15, ty = tid >> 4;
    float acc[4][8];
#pragma unroll
    for (int i = 0; i < 4; ++i)
#pragma unroll
        for (int j = 0; j < 8; ++j) acc[i][j] = 0.f;
    const int ar = tid >> 2, ak = (tid & 3) * 4;
    const int grow = tm * 128 + ar;
    const float* aptr = nullptr;
    if (grow < g.M) { const int r = g.arow ? g.arow[grow] : grow; aptr = g.A + (size_t)r * g.lda + ak; }
    const int bk = tid >> 5, bc = (tid & 31) * 4;
    const int gcol = tn * 128 + bc;
    for (int k0 = 0; k0 < g.K; k0 += 16) {
        float4 av = make_float4(0.f, 0.f, 0.f, 0.f), bv = make_float4(0.f, 0.f, 0.f, 0.f);
        if (aptr) av = *(const float4*)(aptr + k0);
        if (gcol < g.N) bv = *(const float4*)(g.B + (size_t)(k0 + bk) * g.ldb + gcol);
        __syncthreads();
        As[(ak + 0) * 132 + ar] = av.x; As[(ak + 1) * 132 + ar] = av.y; As[(ak + 2) * 132 + ar] = av.z; As[(ak + 3) * 132 + ar] = av.w;
        *(float4*)(Bs + bk * 128 + bc) = bv;
        __syncthreads();
#pragma unroll
        for (int k = 0; k < 16; ++k) {
            const float4 a4 = *(const float4*)(As + k * 132 + ty * 4);
            const float4 b0 = *(const float4*)(Bs + k * 128 + tx * 8), b1 = *(const float4*)(Bs + k * 128 + tx * 8 + 4);
            const float a[4] = {a4.x, a4.y, a4.z, a4.w};
            const float b[8] = {b0.x, b0.y, b0.z, b0.w, b1.x, b1.y, b1.z, b1.w};
#pragma unroll
            for (int i = 0; i < 4; ++i)
#pragma unroll
                for (int j = 0; j < 8; ++j) acc[i][j] = fmaf(a[i], b[j], acc[i][j]);
        }
    }
#pragma unroll
    for (int i = 0; i < 4; ++i) {
        const int r = tm * 128 + ty * 4 + i;
        if (r < g.M) {
#pragma unroll
            for (int j = 0; j < 8; ++j) { const int c = tn * 128 + tx * 8 + j; if (c < g.N) epi(r, c, acc[i][j]); }
        }
    }
}
template <class Epi>
__device__ __forceinline__ void sgemm_phase(float* lds, const GemmDesc g, const Epi& epi, int u0 = 0, int ustride = 0) {
    const int ntm = (g.M + 127) / 128, ntn = (g.N + 127) / 128;
    for (int u = blockIdx.x; u < ntm * ntn; u += gridDim.x) sgemm_tile(lds, g, u / ntn, u % ntn, epi);
}


namespace pg8 {
#define PG8_LAS __attribute__((address_space(3)))
typedef unsigned short bf16_t;
typedef short bf16x8 __attribute__((ext_vector_type(8)));
typedef float f32x4 __attribute__((ext_vector_type(4)));
typedef unsigned u32x4 __attribute__((ext_vector_type(4)));
typedef unsigned u32x2 __attribute__((ext_vector_type(2)));
constexpr int BM = 256, BK = 64, HALF = 128, HTB = HALF * BK * 2, STAGE_BYTES = 8 * HTB, NXCD = 8, WGM = 8;
__host__ __device__ __forceinline__ int lds_byte(int r, int c) { const int st = (r >> 4) * 2 + (c >> 5), rr = r & 15, cc = c & 31, ob = rr * 64 + cc * 2; return st * 1024 + (ob ^ (((ob >> 9) & 1) << 5)); }
__host__ __device__ __forceinline__ void stage_rc(int b, int& R, int& C) { const int st = b / 1024, sb = b % 1024, swz = sb ^ (((sb >> 9) & 1) << 5); R = (st >> 1) * 16 + swz / 64; C = (st & 1) * 32 + (swz % 64) / 2; }
__host__ __device__ __forceinline__ int perm32(int rho) { const int n = rho >> 4, i = rho & 15; return 8 * (i >> 2) + 4 * n + (i & 3); }
__device__ __forceinline__ unsigned cvt_pk_bf16(float lo, float hi) { unsigned r; asm volatile("v_cvt_pk_bf16_f32 %0, %1, %2" : "=v"(r) : "v"(lo), "v"(hi)); return r; }

struct Unit { int pm, pn, g, row0; };

struct PlainSched {
    int nM, nN, nwg, G, c, lda, K; const char* Bt;
    __device__ void init(int M, int N, int K_, int lda_, const void* Bt_, int G_, int c_) { nM = M / BM; nN = N / BM; nwg = nM * nN; G = G_; c = c_; lda = lda_; K = K_; Bt = (const char*)Bt_; }
    __device__ __forceinline__ bool next(int i, Unit& u) const {
        const long L = (long)i * G + c; if (L >= nwg) return false;
        int wgid = (int)L; { const int q = nwg / NXCD, r = nwg % NXCD, xcd = wgid % NXCD, off = wgid / NXCD; wgid = (xcd < r ? xcd * (q + 1) : r * (q + 1) + (xcd - r) * q) + off; }
        const int nig = WGM * nN, gid = wgid / nig, fm = gid * WGM, gsz = (nM - fm) < WGM ? (nM - fm) : WGM;
        u.pm = fm + ((wgid % nig) % gsz); u.pn = (wgid % nig) / gsz; u.g = 0; u.row0 = u.pm * BM; return true;
    }
    __device__ __forceinline__ unsigned a_rowoff(const Unit& u, int r) const { return (unsigned)(u.pm * BM + r) * (unsigned)(lda * 2); }
    __device__ __forceinline__ const char* b_base(const Unit& u) const { return Bt + (size_t)u.pn * BM * K * 2; }
};

template <class Epi, class Sched, bool ALIGN_EPI>
__device__ __forceinline__ void gemm_phase(PG8_LAS unsigned char* lds, const bf16_t* Aptr, const int K, const Sched& S, const Epi& E) {
    const int tid = threadIdx.x, wid = __builtin_amdgcn_readfirstlane(tid >> 6), lane = tid & 63, wr = wid >> 2, wc = wid & 3, fr = lane & 15, fq = lane >> 4;
    const int nt = K / BK;
    unsigned voffB[2];
#pragma unroll
    for (int i = 0; i < 2; ++i) { int R, C; stage_rc(tid * 16 + i * 8192, R, C); const int Rb = Epi::PERM ? ((R & ~31) + perm32(R & 31)) : R;
        voffB[i] = (unsigned)(Rb * K + C) * 2u; }
    const size_t kstep = (size_t)(BK * 2);
    const size_t hstepB = (size_t)HALF * K * 2;
    const unsigned ldsw = (unsigned)wid * 1024u;
    const int aoff = lds_byte(wr * 64 + fr, fq * 8), boff = lds_byte(wc * 32 + fr, fq * 8);
#define PG8_SA(b, h) (((b) * 2 + (h)) * HTB)
#define PG8_SB(b, h) ((4 + (b) * 2 + (h)) * HTB)
#define PG8_STAGE(bufoff, gbase, voff) do { _Pragma("unroll") for (int _i = 0; _i < 2; ++_i) \
        __builtin_amdgcn_global_load_lds((const unsigned*)((const char*)(gbase) + (voff)[_i]), (PG8_LAS unsigned*)(lds + (bufoff) + ldsw + _i * 8192), 16, 0, 0); } while (0)
#define PG8_LDA(dst, b, h) do { _Pragma("unroll") for (int m = 0; m < 4; ++m) _Pragma("unroll") for (int k = 0; k < 2; ++k) dst[m][k] = *(const PG8_LAS bf16x8*)(lds + PG8_SA(b, h) + aoff + m * 2048 + k * 1024); } while (0)
#define PG8_LDB(dst, b, h) do { _Pragma("unroll") for (int n = 0; n < 2; ++n) _Pragma("unroll") for (int k = 0; k < 2; ++k) dst[n][k] = *(const PG8_LAS bf16x8*)(lds + PG8_SB(b, h) + boff + n * 2048 + k * 1024); } while (0)
#define PG8_MMA(ai, bj, At, Bt) do { __builtin_amdgcn_s_setprio(1); _Pragma("unroll") for (int m = 0; m < 4; ++m) _Pragma("unroll") for (int n = 0; n < 2; ++n) _Pragma("unroll") for (int k = 0; k < 2; ++k) \
        acc[ai][bj][m][n] = __builtin_amdgcn_mfma_f32_16x16x32_bf16(Bt[n][k], At[m][k], acc[ai][bj][m][n], 0, 0, 0); __builtin_amdgcn_s_setprio(0); } while (0)
#define PG8_WAIT_V(n) asm volatile("s_waitcnt vmcnt(" #n ")" ::: "memory")
#define PG8_WAIT_L(n) asm volatile("s_waitcnt lgkmcnt(" #n ")" ::: "memory")
#define PG8_BAR __builtin_amdgcn_s_barrier()
#define PG8_SCHED __builtin_amdgcn_sched_barrier(0)
    Unit cur, nxt; int ui = 0;
    if (!S.next(0, cur)) return;
    f32x4 acc[2][2][4][2];
#pragma unroll
    for (int a = 0; a < 2; ++a)
#pragma unroll
        for (int b = 0; b < 2; ++b)
#pragma unroll
            for (int m = 0; m < 4; ++m)
#pragma unroll
                for (int n = 0; n < 2; ++n) acc[a][b][m][n] = (f32x4){0.f, 0.f, 0.f, 0.f};
    bf16x8 At[4][2], B0[2][2], B1[2][2];
    unsigned oA0[2], oA1[2];
#pragma unroll
    for (int i = 0; i < 2; ++i) { int R, C; stage_rc(tid * 16 + i * 8192, R, C); oA0[i] = S.a_rowoff(cur, R) + (unsigned)C * 2u; oA1[i] = S.a_rowoff(cur, HALF + R) + (unsigned)C * 2u; }
    const char* const cA = (const char*)Aptr;
    const char* cB = S.b_base(cur);
    PG8_STAGE(PG8_SB(0, 0), cB, voffB); PG8_STAGE(PG8_SB(0, 1), cB + hstepB, voffB); PG8_STAGE(PG8_SA(0, 0), cA, oA0); PG8_STAGE(PG8_SA(0, 1), cA, oA1);
    if (wr == 1) PG8_BAR;
    PG8_WAIT_V(2); PG8_BAR;
    PG8_STAGE(PG8_SB(1, 0), cB + kstep, voffB); PG8_STAGE(PG8_SA(1, 0), cA + kstep, oA0); PG8_STAGE(PG8_SB(1, 1), cB + hstepB + kstep, voffB);
    PG8_WAIT_V(6); PG8_BAR;
    for (;;) {
        const bool has_next = S.next(ui + 1, nxt);
        const char* nB = has_next ? S.b_base(nxt) : cB;
#pragma unroll 1
        for (int t = 0; t < nt; t += 2) {
            const bool last = (t == nt - 2);
            const char* a1 = cA + (size_t)(t + 1) * kstep;
            const char* a2 = last ? cA : cA + (size_t)(t + 2) * kstep; const char* b2 = last ? nB : cB + (size_t)(t + 2) * kstep;
            const char* a3 = a2 + kstep; const char* b3 = b2 + kstep;
            PG8_LDB(B0, 0, 0); PG8_LDB(B1, 0, 1); PG8_SCHED; PG8_LDA(At, 0, 0); PG8_STAGE(PG8_SA(1, 1), a1, oA1);
            if (last && has_next) {
#pragma unroll
                for (int i = 0; i < 2; ++i) { int R, C; stage_rc((int)threadIdx.x * 16 + i * 8192, R, C); oA0[i] = S.a_rowoff(nxt, R) + (unsigned)C * 2u; oA1[i] = S.a_rowoff(nxt, HALF + R) + (unsigned)C * 2u; }
            }
            PG8_WAIT_V(8); PG8_WAIT_L(0); PG8_BAR; PG8_MMA(0, 0, At, B0); PG8_MMA(0, 1, At, B1); PG8_BAR; PG8_SCHED;
            PG8_LDA(At, 0, 1); PG8_STAGE(PG8_SB(0, 0), b2, voffB); PG8_STAGE(PG8_SB(0, 1), b2 + hstepB, voffB); PG8_STAGE(PG8_SA(0, 0), a2, oA0);
            PG8_WAIT_V(8); PG8_WAIT_L(0); PG8_BAR; PG8_MMA(1, 0, At, B0); PG8_MMA(1, 1, At, B1); PG8_BAR; PG8_SCHED;
            PG8_LDB(B0, 1, 0); PG8_LDB(B1, 1, 1); PG8_SCHED; PG8_LDA(At, 1, 0); PG8_STAGE(PG8_SA(0, 1), a2, oA1);
            PG8_WAIT_V(8); PG8_WAIT_L(0); PG8_BAR; PG8_MMA(0, 0, At, B0); PG8_MMA(0, 1, At, B1); PG8_BAR; PG8_SCHED;
            PG8_LDA(At, 1, 1); PG8_STAGE(PG8_SB(1, 0), b3, voffB); PG8_STAGE(PG8_SB(1, 1), b3 + hstepB, voffB); PG8_STAGE(PG8_SA(1, 0), a3, oA0);
            PG8_WAIT_V(8); PG8_WAIT_L(0); PG8_BAR; PG8_MMA(1, 0, At, B0); PG8_MMA(1, 1, At, B1); PG8_BAR; PG8_SCHED;
        }
        if constexpr (ALIGN_EPI) { if (wr == 0) PG8_BAR; }
        E(acc, cur, wr, wc, fr, fq);
        if (!has_next) break;
#pragma unroll
        for (int a = 0; a < 2; ++a)
#pragma unroll
            for (int b = 0; b < 2; ++b)
#pragma unroll
                for (int m = 0; m < 4; ++m)
#pragma unroll
                    for (int n = 0; n < 2; ++n) acc[a][b][m][n] = (f32x4){0.f, 0.f, 0.f, 0.f};
        cur = nxt; cB = nB; ++ui;
        if constexpr (ALIGN_EPI) { if (wr == 1) PG8_BAR; }
    }
    PG8_WAIT_V(0);
    if constexpr (!ALIGN_EPI) { if (wr == 0) PG8_BAR; }
    PG8_BAR;
#undef PG8_SA
#undef PG8_SB
#undef PG8_STAGE
#undef PG8_LDA
#undef PG8_LDB
#undef PG8_MMA
#undef PG8_WAIT_V
#undef PG8_WAIT_L
#undef PG8_BAR
#undef PG8_SCHED
}

struct EpiF32 {
    static constexpr bool PERM = false;
    float* C; int ldc; int ncols;
    __device__ __forceinline__ void operator()(const f32x4 (&acc)[2][2][4][2], const Unit& u, int wr, int wc, int fr, int fq) const {
        const int row0 = u.row0 + wr * 64 + fr, col0 = u.pn * BM + wc * 32 + 4 * fq;
#pragma unroll
        for (int ai = 0; ai < 2; ++ai)
#pragma unroll
            for (int m = 0; m < 4; ++m) { float* rowp = C + (size_t)(row0 + ai * HALF + m * 16) * ldc + col0;
#pragma unroll
                for (int bj = 0; bj < 2; ++bj)
#pragma unroll
                    for (int n = 0; n < 2; ++n) if (col0 + bj * HALF + n * 16 < ncols) *(f32x4*)(rowp + bj * HALF + n * 16) = acc[ai][bj][m][n]; }
    }
};
struct MoeSched {
    const PG8_LAS int* tp; const PG8_LAS int* ro; const PG8_LAS int* cn; int nN, G, c, K, lda, gather; const int* list; const char* Bt; size_t bstride;
    __device__ __forceinline__ bool next(int i, Unit& u) const {
        const int nwg = tp[32] * nN; const long L = (long)i * G + c; if (L >= nwg) return false;
        int wgid = (int)L; { const int q = nwg / NXCD, r = nwg % NXCD, xcd = wgid % NXCD, off = wgid / NXCD; wgid = (xcd < r ? xcd * (q + 1) : r * (q + 1) + (xcd - r) * q) + off; }
        const int tile = wgid / nN; int g = 0;
#pragma unroll 1
        for (int e = 1; e < 32; ++e) g = (tp[e] <= tile) ? e : g;
        const int ntm = tp[g + 1] - tp[g]; const int rem = wgid - tp[g] * nN;
        u.g = g; u.pm = rem % ntm; u.pn = rem / ntm; u.row0 = ro[g] + u.pm * BM; return true;
    }
    __device__ __forceinline__ unsigned a_rowoff(const Unit& u, int r) const {
        const int rr = u.pm * BM + r;
        if (gather) { const int tok = (rr < cn[u.g]) ? list[u.g * 16384 + rr] : 0; return (unsigned)tok * (unsigned)(lda * 2); }
        return (unsigned)(u.row0 + r) * (unsigned)(lda * 2);
    }
    __device__ __forceinline__ const char* b_base(const Unit& u) const { return Bt + (size_t)u.g * bstride + (size_t)u.pn * BM * K * 2; }
};
struct EpiSwiglu {
    static constexpr bool PERM = true;
    bf16_t* O; const float* bias;
    __device__ __forceinline__ void operator()(const f32x4 (&acc)[2][2][4][2], const Unit& u, int wr, int wc, int fr, int fq) const {
        const int row0 = u.row0 + wr * 64 + fr, col0 = u.pn * 128 + wc * 32 + 8 * fq;
        const float* bg = bias + (size_t)u.g * 2048 + col0;
        f32x4 bgl[2], bln[2];
#pragma unroll
        for (int n = 0; n < 2; ++n) { bgl[n] = *(const f32x4*)(bg + 4 * n); bln[n] = *(const f32x4*)(bg + 1024 + 4 * n); }
#pragma unroll
        for (int ai = 0; ai < 2; ++ai)
#pragma unroll
            for (int m = 0; m < 4; ++m) {
                float o[8];
#pragma unroll
                for (int n = 0; n < 2; ++n)
#pragma unroll
                    for (int j = 0; j < 4; ++j) {
                        const float gl = fminf(acc[ai][0][m][n][j] + bgl[n][j], 7.f);
                        const float ln = fminf(fmaxf(acc[ai][1][m][n][j] + bln[n][j], -7.f), 7.f);
                        o[4 * n + j] = gl * __builtin_amdgcn_rcpf(1.f + __expf(-1.702f * gl)) * (ln + 1.f);
                    }
                u32x4 w; w.x = cvt_pk_bf16(o[0], o[1]); w.y = cvt_pk_bf16(o[2], o[3]); w.z = cvt_pk_bf16(o[4], o[5]); w.w = cvt_pk_bf16(o[6], o[7]);
                *(u32x4*)(O + (size_t)(row0 + ai * HALF + m * 16) * 1024 + col0) = w;
            }
    }
};
struct EpiDown {
    static constexpr bool PERM = true;
    bf16_t* O; const float* bias; const float* rgate; const PG8_LAS int* ro;
    __device__ __forceinline__ void operator()(const f32x4 (&acc)[2][2][4][2], const Unit& u, int wr, int wc, int fr, int fq) const {
        const int row0 = u.row0 + wr * 64 + fr, col0 = u.pn * BM + wc * 32 + 8 * fq;
        const float* bd = bias + (size_t)u.g * 1024 + col0;
        const float* gt = rgate + (size_t)u.g * 16384 + (row0 - ro[u.g]);
        f32x4 bv[2][2];
#pragma unroll
        for (int bj = 0; bj < 2; ++bj)
#pragma unroll
            for (int n = 0; n < 2; ++n) bv[bj][n] = *(const f32x4*)(bd + bj * HALF + 4 * n);
#pragma unroll
        for (int ai = 0; ai < 2; ++ai)
#pragma unroll
            for (int m = 0; m < 4; ++m) {
                const float gv = gt[ai * HALF + m * 16];
                bf16_t* rowp = O + (size_t)(row0 + ai * HALF + m * 16) * 1024 + col0;
#pragma unroll
                for (int bj = 0; bj < 2; ++bj) { const f32x4 v0 = (acc[ai][bj][m][0] + bv[bj][0]) * gv, v1 = (acc[ai][bj][m][1] + bv[bj][1]) * gv;
                    u32x4 w; w.x = cvt_pk_bf16(v0[0], v0[1]); w.y = cvt_pk_bf16(v0[2], v0[3]); w.z = cvt_pk_bf16(v1[0], v1[1]); w.w = cvt_pk_bf16(v1[2], v1[3]);
                    *(u32x4*)(rowp + bj * HALF) = w; }
            }
    }
};
struct EpiInproj {
    static constexpr bool PERM = true;
    bf16_t* P; float* gates; float* stat; bf16_t* Kb; const float* cs; const float* sn;
    __device__ __forceinline__ void operator()(const f32x4 (&acc)[2][2][4][2], const Unit& u, int wr, int wc, int fr, int fq) const {
        const int row0 = u.row0 + wr * 64 + fr, colb = u.pn * BM + wc * 32 + 8 * fq;
#pragma unroll
        for (int ai = 0; ai < 2; ++ai)
#pragma unroll
            for (int m = 0; m < 4; ++m) { const int row = row0 + ai * HALF + m * 16;
#pragma unroll
                for (int bj = 0; bj < 2; ++bj) { const f32x4 v0 = acc[ai][bj][m][0], v1 = acc[ai][bj][m][1];
                    u32x4 w; w.x = cvt_pk_bf16(v0[0], v0[1]); w.y = cvt_pk_bf16(v0[2], v0[3]); w.z = cvt_pk_bf16(v1[0], v1[1]); w.w = cvt_pk_bf16(v1[2], v1[3]);
                    *(u32x4*)(P + (size_t)row * 2304 + colb + bj * HALF) = w;
                    if (u.pn <= 2) { float sq = (v0[0] * v0[0] + v0[1] * v0[1]) + (v0[2] * v0[2] + v0[3] * v0[3]) + (v1[0] * v1[0] + v1[1] * v1[1]) + (v1[2] * v1[2] + v1[3] * v1[3]);
                        sq += __shfl_xor(sq, 16); sq += __shfl_xor(sq, 32);
                        if (fq == 0) stat[(size_t)row * 24 + (u.pn * 2 + bj) * 4 + wc] = sq; }
                    if (u.pn == 8 && bj == 1 && wc == 1 && fq < 2) { *(f32x4*)(gates + (size_t)row * 16 + fq * 8) = v0; *(f32x4*)(gates + (size_t)row * 16 + fq * 8 + 4) = v1; }
                    if (u.pn == 2 && bj == 1 && wc == 0) {
                        f32x4 r0 = v0, r1 = v1;
                        f32x4 o0, o1;
#pragma unroll
                        for (int j = 0; j < 4; ++j) { o0[j] = __shfl_xor(v0[j], 32); o1[j] = __shfl_xor(v1[j], 32); }
                        int krow;
                        if (row < 16384) { const int pos = row & 4095; const int jb = 8 * (fq & 1);
                            const f32x4 c0 = *(const f32x4*)(cs + pos * 16 + jb), c1 = *(const f32x4*)(cs + pos * 16 + jb + 4), s0 = *(const f32x4*)(sn + pos * 16 + jb), s1 = *(const f32x4*)(sn + pos * 16 + jb + 4);
                            if (fq < 2) { r0 = v0 * c0 - o0 * s0; r1 = v1 * c1 - o1 * s1; } else { r0 = o0 * s0 + v0 * c0; r1 = o1 * s1 + v1 * c1; }
                            krow = (row >> 12) * 4352 + 256 + pos; }
                        else krow = ((row - 16384) >> 8) * 4352 + ((row - 16384) & 255);
                        u32x4 kw; kw.x = cvt_pk_bf16(r0[0], r0[1]); kw.y = cvt_pk_bf16(r0[2], r0[3]); kw.z = cvt_pk_bf16(r1[0], r1[1]); kw.w = cvt_pk_bf16(r1[2], r1[3]);
#pragma unroll
                        for (int hh = 0; hh < 8; ++hh) *(u32x4*)(Kb + (size_t)krow * 768 + hh * 96 + 64 + 8 * fq) = kw;
                    }
                } }
    }
};
struct EpiF32RowScale {
    static constexpr bool PERM = false;
    float* C; int ldc; const float* rs;
    __device__ __forceinline__ void operator()(const f32x4 (&acc)[2][2][4][2], const Unit& u, int wr, int wc, int fr, int fq) const {
        const int row0 = u.row0 + wr * 64 + fr, col0 = u.pn * BM + wc * 32 + 4 * fq;
#pragma unroll
        for (int ai = 0; ai < 2; ++ai)
#pragma unroll
            for (int m = 0; m < 4; ++m) { const int row = row0 + ai * HALF + m * 16; const float sc = rs[row]; float* rowp = C + (size_t)row * ldc + col0;
#pragma unroll
                for (int bj = 0; bj < 2; ++bj)
#pragma unroll
                    for (int n = 0; n < 2; ++n) *(f32x4*)(rowp + bj * HALF + n * 16) = acc[ai][bj][m][n] * sc; }
    }
};
struct EpiResid {
    static constexpr bool PERM = false;
    float* C; const float* X; const float* mod; float* stat2;
    __device__ __forceinline__ void operator()(const f32x4 (&acc)[2][2][4][2], const Unit& u, int wr, int wc, int fr, int fq) const {
        const int row0 = u.row0 + wr * 64 + fr, col0 = u.pn * BM + wc * 32 + 4 * fq;
        const float* g1 = mod + (size_t)(u.row0 / 4096) * 6144 + 2048 + col0;
        f32x4 gv[2][2];
#pragma unroll
        for (int bj = 0; bj < 2; ++bj)
#pragma unroll
            for (int n = 0; n < 2; ++n) gv[bj][n] = *(const f32x4*)(g1 + bj * HALF + n * 16);
#pragma unroll
        for (int ai = 0; ai < 2; ++ai)
#pragma unroll
            for (int m = 0; m < 4; ++m) { const size_t off = (size_t)(row0 + ai * HALF + m * 16) * 1024 + col0;
#pragma unroll
                for (int bj = 0; bj < 2; ++bj) { float sq = 0.f;
#pragma unroll
                    for (int n = 0; n < 2; ++n) { const f32x4 xv = *(const f32x4*)(X + off + bj * HALF + n * 16); const f32x4 o = xv + gv[bj][n] * acc[ai][bj][m][n]; *(f32x4*)(C + off + bj * HALF + n * 16) = o;
                        sq += (o[0] * o[0] + o[1] * o[1]) + (o[2] * o[2] + o[3] * o[3]); }
                    sq += __shfl_xor(sq, 16); sq += __shfl_xor(sq, 32);
                    if (fq == 0) stat2[(size_t)(row0 + ai * HALF + m * 16) * 32 + (u.pn * 2 + bj) * 4 + wc] = sq; }
                asm volatile("" ::: "memory"); }
    }
};
struct EpiQ {
    static constexpr bool PERM = false;
    bf16_t* Q; const float* stat; const float* cs; const float* sn;
    __device__ __forceinline__ void operator()(const f32x4 (&acc)[2][2][4][2], const Unit& u, int wr, int wc, int fr, int fq) const {
        const int row0 = u.row0 + wr * 64 + fr;
#pragma unroll
        for (int ai = 0; ai < 2; ++ai)
#pragma unroll
            for (int m = 0; m < 4; ++m) { const int row = row0 + ai * HALF + m * 16; const int pos = row & 4095;
                float sc; { const f32x4* sp = (const f32x4*)(stat + (size_t)row * 24); const f32x4 a0 = sp[0], a1 = sp[1], a2 = sp[2];
                    sc = rsqrtf((((a0[0] + a0[1]) + (a0[2] + a0[3])) + ((a1[0] + a1[1]) + (a1[2] + a1[3])) + ((a2[0] + a2[1]) + (a2[2] + a2[3]))) * (1.f / 384.f) + 1e-6f); }
                const f32x4 cv = *(const f32x4*)(cs + pos * 16 + 4 * fq), sv = *(const f32x4*)(sn + pos * 16 + 4 * fq);
#pragma unroll
                for (int bj = 0; bj < 2; ++bj) { const int c32 = u.pn * BM + bj * HALF + wc * 32; const bool rope = ((c32 % 96) == 64);
                    f32x4 v0 = acc[ai][bj][m][0], v1 = acc[ai][bj][m][1];
                    if (rope) { const f32x4 a = v0 * cv - v1 * sv, b = v0 * sv + v1 * cv; v0 = a; v1 = b; }
                    v0 = v0 * sc; v1 = v1 * sc;
                    u32x2 w0, w1; w0.x = cvt_pk_bf16(v0[0], v0[1]); w0.y = cvt_pk_bf16(v0[2], v0[3]); w1.x = cvt_pk_bf16(v1[0], v1[1]); w1.y = cvt_pk_bf16(v1[2], v1[3]);
                    bf16_t* dst = Q + (size_t)row * 768 + c32 + 4 * fq;
                    *(u32x2*)dst = w0; *(u32x2*)(dst + 16) = w1; }
                asm volatile("" ::: "memory"); }
    }
};
struct EpiKV {
    static constexpr bool PERM = true;
    bf16_t* K; bf16_t* V; const float* stat;
    __device__ __forceinline__ void operator()(const f32x4 (&acc)[2][2][4][2], const Unit& u, int wr, int wc, int fr, int fq) const {
        const int row0 = u.row0 + wr * 64 + fr;
#pragma unroll
        for (int ai = 0; ai < 2; ++ai)
#pragma unroll
            for (int m = 0; m < 4; ++m) { const int row = row0 + ai * HALF + m * 16;
                float sc; { const f32x4* sp = (const f32x4*)(stat + (size_t)row * 24); const f32x4 a3 = sp[3], a4 = sp[4];
                    sc = rsqrtf((((a3[0] + a3[1]) + (a3[2] + a3[3])) + ((a4[0] + a4[1]) + (a4[2] + a4[3]))) * (1.f / 256.f) + 1e-6f); }
                const int krow = (row < 16384) ? ((row >> 12) * 4352 + 256 + (row & 4095)) : (((row - 16384) >> 8) * 4352 + ((row - 16384) & 255));
#pragma unroll
                for (int bj = 0; bj < 2; ++bj) { const int head = 2 * u.pn + bj; const f32x4 v0 = acc[ai][bj][m][0] * sc, v1 = acc[ai][bj][m][1] * sc;
                    u32x4 w; w.x = cvt_pk_bf16(v0[0], v0[1]); w.y = cvt_pk_bf16(v0[2], v0[3]); w.z = cvt_pk_bf16(v1[0], v1[1]); w.w = cvt_pk_bf16(v1[2], v1[3]);
                    if (wc < 2) *(u32x4*)(K + (size_t)krow * 768 + head * 96 + wc * 32 + 8 * fq) = w;
                    else *(u32x4*)(V + (size_t)krow * 512 + head * 64 + (wc - 2) * 32 + 8 * fq) = w; }
                asm volatile("" ::: "memory"); }
    }
};
}

template <class RowMap>
__device__ __forceinline__ void transpose_item(const float* W, int K, int N, int nblk, unsigned short* WT, const RowMap& rowmap, LAS float* scr, int item, int lane, const float* kscale = nullptr) {
    const int kb = item / nblk, nb = item % nblk, k0 = 64 * kb, n0 = 32 * nb;
    const int ncol = n0 + (lane & 31);
    float tv[32];
#pragma unroll
    for (int i = 0; i < 32; ++i) { const int kk = 2 * i + (lane >> 5); tv[i] = (ncol < N) ? __builtin_nontemporal_load(W + (size_t)(k0 + kk) * N + ncol) : 0.f; }
    if (kscale) {
#pragma unroll
        for (int i = 0; i < 32; ++i) tv[i] *= kscale[k0 + 2 * i + (lane >> 5)]; }
#pragma unroll
    for (int i = 0; i < 32; ++i) scr[(2 * i + (lane >> 5)) * 33 + (lane & 31)] = tv[i];
    asm volatile("s_waitcnt lgkmcnt(0)" ::: "memory");
    const int c = lane & 7;
    const int r0 = rowmap(n0);
#pragma unroll
    for (int j = 0; j < 4; ++j) { const int n = (lane >> 3) + 8 * j; const LAS float* sp = scr + (8 * c) * 33 + n;
        pg8::u32x4 o; o.x = pg8::cvt_pk_bf16(sp[0 * 33], sp[1 * 33]); o.y = pg8::cvt_pk_bf16(sp[2 * 33], sp[3 * 33]); o.z = pg8::cvt_pk_bf16(sp[4 * 33], sp[5 * 33]); o.w = pg8::cvt_pk_bf16(sp[6 * 33], sp[7 * 33]);
        __builtin_nontemporal_store(o, (pg8::u32x4*)(WT + (size_t)(r0 + n) * K + k0 + 8 * c)); }
    asm volatile("s_waitcnt lgkmcnt(0)" ::: "memory");
}


namespace att {
using bf16x8 = __attribute__((ext_vector_type(8))) short;
using s16x4  = __attribute__((ext_vector_type(4))) short;
using f32x16 = __attribute__((ext_vector_type(16))) float;
using u32x4  = __attribute__((ext_vector_type(4))) unsigned;
constexpr int NW = 8, QBLK = 32, KVBLK = 64;
constexpr float SCALE = 0.10206207261596577f;
constexpr float THR = 8.f;
constexpr int LDQ = 768, LDK = 768, LDV = 512, LDO = 1024;
constexpr int SHM_V = KVBLK * 64 * 2, SHM_K = KVBLK * 256;
constexpr int SHM_ATTN = 2 * SHM_V + 2 * SHM_K + NW * 64 * 4;
#define KSWZ(row, colB) ((row) * 256 + ((colB) ^ (((row) & 7) << 4)))
#define SBAR() __builtin_amdgcn_sched_barrier(0)
__device__ __forceinline__ int crow(int r, int hi) { return (r & 3) + 8 * (r >> 2) + 4 * hi; }
__device__ __forceinline__ unsigned cvtpk(float lo, float hi) { unsigned r; asm volatile("v_cvt_pk_bf16_f32 %0, %1, %2" : "=v"(r) : "v"(lo), "v"(hi)); return r; }

__device__ __forceinline__ void partialSM(f32x16& p0, f32x16& p1, float& m_reg, float& mn, float& alpha) {
  constexpr float C = SCALE * 1.4426950408889634f;
  float pmax = p0[0]; for (int r = 1; r < 16; ++r) pmax = fmaxf(pmax, p0[r]); for (int r = 0; r < 16; ++r) pmax = fmaxf(pmax, p1[r]);
  { auto rr = __builtin_amdgcn_permlane32_swap(__float_as_uint(pmax), __float_as_uint(pmax), false, false);
    pmax = fmaxf(__uint_as_float(rr[0]), __uint_as_float(rr[1])); }
  if (__builtin_expect(__all(pmax - m_reg <= THR / SCALE), 1)) { mn = m_reg; alpha = 1.f; }
  else { mn = fmaxf(m_reg, pmax); alpha = __builtin_amdgcn_exp2f((m_reg - mn) * C); m_reg = mn; }
  float mnC = -mn * C;
  for (int r = 0; r < 16; ++r) p0[r] = fmaf(p0[r], C, mnC); for (int r = 0; r < 16; ++r) p1[r] = fmaf(p1[r], C, mnC);
  for (int r = 0; r < 16; ++r) p0[r] = __builtin_amdgcn_exp2f(p0[r]);
}
__device__ __forceinline__ void finishSM(f32x16& p0, f32x16& p1, float alpha, float& l_reg, bf16x8& pa0, bf16x8& pa1, bf16x8& pa2, bf16x8& pa3) {
  for (int r = 0; r < 16; ++r) p1[r] = __builtin_amdgcn_exp2f(p1[r]);
  float ps = 0; for (int r = 0; r < 16; ++r) ps += p0[r]; for (int r = 0; r < 16; ++r) ps += p1[r];
  { auto rr = __builtin_amdgcn_permlane32_swap(__float_as_uint(ps), __float_as_uint(ps), false, false);
    ps = __uint_as_float(rr[0]) + __uint_as_float(rr[1]); }
  l_reg = l_reg * alpha + ps;
#define PK4(P, BASE, OUT) do { unsigned a0 = cvtpk(P[BASE + 0], P[BASE + 1]), a1 = cvtpk(P[BASE + 2], P[BASE + 3]);   \
    unsigned b0 = cvtpk(P[BASE + 4], P[BASE + 5]), b1 = cvtpk(P[BASE + 6], P[BASE + 7]);                              \
    auto r0 = __builtin_amdgcn_permlane32_swap(a0, b0, false, false); auto r1 = __builtin_amdgcn_permlane32_swap(a1, b1, false, false); \
    u32x4 w = {r0[0], r1[0], r0[1], r1[1]}; OUT = *reinterpret_cast<bf16x8*>(&w); } while (0)
  PK4(p0, 0, pa0); PK4(p0, 8, pa1); PK4(p1, 0, pa2); PK4(p1, 8, pa3);
#undef PK4
}
__device__ __forceinline__ void qkt(f32x16& p0, f32x16& p1, const char* Ks, const bf16x8* qr, int r32, int hi) {
  p0 = f32x16{}; p1 = f32x16{};
#pragma unroll
  for (int d0 = 0; d0 < 6; ++d0) { int cb = (d0 * 16 + hi * 8) * 2;
    bf16x8 b0 = *reinterpret_cast<const bf16x8*>(Ks + KSWZ(r32, cb));
    bf16x8 b1 = *reinterpret_cast<const bf16x8*>(Ks + KSWZ(32 + r32, cb));
    p0 = __builtin_amdgcn_mfma_f32_32x32x16_bf16(b0, qr[d0], p0, 0, 0, 0);
    p1 = __builtin_amdgcn_mfma_f32_32x32x16_bf16(b1, qr[d0], p1, 0, 0, 0); }
}
__device__ __forceinline__ int v_st(int k, int c) { const int kk = (k & ~0xC) | ((k & 4) << 1) | ((k & 8) >> 1); return ((kk >> 3) * 2 + (c >> 5)) * 512 + ((kk & 7) * 32 + (c & 31)) * 2; }
__device__ __forceinline__ int v_rd_base(int lane) { return ((lane & 3) << 3) | (((lane >> 2) & 3) << 6) | (((lane >> 4) & 1) << 5) | (((lane >> 5) & 1) << 8); }
constexpr int v_rd_off(int d0, int ks, int half) { return d0 * 512 + ks * 2048 + half * 1024; }
template <int OFF> __device__ __forceinline__ s16x4 tr_read(int vb) {
  s16x4 r; asm volatile("ds_read_b64_tr_b16 %0, %1 offset:%2" : "=&v"(r) : "v"(vb), "i"(OFF) : "memory"); return r;
}
template <int D0> __device__ __forceinline__ void pv_one(f32x16& od, int vb, bf16x8 pa0, bf16x8 pa1, bf16x8 pa2, bf16x8 pa3) {
  const s16x4 l0 = tr_read<v_rd_off(D0, 0, 0)>(vb), h0 = tr_read<v_rd_off(D0, 0, 1)>(vb), l1 = tr_read<v_rd_off(D0, 1, 0)>(vb), h1 = tr_read<v_rd_off(D0, 1, 1)>(vb);
  const s16x4 l2 = tr_read<v_rd_off(D0, 2, 0)>(vb), h2 = tr_read<v_rd_off(D0, 2, 1)>(vb), l3 = tr_read<v_rd_off(D0, 3, 0)>(vb), h3 = tr_read<v_rd_off(D0, 3, 1)>(vb);
  asm volatile("s_waitcnt lgkmcnt(0)" ::: "memory"); SBAR();
#define PK(L, H) (bf16x8){L[0], L[1], L[2], L[3], H[0], H[1], H[2], H[3]}
  od = __builtin_amdgcn_mfma_f32_32x32x16_bf16(pa0, PK(l0, h0), od, 0, 0, 0);
  od = __builtin_amdgcn_mfma_f32_32x32x16_bf16(pa1, PK(l1, h1), od, 0, 0, 0);
  od = __builtin_amdgcn_mfma_f32_32x32x16_bf16(pa2, PK(l2, h2), od, 0, 0, 0);
  od = __builtin_amdgcn_mfma_f32_32x32x16_bf16(pa3, PK(l3, h3), od, 0, 0, 0);
#undef PK
}
__device__ __forceinline__ void pv_d0(f32x16* o, int vb, bf16x8 pa0, bf16x8 pa1, bf16x8 pa2, bf16x8 pa3) {
  pv_one<0>(o[0], vb, pa0, pa1, pa2, pa3); pv_one<1>(o[1], vb, pa0, pa1, pa2, pa3);
}
__device__ __forceinline__ void attn_body(const unsigned short* __restrict__ Qb, const unsigned short* __restrict__ Kh, const unsigned short* __restrict__ Vh,
                                          unsigned short* __restrict__ Ob, int seq, char* lds) {
  const int tid = threadIdx.x, wid = tid >> 6, lane = tid & 63, r32 = lane & 31, hi = lane >> 5;
  char* V_lds = lds; char* K_lds = lds + 2 * SHM_V;
  float* ws = (float*)(lds + 2 * SHM_V + 2 * SHM_K) + wid * 64; float* li_l = ws; float* al_l = ws + 32;
  float m_reg = -1e30f, l_reg = 0; f32x16 o[2] = {}; bf16x8 qr[6];
  const unsigned short* Qw = Qb + (long)(wid * QBLK + r32) * LDQ + hi * 8;
#pragma unroll
  for (int d0 = 0; d0 < 6; ++d0) qr[d0] = *reinterpret_cast<const bf16x8*>(Qw + d0 * 16);
  const int vr = tid >> 3, vc = (tid & 7) * 8, vst = v_st(vr, vc);
  const int k0r = tid / 12, k0c = tid % 12, id1 = 512 + (tid & 255), k1r = id1 / 12, k1c = id1 % 12;
  const int kst0 = KSWZ(k0r, k0c * 16), kst1 = KSWZ(k1r, k1c * 16);
  const long vg = (long)vr * LDV + vc, kg0 = (long)k0r * LDK + k0c * 8, kg1 = (long)k1r * LDK + k1c * 8;
  const int vb0 = (int)(uintptr_t)V_lds + v_rd_base(lane);
  struct { bf16x8 vs, ks0, ks1; } sr_[2];
#define SLOAD(i, kk0) do { sr_[i].vs = *reinterpret_cast<const bf16x8*>(Vh + (long)(kk0) * LDV + vg); \
    sr_[i].ks0 = *reinterpret_cast<const bf16x8*>(Kh + (long)(kk0) * LDK + kg0); sr_[i].ks1 = *reinterpret_cast<const bf16x8*>(Kh + (long)(kk0) * LDK + kg1); } while (0)
#define SWRITE(b, i) do { *(bf16x8*)(V_lds + (b) * SHM_V + vst) = sr_[i].vs; \
    *(bf16x8*)(K_lds + (b) * SHM_K + kst0) = sr_[i].ks0; *(bf16x8*)(K_lds + (b) * SHM_K + kst1) = sr_[i].ks1; } while (0)
#define SWAIT() asm volatile("s_waitcnt vmcnt(3)" ::: "memory")
#define RESC(a) do { if (__any((a) < 1.f)) { if (hi == 0) al_l[r32] = (a); asm volatile("s_waitcnt lgkmcnt(0)" ::: "memory"); \
    for (int d = 0; d < 2; ++d) for (int r = 0; r < 16; ++r) o[d][r] *= al_l[crow(r, hi)]; } } while (0)
  f32x16 pA0, pA1, pB0, pB1; float mnA, mnB, alA, alB; bf16x8 pa0, pa1, pa2, pa3; const int NT = seq / KVBLK;
  constexpr int SE = 0, SO = 1;
  SLOAD(SE, 0); asm volatile("s_waitcnt vmcnt(0)" ::: "memory"); SWRITE(0, SE); __syncthreads();
  qkt(pA0, pA1, K_lds, qr, r32, hi); partialSM(pA0, pA1, m_reg, mnA, alA);
  SLOAD(SO, KVBLK); if (2 < NT) SLOAD(SE, 2 * KVBLK);
  SWAIT(); SWRITE(1, SO); __syncthreads();
  for (int j = 1; j + 1 < NT; j += 2) {
    SBAR(); qkt(pB0, pB1, K_lds + SHM_K, qr, r32, hi);
    finishSM(pA0, pA1, alA, l_reg, pa0, pa1, pa2, pa3); SBAR();
    SLOAD(SO, (j + 2) * KVBLK); SBAR();
    pv_d0(o, vb0, pa0, pa1, pa2, pa3); partialSM(pB0, pB1, m_reg, mnB, alB);
    __syncthreads(); SWAIT(); SWRITE(0, SE);
    RESC(alB); __syncthreads();
    SBAR(); qkt(pA0, pA1, K_lds, qr, r32, hi);
    finishSM(pB0, pB1, alB, l_reg, pa0, pa1, pa2, pa3); SBAR();
    if (j + 3 < NT) SLOAD(SE, (j + 3) * KVBLK); SBAR();
    pv_d0(o, vb0 + SHM_V, pa0, pa1, pa2, pa3); partialSM(pA0, pA1, m_reg, mnA, alA);
    __syncthreads(); SWAIT(); SWRITE(1, SO);
    RESC(alA); __syncthreads();
  }
  SBAR(); qkt(pB0, pB1, K_lds + SHM_K, qr, r32, hi);
  finishSM(pA0, pA1, alA, l_reg, pa0, pa1, pa2, pa3); SBAR();
  pv_d0(o, vb0, pa0, pa1, pa2, pa3); partialSM(pB0, pB1, m_reg, mnB, alB);
  __syncthreads(); RESC(alB);
  finishSM(pB0, pB1, alB, l_reg, pa0, pa1, pa2, pa3); SBAR();
  pv_d0(o, vb0 + SHM_V, pa0, pa1, pa2, pa3);
  if (hi == 0) li_l[r32] = l_reg; asm volatile("s_waitcnt lgkmcnt(0)" ::: "memory");
  float rli[16];
#pragma unroll
  for (int r = 0; r < 16; ++r) rli[r] = __builtin_amdgcn_rcpf(li_l[crow(r, hi)]);
  unsigned short* Ow = Ob + (long)(wid * QBLK) * LDO;
#pragma unroll
  for (int r = 0; r < 16; ++r) { int orow = crow(r, hi);
#pragma unroll
    for (int d0 = 0; d0 < 2; ++d0) Ow[(long)orow * LDO + d0 * 32 + r32] = (unsigned short)(cvtpk(o[d0][r] * rli[r], 0.f) & 0xffffu); }
  __syncthreads();
#undef SLOAD
#undef SWRITE
#undef SWAIT
#undef RESC
}
#undef KSWZ
#undef SBAR
}


namespace ml {
using bf16x8 = __attribute__((ext_vector_type(8))) short;
using s16x4  = __attribute__((ext_vector_type(4))) short;
using f32x16 = __attribute__((ext_vector_type(16))) float;
using f32x4  = __attribute__((ext_vector_type(4))) float;
using u32x4  = __attribute__((ext_vector_type(4))) unsigned;
constexpr float L2E = 1.4426950408889634f;
constexpr int NXC = 34;
__device__ __forceinline__ int crow(int r, int hi) { return (r & 3) + 8 * (r >> 2) + 4 * hi; }
__device__ __forceinline__ unsigned cvtpk(float lo, float hi) { unsigned r; asm volatile("v_cvt_pk_bf16_f32 %0, %1, %2" : "=v"(r) : "v"(lo), "v"(hi)); return r; }
template <int NC> __device__ __forceinline__ int t_st(int k, int c) { const int kk = (k & ~0xC) | ((k & 4) << 1) | ((k & 8) >> 1); return ((kk >> 3) * NC + (c >> 5)) * 512 + ((kk & 7) * 32 + (c & 31)) * 2; }
__device__ __forceinline__ int t_rd_base(int lane) { return ((lane & 3) << 3) | (((lane >> 2) & 3) << 6) | (((lane >> 4) & 1) << 5) | (((lane >> 5) & 1) << 8); }
template <int NC> constexpr int t_rd_off(int d0, int ks, int half) { return d0 * 512 + ks * (NC * 1024) + half * (NC * 512); }
template <int OFF> __device__ __forceinline__ s16x4 tr_read(int vb) { s16x4 r; asm volatile("ds_read_b64_tr_b16 %0, %1 offset:%2" : "=&v"(r) : "v"(vb), "i"(OFF) : "memory"); return r; }
#define ML_PK(L, H) (bf16x8){L[0], L[1], L[2], L[3], H[0], H[1], H[2], H[3]}
#define ML_KS(row, colB) ((row) * 128 + ((colB) ^ (((row) & 7) << 4)))
__device__ __forceinline__ int chunk_row(int b, int X, int i) { return X < 2 ? (16384 + b * 256 + X * 128 + i) : (b * 4096 + (X - 2) * 128 + i); }
__device__ __forceinline__ float lsig(float x) { return fminf(x, 0.f) - __logf(1.f + __expf(-fabsf(x))); }

__device__ __forceinline__ void gate_prep(const float* GATES, const float* bg, int b, int h, int X, LAS float* cum, LAS float* av, LAS float* pm, LAS float* wsr, LAS float* tot, int wave, int lane) {
    if (wave < 2) {
        const int dir = wave;
        const int e0 = dir ? (127 - 2 * lane) : (2 * lane), e1 = dir ? (126 - 2 * lane) : (2 * lane + 1);
        const int r0 = chunk_row(b, X, e0), r1 = chunk_row(b, X, e1);
        const float bi = bg[(2 * dir) * 4 + h], bf = bg[(2 * dir + 1) * 4 + h];
        const float li0 = GATES[(size_t)r0 * 16 + (2 * dir) * 4 + h] + bi, li1 = GATES[(size_t)r1 * 16 + (2 * dir) * 4 + h] + bi;
        const float x0 = lsig(GATES[(size_t)r0 * 16 + (2 * dir + 1) * 4 + h] + bf), x1 = lsig(GATES[(size_t)r1 * 16 + (2 * dir + 1) * 4 + h] + bf);
        float sc = x0 + x1;
#pragma unroll
        for (int o = 1; o < 64; o <<= 1) { const float y = __shfl_up(sc, o); if (lane >= o) sc += y; }
        const float c1 = sc, c0 = sc - x1; const float total = __shfl(sc, 63);
        const float a0 = li0 - c0, a1 = li1 - c1;
        float mx = fmaxf(a0, a1);
#pragma unroll
        for (int o = 1; o < 64; o <<= 1) { const float y = __shfl_up(mx, o); if (lane >= o) mx = fmaxf(mx, y); }
        float prev = __shfl_up(mx, 1); if (lane == 0) prev = -3.0e38f;
        cum[dir * 128 + e0] = c0; cum[dir * 128 + e1] = c1; av[dir * 128 + e0] = a0; av[dir * 128 + e1] = a1;
        pm[dir * 128 + e0] = fmaxf(prev, a0); pm[dir * 128 + e1] = mx;
        wsr[dir * 128 + e0] = total - c0 + li0; wsr[dir * 128 + e1] = total - c1 + li1;
        if (lane == 0) tot[dir] = total;
    }
}

__device__ __forceinline__ void stepA_unit(const unsigned short* P16, const float* GATES, const float* bg, int bh, int X, float* CLOC, float* NLOC, float* MLOC, float* TOT, char* lds) {
    const int tid = threadIdx.x, wave = __builtin_amdgcn_readfirstlane(tid >> 6), lane = tid & 63, r32 = lane & 31, hi = lane >> 5;
    const int b = bh >> 2, h = bh & 3;
    LAS float* fa = (LAS float*)(lds + 65536);
    LAS float* cum = fa, *av = fa + 256, *pm = fa + 512, *wsr = fa + 768, *tot = fa + 1024, *wl = fa + 1040, *mlo = fa + 1296, *npart = fa + 1312;
    gate_prep(GATES, bg, b, h, X, cum, av, pm, wsr, tot, wave, lane);
    __syncthreads();
    if (wave < 2) {
        const int dir = wave; const float w0 = wsr[dir * 128 + lane], w1 = wsr[dir * 128 + 64 + lane];
        float mx = fmaxf(w0, w1);
#pragma unroll
        for (int o = 1; o < 64; o <<= 1) mx = fmaxf(mx, __shfl_xor(mx, o));
        wl[dir * 128 + lane] = __expf(w0 - mx); wl[dir * 128 + 64 + lane] = __expf(w1 - mx);
        if (lane == 0) { mlo[dir] = mx; MLOC[(bh * NXC + X) * 2 + dir] = mx; TOT[(bh * NXC + X) * 2 + dir] = tot[dir]; }
    }
    __syncthreads();
#pragma unroll
    for (int j = 0; j < 4; ++j) { const int id = tid + 512 * j, row = id >> 4, ch = id & 15;
        const bf16x8 v = *reinterpret_cast<const bf16x8*>(P16 + (size_t)chunk_row(b, X, row) * 2304 + 1184 + h * 128 + ch * 8);
        *(bf16x8*)(lds + t_st<4>(row, ch * 8)) = v; }
#pragma unroll
    for (int j = 0; j < 2; ++j) { const int id = tid + 512 * j, row = id >> 3, ch = id & 7;
        const u32x4 kv = *reinterpret_cast<const u32x4*>(P16 + (size_t)chunk_row(b, X, row) * 2304 + 928 + h * 64 + ch * 8);
        const float wf = wl[row], wb = wl[128 + row];
        u32x4 of, ob;
#pragma unroll
        for (int q = 0; q < 4; ++q) { const float lo = __uint_as_float(kv[q] << 16), hi2 = __uint_as_float(kv[q] & 0xffff0000u); of[q] = cvtpk(lo * wf, hi2 * wf); ob[q] = cvtpk(lo * wb, hi2 * wb); }
        *(u32x4*)(lds + 32768 + t_st<2>(row, ch * 8)) = of; *(u32x4*)(lds + 49152 + t_st<2>(row, ch * 8)) = ob; }
    __syncthreads();
    {
        const int dir = wave >> 2, mb = wave & 3;
        const int vb = (int)(uintptr_t)lds + t_rd_base(lane) + mb * 512;
        const int kb = (int)(uintptr_t)lds + 32768 + dir * 16384 + t_rd_base(lane);
        f32x16 acc0 = {}, acc1 = {};
#define ML_A_STEP(KS) do { \
        const s16x4 vl = tr_read<t_rd_off<4>(0, KS, 0)>(vb), vh = tr_read<t_rd_off<4>(0, KS, 1)>(vb); \
        const s16x4 k0l = tr_read<t_rd_off<2>(0, KS, 0)>(kb), k0h = tr_read<t_rd_off<2>(0, KS, 1)>(kb), k1l = tr_read<t_rd_off<2>(1, KS, 0)>(kb), k1h = tr_read<t_rd_off<2>(1, KS, 1)>(kb); \
        asm volatile("s_waitcnt lgkmcnt(0)" ::: "memory"); __builtin_amdgcn_sched_barrier(0); \
        acc0 = __builtin_amdgcn_mfma_f32_32x32x16_bf16(ML_PK(vl, vh), ML_PK(k0l, k0h), acc0, 0, 0, 0); \
        acc1 = __builtin_amdgcn_mfma_f32_32x32x16_bf16(ML_PK(vl, vh), ML_PK(k1l, k1h), acc1, 0, 0, 0); } while (0)
        ML_A_STEP(0); ML_A_STEP(1); ML_A_STEP(2); ML_A_STEP(3); ML_A_STEP(4); ML_A_STEP(5); ML_A_STEP(6); ML_A_STEP(7);
#undef ML_A_STEP
        float* dst = CLOC + ((size_t)(bh * NXC + X) * 2 + dir) * 8192;
#pragma unroll
        for (int r = 0; r < 16; ++r) { const int dv = 32 * mb + crow(r, hi); dst[dv * 64 + r32] = acc0[r]; dst[dv * 64 + 32 + r32] = acc1[r]; }
    }
    {
        const int dir = tid >> 8, part = (tid >> 6) & 3, d = tid & 63; float a = 0.f;
        for (int i = 0; i < 32; ++i) { const int row = part * 32 + i; a = fmaf(wl[dir * 128 + row], bf2f(P16[(size_t)chunk_row(b, X, row) * 2304 + 928 + h * 64 + d]), a); }
        npart[(dir * 4 + part) * 64 + d] = a;
    }
    __syncthreads();
    if (tid < 128) { const int dir = tid >> 6, d = tid & 63; NLOC[((size_t)(bh * NXC + X) * 2 + dir) * 64 + d] = (npart[(dir * 4 + 0) * 64 + d] + npart[(dir * 4 + 1) * 64 + d]) + (npart[(dir * 4 + 2) * 64 + d] + npart[(dir * 4 + 3) * 64 + d]); }
    __syncthreads();
}

__device__ __forceinline__ int scanX(int dir, int j) { return dir ? (j == 0 ? 1 : (j == 1 ? 0 : 35 - j)) : j; }
__device__ __forceinline__ void stepB(const float* CLOC, const float* NLOC, const float* MLOC, const float* TOT, unsigned* CIN, float* NIN, float* MIN, int gtid, int gthreads) {
    for (int it = gtid; it < 32 * 4096 + 32 * 64; it += gthreads) {
        const bool isn = it >= 32 * 4096;
        const int sq = isn ? (it - 32 * 4096) >> 6 : it >> 12, e = isn ? (it - 32 * 4096) & 63 : it & 4095;
        const int bh = sq >> 1, dir = sq & 1;
        float c0 = 0.f, c1 = 0.f, m = 0.f;
#pragma unroll 2
        for (int j = 0; j < NXC; ++j) {
            const int X = scanX(dir, j);
            if (X >= 2) {
                const size_t ci = (size_t)(bh * 32 + (X - 2)) * 2 + dir;
                if (isn) { NIN[ci * 64 + e] = c0; if (e == 0) MIN[ci] = m; }
                else CIN[ci * 4096 + e] = cvtpk(c0, c1);
            }
            const size_t li = (size_t)(bh * NXC + X) * 2 + dir;
            const float tot = TOT[li], mloc = MLOC[li];
            const float mn = fmaxf(tot + m, mloc), dec = __expf(tot + m - mn), scl = __expf(mloc - mn);
            if (isn) c0 = dec * c0 + scl * NLOC[li * 64 + e];
            else { const float2 v = *(const float2*)(CLOC + li * 8192 + 2 * e); c0 = dec * c0 + scl * v.x; c1 = dec * c1 + scl * v.y; }
            m = mn;
        }
    }
}

__device__ __forceinline__ void stepC_unit(const unsigned short* P16, const float* GATES, const float* bg, const unsigned short* CIN, const float* NIN, const float* MIN, const float* mng,
                                           unsigned short* MIX16, int bh, int c, char* lds) {
    const int tid = threadIdx.x, wave = __builtin_amdgcn_readfirstlane(tid >> 6), lane = tid & 63, r32 = lane & 31, hi = lane >> 5;
    const int b = bh >> 2, h = bh & 3, X = c + 2;
    LAS float* fa = (LAS float*)(lds + 114688);
    LAS float* cum = fa, *av = fa + 256, *pm = fa + 512, *wsr = fa + 768, *tot = fa + 1024, *scl = fa + 1040;
    LAS float* hb = (LAS float*)(lds + 49152);
    gate_prep(GATES, bg, b, h, X, cum, av, pm, wsr, tot, wave, lane);
#pragma unroll
    for (int j = 0; j < 2; ++j) { const int id = tid + 512 * j, row = id >> 3, ch = id & 7;
        const bf16x8 kv = *reinterpret_cast<const bf16x8*>(P16 + (size_t)chunk_row(b, X, row) * 2304 + 928 + h * 64 + ch * 8);
        *(bf16x8*)(lds + ML_KS(row, ch * 16)) = kv; }
#pragma unroll
    for (int j = 0; j < 4; ++j) { const int id = tid + 512 * j, row = id >> 4, ch = id & 15;
        const bf16x8 v = *reinterpret_cast<const bf16x8*>(P16 + (size_t)chunk_row(b, X, row) * 2304 + 1184 + h * 128 + ch * 8);
        *(bf16x8*)(lds + 16384 + t_st<4>(row, ch * 8)) = v; }
    __syncthreads();
    const int dir = wave >> 2, tb = wave & 3;
    const int t = 32 * tb + r32;
    const size_t ci = (size_t)(bh * 32 + c) * 2 + dir;
    const float min2 = MIN[ci] * L2E;
    const float el2 = fmaxf(min2, pm[dir * 128 + t] * L2E);
    const float wint = __builtin_amdgcn_exp2f(min2 - el2);
    bf16x8 qr[4];
    {
        const unsigned short* qp = P16 + (size_t)chunk_row(b, X, t) * 2304 + 672 + h * 64 + hi * 8;
#pragma unroll
        for (int ks = 0; ks < 4; ++ks) qr[ks] = *reinterpret_cast<const bf16x8*>(qp + ks * 16);
    }
    f32x16 o[4] = {}; float den = 0.f;
    const int vb = (int)(uintptr_t)lds + 16384 + t_rd_base(lane);
    const char* Kl = lds;
#define ML_C_BLOCK(SB) do { if (dir ? (SB >= tb) : (SB <= tb)) { \
        f32x16 p = {}; \
        _Pragma("unroll") for (int ks = 0; ks < 4; ++ks) { const bf16x8 kf = *reinterpret_cast<const bf16x8*>(Kl + ML_KS(32 * SB + r32, (ks * 16 + hi * 8) * 2)); p = __builtin_amdgcn_mfma_f32_32x32x16_bf16(kf, qr[ks], p, 0, 0, 0); } \
        _Pragma("unroll") for (int g = 0; g < 4; ++g) { const f32x4 a4 = *(const LAS f32x4*)(av + dir * 128 + 32 * SB + 8 * g + 4 * hi); \
            _Pragma("unroll") for (int i = 0; i < 4; ++i) { const int sidx = 32 * SB + 8 * g + 4 * hi + i; const bool ok = dir ? (sidx >= t) : (sidx <= t); \
                const float f = __builtin_amdgcn_exp2f(a4[i] * L2E - el2) * 0.125f; p[4 * g + i] = ok ? p[4 * g + i] * f : 0.f; den += p[4 * g + i]; } } \
        bf16x8 pa0, pa1; \
        { unsigned a0 = cvtpk(p[0], p[1]), a1 = cvtpk(p[2], p[3]), b0 = cvtpk(p[4], p[5]), b1 = cvtpk(p[6], p[7]); \
          auto r0 = __builtin_amdgcn_permlane32_swap(a0, b0, false, false); auto r1 = __builtin_amdgcn_permlane32_swap(a1, b1, false, false); u32x4 w = {r0[0], r1[0], r0[1], r1[1]}; pa0 = *reinterpret_cast<bf16x8*>(&w); } \
        { unsigned a0 = cvtpk(p[8], p[9]), a1 = cvtpk(p[10], p[11]), b0 = cvtpk(p[12], p[13]), b1 = cvtpk(p[14], p[15]); \
          auto r0 = __builtin_amdgcn_permlane32_swap(a0, b0, false, false); auto r1 = __builtin_amdgcn_permlane32_swap(a1, b1, false, false); u32x4 w = {r0[0], r1[0], r0[1], r1[1]}; pa1 = *reinterpret_cast<bf16x8*>(&w); } \
        ML_C_PV(0, SB, pa0, pa1); ML_C_PV(1, SB, pa0, pa1); ML_C_PV(2, SB, pa0, pa1); ML_C_PV(3, SB, pa0, pa1); } } while (0)
#define ML_C_PV(D0, SB, PA0, PA1) do { \
        const s16x4 l0 = tr_read<t_rd_off<4>(D0, 2 * SB, 0)>(vb), h0 = tr_read<t_rd_off<4>(D0, 2 * SB, 1)>(vb), l1 = tr_read<t_rd_off<4>(D0, 2 * SB + 1, 0)>(vb), h1 = tr_read<t_rd_off<4>(D0, 2 * SB + 1, 1)>(vb); \
        asm volatile("s_waitcnt lgkmcnt(0)" ::: "memory"); __builtin_amdgcn_sched_barrier(0); \
        o[D0] = __builtin_amdgcn_mfma_f32_32x32x16_bf16(PA0, ML_PK(l0, h0), o[D0], 0, 0, 0); \
        o[D0] = __builtin_amdgcn_mfma_f32_32x32x16_bf16(PA1, ML_PK(l1, h1), o[D0], 0, 0, 0); } while (0)
    ML_C_BLOCK(0); ML_C_BLOCK(1); ML_C_BLOCK(2); ML_C_BLOCK(3);
#undef ML_C_BLOCK
#undef ML_C_PV
    float ndot = 0.f;
    {
        bf16x8 qw[4];
        const float* np = NIN + ci * 64 + hi * 8;
#pragma unroll
        for (int ks = 0; ks < 4; ++ks) { const u32x4 q4 = *reinterpret_cast<const u32x4*>(&qr[ks]);
            const f32x4 n0 = *(const f32x4*)(np + ks * 16), n1 = *(const f32x4*)(np + ks * 16 + 4);
            u32x4 w4;
#pragma unroll
            for (int q = 0; q < 4; ++q) { const float lo = __uint_as_float(q4[q] << 16), hi2 = __uint_as_float(q4[q] & 0xffff0000u);
                const float nl = (q < 2) ? n0[2 * q] : n1[2 * q - 4], nh = (q < 2) ? n0[2 * q + 1] : n1[2 * q - 3];
                ndot = fmaf(lo, nl, ndot); ndot = fmaf(hi2, nh, ndot);
                w4[q] = cvtpk(lo * (0.125f * wint), hi2 * (0.125f * wint)); }
            qw[ks] = *reinterpret_cast<const bf16x8*>(&w4); }
        const unsigned short* cp = CIN + ci * 8192 + (size_t)r32 * 64 + hi * 8;
#pragma unroll
        for (int d0 = 0; d0 < 4; ++d0)
#pragma unroll
            for (int ks = 0; ks < 4; ++ks) { const bf16x8 cf = *reinterpret_cast<const bf16x8*>(cp + (size_t)d0 * 32 * 64 + ks * 16); o[d0] = __builtin_amdgcn_mfma_f32_32x32x16_bf16(qw[ks], cf, o[d0], 0, 0, 0); }
    }
    { auto rr = __builtin_amdgcn_permlane32_swap(__float_as_uint(den), __float_as_uint(den), false, false); den = __uint_as_float(rr[0]) + __uint_as_float(rr[1]); }
    { auto rr = __builtin_amdgcn_permlane32_swap(__float_as_uint(ndot), __float_as_uint(ndot), false, false); ndot = __uint_as_float(rr[0]) + __uint_as_float(rr[1]); }
    den += wint * 0.125f * ndot;
    const float sct = 1.f / fmaxf(fabsf(den), __builtin_amdgcn_exp2f(-cum[dir * 128 + t] * L2E - el2));
    if (hi == 0) scl[wave * 32 + r32] = sct;
    asm volatile("s_waitcnt lgkmcnt(0)" ::: "memory");
    if (dir == 1) {
#pragma unroll
        for (int r = 0; r < 16; ++r)
#pragma unroll
            for (int d0 = 0; d0 < 4; ++d0) hb[(32 * tb + crow(r, hi)) * 128 + 32 * d0 + r32] = o[d0][r] * scl[wave * 32 + crow(r, hi)];
    }
    __syncthreads();
    if (dir == 0) {
        const float* gn = mng + h * 128;
        const float g0 = gn[r32], g1 = gn[32 + r32], g2 = gn[64 + r32], g3 = gn[96 + r32];
#pragma unroll
        for (int r = 0; r < 16; ++r) { const int tt = 32 * tb + crow(r, hi);
            const float rsr = scl[wave * 32 + crow(r, hi)];
            const float v0 = o[0][r] * rsr + hb[tt * 128 + r32], v1 = o[1][r] * rsr + hb[tt * 128 + 32 + r32], v2 = o[2][r] * rsr + hb[tt * 128 + 64 + r32], v3 = o[3][r] * rsr + hb[tt * 128 + 96 + r32];
            float ss = (v0 * v0 + v1 * v1) + (v2 * v2 + v3 * v3);
#pragma unroll
            for (int of = 1; of < 32; of <<= 1) ss += __shfl_xor(ss, of);
            const float rstd = rsqrtf(ss * (1.f / 128.f) + 1e-6f);
            const size_t grow = (size_t)chunk_row(b, X, tt);
            const unsigned short* og = P16 + grow * 2304 + 1696 + h * 128 + r32;
            unsigned short* dst = MIX16 + grow * 1024 + 512 + h * 128 + r32;
            dst[0]  = (unsigned short)(cvtpk(v0 * rstd * g0 * __builtin_amdgcn_rcpf(1.f + __expf(-bf2f(og[0]))), 0.f) & 0xffffu);
            dst[32] = (unsigned short)(cvtpk(v1 * rstd * g1 * __builtin_amdgcn_rcpf(1.f + __expf(-bf2f(og[32]))), 0.f) & 0xffffu);
            dst[64] = (unsigned short)(cvtpk(v2 * rstd * g2 * __builtin_amdgcn_rcpf(1.f + __expf(-bf2f(og[64]))), 0.f) & 0xffffu);
            dst[96] = (unsigned short)(cvtpk(v3 * rstd * g3 * __builtin_amdgcn_rcpf(1.f + __expf(-bf2f(og[96]))), 0.f) & 0xffffu);
        }
    }
    __syncthreads();
}
#undef ML_PK
#undef ML_KS
}


__device__ __forceinline__ void convert_chunk(const float* wgu, const float* wdn, unsigned short* WguT, unsigned short* WdnT, int which, int chunk, LAS float* scr, int wave, int lane) {
#pragma unroll 1
    for (int j = 0; j < 8; ++j) {
        const int it = chunk * 64 + wave * 8 + j;
        if (which == 0) { const int e = it >> 10, r = it & 1023;
            transpose_item(wgu + (size_t)e * D * 2 * DFF, D, 2 * DFF, 2 * DFF / 32, WguT + (size_t)e * 2 * DFF * D,
                           [](int n0) { return n0 < DFF ? (n0 >> 7) * 256 + (n0 & 127) : ((n0 - DFF) >> 7) * 256 + 128 + ((n0 - DFF) & 127); }, scr, r, lane); }
        else { const int e = it >> 9, r = it & 511;
            transpose_item(wdn + (size_t)e * DFF * D, DFF, D, D / 32, WdnT + (size_t)e * D * DFF, [](int n0) { return n0; }, scr, r, lane); }
    }
}
__device__ __forceinline__ void pull_chunks(unsigned* qword, int first, int total, int maxc, const float* wgu, const float* wdn, unsigned short* WguT, unsigned short* WdnT, int which,
                                            unsigned char* lds_raw, int wave, int lane) {
    LAS int* bc = (LAS int*)(lds_raw + 131072 + 1024);
    LAS float* scr = (LAS float*)(lds_raw + wave * 16384);
    for (int n = 0; n < maxc; ++n) {
        __syncthreads();
        if (threadIdx.x == 0) bc[0] = first + (int)__hip_atomic_fetch_add(qword, 1u, __ATOMIC_RELAXED, __HIP_MEMORY_SCOPE_AGENT);
        __syncthreads();
        const int c = bc[0];
        if (c >= total) break;
        convert_chunk(wgu, wdn, WguT, WdnT, which, c, scr, wave, lane);
    }
    __syncthreads();
}

constexpr int LDS_BYTES = 147456;
constexpr int N_PHASES = 12;

__global__ void __launch_bounds__(NT, 2) fwd_kernel(Params p) {
    extern __shared__ __attribute__((aligned(16))) unsigned char lds_raw[];
    float* lds = (float*)lds_raw;
    LAS unsigned* misc = (LAS unsigned*)(lds_raw + 131072 + 4096);
    const int tid = threadIdx.x, lane = tid & 63, wave = tid >> 6;
    const int bid = blockIdx.x, G = gridDim.x;
    unsigned char* ws = p.ws;
    unsigned* ctl = (unsigned*)(ws + WS_CTL);
    if (tid < 4) misc[tid] = 0u;
    __syncthreads();
    const bool single = (p.ph_hi - p.ph_lo) > 1;
    XcdBarrier bar; bar.bar = ctl + CW_BAR; bar.x = 0; bar.st = nullptr;
    if (single) bar = xcd_barrier_post(ctl + CW_BAR, (volatile LAS unsigned*)misc);
#ifndef PH_MASK
#define PH_MASK 0xFFFF
#endif
#define IN(k) ((((PH_MASK) >> (k)) & 1) && p.ph_lo <= (k) && (k) < p.ph_hi)
#define SEAM(k) do { if (IN(k) && IN((k) + 1)) xcd_barrier(bar); } while (0)
#ifndef PROBE_DUP
#define PROBE_DUP (-1)
#endif
#if PROBE_DUP == 0
#define PH_BEGIN_0 for (int rep_ = 0; rep_ < 2; ++rep_) {
#define PH_END_0 if (rep_ == 0) xcd_barrier(bar); }
#else
#define PH_BEGIN_0
#define PH_END_0
#endif
#if PROBE_DUP == 1
#define PH_BEGIN_1 for (int rep_ = 0; rep_ < 2; ++rep_) {
#define PH_END_1 if (rep_ == 0) xcd_barrier(bar); }
#else
#define PH_BEGIN_1
#define PH_END_1
#endif
#if PROBE_DUP == 2
#define PH_BEGIN_2 for (int rep_ = 0; rep_ < 2; ++rep_) {
#define PH_END_2 if (rep_ == 0) xcd_barrier(bar); }
#else
#define PH_BEGIN_2
#define PH_END_2
#endif
#if PROBE_DUP == 4
#define PH_BEGIN_4 for (int rep_ = 0; rep_ < 2; ++rep_) {
#define PH_END_4 if (rep_ == 0) xcd_barrier(bar); }
#else
#define PH_BEGIN_4
#define PH_END_4
#endif
#if PROBE_DUP == 5
#define PH_BEGIN_5 for (int rep_ = 0; rep_ < 2; ++rep_) {
#define PH_END_5 if (rep_ == 0) xcd_barrier(bar); }
#else
#define PH_BEGIN_5
#define PH_END_5
#endif
#if PROBE_DUP == 6
#define PH_BEGIN_6 for (int rep_ = 0; rep_ < 2; ++rep_) {
#define PH_END_6 if (rep_ == 0) xcd_barrier(bar); }
#else
#define PH_BEGIN_6
#define PH_END_6
#endif
#if PROBE_DUP == 7
#define PH_BEGIN_7 for (int rep_ = 0; rep_ < 2; ++rep_) {
#define PH_END_7 if (rep_ == 0) xcd_barrier(bar); }
#else
#define PH_BEGIN_7
#define PH_END_7
#endif
#if PROBE_DUP == 8
#define PH_BEGIN_8 for (int rep_ = 0; rep_ < 2; ++rep_) {
#define PH_END_8 if (rep_ == 0) xcd_barrier(bar); }
#else
#define PH_BEGIN_8
#define PH_END_8
#endif
#if PROBE_DUP == 9
#define PH_BEGIN_9 for (int rep_ = 0; rep_ < 2; ++rep_) {
#define PH_END_9 if (rep_ == 0) xcd_barrier(bar); }
#else
#define PH_BEGIN_9
#define PH_END_9
#endif
#if PROBE_DUP == 10
#define PH_BEGIN_10 for (int rep_ = 0; rep_ < 2; ++rep_) {
#define PH_END_10 if (rep_ == 0) xcd_barrier(bar); }
#else
#define PH_BEGIN_10
#define PH_END_10
#endif
#if PROBE_DUP == 11
#define PH_BEGIN_11 for (int rep_ = 0; rep_ < 2; ++rep_) {
#define PH_END_11 if (rep_ == 0) xcd_barrier(bar); }
#else
#define PH_BEGIN_11
#define PH_END_11
#endif
#define PH_BEGIN(k) PH_BEGIN_##k
#define PH_END(k) PH_END_##k
#define SEAM2(k) do { if (IN(k) && IN((k) + 2)) xcd_barrier(bar); } while (0)

    float* MOD = (float*)(ws + WS_MOD);
    float* NLOC = (float*)(ws + WS_MLS); float* MLOC = (float*)(ws + WS_MLS + 512 * 1024); float* TOT = (float*)(ws + WS_MLS + 576 * 1024); float* NIN = (float*)(ws + WS_MLS + 1 * MiB); float* MIN_ = (float*)(ws + WS_MLS + 1536 * 1024);
    float* CLOC = (float*)(ws + WS_CLOC); unsigned short* CIN = (unsigned short*)(ws + WS_CIN);
    float* ROPEC = (float*)(ws + WS_ROPE); float* ROPES = ROPEC + S * 16;
    int* TOPE = (int*)(ws + WS_TOPE); int* SLOT = (int*)(ws + WS_SLOT); int* LIST = (int*)(ws + WS_LIST); float* RGATE = (float*)(ws + WS_RGATE);
    unsigned short* Hb16 = (unsigned short*)(ws + WS_H); unsigned short* WinT = (unsigned short*)(ws + WS_WINT);
 unsigned short* Q16 = (unsigned short*)(ws + WS_Q); unsigned short* K16 = (unsigned short*)(ws + WS_KV); unsigned short* V16 = (unsigned short*)(ws + WS_KV + 32 * MiB);
    float* X1 = (float*)(ws + WS_X1); unsigned short* H2 = (unsigned short*)(ws + WS_H2);
    unsigned short* YG = (unsigned short*)(ws + WS_YG); unsigned short* ACT = (unsigned short*)(ws + WS_ACT);
    unsigned short* WguT = (unsigned short*)(ws + WS_WGUT); unsigned short* WdnT = (unsigned short*)(ws + WS_WDNT);
    unsigned short* WuqT = (unsigned short*)(ws + WS_WUQT); unsigned short* WukvT = (unsigned short*)(ws + WS_WUKVT); unsigned short* WoutT = (unsigned short*)(ws + WS_WOUTT);
    float* GATES = (float*)(ws + WS_GATES); float* STAT = (float*)(ws + WS_STAT); float* STAT2 = (float*)(ws + WS_STAT2);
    float* GM2 = (float*)(ws + WS_RSTD); unsigned short* RWH = (unsigned short*)(ws + WS_RSTD + 65536); unsigned short* RWL = (unsigned short*)(ws + WS_RSTD + 131072); unsigned short* MIX16 = (unsigned short*)(ws + WS_MIX16);
    unsigned short* P16 = (unsigned short*)(ws + WS_P);
    unsigned* CNT = ctl + CW_CNT;

    PH_BEGIN(0) if (IN(0)) {
        {
            const float* wmod = p.in[I_WMOD]; const float* bmod = p.in[I_BMOD];
            float* sil = lds;
            float* red = lds + 5 * 1024;
            for (int cg = bid; cg < 96; cg += G) {
                for (int e = tid; e < 5 * D; e += NT) { const int r = e >> 10, k = e & 1023; const float cv = (r < 4) ? p.in[I_C][r * D + k] : p.in[I_CCTX][k]; sil[e] = siluf_(cv); }
                __syncthreads();
                const int col = cg * 64 + (tid & 63), part = tid >> 6;
                float a0 = 0.f, a1 = 0.f, a2 = 0.f, a3 = 0.f, a4 = 0.f;
#pragma unroll 8
                for (int kk = 0; kk < 128; ++kk) { const int k = part * 128 + kk; const float w = wmod[(size_t)k * 6144 + col];
                    a0 = fmaf(sil[k], w, a0); a1 = fmaf(sil[1024 + k], w, a1); a2 = fmaf(sil[2048 + k], w, a2); a3 = fmaf(sil[3072 + k], w, a3); a4 = fmaf(sil[4096 + k], w, a4); }
                red[(part * 5 + 0) * 64 + (tid & 63)] = a0; red[(part * 5 + 1) * 64 + (tid & 63)] = a1; red[(part * 5 + 2) * 64 + (tid & 63)] = a2; red[(part * 5 + 3) * 64 + (tid & 63)] = a3; red[(part * 5 + 4) * 64 + (tid & 63)] = a4;
                __syncthreads();
                if (tid < 320) { const int r = tid >> 6, cc = tid & 63; float t = 0.f;
#pragma unroll
                    for (int pp = 0; pp < 8; ++pp) t += red[(pp * 5 + r) * 64 + cc];
                    MOD[r * 6144 + cg * 64 + cc] = t + bmod[cg * 64 + cc]; }
                __syncthreads();
            }
        }
        for (int e = bid * NT + tid; e < NE * D; e += G * NT) { const int ex = e >> 10, k = e & 1023; const float w = p.in[I_RW][(size_t)k * NE + ex];
            const unsigned hi = pg8::cvt_pk_bf16(w, 0.f) & 0xffffu; const float lo = w - __uint_as_float(hi << 16);
            RWH[e] = (unsigned short)hi; RWL[e] = (unsigned short)(pg8::cvt_pk_bf16(lo, 0.f) & 0xffffu); }
        for (int e = bid * NT + tid; e < S * 16; e += G * NT) { float cs, sn; rope_angles(e >> 4, e & 15, cs, sn); ROPEC[e] = cs; ROPES[e] = sn; }
        {
            LAS float* scr = (LAS float*)(lds_raw + wave * 16384);
            const int gw = bid * 8 + wave, NGW = G * 8;
            for (int it = gw; it < (D / 64) * (PW / 32); it += NGW) transpose_item(p.in[I_WIN], D, INW, PW / 32, WinT, [](int n0) { return n0; }, scr, it, lane);
            for (int it = gw; it < (QL / 64) * (768 / 32); it += NGW) transpose_item(p.in[I_WUQ], QL, 768, 768 / 32, WuqT, [](int n0) { return n0; }, scr, it, lane, p.in[I_QNG]);
            for (int it = gw; it < (KVL / 64) * (1024 / 32); it += NGW) transpose_item(p.in[I_WUKV], KVL, 1024, 1024 / 32, WukvT, [](int n0) { return n0; }, scr, it, lane, p.in[I_KVNG]);
            for (int it = gw; it < (D / 64) * (D / 32); it += NGW) transpose_item(p.in[I_WOUT], D, D, D / 32, WoutT, [](int n0) { return n0; }, scr, it, lane);
            for (int c = bid; c < GU_STATIC; c += G) convert_chunk(p.in[I_WGU], p.in[I_WDN], WguT, WdnT, 0, c, scr, wave, lane);
        }
    }
    PH_END(0)
    SEAM(0);
    PH_BEGIN(1) if (IN(1)) {
        const float* g1n = p.in[I_N1G];
        for (int e = bid * NT + tid; e < 4 * D; e += G * NT) GM2[e] = p.in[I_N2G][e & 1023] * (1.f + MOD[(e >> 10) * 6144 + 4 * D + (e & 1023)]);
        for (int r = bid * 8 + wave; r < MT; r += G * 8) {
            const float* src = (r < MX) ? p.in[I_X] + (size_t)r * D : p.in[I_CTX] + (size_t)(r - MX) * D;
            const int mb = (r < MX) ? r / S : 4;
            const float* sh = MOD + mb * 6144, *sc = sh + D;
            float v[16]; float ss = 0.f;
#pragma unroll
            for (int j = 0; j < 4; ++j) { const float4 t = *(const float4*)(src + j * 256 + lane * 4); v[4 * j] = t.x; v[4 * j + 1] = t.y; v[4 * j + 2] = t.z; v[4 * j + 3] = t.w; ss += t.x * t.x + t.y * t.y + t.z * t.z + t.w * t.w; }
            const float rstd = rsqrtf(wave_sum(ss) * (1.f / D) + EPS);
#pragma unroll
            for (int j = 0; j < 4; ++j) {
                const int c = j * 256 + lane * 4; float4 o;
                o.x = v[4 * j] * rstd * g1n[c] * (1.f + sc[c]) + sh[c];
                o.y = v[4 * j + 1] * rstd * g1n[c + 1] * (1.f + sc[c + 1]) + sh[c + 1];
                o.z = v[4 * j + 2] * rstd * g1n[c + 2] * (1.f + sc[c + 2]) + sh[c + 2];
                o.w = v[4 * j + 3] * rstd * g1n[c + 3] * (1.f + sc[c + 3]) + sh[c + 3];
                pg8::u32x2 w; w.x = pg8::cvt_pk_bf16(o.x, o.y); w.y = pg8::cvt_pk_bf16(o.z, o.w);
                *(pg8::u32x2*)(Hb16 + (size_t)r * D + c) = w;
            }
        }
    }
    PH_END(1)
    SEAM(1);
    PH_BEGIN(2) if (IN(2)) {
        pg8::PlainSched Sd; Sd.init(MT, PW, D, D, WinT, G, bid);
        pg8::EpiInproj E{P16, GATES, STAT, K16, ROPEC, ROPES};
        pg8::gemm_phase<pg8::EpiInproj, pg8::PlainSched, true>((LAS unsigned char*)lds_raw, Hb16, D, Sd, E);
        if ((Sd.nwg % G) != 0 && bid >= (Sd.nwg % G))
            pull_chunks(ctl + CW_QGU, GU_STATIC, GU_CHUNKS, 2, p.in[I_WGU], p.in[I_WDN], WguT, WdnT, 0, lds_raw, wave, lane);
    }
    PH_END(2)
    SEAM2(2);
    PH_BEGIN(4) if (IN(4)) {
#ifndef NO_QG
        { pg8::PlainSched Sd; Sd.init(MX, 768, QL, PW, WuqT, G, (bid + G - 16) % G);
          pg8::EpiQ E{Q16, STAT, ROPEC, ROPES};
          pg8::gemm_phase<pg8::EpiQ, pg8::PlainSched, true>((LAS unsigned char*)lds_raw, P16 + O_CQ, QL, Sd, E); }
#endif
#ifndef NO_KVG
        { pg8::PlainSched Sd; Sd.init(MT, 1024, KVL, PW, WukvT, G, bid);
          pg8::EpiKV E{K16, V16, STAT};
          pg8::gemm_phase<pg8::EpiKV, pg8::PlainSched, true>((LAS unsigned char*)lds_raw, P16 + O_CKV, KVL, Sd, E); }
#endif
        for (int u = (bid + 48) % G; u < 16 * ml::NXC; u += G) ml::stepA_unit(P16, GATES, p.in[I_BG], u / ml::NXC, u % ml::NXC, CLOC, NLOC, MLOC, TOT, (char*)lds_raw);
    }
    PH_END(4)
    SEAM(4);
    PH_BEGIN(5) if (IN(5)) {
        ml::stepB(CLOC, NLOC, MLOC, TOT, (unsigned*)CIN, NIN, MIN_, bid * NT + tid, G * NT);
        {
            const int nun = NB * HA * (S / 256);
            for (int i = 0; i * G < nun; ++i) {
                int bh, qb;
                if (G == 256) { const int x = bid & 7, slot = bid >> 3; bh = i * 16 + x * 2 + (slot >> 4); qb = slot & 15; }
                else { const int u = i * G + bid; if (u >= nun) break; bh = u >> 4; qb = u & 15; }
                const int b = bh >> 3, h = bh & 7;
                att::attn_body(Q16 + (size_t)(b * S + qb * 256) * 768 + h * 96, K16 + (size_t)(b * SKV) * 768 + h * 96, V16 + (size_t)(b * SKV) * 512 + h * 64,
                               MIX16 + (size_t)(b * S + qb * 256) * D + h * 64, SKV, (char*)lds_raw);
            }
        }
    }
    PH_END(5)
    SEAM(5);
    PH_BEGIN(6) if (IN(6)) {
        for (int u = bid; u < 16 * 32; u += G) ml::stepC_unit(P16, GATES, p.in[I_BG], CIN, NIN, MIN_, p.in[I_MNG], MIX16, u >> 5, u & 31, (char*)lds_raw);
    }
    PH_END(6)
    SEAM(6);
    PH_BEGIN(7) if (IN(7)) {
        pg8::PlainSched Sd; Sd.init(MX, D, D, D, WoutT, G, bid);
        pg8::EpiResid E{X1, p.in[I_X], MOD, STAT2};
        pg8::gemm_phase<pg8::EpiResid, pg8::PlainSched, true>((LAS unsigned char*)lds_raw, MIX16, D, Sd, E);
    }
    PH_END(7)
    SEAM(7);
    PH_BEGIN(8) if (IN(8)) {
        typedef short bf16x8v __attribute__((ext_vector_type(8)));
        typedef float f32x4v __attribute__((ext_vector_type(4)));
        float* LG = lds;
        LAS int* lcnt = (LAS int*)(lds_raw + 32768); LAS int* gbase = lcnt + 32;
        const float* rb = p.in[I_RB];
        for (int base = bid * 64; base < MX; base += G * 64) {
            if (tid < 32) lcnt[tid] = 0;
            __syncthreads();
            int te[4] = {0, 0, 0, 0}, rk[4] = {0, 0, 0, 0}; float tg[4] = {0.f, 0.f, 0.f, 0.f};
            {
                const int rt = wave & 3, kh = wave >> 2;
                const int r0 = base + 16 * rt, row = lane & 15, kg = lane >> 4, bq = r0 / S;
                float ss;
                { const float4 s0 = *(const float4*)(STAT2 + (size_t)(r0 + row) * 32 + kg * 8), s1 = *(const float4*)(STAT2 + (size_t)(r0 + row) * 32 + kg * 8 + 4);
                  ss = ((s0.x + s0.y) + (s0.z + s0.w)) + ((s1.x + s1.y) + (s1.z + s1.w)); ss += __shfl_xor(ss, 16); ss += __shfl_xor(ss, 32); }
                const float rstd = rsqrtf(ss * (1.f / D) + EPS);
                const int ko = kh * 512 + 8 * kg;
                const float* xr = X1 + (size_t)(r0 + row) * D + ko; const float* gmr = GM2 + bq * D + ko; const float* shr = MOD + bq * 6144 + 3 * D + ko;
                unsigned short* hr = H2 + (size_t)(r0 + row) * D + ko;
                const unsigned short* wh0 = RWH + (size_t)row * D + ko, *wh1 = RWH + (size_t)(16 + row) * D + ko, *wl0 = RWL + (size_t)row * D + ko, *wl1 = RWL + (size_t)(16 + row) * D + ko;
                f32x4v acc0 = {0.f, 0.f, 0.f, 0.f}, acc1 = {0.f, 0.f, 0.f, 0.f};
#pragma unroll 4
                for (int st = 0; st < 16; ++st) {
                    const float4 x0 = *(const float4*)(xr + 32 * st), x1v = *(const float4*)(xr + 32 * st + 4), g0 = *(const float4*)(gmr + 32 * st), g1v = *(const float4*)(gmr + 32 * st + 4), h0 = *(const float4*)(shr + 32 * st), h1 = *(const float4*)(shr + 32 * st + 4);
                    float hv[8] = {x0.x * rstd * g0.x + h0.x, x0.y * rstd * g0.y + h0.y, x0.z * rstd * g0.z + h0.z, x0.w * rstd * g0.w + h0.w, x1v.x * rstd * g1v.x + h1.x, x1v.y * rstd * g1v.y + h1.y, x1v.z * rstd * g1v.z + h1.z, x1v.w * rstd * g1v.w + h1.w};
                    pg8::u32x4 hi4, lo4;
#pragma unroll
                    for (int q = 0; q < 4; ++q) { hi4[q] = pg8::cvt_pk_bf16(hv[2 * q], hv[2 * q + 1]);
                        lo4[q] = pg8::cvt_pk_bf16(hv[2 * q] - __uint_as_float(hi4[q] << 16), hv[2 * q + 1] - __uint_as_float(hi4[q] & 0xffff0000u)); }
                    *(pg8::u32x4*)(hr + 32 * st) = hi4;
                    const bf16x8v ah = *reinterpret_cast<const bf16x8v*>(&hi4), al = *reinterpret_cast<const bf16x8v*>(&lo4);
                    const bf16x8v bh0 = *reinterpret_cast<const bf16x8v*>(wh0 + 32 * st), bh1 = *reinterpret_cast<const bf16x8v*>(wh1 + 32 * st), bl0 = *reinterpret_cast<const bf16x8v*>(wl0 + 32 * st), bl1 = *reinterpret_cast<const bf16x8v*>(wl1 + 32 * st);
                    acc0 = __builtin_amdgcn_mfma_f32_16x16x32_bf16(ah, bh0, acc0, 0, 0, 0); acc0 = __builtin_amdgcn_mfma_f32_16x16x32_bf16(al, bh0, acc0, 0, 0, 0); acc0 = __builtin_amdgcn_mfma_f32_16x16x32_bf16(ah, bl0, acc0, 0, 0, 0);
                    acc1 = __builtin_amdgcn_mfma_f32_16x16x32_bf16(ah, bh1, acc1, 0, 0, 0); acc1 = __builtin_amdgcn_mfma_f32_16x16x32_bf16(al, bh1, acc1, 0, 0, 0); acc1 = __builtin_amdgcn_mfma_f32_16x16x32_bf16(ah, bl1, acc1, 0, 0, 0);
                }
                float* lgp = LG + kh * (64 * 33);
#pragma unroll
                for (int j = 0; j < 4; ++j) { lgp[(16 * rt + 4 * kg + j) * 33 + row] = acc0[j]; lgp[(16 * rt + 4 * kg + j) * 33 + 16 + row] = acc1[j]; }
            }
            __syncthreads();
            if (wave < 4 && lane < 16) {
                float* lr = LG + (16 * wave + lane) * 33; float tv[4];
                for (int e = 0; e < 32; ++e) lr[e] = (lr[e] + lr[64 * 33 + e]) + rb[e];
#pragma unroll
                for (int k = 0; k < 4; ++k) { float best = -3.0e38f; int bi = 0;
                    for (int e = 0; e < 32; ++e) { const float v = lr[e]; if (v > best) { best = v; bi = e; } }
                    te[k] = bi; tv[k] = best; lr[bi] = -3.0e38f; }
                const float e1 = __expf(tv[1] - tv[0]), e2 = __expf(tv[2] - tv[0]), e3 = __expf(tv[3] - tv[0]); const float inv = 1.f / (1.f + e1 + e2 + e3);
                tg[0] = inv; tg[1] = e1 * inv; tg[2] = e2 * inv; tg[3] = e3 * inv;
#pragma unroll
                for (int k = 0; k < 4; ++k) rk[k] = atomicAdd((int*)&lcnt[te[k]], 1);
            }
            __syncthreads();
            if (tid < 32) gbase[tid] = (int)atomicAdd(&CNT[tid], (unsigned)lcnt[tid]);
            __syncthreads();
            if (wave < 4 && lane < 16) { const int r = base + 16 * wave + lane;
#pragma unroll
                for (int k = 0; k < 4; ++k) { const int e = te[k], pos = gbase[e] + rk[k]; TOPE[r * 4 + k] = e; SLOT[r * 4 + k] = pos; LIST[e * MX + pos] = r; RGATE[e * MX + pos] = tg[k]; } }
            __syncthreads();
        }
    }
    if (IN(8)) pull_chunks(ctl + CW_QGU, GU_STATIC, GU_CHUNKS, GU_CHUNKS, p.in[I_WGU], p.in[I_WDN], WguT, WdnT, 0, lds_raw, wave, lane);
    PH_END(8)
    SEAM(8);
    LAS int* mtp = (LAS int*)(lds_raw + 131072); LAS int* mro = mtp + 40; LAS int* mcn = mro + 40;
    if (IN(9) || IN(10) || IN(11)) {
        __syncthreads();
        if (tid == 0) { int tp = 0; for (int e = 0; e < NE; ++e) { const int cnt = (int)__hip_atomic_load(&CNT[e], __ATOMIC_RELAXED, __HIP_MEMORY_SCOPE_AGENT); mcn[e] = cnt; mtp[e] = tp; mro[e] = tp * 256; tp += (cnt + 255) / 256; } mtp[NE] = tp; mro[NE] = tp * 256; }
        __syncthreads();
    }
    PH_BEGIN(9) if (IN(9)) {
        pg8::MoeSched Sd{mtp, mro, mcn, DFF / 128, G, bid, D, D, 1, LIST, (const char*)WguT, (size_t)2 * DFF * D * 2};
        pg8::EpiSwiglu E{ACT, p.in[I_BGU]};
        pg8::gemm_phase<pg8::EpiSwiglu, pg8::MoeSched, true>((LAS unsigned char*)lds_raw, H2, D, Sd, E);
        {
            const int nun = mtp[NE] * (DFF / 128); const int mine = (nun - bid + G - 1) / G, most = (nun + G - 1) / G;
            if (mine < most) pull_chunks(ctl + CW_QDN, 0, DN_CHUNKS, 3, p.in[I_WGU], p.in[I_WDN], WguT, WdnT, 1, lds_raw, wave, lane);
            pull_chunks(ctl + CW_QDN, 0, DN_CHUNKS, DN_CHUNKS, p.in[I_WGU], p.in[I_WDN], WguT, WdnT, 1, lds_raw, wave, lane);
        }
    }
    PH_END(9)
    SEAM(9);
    PH_BEGIN(10) if (IN(10)) {
        pg8::MoeSched Sd{mtp, mro, mcn, D / 256, G, bid, DFF, DFF, 0, LIST, (const char*)WdnT, (size_t)D * DFF * 2};
        pg8::EpiDown E{YG, p.in[I_BDN], RGATE, mro};
        pg8::gemm_phase<pg8::EpiDown, pg8::MoeSched, true>((LAS unsigned char*)lds_raw, ACT, DFF, Sd, E);
    }
    PH_END(10)
    SEAM(10);
    PH_BEGIN(11) if (IN(11)) {
        const float* fng = p.in[I_FNG];
        for (int r = bid * 8 + wave; r < MX; r += G * 8) {
            const int mb = r / S; const float* g2 = MOD + mb * 6144 + 5 * D;
            float acc[16];
#pragma unroll
            for (int i = 0; i < 16; ++i) acc[i] = 0.f;
#pragma unroll
            for (int k = 0; k < 4; ++k) {
                const int e = TOPE[r * 4 + k]; const int row = mro[e] + SLOT[r * 4 + k];
                const unsigned short* yr = YG + (size_t)row * D;
#pragma unroll
                for (int j = 0; j < 4; ++j) { const pg8::u32x2 t = *(const pg8::u32x2*)(yr + j * 256 + lane * 4);
                    acc[4 * j] += __uint_as_float(t.x << 16); acc[4 * j + 1] += __uint_as_float(t.x & 0xffff0000u); acc[4 * j + 2] += __uint_as_float(t.y << 16); acc[4 * j + 3] += __uint_as_float(t.y & 0xffff0000u); }
            }
            float v[16]; float ss = 0.f;
#pragma unroll
            for (int j = 0; j < 4; ++j) { const float4 t = *(const float4*)(X1 + (size_t)r * D + j * 256 + lane * 4); const int c = j * 256 + lane * 4;
                v[4 * j] = t.x + g2[c] * acc[4 * j]; v[4 * j + 1] = t.y + g2[c + 1] * acc[4 * j + 1]; v[4 * j + 2] = t.z + g2[c + 2] * acc[4 * j + 2]; v[4 * j + 3] = t.w + g2[c + 3] * acc[4 * j + 3];
                ss += v[4 * j] * v[4 * j] + v[4 * j + 1] * v[4 * j + 1] + v[4 * j + 2] * v[4 * j + 2] + v[4 * j + 3] * v[4 * j + 3]; }
            const float rstd = rsqrtf(wave_sum(ss) * (1.f / D) + EPS);
#pragma unroll
            for (int j = 0; j < 4; ++j) { const int c = j * 256 + lane * 4;
                *(float4*)(p.out + (size_t)r * D + c) = make_float4(v[4 * j] * rstd * fng[c], v[4 * j + 1] * rstd * fng[c + 1], v[4 * j + 2] * rstd * fng[c + 2], v[4 * j + 3] * rstd * fng[c + 3]); }
        }
    }
    PH_END(11)
#undef IN
#undef SEAM
}

#ifndef PROBE_SPLIT_DUP
#define PROBE_SPLIT_DUP (-1)
#endif
#ifndef N_LAUNCH_SPLIT
#define N_LAUNCH_SPLIT 0
#endif

extern "C" void kernel_launch(void* const* d_in, const int* in_sizes, int n_in, void* d_out, int out_size, void* d_ws, size_t ws_size, hipStream_t stream) {
    static int grid = 0;
    if (grid == 0) {
        if (n_in != 23 || out_size != MX * D || ws_size < WS_END) { fprintf(stderr, "kernel_launch: unexpected shapes n_in %d out %d ws %zu (need %zu)\n", n_in, out_size, ws_size, (size_t)WS_END); grid = -1; return; }
        int dev = 0, cus = 0, per_cu = 0;
        hipGetDevice(&dev); hipDeviceGetAttribute(&cus, hipDeviceAttributeMultiprocessorCount, dev);
        if (hipFuncSetAttribute((const void*)fwd_kernel, hipFuncAttributeMaxDynamicSharedMemorySize, LDS_BYTES) != hipSuccess) { fprintf(stderr, "kernel_launch: hipFuncSetAttribute failed\n"); grid = -1; return; }
        hipOccupancyMaxActiveBlocksPerMultiprocessor(&per_cu, (const void*)fwd_kernel, NT, LDS_BYTES);
        if (per_cu < 1) fprintf(stderr, "kernel_launch: occupancy query says %d\n", per_cu);
        (void)hipGetLastError();
        grid = cus > 0 ? cus : 256;
    }
    if (grid < 0) return;
    hipMemsetAsync((char*)d_ws + WS_CTL, 0, CTL_BYTES, stream);
    Params p{};
    for (int i = 0; i < 23; ++i) p.in[i] = (const float*)d_in[i];
    p.out = (float*)d_out; p.ws = (unsigned char*)d_ws;
#if N_LAUNCH_SPLIT
    for (int k = 0; k < N_PHASES; ++k) {
        if (k == 3) continue;
        const int reps = (k == PROBE_SPLIT_DUP) ? 2 : 1;
        for (int r = 0; r < reps; ++r) {
            if (k == 8 && r == 1) hipMemsetAsync((char*)d_ws + WS_CTL, 0, CTL_BYTES, stream);
            p.ph_lo = k; p.ph_hi = k + 1; hipLaunchKernelGGL(fwd_kernel, dim3(grid), dim3(NT), LDS_BYTES, stream, p);
        }
    }
#else
    p.ph_lo = 0; p.ph_hi = N_PHASES;
    hipLaunchKernelGGL(fwd_kernel, dim3(grid), dim3(NT), LDS_BYTES, stream, p);
#endif
}
```

```cpp
#include <hip/hip_runtime.h>
#include <cstdio>
#include <cstdint>

#define LAS __attribute__((address_space(3)))

#define XB_TMO      128
#define XB_XCNT(j)  (256  + 64 * (j))
#define XB_XSUB(j)  (1280 + 64 * (j))
#define XB_XGEN(j)  (2304 + 64 * (j))
#define XB_TOP      3328
#define XB_TOPGEN   3392
#define XCD_BAR_WORDS 3456
#define XB_SPIN_CAP (1u << 22)

__device__ __forceinline__ unsigned xb_ld(unsigned* p)              { return __hip_atomic_load(p, __ATOMIC_RELAXED, __HIP_MEMORY_SCOPE_AGENT); }
__device__ __forceinline__ unsigned xb_add(unsigned* p, unsigned v) { return __hip_atomic_fetch_add(p, v, __ATOMIC_RELAXED, __HIP_MEMORY_SCOPE_AGENT); }
__device__ __forceinline__ unsigned xb_xcc_id() { return (unsigned)__builtin_amdgcn_s_getreg((3 << 11) | 20) & 0xFu; }
#define XB_SPIN(cond, bar) do { unsigned _sp = 0; while (cond) { __builtin_amdgcn_s_sleep(1); \
    if ((++_sp & 255u) == 0u) { if (xb_ld(&(bar)[XB_TMO])) break; if (_sp > XB_SPIN_CAP) { atomicAdd(&(bar)[XB_TMO], 1u); break; } } } } while (0)

struct XcdBarrier { unsigned* bar; unsigned x; volatile LAS unsigned* st; };

__device__ __forceinline__ XcdBarrier xcd_barrier_post(unsigned* bar, volatile LAS unsigned* st) {
    XcdBarrier b; b.bar = bar; b.x = xb_xcc_id(); b.st = st;
    if (threadIdx.x == 0) (void)xb_add(&bar[XB_XCNT(b.x)], 1u);
    return b;
}
__device__ __forceinline__ void xcd_barrier_complete(unsigned* bar, unsigned x, unsigned& nloc, unsigned& nx) {
    const unsigned G = gridDim.x * gridDim.y * gridDim.z;
    unsigned sum, cnt, mine, sp = 0u;
    for (;;) {
        sum = 0u; cnt = 0u; mine = 0u;
#pragma unroll
        for (unsigned j = 0; j < 16; ++j) { const unsigned c = xb_ld(&bar[XB_XCNT(j)]); sum += c; cnt += (c > 0u) ? 1u : 0u; mine = (j == x) ? c : mine; }
        if (sum == G) break;
        __builtin_amdgcn_s_sleep(1);
        if ((++sp & 255u) == 0u) { if (xb_ld(&bar[XB_TMO])) break; if (sp > XB_SPIN_CAP) { atomicAdd(&bar[XB_TMO], 1u); break; } }
    }
    nloc = mine > 0u ? mine : 1u; nx = cnt > 0u ? cnt : 1u;
}
__device__ __forceinline__ void xcd_barrier(const XcdBarrier& b) {
    asm volatile("s_waitcnt vmcnt(0)" ::: "memory");
    __syncthreads();
    if (threadIdx.x == 0) {
        unsigned* bar = b.bar;
        __builtin_amdgcn_s_waitcnt(0);
        unsigned nloc = b.st[0], nx = b.st[1];
        if (nloc == 0u) { xcd_barrier_complete(bar, b.x, nloc, nx); b.st[0] = nloc; b.st[1] = nx; }
        const unsigned old = xb_add(&bar[XB_XSUB(b.x)], 1u);
        const unsigned gen = old / nloc;
        if (old + 1u == (gen + 1u) * nloc) {
            __builtin_amdgcn_fence(__ATOMIC_RELEASE, "agent");
            asm volatile("s_waitcnt vmcnt(0)" ::: "memory");
            const unsigned og = xb_add(&bar[XB_TOP], 1u);
            const unsigned tg = og / nx;
            if (og + 1u == (tg + 1u) * nx) xb_add(&bar[XB_TOPGEN], 1u);
            else XB_SPIN(xb_ld(&bar[XB_TOPGEN]) == tg, bar);
            __builtin_amdgcn_fence(__ATOMIC_ACQUIRE, "agent");
            xb_add(&bar[XB_XGEN(b.x)], 1u);
            asm volatile("s_waitcnt vmcnt(0)" ::: "memory");
        } else {
            XB_SPIN(xb_ld(&bar[XB_XGEN(b.x)]) == gen, bar);
            __builtin_amdgcn_fence(__ATOMIC_ACQUIRE, "agent");
            asm volatile("s_waitcnt vmcnt(0)" ::: "memory");
        }
    }
    __syncthreads();
}

constexpr int D = 1024, NB = 4, S = 4096, CTX = 256, SKV = S + CTX;
constexpr int MX = NB * S, MC = NB * CTX, MT = MX + MC;
constexpr int INW = 2224, PW = 2304;
constexpr int O_CQ = 0, O_CKV = 384, O_KR = 640, O_MQ = 672, O_MK = 928, O_MV = 1184, O_MO = 1696, O_G = 2208;
constexpr int QL = 384, KVL = 256, HA = 8, DN = 64, DR = 32, DQK = 96, DVH = 64;
constexpr int NH = 4, MDQK = 64, MDV = 128;
constexpr int NE = 32, TOPK = 4, DFF = 1024;
constexpr float EPS = 1e-6f;
constexpr int NT = 512;
constexpr int NSEQ = NB * NH * 2;
constexpr int RCAP = MX * TOPK + NE * 256;

constexpr size_t MiB = 1u << 20;
constexpr size_t WS_CTL = 0, CTL_BYTES = 1 * MiB;
constexpr size_t WS_MOD = 1 * MiB;
constexpr size_t WS_MLS = 2 * MiB;
constexpr size_t WS_ROPE = 5 * MiB;
constexpr size_t WS_STAT2 = 6 * MiB;
constexpr size_t WS_TOPE = 8 * MiB;
constexpr size_t WS_SLOT = 9 * MiB;
constexpr size_t WS_LIST = 10 * MiB;
constexpr size_t WS_RGATE = 12 * MiB;
constexpr size_t WS_H = 16 * MiB;
constexpr size_t WS_P = 52 * MiB;
constexpr size_t WS_ACT = WS_P;
constexpr size_t WS_Q = 206 * MiB;
constexpr size_t WS_KV = 254 * MiB;
constexpr size_t WS_CLOC = 322 * MiB;
constexpr size_t WS_CIN = 386 * MiB;
constexpr size_t WS_X1 = 450 * MiB;
constexpr size_t WS_H2 = 514 * MiB;
constexpr size_t WS_YG = 546 * MiB;
constexpr size_t WS_WGUT = 690 * MiB;
constexpr size_t WS_WDNT = 818 * MiB;
constexpr size_t WS_WINT = 882 * MiB;
constexpr size_t WS_WUQT = 887 * MiB;
constexpr size_t WS_WUKVT = 888 * MiB;
constexpr size_t WS_WOUTT = 889 * MiB;
constexpr size_t WS_GATES = 891 * MiB;
constexpr size_t WS_STAT = 893 * MiB;
constexpr size_t WS_RSTD = 895 * MiB;
constexpr size_t WS_MIX16 = 896 * MiB;
constexpr size_t WS_END = 928 * MiB;
static_assert((size_t)MT * PW * 2 <= 153 * MiB && (size_t)RCAP * DFF * 2 <= 144 * MiB, "map");

constexpr int CW_BAR = 4096;
constexpr int CW_CNT = 16384;
constexpr int CW_QGU = 16384 + 64, CW_QDN = 16384 + 128;
constexpr int GU_CHUNKS = 512, DN_CHUNKS = 256;
#ifndef GU_STATIC
#define GU_STATIC 312
#endif

struct Params {
    const float* in[23];
    float* out;
    unsigned char* ws;
    int ph_lo, ph_hi;
};
enum { I_X = 0, I_C, I_CTX, I_CCTX, I_WMOD, I_BMOD, I_N1G, I_WIN, I_BG, I_QNG, I_WUQ, I_KVNG, I_WUKV, I_MNG, I_WOUT, I_N2G, I_RW, I_RB, I_WGU, I_BGU, I_WDN, I_BDN, I_FNG };

__device__ __forceinline__ float wave_sum(float v) {
#pragma unroll
    for (int o = 1; o < 64; o <<= 1) v += __shfl_xor(v, o);
    return v;
}
__device__ __forceinline__ float bf2f(unsigned short v) { return __uint_as_float(((unsigned)v) << 16); }
__device__ __forceinline__ float sigmoidf_(float x) { return 1.f / (1.f + __expf(-x)); }
__device__ __forceinline__ float siluf_(float x) { return x / (1.f + expf(-x)); }
__device__ __forceinline__ float logsigmoidf_(float x) { return fminf(x, 0.f) - log1pf(expf(-fabsf(x))); }

__device__ __forceinline__ int krow(int b, int key) { return key < CTX ? MX + b * CTX + key : b * S + (key - CTX); }
__device__ __forceinline__ int srow(int b, int dir, int u) {
    if (u < CTX) { const int c = dir ? (CTX - 1 - u) : u; return MX + b * CTX + c; }
    const int tt = u - CTX; const int s = dir ? (S - 1 - tt) : tt; return b * S + s;
}
__device__ __forceinline__ void rope_angles(int s, int j, float& cs, float& sn) {
    const int jj = j & 7; const float pos = (j < 8) ? (float)(s / 64) : (float)(s % 64);
    const float inv = powf(10000.f, -(float)jj / 8.f);
    const float ang = pos * inv; cs = cosf(ang); sn = sinf(ang);
}

struct GemmDesc { const float* A; int lda; const int* arow; int M; const float* B; int ldb; int N; int K; };
template <class Epi>
__device__ __forceinline__ void sgemm_tile(float* lds, const GemmDesc g, int tm, int tn, const Epi& epi) {
    float* As = lds;
    float* Bs = lds + 16 * 132;
    const int tid = threadIdx.x, tx = tid & 15, ty = tid >> 4;
    float acc[4][8];
#pragma unroll
    for (int i = 0; i < 4; ++i)
#pragma unroll
        for (int j = 0; j < 8; ++j) acc[i][j] = 0.f;
    const int ar = tid >> 2, ak = (tid & 3) * 4;
    const int grow = tm * 128 + ar;
    const float* aptr = nullptr;
    if (grow < g.M) { const int r = g.arow ? g.arow[grow] : grow; aptr = g.A + (size_t)r * g.lda + ak; }
    const int bk = tid >> 5, bc = (tid & 31) * 4;
    const int gcol = tn * 128 + bc;
    for (int k0 = 0; k0 < g.K; k0 += 16) {
        float4 av = make_float4(0.f, 0.f, 0.f, 0.f), bv = make_float4(0.f, 0.f, 0.f, 0.f);
        if (aptr) av = *(const float4*)(aptr + k0);
        if (gcol < g.N) bv = *(const float4*)(g.B + (size_t)(k0 + bk) * g.ldb + gcol);
        __syncthreads();
        As[(ak + 0) * 132 + ar] = av.x; As[(ak + 1) * 132 + ar] = av.y; As[(ak + 2) * 132 + ar] = av.z; As[(ak + 3) * 132 + ar] = av.w;
        *(float4*)(Bs + bk * 128 + bc) = bv;
        __syncthreads();
#pragma unroll
        for (int k = 0; k < 16; ++k) {
            const float4 a4 = *(const float4*)(As + k * 132 + ty * 4);
            const float4 b0 = *(const float4*)(Bs + k * 128 + tx * 8), b1 = *(const float4*)(Bs + k * 128 + tx * 8 + 4);
            const float a[4] = {a4.x, a4.y, a4.z, a4.w};
            const float b[8] = {b0.x, b0.y, b0.z, b0.w, b1.x, b1.y, b1.z, b1.w};
#pragma unroll
            for (int i = 0; i < 4; ++i)
#pragma unroll
                for (int j = 0; j < 8; ++j) acc[i][j] = fmaf(a[i], b[j], acc[i][j]);
        }
    }
#pragma unroll
    for (int i = 0; i < 4; ++i) {
        const int r = tm * 128 + ty * 4 + i;
        if (r < g.M) {
#pragma unroll
            for (int j = 0; j < 8; ++j) { const int c = tn * 128 + tx * 8 + j; if (c < g.N) epi(r, c, acc[i][j]); }
        }
    }
}
template <class Epi>
__device__ __forceinline__ void sgemm_phase(float* lds, const GemmDesc g, const Epi& epi, int u0 = 0, int ustride = 0) {
    const int ntm = (g.M + 127) / 128, ntn = (g.N + 127) / 128;
    for (int u = blockIdx.x; u < ntm * ntn; u += gridDim.x) sgemm_tile(lds, g, u / ntn, u % ntn, epi);
}


namespace pg8 {
#define PG8_LAS __attribute__((address_space(3)))
typedef unsigned short bf16_t;
typedef short bf16x8 __attribute__((ext_vector_type(8)));
typedef float f32x4 __attribute__((ext_vector_type(4)));
typedef unsigned u32x4 __attribute__((ext_vector_type(4)));
typedef unsigned u32x2 __attribute__((ext_vector_type(2)));
constexpr int BM = 256, BK = 64, HALF = 128, HTB = HALF * BK * 2, STAGE_BYTES = 8 * HTB, NXCD = 8, WGM = 8;
__host__ __device__ __forceinline__ int lds_byte(int r, int c) { const int st = (r >> 4) * 2 + (c >> 5), rr = r & 15, cc = c & 31, ob = rr * 64 + cc * 2; return st * 1024 + (ob ^ (((ob >> 9) & 1) << 5)); }
__host__ __device__ __forceinline__ void stage_rc(int b, int& R, int& C) { const int st = b / 1024, sb = b % 1024, swz = sb ^ (((sb >> 9) & 1) << 5); R = (st >> 1) * 16 + swz / 64; C = (st & 1) * 32 + (swz % 64) / 2; }
__host__ __device__ __forceinline__ int perm32(int rho) { const int n = rho >> 4, i = rho & 15; return 8 * (i >> 2) + 4 * n + (i & 3); }
__device__ __forceinline__ unsigned cvt_pk_bf16(float lo, float hi) { unsigned r; asm volatile("v_cvt_pk_bf16_f32 %0, %1, %2" : "=v"(r) : "v"(lo), "v"(hi)); return r; }

struct Unit { int pm, pn, g, row0; };

struct PlainSched {
    int nM, nN, nwg, G, c, lda, K; const char* Bt;
    __device__ void init(int M, int N, int K_, int lda_, const void* Bt_, int G_, int c_) { nM = M / BM; nN = N / BM; nwg = nM * nN; G = G_; c = c_; lda = lda_; K = K_; Bt = (const char*)Bt_; }
    __device__ __forceinline__ bool next(int i, Unit& u) const {
        const long L = (long)i * G + c; if (L >= nwg) return false;
        int wgid = (int)L; { const int q = nwg / NXCD, r = nwg % NXCD, xcd = wgid % NXCD, off = wgid / NXCD; wgid = (xcd < r ? xcd * (q + 1) : r * (q + 1) + (xcd - r) * q) + off; }
        const int nig = WGM * nN, gid = wgid / nig, fm = gid * WGM, gsz = (nM - fm) < WGM ? (nM - fm) : WGM;
        u.pm = fm + ((wgid % nig) % gsz); u.pn = (wgid % nig) / gsz; u.g = 0; u.row0 = u.pm * BM; return true;
    }
    __device__ __forceinline__ unsigned a_rowoff(const Unit& u, int r) const { return (unsigned)(u.pm * BM + r) * (unsigned)(lda * 2); }
    __device__ __forceinline__ void rows4(const Unit& u, int R0, int R1, unsigned (&o)[4]) const { o[0] = a_rowoff(u, R0); o[1] = a_rowoff(u, R1); o[2] = a_rowoff(u, HALF + R0); o[3] = a_rowoff(u, HALF + R1); }
    __device__ __forceinline__ const char* b_base(const Unit& u) const { return Bt + (size_t)u.pn * BM * K * 2; }
};

template <class Epi, class Sched, bool ALIGN_EPI>
__device__ __forceinline__ void gemm_phase(PG8_LAS unsigned char* lds, const bf16_t* Aptr, const int K, const Sched& S, const Epi& E) {
    const int tid = threadIdx.x, wid = __builtin_amdgcn_readfirstlane(tid >> 6), lane = tid & 63, wr = wid >> 2, wc = wid & 3, fr = lane & 15, fq = lane >> 4;
    const int nt = K / BK;
    unsigned voffB[2];
#pragma unroll
    for (int i = 0; i < 2; ++i) { int R, C; stage_rc(tid * 16 + i * 8192, R, C); const int Rb = Epi::PERM ? ((R & ~31) + perm32(R & 31)) : R;
        voffB[i] = (unsigned)(Rb * K + C) * 2u; }
    const size_t kstep = (size_t)(BK * 2);
    const size_t hstepB = (size_t)HALF * K * 2;
    const unsigned ldsw = (unsigned)wid * 1024u;
    const int aoff = lds_byte(wr * 64 + fr, fq * 8), boff = lds_byte(wc * 32 + fr, fq * 8);
#define PG8_SA(b, h) (((b) * 2 + (h)) * HTB)
#define PG8_SB(b, h) ((4 + (b) * 2 + (h)) * HTB)
#define PG8_STAGE(bufoff, gbase, voff) do { _Pragma("unroll") for (int _i = 0; _i < 2; ++_i) \
        __builtin_amdgcn_global_load_lds((const unsigned*)((const char*)(gbase) + (voff)[_i]), (PG8_LAS unsigned*)(lds + (bufoff) + ldsw + _i * 8192), 16, 0, 0); } while (0)
#define PG8_LDA(dst, b, h) do { _Pragma("unroll") for (int m = 0; m < 4; ++m) _Pragma("unroll") for (int k = 0; k < 2; ++k) dst[m][k] = *(const PG8_LAS bf16x8*)(lds + PG8_SA(b, h) + aoff + m * 2048 + k * 1024); } while (0)
#define PG8_LDB(dst, b, h) do { _Pragma("unroll") for (int n = 0; n < 2; ++n) _Pragma("unroll") for (int k = 0; k < 2; ++k) dst[n][k] = *(const PG8_LAS bf16x8*)(lds + PG8_SB(b, h) + boff + n * 2048 + k * 1024); } while (0)
#define PG8_MMA(ai, bj, At, Bt) do { __builtin_amdgcn_s_setprio(1); _Pragma("unroll") for (int m = 0; m < 4; ++m) _Pragma("unroll") for (int n = 0; n < 2; ++n) _Pragma("unroll") for (int k = 0; k < 2; ++k) \
        acc[ai][bj][m][n] = __builtin_amdgcn_mfma_f32_16x16x32_bf16(Bt[n][k], At[m][k], acc[ai][bj][m][n], 0, 0, 0); __builtin_amdgcn_s_setprio(0); } while (0)
#define PG8_WAIT_V(n) asm volatile("s_waitcnt vmcnt(" #n ")" ::: "memory")
#define PG8_WAIT_L(n) asm volatile("s_waitcnt lgkmcnt(" #n ")" ::: "memory")
#define PG8_BAR __builtin_amdgcn_s_barrier()
#define PG8_SCHED __builtin_amdgcn_sched_barrier(0)
    Unit cur, nxt; int ui = 0;
    if (!S.next(0, cur)) return;
    f32x4 acc[2][2][4][2];
#pragma unroll
    for (int a = 0; a < 2; ++a)
#pragma unroll
        for (int b = 0; b < 2; ++b)
#pragma unroll
            for (int m = 0; m < 4; ++m)
#pragma unroll
                for (int n = 0; n < 2; ++n) acc[a][b][m][n] = (f32x4){0.f, 0.f, 0.f, 0.f};
    bf16x8 At[4][2], B0[2][2], B1[2][2];
    unsigned oA0[2], oA1[2];
    { int R0, C0, R1, C1; stage_rc(tid * 16, R0, C0); stage_rc(tid * 16 + 8192, R1, C1); unsigned o4[4]; S.rows4(cur, R0, R1, o4);
      oA0[0] = o4[0] + (unsigned)C0 * 2u; oA0[1] = o4[1] + (unsigned)C1 * 2u; oA1[0] = o4[2] + (unsigned)C0 * 2u; oA1[1] = o4[3] + (unsigned)C1 * 2u; }
    const char* const cA = (const char*)Aptr;
    const char* cB = S.b_base(cur);
    PG8_STAGE(PG8_SB(0, 0), cB, voffB); PG8_STAGE(PG8_SB(0, 1), cB + hstepB, voffB); PG8_STAGE(PG8_SA(0, 0), cA, oA0); PG8_STAGE(PG8_SA(0, 1), cA, oA1);
    if (wr == 1) PG8_BAR;
    PG8_WAIT_V(2); PG8_BAR;
    PG8_STAGE(PG8_SB(1, 0), cB + kstep, voffB); PG8_STAGE(PG8_SA(1, 0), cA + kstep, oA0); PG8_STAGE(PG8_SB(1, 1), cB + hstepB + kstep, voffB);
    PG8_WAIT_V(6); PG8_BAR;
    for (;;) {
        const bool has_next = S.next(ui + 1, nxt);
        const char* nB = has_next ? S.b_base(nxt) : cB;
        unsigned pre[4] = {0u, 0u, 0u, 0u};
        if (has_next) { int R0, C0, R1, C1; stage_rc((int)threadIdx.x * 16, R0, C0); stage_rc((int)threadIdx.x * 16 + 8192, R1, C1); S.rows4(nxt, R0, R1, pre);
            asm volatile("" : "+v"(pre[0]), "+v"(pre[1]), "+v"(pre[2]), "+v"(pre[3])); }
#pragma unroll 1
        for (int t = 0; t < nt; t += 2) {
            const bool last = (t == nt - 2);
            const char* a1 = cA + (size_t)(t + 1) * kstep;
            const char* a2 = last ? cA : cA + (size_t)(t + 2) * kstep; const char* b2 = last ? nB : cB + (size_t)(t + 2) * kstep;
            const char* a3 = a2 + kstep; const char* b3 = b2 + kstep;
            PG8_LDB(B0, 0, 0); PG8_LDB(B1, 0, 1); PG8_SCHED; PG8_LDA(At, 0, 0); PG8_STAGE(PG8_SA(1, 1), a1, oA1);
            if (last && has_next) {
                int R0, C0, R1, C1; stage_rc((int)threadIdx.x * 16, R0, C0); stage_rc((int)threadIdx.x * 16 + 8192, R1, C1);
                oA0[0] = pre[0] + (unsigned)C0 * 2u; oA0[1] = pre[1] + (unsigned)C1 * 2u; oA1[0] = pre[2] + (unsigned)C0 * 2u; oA1[1] = pre[3] + (unsigned)C1 * 2u;
            }
            PG8_WAIT_V(8); PG8_WAIT_L(0); PG8_BAR; PG8_MMA(0, 0, At, B0); PG8_MMA(0, 1, At, B1); PG8_BAR; PG8_SCHED;
            PG8_LDA(At, 0, 1); PG8_STAGE(PG8_SB(0, 0), b2, voffB); PG8_STAGE(PG8_SB(0, 1), b2 + hstepB, voffB); PG8_STAGE(PG8_SA(0, 0), a2, oA0);
            PG8_WAIT_V(8); PG8_WAIT_L(0); PG8_BAR; PG8_MMA(1, 0, At, B0); PG8_MMA(1, 1, At, B1); PG8_BAR; PG8_SCHED;
            PG8_LDB(B0, 1, 0); PG8_LDB(B1, 1, 1); PG8_SCHED; PG8_LDA(At, 1, 0); PG8_STAGE(PG8_SA(0, 1), a2, oA1);
            PG8_WAIT_V(8); PG8_WAIT_L(0); PG8_BAR; PG8_MMA(0, 0, At, B0); PG8_MMA(0, 1, At, B1); PG8_BAR; PG8_SCHED;
            PG8_LDA(At, 1, 1); PG8_STAGE(PG8_SB(1, 0), b3, voffB); PG8_STAGE(PG8_SB(1, 1), b3 + hstepB, voffB); PG8_STAGE(PG8_SA(1, 0), a3, oA0);
            PG8_WAIT_V(8); PG8_WAIT_L(0); PG8_BAR; PG8_MMA(1, 0, At, B0); PG8_MMA(1, 1, At, B1); PG8_BAR; PG8_SCHED;
        }
        if constexpr (ALIGN_EPI) { if (wr == 0) PG8_BAR; }
        E(acc, cur, wr, wc, fr, fq);
        if (!has_next) break;
#pragma unroll
        for (int a = 0; a < 2; ++a)
#pragma unroll
            for (int b = 0; b < 2; ++b)
#pragma unroll
                for (int m = 0; m < 4; ++m)
#pragma unroll
                    for (int n = 0; n < 2; ++n) acc[a][b][m][n] = (f32x4){0.f, 0.f, 0.f, 0.f};
        cur = nxt; cB = nB; ++ui;
        if constexpr (ALIGN_EPI) { if (wr == 1) PG8_BAR; }
    }
    PG8_WAIT_V(0);
    if constexpr (!ALIGN_EPI) { if (wr == 0) PG8_BAR; }
    PG8_BAR;
#undef PG8_SA
#undef PG8_SB
#undef PG8_STAGE
#undef PG8_LDA
#undef PG8_LDB
#undef PG8_MMA
#undef PG8_WAIT_V
#undef PG8_WAIT_L
#undef PG8_BAR
#undef PG8_SCHED
}

struct EpiF32 {
    static constexpr bool PERM = false;
    float* C; int ldc; int ncols;
    __device__ __forceinline__ void operator()(const f32x4 (&acc)[2][2][4][2], const Unit& u, int wr, int wc, int fr, int fq) const {
        const int row0 = u.row0 + wr * 64 + fr, col0 = u.pn * BM + wc * 32 + 4 * fq;
#pragma unroll
        for (int ai = 0; ai < 2; ++ai)
#pragma unroll
            for (int m = 0; m < 4; ++m) { float* rowp = C + (size_t)(row0 + ai * HALF + m * 16) * ldc + col0;
#pragma unroll
                for (int bj = 0; bj < 2; ++bj)
#pragma unroll
                    for (int n = 0; n < 2; ++n) if (col0 + bj * HALF + n * 16 < ncols) *(f32x4*)(rowp + bj * HALF + n * 16) = acc[ai][bj][m][n]; }
    }
};
struct MoeSched {
    const PG8_LAS int* tp; const PG8_LAS int* ro; const PG8_LAS int* cn; int nN, G, c, K, lda, gather; const int* list; const char* Bt; size_t bstride;
    __device__ __forceinline__ bool next(int i, Unit& u) const {
        const int nwg = tp[32] * nN; const long L = (long)i * G + c; if (L >= nwg) return false;
        int wgid = (int)L; { const int q = nwg / NXCD, r = nwg % NXCD, xcd = wgid % NXCD, off = wgid / NXCD; wgid = (xcd < r ? xcd * (q + 1) : r * (q + 1) + (xcd - r) * q) + off; }
        const int tile = wgid / nN; int g = 0;
#pragma unroll 1
        for (int e = 1; e < 32; ++e) g = (tp[e] <= tile) ? e : g;
        const int ntm = tp[g + 1] - tp[g]; const int rem = wgid - tp[g] * nN;
        u.g = g; u.pm = rem % ntm; u.pn = rem / ntm; u.row0 = ro[g] + u.pm * BM; return true;
    }
    __device__ __forceinline__ unsigned a_rowoff(const Unit& u, int r) const {
        const int rr = u.pm * BM + r;
        if (gather) { const int tok = (rr < cn[u.g]) ? list[u.g * 16384 + rr] : 0; return (unsigned)tok * (unsigned)(lda * 2); }
        return (unsigned)(u.row0 + r) * (unsigned)(lda * 2);
    }
    __device__ __forceinline__ void rows4(const Unit& u, int R0, int R1, unsigned (&o)[4]) const {
        if (gather) { const int last = cn[u.g] - 1, b0 = u.pm * BM; const int* lp = list + u.g * 16384;
            const int t0 = lp[min(b0 + R0, last)], t1 = lp[min(b0 + R1, last)], t2 = lp[min(b0 + HALF + R0, last)], t3 = lp[min(b0 + HALF + R1, last)];
            o[0] = (unsigned)t0 * (unsigned)(lda * 2); o[1] = (unsigned)t1 * (unsigned)(lda * 2); o[2] = (unsigned)t2 * (unsigned)(lda * 2); o[3] = (unsigned)t3 * (unsigned)(lda * 2); }
        else { o[0] = a_rowoff(u, R0); o[1] = a_rowoff(u, R1); o[2] = a_rowoff(u, HALF + R0); o[3] = a_rowoff(u, HALF + R1); }
    }
    __device__ __forceinline__ const char* b_base(const Unit& u) const { return Bt + (size_t)u.g * bstride + (size_t)u.pn * BM * K * 2; }
};
struct EpiSwiglu {
    static constexpr bool PERM = true;
    bf16_t* O; const float* bias;
    __device__ __forceinline__ void operator()(const f32x4 (&acc)[2][2][4][2], const Unit& u, int wr, int wc, int fr, int fq) const {
        const int row0 = u.row0 + wr * 64 + fr, col0 = u.pn * 128 + wc * 32 + 8 * fq;
        const float* bg = bias + (size_t)u.g * 2048 + col0;
        f32x4 bgl[2], bln[2];
#pragma unroll
        for (int n = 0; n < 2; ++n) { bgl[n] = *(const f32x4*)(bg + 4 * n); bln[n] = *(const f32x4*)(bg + 1024 + 4 * n); }
#pragma unroll
        for (int ai = 0; ai < 2; ++ai)
#pragma unroll
            for (int m = 0; m < 4; ++m) {
                float o[8];
#pragma unroll
                for (int n = 0; n < 2; ++n)
#pragma unroll
                    for (int j = 0; j < 4; ++j) {
                        const float gl = fminf(acc[ai][0][m][n][j] + bgl[n][j], 7.f);
                        const float ln = fminf(fmaxf(acc[ai][1][m][n][j] + bln[n][j], -7.f), 7.f);
                        o[4 * n + j] = gl * __builtin_amdgcn_rcpf(1.f + __expf(-1.702f * gl)) * (ln + 1.f);
                    }
                u32x4 w; w.x = cvt_pk_bf16(o[0], o[1]); w.y = cvt_pk_bf16(o[2], o[3]); w.z = cvt_pk_bf16(o[4], o[5]); w.w = cvt_pk_bf16(o[6], o[7]);
                *(u32x4*)(O + (size_t)(row0 + ai * HALF + m * 16) * 1024 + col0) = w;
            }
    }
};
struct EpiDown {
    static constexpr bool PERM = true;
    bf16_t* O; const float* bias; const float* rgate; const PG8_LAS int* ro;
    __device__ __forceinline__ void operator()(const f32x4 (&acc)[2][2][4][2], const Unit& u, int wr, int wc, int fr, int fq) const {
        const int row0 = u.row0 + wr * 64 + fr, col0 = u.pn * BM + wc * 32 + 8 * fq;
        const float* bd = bias + (size_t)u.g * 1024 + col0;
        const float* gt = rgate + (size_t)u.g * 16384 + (row0 - ro[u.g]);
        f32x4 bv[2][2];
#pragma unroll
        for (int bj = 0; bj < 2; ++bj)
#pragma unroll
            for (int n = 0; n < 2; ++n) bv[bj][n] = *(const f32x4*)(bd + bj * HALF + 4 * n);
#pragma unroll
        for (int ai = 0; ai < 2; ++ai)
#pragma unroll
            for (int m = 0; m < 4; ++m) {
                const float gv = gt[ai * HALF + m * 16];
                bf16_t* rowp = O + (size_t)(row0 + ai * HALF + m * 16) * 1024 + col0;
#pragma unroll
                for (int bj = 0; bj < 2; ++bj) { const f32x4 v0 = (acc[ai][bj][m][0] + bv[bj][0]) * gv, v1 = (acc[ai][bj][m][1] + bv[bj][1]) * gv;
                    u32x4 w; w.x = cvt_pk_bf16(v0[0], v0[1]); w.y = cvt_pk_bf16(v0[2], v0[3]); w.z = cvt_pk_bf16(v1[0], v1[1]); w.w = cvt_pk_bf16(v1[2], v1[3]);
                    *(u32x4*)(rowp + bj * HALF) = w; }
            }
    }
};
struct EpiInproj {
    static constexpr bool PERM = true;
    bf16_t* P; float* gates; float* stat; bf16_t* Kb; const float* cs; const float* sn;
    __device__ __forceinline__ void operator()(const f32x4 (&acc)[2][2][4][2], const Unit& u, int wr, int wc, int fr, int fq) const {
        const int row0 = u.row0 + wr * 64 + fr, colb = u.pn * BM + wc * 32 + 8 * fq;
#pragma unroll
        for (int ai = 0; ai < 2; ++ai)
#pragma unroll
            for (int m = 0; m < 4; ++m) { const int row = row0 + ai * HALF + m * 16;
#pragma unroll
                for (int bj = 0; bj < 2; ++bj) { const f32x4 v0 = acc[ai][bj][m][0], v1 = acc[ai][bj][m][1];
                    u32x4 w; w.x = cvt_pk_bf16(v0[0], v0[1]); w.y = cvt_pk_bf16(v0[2], v0[3]); w.z = cvt_pk_bf16(v1[0], v1[1]); w.w = cvt_pk_bf16(v1[2], v1[3]);
                    *(u32x4*)(P + (size_t)row * 2304 + colb + bj * HALF) = w;
                    if (u.pn <= 2) { float sq = (v0[0] * v0[0] + v0[1] * v0[1]) + (v0[2] * v0[2] + v0[3] * v0[3]) + (v1[0] * v1[0] + v1[1] * v1[1]) + (v1[2] * v1[2] + v1[3] * v1[3]);
                        sq += __shfl_xor(sq, 16); sq += __shfl_xor(sq, 32);
                        if (fq == 0) stat[(size_t)row * 24 + (u.pn * 2 + bj) * 4 + wc] = sq; }
                    if (u.pn == 8 && bj == 1 && wc == 1 && fq < 2) { *(f32x4*)(gates + (size_t)row * 16 + fq * 8) = v0; *(f32x4*)(gates + (size_t)row * 16 + fq * 8 + 4) = v1; }
                    if (u.pn == 2 && bj == 1 && wc == 0) {
                        f32x4 r0 = v0, r1 = v1;
                        f32x4 o0, o1;
#pragma unroll
                        for (int j = 0; j < 4; ++j) { o0[j] = __shfl_xor(v0[j], 32); o1[j] = __shfl_xor(v1[j], 32); }
                        int krow;
                        if (row < 16384) { const int pos = row & 4095; const int jb = 8 * (fq & 1);
                            const f32x4 c0 = *(const f32x4*)(cs + pos * 16 + jb), c1 = *(const f32x4*)(cs + pos * 16 + jb + 4), s0 = *(const f32x4*)(sn + pos * 16 + jb), s1 = *(const f32x4*)(sn + pos * 16 + jb + 4);
                            if (fq < 2) { r0 = v0 * c0 - o0 * s0; r1 = v1 * c1 - o1 * s1; } else { r0 = o0 * s0 + v0 * c0; r1 = o1 * s1 + v1 * c1; }
                            krow = (row >> 12) * 4352 + 256 + pos; }
                        else krow = ((row - 16384) >> 8) * 4352 + ((row - 16384) & 255);
                        u32x4 kw; kw.x = cvt_pk_bf16(r0[0], r0[1]); kw.y = cvt_pk_bf16(r0[2], r0[3]); kw.z = cvt_pk_bf16(r1[0], r1[1]); kw.w = cvt_pk_bf16(r1[2], r1[3]);
#pragma unroll
                        for (int hh = 0; hh < 8; ++hh) *(u32x4*)(Kb + (size_t)krow * 768 + hh * 96 + 64 + 8 * fq) = kw;
                    }
                } }
    }
};
struct EpiF32RowScale {
    static constexpr bool PERM = false;
    float* C; int ldc; const float* rs;
    __device__ __forceinline__ void operator()(const f32x4 (&acc)[2][2][4][2], const Unit& u, int wr, int wc, int fr, int fq) const {
        const int row0 = u.row0 + wr * 64 + fr, col0 = u.pn * BM + wc * 32 + 4 * fq;
#pragma unroll
        for (int ai = 0; ai < 2; ++ai)
#pragma unroll
            for (int m = 0; m < 4; ++m) { const int row = row0 + ai * HALF + m * 16; const float sc = rs[row]; float* rowp = C + (size_t)row * ldc + col0;
#pragma unroll
                for (int bj = 0; bj < 2; ++bj)
#pragma unroll
                    for (int n = 0; n < 2; ++n) *(f32x4*)(rowp + bj * HALF + n * 16) = acc[ai][bj][m][n] * sc; }
    }
};
struct EpiResid {
    static constexpr bool PERM = true;
    bf16_t* C; const float* X; const float* mod; float* stat2;
    __device__ __forceinline__ void operator()(const f32x4 (&acc)[2][2][4][2], const Unit& u, int wr, int wc, int fr, int fq) const {
        const int row0 = u.row0 + wr * 64 + fr, col0 = u.pn * BM + wc * 32 + 8 * fq;
        const float* g1 = mod + (size_t)(u.row0 / 4096) * 6144 + 2048 + col0;
        f32x4 gv[2][2];
#pragma unroll
        for (int bj = 0; bj < 2; ++bj)
#pragma unroll
            for (int n = 0; n < 2; ++n) gv[bj][n] = *(const f32x4*)(g1 + bj * HALF + 4 * n);
#pragma unroll
        for (int ai = 0; ai < 2; ++ai)
#pragma unroll
            for (int m = 0; m < 4; ++m) { const size_t off = (size_t)(row0 + ai * HALF + m * 16) * 1024 + col0;
#pragma unroll
                for (int bj = 0; bj < 2; ++bj) {
                    const f32x4 x0 = *(const f32x4*)(X + off + bj * HALF), x1 = *(const f32x4*)(X + off + bj * HALF + 4);
                    const f32x4 o0 = x0 + gv[bj][0] * acc[ai][bj][m][0], o1 = x1 + gv[bj][1] * acc[ai][bj][m][1];
                    u32x4 w; w.x = cvt_pk_bf16(o0[0], o0[1]); w.y = cvt_pk_bf16(o0[2], o0[3]); w.z = cvt_pk_bf16(o1[0], o1[1]); w.w = cvt_pk_bf16(o1[2], o1[3]);
                    *(u32x4*)(C + off + bj * HALF) = w;
                    float sq = ((o0[0] * o0[0] + o0[1] * o0[1]) + (o0[2] * o0[2] + o0[3] * o0[3])) + ((o1[0] * o1[0] + o1[1] * o1[1]) + (o1[2] * o1[2] + o1[3] * o1[3]));
                    sq += __shfl_xor(sq, 16); sq += __shfl_xor(sq, 32);
                    if (fq == 0) stat2[(size_t)(row0 + ai * HALF + m * 16) * 32 + (u.pn * 2 + bj) * 4 + wc] = sq; }
                asm volatile("" ::: "memory"); }
    }
};
struct EpiQ {
    static constexpr bool PERM = false;
    bf16_t* Q; const float* stat; const float* cs; const float* sn;
    __device__ __forceinline__ void operator()(const f32x4 (&acc)[2][2][4][2], const Unit& u, int wr, int wc, int fr, int fq) const {
        const int row0 = u.row0 + wr * 64 + fr;
#pragma unroll
        for (int ai = 0; ai < 2; ++ai)
#pragma unroll
            for (int m = 0; m < 4; ++m) { const int row = row0 + ai * HALF + m * 16; const int pos = row & 4095;
                float sc; { const f32x4* sp = (const f32x4*)(stat + (size_t)row * 24); const f32x4 a0 = sp[0], a1 = sp[1], a2 = sp[2];
                    sc = rsqrtf((((a0[0] + a0[1]) + (a0[2] + a0[3])) + ((a1[0] + a1[1]) + (a1[2] + a1[3])) + ((a2[0] + a2[1]) + (a2[2] + a2[3]))) * (1.f / 384.f) + 1e-6f); }
                const f32x4 cv = *(const f32x4*)(cs + pos * 16 + 4 * fq), sv = *(const f32x4*)(sn + pos * 16 + 4 * fq);
#pragma unroll
                for (int bj = 0; bj < 2; ++bj) { const int c32 = u.pn * BM + bj * HALF + wc * 32; const bool rope = ((c32 % 96) == 64);
                    f32x4 v0 = acc[ai][bj][m][0], v1 = acc[ai][bj][m][1];
                    if (rope) { const f32x4 a = v0 * cv - v1 * sv, b = v0 * sv + v1 * cv; v0 = a; v1 = b; }
                    v0 = v0 * sc; v1 = v1 * sc;
                    u32x2 w0, w1; w0.x = cvt_pk_bf16(v0[0], v0[1]); w0.y = cvt_pk_bf16(v0[2], v0[3]); w1.x = cvt_pk_bf16(v1[0], v1[1]); w1.y = cvt_pk_bf16(v1[2], v1[3]);
                    bf16_t* dst = Q + (size_t)row * 768 + c32 + 4 * fq;
                    *(u32x2*)dst = w0; *(u32x2*)(dst + 16) = w1; }
                asm volatile("" ::: "memory"); }
    }
};
struct EpiKV {
    static constexpr bool PERM = true;
    bf16_t* K; bf16_t* V; const float* stat;
    __device__ __forceinline__ void operator()(const f32x4 (&acc)[2][2][4][2], const Unit& u, int wr, int wc, int fr, int fq) const {
        const int row0 = u.row0 + wr * 64 + fr;
#pragma unroll
        for (int ai = 0; ai < 2; ++ai)
#pragma unroll
            for (int m = 0; m < 4; ++m) { const int row = row0 + ai * HALF + m * 16;
                float sc; { const f32x4* sp = (const f32x4*)(stat + (size_t)row * 24); const f32x4 a3 = sp[3], a4 = sp[4];
                    sc = rsqrtf((((a3[0] + a3[1]) + (a3[2] + a3[3])) + ((a4[0] + a4[1]) + (a4[2] + a4[3]))) * (1.f / 256.f) + 1e-6f); }
                const int krow = (row < 16384) ? ((row >> 12) * 4352 + 256 + (row & 4095)) : (((row - 16384) >> 8) * 4352 + ((row - 16384) & 255));
#pragma unroll
                for (int bj = 0; bj < 2; ++bj) { const int head = 2 * u.pn + bj; const f32x4 v0 = acc[ai][bj][m][0] * sc, v1 = acc[ai][bj][m][1] * sc;
                    u32x4 w; w.x = cvt_pk_bf16(v0[0], v0[1]); w.y = cvt_pk_bf16(v0[2], v0[3]); w.z = cvt_pk_bf16(v1[0], v1[1]); w.w = cvt_pk_bf16(v1[2], v1[3]);
                    if (wc < 2) *(u32x4*)(K + (size_t)krow * 768 + head * 96 + wc * 32 + 8 * fq) = w;
                    else *(u32x4*)(V + (size_t)krow * 512 + head * 64 + (wc - 2) * 32 + 8 * fq) = w; }
                asm volatile("" ::: "memory"); }
    }
};
}

template <class RowMap>
__device__ __forceinline__ void transpose_item(const float* W, int K, int N, int nblk, unsigned short* WT, const RowMap& rowmap, LAS float* scr, int item, int lane, const float* kscale = nullptr) {
    const int kb = item / nblk, nb = item % nblk, k0 = 64 * kb, n0 = 32 * nb;
    const int ncol = n0 + (lane & 31);
    float tv[32];
#pragma unroll
    for (int i = 0; i < 32; ++i) { const int kk = 2 * i + (lane >> 5); tv[i] = (ncol < N) ? __builtin_nontemporal_load(W + (size_t)(k0 + kk) * N + ncol) : 0.f; }
    if (kscale) {
#pragma unroll
        for (int i = 0; i < 32; ++i) tv[i] *= kscale[k0 + 2 * i + (lane >> 5)]; }
#pragma unroll
    for (int i = 0; i < 32; ++i) scr[(2 * i + (lane >> 5)) * 33 + (lane & 31)] = tv[i];
    asm volatile("s_waitcnt lgkmcnt(0)" ::: "memory");
    const int c = lane & 7;
    const int r0 = rowmap(n0);
#pragma unroll
    for (int j = 0; j < 4; ++j) { const int n = (lane >> 3) + 8 * j; const LAS float* sp = scr + (8 * c) * 33 + n;
        pg8::u32x4 o; o.x = pg8::cvt_pk_bf16(sp[0 * 33], sp[1 * 33]); o.y = pg8::cvt_pk_bf16(sp[2 * 33], sp[3 * 33]); o.z = pg8::cvt_pk_bf16(sp[4 * 33], sp[5 * 33]); o.w = pg8::cvt_pk_bf16(sp[6 * 33], sp[7 * 33]);
        __builtin_nontemporal_store(o, (pg8::u32x4*)(WT + (size_t)(r0 + n) * K + k0 + 8 * c)); }
    asm volatile("s_waitcnt lgkmcnt(0)" ::: "memory");
}


namespace att {
using bf16x8 = __attribute__((ext_vector_type(8))) short;
using s16x4  = __attribute__((ext_vector_type(4))) short;
using f32x16 = __attribute__((ext_vector_type(16))) float;
using u32x4  = __attribute__((ext_vector_type(4))) unsigned;
constexpr int NW = 8, QBLK = 32, KVBLK = 64;
constexpr float SCALE = 0.10206207261596577f;
constexpr float THR = 8.f;
constexpr int LDQ = 768, LDK = 768, LDV = 512, LDO = 1024;
constexpr int SHM_V = KVBLK * 64 * 2, SHM_K = KVBLK * 256;
constexpr int SHM_ATTN = 2 * SHM_V + 2 * SHM_K + NW * 64 * 4;
#define KSWZ(row, colB) ((row) * 256 + ((colB) ^ (((row) & 7) << 4)))
#define SBAR() __builtin_amdgcn_sched_barrier(0)
__device__ __forceinline__ int crow(int r, int hi) { return (r & 3) + 8 * (r >> 2) + 4 * hi; }
__device__ __forceinline__ unsigned cvtpk(float lo, float hi) { unsigned r; asm volatile("v_cvt_pk_bf16_f32 %0, %1, %2" : "=v"(r) : "v"(lo), "v"(hi)); return r; }

__device__ __forceinline__ void partialSM(f32x16& p0, f32x16& p1, float& m_reg, float& mn, float& alpha) {
  constexpr float C = SCALE * 1.4426950408889634f;
  float pmax = p0[0]; for (int r = 1; r < 16; ++r) pmax = fmaxf(pmax, p0[r]); for (int r = 0; r < 16; ++r) pmax = fmaxf(pmax, p1[r]);
  { auto rr = __builtin_amdgcn_permlane32_swap(__float_as_uint(pmax), __float_as_uint(pmax), false, false);
    pmax = fmaxf(__uint_as_float(rr[0]), __uint_as_float(rr[1])); }
  if (__builtin_expect(__all(pmax - m_reg <= THR / SCALE), 1)) { mn = m_reg; alpha = 1.f; }
  else { mn = fmaxf(m_reg, pmax); alpha = __builtin_amdgcn_exp2f((m_reg - mn) * C); m_reg = mn; }
  float mnC = -mn * C;
  for (int r = 0; r < 16; ++r) p0[r] = fmaf(p0[r], C, mnC); for (int r = 0; r < 16; ++r) p1[r] = fmaf(p1[r], C, mnC);
  for (int r = 0; r < 16; ++r) p0[r] = __builtin_amdgcn_exp2f(p0[r]);
}
__device__ __forceinline__ void finishSM(f32x16& p0, f32x16& p1, float alpha, float& l_reg, bf16x8& pa0, bf16x8& pa1, bf16x8& pa2, bf16x8& pa3) {
  for (int r = 0; r < 16; ++r) p1[r] = __builtin_amdgcn_exp2f(p1[r]);
  float ps = 0; for (int r = 0; r < 16; ++r) ps += p0[r]; for (int r = 0; r < 16; ++r) ps += p1[r];
  { auto rr = __builtin_amdgcn_permlane32_swap(__float_as_uint(ps), __float_as_uint(ps), false, false);
    ps = __uint_as_float(rr[0]) + __uint_as_float(rr[1]); }
  l_reg = l_reg * alpha + ps;
#define PK4(P, BASE, OUT) do { unsigned a0 = cvtpk(P[BASE + 0], P[BASE + 1]), a1 = cvtpk(P[BASE + 2], P[BASE + 3]);   \
    unsigned b0 = cvtpk(P[BASE + 4], P[BASE + 5]), b1 = cvtpk(P[BASE + 6], P[BASE + 7]);                              \
    auto r0 = __builtin_amdgcn_permlane32_swap(a0, b0, false, false); auto r1 = __builtin_amdgcn_permlane32_swap(a1, b1, false, false); \
    u32x4 w = {r0[0], r1[0], r0[1], r1[1]}; OUT = *reinterpret_cast<bf16x8*>(&w); } while (0)
  PK4(p0, 0, pa0); PK4(p0, 8, pa1); PK4(p1, 0, pa2); PK4(p1, 8, pa3);
#undef PK4
}
__device__ __forceinline__ void qkt(f32x16& p0, f32x16& p1, const char* Ks, const bf16x8* qr, int r32, int hi) {
  p0 = f32x16{}; p1 = f32x16{};
#pragma unroll
  for (int d0 = 0; d0 < 6; ++d0) { int cb = (d0 * 16 + hi * 8) * 2;
    bf16x8 b0 = *reinterpret_cast<const bf16x8*>(Ks + KSWZ(r32, cb));
    bf16x8 b1 = *reinterpret_cast<const bf16x8*>(Ks + KSWZ(32 + r32, cb));
    p0 = __builtin_amdgcn_mfma_f32_32x32x16_bf16(b0, qr[d0], p0, 0, 0, 0);
    p1 = __builtin_amdgcn_mfma_f32_32x32x16_bf16(b1, qr[d0], p1, 0, 0, 0); }
}
__device__ __forceinline__ int v_st(int k, int c) { const int kk = (k & ~0xC) | ((k & 4) << 1) | ((k & 8) >> 1); return ((kk >> 3) * 2 + (c >> 5)) * 512 + ((kk & 7) * 32 + (c & 31)) * 2; }
__device__ __forceinline__ int v_rd_base(int lane) { return ((lane & 3) << 3) | (((lane >> 2) & 3) << 6) | (((lane >> 4) & 1) << 5) | (((lane >> 5) & 1) << 8); }
constexpr int v_rd_off(int d0, int ks, int half) { return d0 * 512 + ks * 2048 + half * 1024; }
template <int OFF> __device__ __forceinline__ s16x4 tr_read(int vb) {
  s16x4 r; asm volatile("ds_read_b64_tr_b16 %0, %1 offset:%2" : "=&v"(r) : "v"(vb), "i"(OFF) : "memory"); return r;
}
template <int D0> __device__ __forceinline__ void pv_one(f32x16& od, int vb, bf16x8 pa0, bf16x8 pa1, bf16x8 pa2, bf16x8 pa3) {
  const s16x4 l0 = tr_read<v_rd_off(D0, 0, 0)>(vb), h0 = tr_read<v_rd_off(D0, 0, 1)>(vb), l1 = tr_read<v_rd_off(D0, 1, 0)>(vb), h1 = tr_read<v_rd_off(D0, 1, 1)>(vb);
  const s16x4 l2 = tr_read<v_rd_off(D0, 2, 0)>(vb), h2 = tr_read<v_rd_off(D0, 2, 1)>(vb), l3 = tr_read<v_rd_off(D0, 3, 0)>(vb), h3 = tr_read<v_rd_off(D0, 3, 1)>(vb);
  asm volatile("s_waitcnt lgkmcnt(0)" ::: "memory"); SBAR();
#define PK(L, H) (bf16x8){L[0], L[1], L[2], L[3], H[0], H[1], H[2], H[3]}
  od = __builtin_amdgcn_mfma_f32_32x32x16_bf16(pa0, PK(l0, h0), od, 0, 0, 0);
  od = __builtin_amdgcn_mfma_f32_32x32x16_bf16(pa1, PK(l1, h1), od, 0, 0, 0);
  od = __builtin_amdgcn_mfma_f32_32x32x16_bf16(pa2, PK(l2, h2), od, 0, 0, 0);
  od = __builtin_amdgcn_mfma_f32_32x32x16_bf16(pa3, PK(l3, h3), od, 0, 0, 0);
#undef PK
}
__device__ __forceinline__ void pv_d0(f32x16* o, int vb, bf16x8 pa0, bf16x8 pa1, bf16x8 pa2, bf16x8 pa3) {
  pv_one<0>(o[0], vb, pa0, pa1, pa2, pa3); pv_one<1>(o[1], vb, pa0, pa1, pa2, pa3);
}
__device__ __forceinline__ void attn_body(const unsigned short* __restrict__ Qb, const unsigned short* __restrict__ Kh, const unsigned short* __restrict__ Vh,
                                          unsigned short* __restrict__ Ob, int seq, char* lds) {
  const int tid = threadIdx.x, wid = tid >> 6, lane = tid & 63, r32 = lane & 31, hi = lane >> 5;
  char* V_lds = lds; char* K_lds = lds + 2 * SHM_V;
  float* ws = (float*)(lds + 2 * SHM_V + 2 * SHM_K) + wid * 64; float* li_l = ws; float* al_l = ws + 32;
  float m_reg = -1e30f, l_reg = 0; f32x16 o[2] = {}; bf16x8 qr[6];
  const unsigned short* Qw = Qb + (long)(wid * QBLK + r32) * LDQ + hi * 8;
#pragma unroll
  for (int d0 = 0; d0 < 6; ++d0) qr[d0] = *reinterpret_cast<const bf16x8*>(Qw + d0 * 16);
  const int vr = tid >> 3, vc = (tid & 7) * 8, vst = v_st(vr, vc);
  const int k0r = tid / 12, k0c = tid % 12, id1 = 512 + (tid & 255), k1r = id1 / 12, k1c = id1 % 12;
  const int kst0 = KSWZ(k0r, k0c * 16), kst1 = KSWZ(k1r, k1c * 16);
  const long vg = (long)vr * LDV + vc, kg0 = (long)k0r * LDK + k0c * 8, kg1 = (long)k1r * LDK + k1c * 8;
  const int vb0 = (int)(uintptr_t)V_lds + v_rd_base(lane);
  struct { bf16x8 vs, ks0, ks1; } sr_[2];
#define SLOAD(i, kk0) do { sr_[i].vs = *reinterpret_cast<const bf16x8*>(Vh + (long)(kk0) * LDV + vg); \
    sr_[i].ks0 = *reinterpret_cast<const bf16x8*>(Kh + (long)(kk0) * LDK + kg0); sr_[i].ks1 = *reinterpret_cast<const bf16x8*>(Kh + (long)(kk0) * LDK + kg1); } while (0)
#define SWRITE(b, i) do { *(bf16x8*)(V_lds + (b) * SHM_V + vst) = sr_[i].vs; \
    *(bf16x8*)(K_lds + (b) * SHM_K + kst0) = sr_[i].ks0; *(bf16x8*)(K_lds + (b) * SHM_K + kst1) = sr_[i].ks1; } while (0)
#define SWAIT() asm volatile("s_waitcnt vmcnt(3)" ::: "memory")
#define RESC(a) do { if (__any((a) < 1.f)) { if (hi == 0) al_l[r32] = (a); asm volatile("s_waitcnt lgkmcnt(0)" ::: "memory"); \
    for (int d = 0; d < 2; ++d) for (int r = 0; r < 16; ++r) o[d][r] *= al_l[crow(r, hi)]; } } while (0)
  f32x16 pA0, pA1, pB0, pB1; float mnA, mnB, alA, alB; bf16x8 pa0, pa1, pa2, pa3; const int NT = seq / KVBLK;
  constexpr int SE = 0, SO = 1;
  SLOAD(SE, 0); asm volatile("s_waitcnt vmcnt(0)" ::: "memory"); SWRITE(0, SE); __syncthreads();
  qkt(pA0, pA1, K_lds, qr, r32, hi); partialSM(pA0, pA1, m_reg, mnA, alA);
  SLOAD(SO, KVBLK); if (2 < NT) SLOAD(SE, 2 * KVBLK);
  SWAIT(); SWRITE(1, SO); __syncthreads();
  for (int j = 1; j + 1 < NT; j += 2) {
    SBAR(); qkt(pB0, pB1, K_lds + SHM_K, qr, r32, hi);
    finishSM(pA0, pA1, alA, l_reg, pa0, pa1, pa2, pa3); SBAR();
    SLOAD(SO, (j + 2) * KVBLK); SBAR();
    pv_d0(o, vb0, pa0, pa1, pa2, pa3); partialSM(pB0, pB1, m_reg, mnB, alB);
    __syncthreads(); SWAIT(); SWRITE(0, SE);
    RESC(alB); __syncthreads();
    SBAR(); qkt(pA0, pA1, K_lds, qr, r32, hi);
    finishSM(pB0, pB1, alB, l_reg, pa0, pa1, pa2, pa3); SBAR();
    if (j + 3 < NT) SLOAD(SE, (j + 3) * KVBLK); SBAR();
    pv_d0(o, vb0 + SHM_V, pa0, pa1, pa2, pa3); partialSM(pA0, pA1, m_reg, mnA, alA);
    __syncthreads(); SWAIT(); SWRITE(1, SO);
    RESC(alA); __syncthreads();
  }
  SBAR(); qkt(pB0, pB1, K_lds + SHM_K, qr, r32, hi);
  finishSM(pA0, pA1, alA, l_reg, pa0, pa1, pa2, pa3); SBAR();
  pv_d0(o, vb0, pa0, pa1, pa2, pa3); partialSM(pB0, pB1, m_reg, mnB, alB);
  __syncthreads(); RESC(alB);
  finishSM(pB0, pB1, alB, l_reg, pa0, pa1, pa2, pa3); SBAR();
  pv_d0(o, vb0 + SHM_V, pa0, pa1, pa2, pa3);
  if (hi == 0) li_l[r32] = l_reg; asm volatile("s_waitcnt lgkmcnt(0)" ::: "memory");
  float rli[16];
#pragma unroll
  for (int r = 0; r < 16; ++r) rli[r] = __builtin_amdgcn_rcpf(li_l[crow(r, hi)]);
  unsigned short* Ow = Ob + (long)(wid * QBLK) * LDO;
#pragma unroll
  for (int r = 0; r < 16; ++r) { int orow = crow(r, hi);
#pragma unroll
    for (int d0 = 0; d0 < 2; ++d0) Ow[(long)orow * LDO + d0 * 32 + r32] = (unsigned short)(cvtpk(o[d0][r] * rli[r], 0.f) & 0xffffu); }
  __syncthreads();
#undef SLOAD
#undef SWRITE
#undef SWAIT
#undef RESC
}
#undef KSWZ
#undef SBAR
}


namespace ml {
using bf16x8 = __attribute__((ext_vector_type(8))) short;
using s16x4  = __attribute__((ext_vector_type(4))) short;
using f32x16 = __attribute__((ext_vector_type(16))) float;
using f32x4  = __attribute__((ext_vector_type(4))) float;
using u32x4  = __attribute__((ext_vector_type(4))) unsigned;
constexpr float L2E = 1.4426950408889634f;
constexpr int NXC = 34;
__device__ __forceinline__ int crow(int r, int hi) { return (r & 3) + 8 * (r >> 2) + 4 * hi; }
__device__ __forceinline__ unsigned cvtpk(float lo, float hi) { unsigned r; asm volatile("v_cvt_pk_bf16_f32 %0, %1, %2" : "=v"(r) : "v"(lo), "v"(hi)); return r; }
template <int NC> __device__ __forceinline__ int t_st(int k, int c) { const int kk = (k & ~0xC) | ((k & 4) << 1) | ((k & 8) >> 1); return ((kk >> 3) * NC + (c >> 5)) * 512 + ((kk & 7) * 32 + (c & 31)) * 2; }
__device__ __forceinline__ int t_rd_base(int lane) { return ((lane & 3) << 3) | (((lane >> 2) & 3) << 6) | (((lane >> 4) & 1) << 5) | (((lane >> 5) & 1) << 8); }
template <int NC> constexpr int t_rd_off(int d0, int ks, int half) { return d0 * 512 + ks * (NC * 1024) + half * (NC * 512); }
template <int OFF> __device__ __forceinline__ s16x4 tr_read(int vb) { s16x4 r; asm volatile("ds_read_b64_tr_b16 %0, %1 offset:%2" : "=&v"(r) : "v"(vb), "i"(OFF) : "memory"); return r; }
#define ML_PK(L, H) (bf16x8){L[0], L[1], L[2], L[3], H[0], H[1], H[2], H[3]}
#define ML_KS(row, colB) ((row) * 128 + ((colB) ^ (((row) & 7) << 4)))
__device__ __forceinline__ int chunk_row(int b, int X, int i) { return X < 2 ? (16384 + b * 256 + X * 128 + i) : (b * 4096 + (X - 2) * 128 + i); }
__device__ __forceinline__ float lsig(float x) { return fminf(x, 0.f) - __logf(1.f + __expf(-fabsf(x))); }

__device__ __forceinline__ void gate_prep(const float* GATES, const float* bg, int b, int h, int X, LAS float* cum, LAS float* av, LAS float* pm, LAS float* wsr, LAS float* tot, int wave, int lane) {
    if (wave < 2) {
        const int dir = wave;
        const int e0 = dir ? (127 - 2 * lane) : (2 * lane), e1 = dir ? (126 - 2 * lane) : (2 * lane + 1);
        const int r0 = chunk_row(b, X, e0), r1 = chunk_row(b, X, e1);
        const float bi = bg[(2 * dir) * 4 + h], bf = bg[(2 * dir + 1) * 4 + h];
        const float li0 = GATES[(size_t)r0 * 16 + (2 * dir) * 4 + h] + bi, li1 = GATES[(size_t)r1 * 16 + (2 * dir) * 4 + h] + bi;
        const float x0 = lsig(GATES[(size_t)r0 * 16 + (2 * dir + 1) * 4 + h] + bf), x1 = lsig(GATES[(size_t)r1 * 16 + (2 * dir + 1) * 4 + h] + bf);
        float sc = x0 + x1;
#pragma unroll
        for (int o = 1; o < 64; o <<= 1) { const float y = __shfl_up(sc, o); if (lane >= o) sc += y; }
        const float c1 = sc, c0 = sc - x1; const float total = __shfl(sc, 63);
        const float a0 = li0 - c0, a1 = li1 - c1;
        float mx = fmaxf(a0, a1);
#pragma unroll
        for (int o = 1; o < 64; o <<= 1) { const float y = __shfl_up(mx, o); if (lane >= o) mx = fmaxf(mx, y); }
        float prev = __shfl_up(mx, 1); if (lane == 0) prev = -3.0e38f;
        cum[dir * 128 + e0] = c0; cum[dir * 128 + e1] = c1; av[dir * 128 + e0] = a0; av[dir * 128 + e1] = a1;
        pm[dir * 128 + e0] = fmaxf(prev, a0); pm[dir * 128 + e1] = mx;
        wsr[dir * 128 + e0] = total - c0 + li0; wsr[dir * 128 + e1] = total - c1 + li1;
        if (lane == 0) tot[dir] = total;
    }
}

__device__ __forceinline__ void stepA_unit(const unsigned short* P16, const float* GATES, const float* bg, int bh, int X, float* CLOC, float* NLOC, float* MLOC, float* TOT, char* lds) {
    const int tid = threadIdx.x, wave = __builtin_amdgcn_readfirstlane(tid >> 6), lane = tid & 63, r32 = lane & 31, hi = lane >> 5;
    const int b = bh >> 2, h = bh & 3;
    LAS float* fa = (LAS float*)(lds + 65536);
    LAS float* cum = fa, *av = fa + 256, *pm = fa + 512, *wsr = fa + 768, *tot = fa + 1024, *wl = fa + 1040, *npart = fa + 1312;
    bf16x8 stV[4]; u32x4 stK[2];
#pragma unroll
    for (int j = 0; j < 4; ++j) { const int id = tid + 512 * j, row = id >> 4, ch = id & 15; stV[j] = *reinterpret_cast<const bf16x8*>(P16 + (size_t)chunk_row(b, X, row) * 2304 + 1184 + h * 128 + ch * 8); }
#pragma unroll
    for (int j = 0; j < 2; ++j) { const int id = tid + 512 * j, row = id >> 3, ch = id & 7; stK[j] = *reinterpret_cast<const u32x4*>(P16 + (size_t)chunk_row(b, X, row) * 2304 + 928 + h * 64 + ch * 8); }
    gate_prep(GATES, bg, b, h, X, cum, av, pm, wsr, tot, wave, lane);
#pragma unroll
    for (int j = 0; j < 4; ++j) { const int id = tid + 512 * j, row = id >> 4, ch = id & 15; *(bf16x8*)(lds + t_st<4>(row, ch * 8)) = stV[j]; }
    __syncthreads();
    if (wave < 2) {
        const int dir = wave; const float w0 = wsr[dir * 128 + lane], w1 = wsr[dir * 128 + 64 + lane];
        float mx = fmaxf(w0, w1);
#pragma unroll
        for (int o = 1; o < 64; o <<= 1) mx = fmaxf(mx, __shfl_xor(mx, o));
        wl[dir * 128 + lane] = __expf(w0 - mx); wl[dir * 128 + 64 + lane] = __expf(w1 - mx);
        if (lane == 0) { MLOC[(bh * NXC + X) * 2 + dir] = mx; TOT[(bh * NXC + X) * 2 + dir] = tot[dir]; }
    }
    __syncthreads();
#pragma unroll
    for (int j = 0; j < 2; ++j) { const int id = tid + 512 * j, row = id >> 3, ch = id & 7;
        const u32x4 kv = stK[j];
        const float wf = wl[row], wb = wl[128 + row];
        u32x4 of, ob;
#pragma unroll
        for (int q = 0; q < 4; ++q) { const float lo = __uint_as_float(kv[q] << 16), hi2 = __uint_as_float(kv[q] & 0xffff0000u); of[q] = cvtpk(lo * wf, hi2 * wf); ob[q] = cvtpk(lo * wb, hi2 * wb); }
        *(u32x4*)(lds + 32768 + t_st<2>(row, ch * 8)) = of; *(u32x4*)(lds + 49152 + t_st<2>(row, ch * 8)) = ob; }
    __syncthreads();
    {
        const int dir = wave >> 2, mb = wave & 3;
        const int vb = (int)(uintptr_t)lds + t_rd_base(lane) + mb * 512;
        const int kb = (int)(uintptr_t)lds + 32768 + dir * 16384 + t_rd_base(lane);
        f32x16 acc0 = {}, acc1 = {};
#define ML_A_STEP(KS) do { \
        const s16x4 vl = tr_read<t_rd_off<4>(0, KS, 0)>(vb), vh = tr_read<t_rd_off<4>(0, KS, 1)>(vb); \
        const s16x4 k0l = tr_read<t_rd_off<2>(0, KS, 0)>(kb), k0h = tr_read<t_rd_off<2>(0, KS, 1)>(kb), k1l = tr_read<t_rd_off<2>(1, KS, 0)>(kb), k1h = tr_read<t_rd_off<2>(1, KS, 1)>(kb); \
        asm volatile("s_waitcnt lgkmcnt(0)" ::: "memory"); __builtin_amdgcn_sched_barrier(0); \
        acc0 = __builtin_amdgcn_mfma_f32_32x32x16_bf16(ML_PK(vl, vh), ML_PK(k0l, k0h), acc0, 0, 0, 0); \
        acc1 = __builtin_amdgcn_mfma_f32_32x32x16_bf16(ML_PK(vl, vh), ML_PK(k1l, k1h), acc1, 0, 0, 0); } while (0)
        ML_A_STEP(0); ML_A_STEP(1); ML_A_STEP(2); ML_A_STEP(3); ML_A_STEP(4); ML_A_STEP(5); ML_A_STEP(6); ML_A_STEP(7);
#undef ML_A_STEP
        float* dst = CLOC + ((size_t)(bh * NXC + X) * 2 + dir) * 8192;
#pragma unroll
        for (int r = 0; r < 16; ++r) { const int dv = 32 * mb + crow(r, hi); dst[dv * 64 + r32] = acc0[r]; dst[dv * 64 + 32 + r32] = acc1[r]; }
    }
    {
        const int dir = tid >> 8, part = (tid >> 6) & 3, d = tid & 63; float a = 0.f;
        const char* img = lds + 32768 + dir * 16384;
#pragma unroll 8
        for (int i = 0; i < 32; ++i) { const int row = part * 32 + i; a += bf2f(*(const unsigned short*)(img + t_st<2>(row, d))); }
        npart[(dir * 4 + part) * 64 + d] = a;
    }
    __syncthreads();
    if (tid < 128) { const int dir = tid >> 6, d = tid & 63; NLOC[((size_t)(bh * NXC + X) * 2 + dir) * 64 + d] = (npart[(dir * 4 + 0) * 64 + d] + npart[(dir * 4 + 1) * 64 + d]) + (npart[(dir * 4 + 2) * 64 + d] + npart[(dir * 4 + 3) * 64 + d]); }
    __syncthreads();
}

__device__ __forceinline__ int scanX(int dir, int j) { return dir ? (j == 0 ? 1 : (j == 1 ? 0 : 35 - j)) : j; }
__device__ __forceinline__ void stepB(const float* CLOC, const float* NLOC, const float* MLOC, const float* TOT, unsigned* CIN, float* NIN, float* MIN, int gtid, int gthreads) {
    for (int it = gtid; it < 32 * 4096 + 32 * 64; it += gthreads) {
        const bool isn = it >= 32 * 4096;
        const int sq = isn ? (it - 32 * 4096) >> 6 : it >> 12, e = isn ? (it - 32 * 4096) & 63 : it & 4095;
        const int bh = sq >> 1, dir = sq & 1;
        float2 v[NXC]; float tt[NXC], mm[NXC];
#pragma unroll
        for (int j = 0; j < NXC; ++j) { const int X = scanX(dir, j); const size_t li = (size_t)(bh * NXC + X) * 2 + dir;
            tt[j] = TOT[li]; mm[j] = MLOC[li];
            if (isn) { v[j].x = NLOC[li * 64 + e]; v[j].y = 0.f; } else v[j] = *(const float2*)(CLOC + li * 8192 + 2 * e); }
        float c0 = 0.f, c1 = 0.f, m = 0.f;
#pragma unroll
        for (int j = 0; j < NXC; ++j) {
            const int X = scanX(dir, j);
            if (X >= 2) {
                const size_t ci = (size_t)(bh * 32 + (X - 2)) * 2 + dir;
                if (isn) { NIN[ci * 64 + e] = c0; if (e == 0) MIN[ci] = m; }
                else CIN[ci * 4096 + e] = cvtpk(c0, c1);
            }
            const float mn = fmaxf(tt[j] + m, mm[j]), dec = __expf(tt[j] + m - mn), scl = __expf(mm[j] - mn);
            c0 = dec * c0 + scl * v[j].x; c1 = dec * c1 + scl * v[j].y;
            m = mn;
        }
    }
}

__device__ __forceinline__ void stepC_unit(const unsigned short* P16, const float* GATES, const float* bg, const unsigned short* CIN, const float* NIN, const float* MIN, const float* mng,
                                           unsigned short* MIX16, int bh, int c, char* lds) {
    const int tid = threadIdx.x, wave = __builtin_amdgcn_readfirstlane(tid >> 6), lane = tid & 63, r32 = lane & 31, hi = lane >> 5;
    const int b = bh >> 2, h = bh & 3, X = c + 2;
    LAS float* fa = (LAS float*)(lds + 98304);
    LAS float* cum = fa, *av = fa + 256, *pm = fa + 512, *wsr = fa + 768, *tot = fa + 1024, *scl = fa + 1040;
    LAS float* hs = (LAS float*)lds;
    const int dir = wave >> 2, tb = wave & 3;
    const int t = 32 * tb + r32;
    const size_t ci = (size_t)(bh * 32 + c) * 2 + dir;
    bf16x8 qr[4]; f32x4 nn[8];
    {
        const unsigned short* qp = P16 + (size_t)chunk_row(b, X, t) * 2304 + 672 + h * 64 + hi * 8;
        const float* np = NIN + ci * 64 + hi * 8;
#pragma unroll
        for (int ks = 0; ks < 4; ++ks) { qr[ks] = *reinterpret_cast<const bf16x8*>(qp + ks * 16); nn[2 * ks] = *(const f32x4*)(np + ks * 16); nn[2 * ks + 1] = *(const f32x4*)(np + ks * 16 + 4); }
    }
    const float min2 = MIN[ci] * L2E;
    bf16x8 stK[2], stV[4], stC[4];
#pragma unroll
    for (int j = 0; j < 2; ++j) { const int id = tid + 512 * j, row = id >> 3, ch = id & 7; stK[j] = *reinterpret_cast<const bf16x8*>(P16 + (size_t)chunk_row(b, X, row) * 2304 + 928 + h * 64 + ch * 8); }
#pragma unroll
    for (int j = 0; j < 4; ++j) { const int id = tid + 512 * j, row = id >> 4, ch = id & 15; stV[j] = *reinterpret_cast<const bf16x8*>(P16 + (size_t)chunk_row(b, X, row) * 2304 + 1184 + h * 128 + ch * 8); }
    gate_prep(GATES, bg, b, h, X, cum, av, pm, wsr, tot, wave, lane);
    asm volatile("" ::: "memory");
#pragma unroll
    for (int j = 0; j < 4; ++j) { const int id = tid + 512 * j, dd = id >> 10, row = (id >> 3) & 127, ch = id & 7;
        stC[j] = *reinterpret_cast<const bf16x8*>(CIN + ((size_t)(bh * 32 + c) * 2 + dd) * 8192 + row * 64 + ch * 8); }
#pragma unroll
    for (int j = 0; j < 2; ++j) { const int id = tid + 512 * j, row = id >> 3, ch = id & 7; *(bf16x8*)(lds + ML_KS(row, ch * 16)) = stK[j]; }
#pragma unroll
    for (int j = 0; j < 4; ++j) { const int id = tid + 512 * j, row = id >> 4, ch = id & 15; *(bf16x8*)(lds + 16384 + t_st<4>(row, ch * 8)) = stV[j]; }
#pragma unroll
    for (int j = 0; j < 4; ++j) { const int id = tid + 512 * j, dd = id >> 10, row = (id >> 3) & 127, ch = id & 7; *(bf16x8*)(lds + 65536 + dd * 16384 + ML_KS(row, ch * 16)) = stC[j]; }
    __syncthreads();
    const float el2 = fmaxf(min2, pm[dir * 128 + t] * L2E);
    const float wint = __builtin_amdgcn_exp2f(min2 - el2);
    float ndot = 0.f;
#pragma unroll
    for (int ks = 0; ks < 4; ++ks) { const u32x4 q4 = *reinterpret_cast<const u32x4*>(&qr[ks]); const f32x4 n0 = nn[2 * ks], n1 = nn[2 * ks + 1];
#pragma unroll
        for (int q = 0; q < 4; ++q) { const float lo = __uint_as_float(q4[q] << 16), hi2 = __uint_as_float(q4[q] & 0xffff0000u);
            const float nl = (q < 2) ? n0[2 * q] : n1[2 * q - 4], nh = (q < 2) ? n0[2 * q + 1] : n1[2 * q - 3];
            ndot = fmaf(lo, nl, ndot); ndot = fmaf(hi2, nh, ndot); } }
    f32x16 o[4] = {}; float den = 0.f;
    const int vb = (int)(uintptr_t)lds + 16384 + t_rd_base(lane);
    const char* Kl = lds;
#define ML_C_BLOCK(SB) do { if (dir ? (SB >= tb) : (SB <= tb)) { \
        f32x16 p = {}; \
        _Pragma("unroll") for (int ks = 0; ks < 4; ++ks) { const bf16x8 kf = *reinterpret_cast<const bf16x8*>(Kl + ML_KS(32 * SB + r32, (ks * 16 + hi * 8) * 2)); p = __builtin_amdgcn_mfma_f32_32x32x16_bf16(kf, qr[ks], p, 0, 0, 0); } \
        _Pragma("unroll") for (int g = 0; g < 4; ++g) { const f32x4 a4 = *(const LAS f32x4*)(av + dir * 128 + 32 * SB + 8 * g + 4 * hi); \
            _Pragma("unroll") for (int i = 0; i < 4; ++i) { const int sidx = 32 * SB + 8 * g + 4 * hi + i; const bool ok = dir ? (sidx >= t) : (sidx <= t); \
                const float f = __builtin_amdgcn_exp2f(a4[i] * L2E - el2) * 0.125f; p[4 * g + i] = ok ? p[4 * g + i] * f : 0.f; den += p[4 * g + i]; } } \
        bf16x8 pa0, pa1; \
        { unsigned a0 = cvtpk(p[0], p[1]), a1 = cvtpk(p[2], p[3]), b0 = cvtpk(p[4], p[5]), b1 = cvtpk(p[6], p[7]); \
          auto r0 = __builtin_amdgcn_permlane32_swap(a0, b0, false, false); auto r1 = __builtin_amdgcn_permlane32_swap(a1, b1, false, false); u32x4 w = {r0[0], r1[0], r0[1], r1[1]}; pa0 = *reinterpret_cast<bf16x8*>(&w); } \
        { unsigned a0 = cvtpk(p[8], p[9]), a1 = cvtpk(p[10], p[11]), b0 = cvtpk(p[12], p[13]), b1 = cvtpk(p[14], p[15]); \
          auto r0 = __builtin_amdgcn_permlane32_swap(a0, b0, false, false); auto r1 = __builtin_amdgcn_permlane32_swap(a1, b1, false, false); u32x4 w = {r0[0], r1[0], r0[1], r1[1]}; pa1 = *reinterpret_cast<bf16x8*>(&w); } \
        ML_C_PV(0, SB, pa0, pa1); ML_C_PV(1, SB, pa0, pa1); ML_C_PV(2, SB, pa0, pa1); ML_C_PV(3, SB, pa0, pa1); } } while (0)
#define ML_C_PV(D0, SB, PA0, PA1) do { \
        const s16x4 l0 = tr_read<t_rd_off<4>(D0, 2 * SB, 0)>(vb), h0 = tr_read<t_rd_off<4>(D0, 2 * SB, 1)>(vb), l1 = tr_read<t_rd_off<4>(D0, 2 * SB + 1, 0)>(vb), h1 = tr_read<t_rd_off<4>(D0, 2 * SB + 1, 1)>(vb); \
        asm volatile("s_waitcnt lgkmcnt(0)" ::: "memory"); __builtin_amdgcn_sched_barrier(0); \
        o[D0] = __builtin_amdgcn_mfma_f32_32x32x16_bf16(PA0, ML_PK(l0, h0), o[D0], 0, 0, 0); \
        o[D0] = __builtin_amdgcn_mfma_f32_32x32x16_bf16(PA1, ML_PK(l1, h1), o[D0], 0, 0, 0); } while (0)
    ML_C_BLOCK(0); ML_C_BLOCK(1); ML_C_BLOCK(2); ML_C_BLOCK(3);
#undef ML_C_BLOCK
#undef ML_C_PV
    {
        bf16x8 qw[4];
#pragma unroll
        for (int ks = 0; ks < 4; ++ks) { const u32x4 q4 = *reinterpret_cast<const u32x4*>(&qr[ks]); u32x4 w4;
#pragma unroll
            for (int q = 0; q < 4; ++q) { const float lo = __uint_as_float(q4[q] << 16), hi2 = __uint_as_float(q4[q] & 0xffff0000u); w4[q] = cvtpk(lo * (0.125f * wint), hi2 * (0.125f * wint)); }
            qw[ks] = *reinterpret_cast<const bf16x8*>(&w4); }
        const char* Cl = lds + 65536 + dir * 16384;
#pragma unroll
        for (int d0 = 0; d0 < 4; ++d0)
#pragma unroll
            for (int ks = 0; ks < 4; ++ks) { const bf16x8 cf = *reinterpret_cast<const bf16x8*>(Cl + ML_KS(32 * d0 + r32, (ks * 16 + hi * 8) * 2)); o[d0] = __builtin_amdgcn_mfma_f32_32x32x16_bf16(qw[ks], cf, o[d0], 0, 0, 0); }
    }
    { auto rr = __builtin_amdgcn_permlane32_swap(__float_as_uint(den), __float_as_uint(den), false, false); den = __uint_as_float(rr[0]) + __uint_as_float(rr[1]); }
    { auto rr = __builtin_amdgcn_permlane32_swap(__float_as_uint(ndot), __float_as_uint(ndot), false, false); ndot = __uint_as_float(rr[0]) + __uint_as_float(rr[1]); }
    den += wint * 0.125f * ndot;
    const float sct = 1.f / fmaxf(fabsf(den), __builtin_amdgcn_exp2f(-cum[dir * 128 + t] * L2E - el2));
    if (hi == 0) scl[wave * 32 + r32] = sct;
    __syncthreads();
    if (dir == 1) {
#pragma unroll
        for (int r = 0; r < 16; ++r) { const float sc = scl[wave * 32 + crow(r, hi)];
#pragma unroll
            for (int d0 = 0; d0 < 4; ++d0) hs[(32 * tb + crow(r, hi)) * 128 + 32 * d0 + r32] = o[d0][r] * sc; }
    }
    __syncthreads();
    if (dir == 0) {
#pragma unroll
        for (int r = 0; r < 16; ++r) { const float sc = scl[wave * 32 + crow(r, hi)];
#pragma unroll
            for (int d0 = 0; d0 < 4; ++d0) hs[(32 * tb + crow(r, hi)) * 128 + 32 * d0 + r32] += o[d0][r] * sc; }
    }
    __syncthreads();
    {
        const int tt = tid >> 2, q4 = tid & 3;
        const size_t grow = (size_t)chunk_row(b, X, tt);
        const unsigned short* og = P16 + grow * 2304 + 1696 + h * 128 + 32 * q4;
        u32x4 og4[4];
#pragma unroll
        for (int j = 0; j < 4; ++j) og4[j] = *reinterpret_cast<const u32x4*>(og + 8 * j);
        f32x4 v[8]; float ss = 0.f;
#pragma unroll
        for (int j = 0; j < 8; ++j) { v[j] = *(const LAS f32x4*)(hs + tt * 128 + 32 * q4 + 4 * j); ss += (v[j][0] * v[j][0] + v[j][1] * v[j][1]) + (v[j][2] * v[j][2] + v[j][3] * v[j][3]); }
        ss += __shfl_xor(ss, 1); ss += __shfl_xor(ss, 2);
        const float rstd = rsqrtf(ss * (1.f / 128.f) + 1e-6f);
        const float* gn = mng + h * 128 + 32 * q4;
        unsigned short* dst = MIX16 + grow * 1024 + 512 + h * 128 + 32 * q4;
#pragma unroll
        for (int j = 0; j < 4; ++j) { const f32x4 g0 = *(const f32x4*)(gn + 8 * j), g1 = *(const f32x4*)(gn + 8 * j + 4); const f32x4 x0 = v[2 * j], x1 = v[2 * j + 1]; const u32x4 ow = og4[j];
            float r8[8];
#pragma unroll
            for (int e = 0; e < 4; ++e) { const float gl = __uint_as_float(ow[e] << 16), gh = __uint_as_float(ow[e] & 0xffff0000u);
                const float xa = (e < 2) ? x0[2 * e] : x1[2 * e - 4], xb = (e < 2) ? x0[2 * e + 1] : x1[2 * e - 3];
                const float ga = (e < 2) ? g0[2 * e] : g1[2 * e - 4], gb = (e < 2) ? g0[2 * e + 1] : g1[2 * e - 3];
                r8[2 * e] = xa * rstd * ga * __builtin_amdgcn_rcpf(1.f + __expf(-gl)); r8[2 * e + 1] = xb * rstd * gb * __builtin_amdgcn_rcpf(1.f + __expf(-gh)); }
            u32x4 w; w.x = cvtpk(r8[0], r8[1]); w.y = cvtpk(r8[2], r8[3]); w.z = cvtpk(r8[4], r8[5]); w.w = cvtpk(r8[6], r8[7]);
            *(u32x4*)(dst + 8 * j) = w; }
    }
    __syncthreads();
}
#undef ML_PK
#undef ML_KS
}


__device__ __forceinline__ void convert_chunk(const float* wgu, const float* wdn, unsigned short* WguT, unsigned short* WdnT, int which, int chunk, LAS float* scr, int wave, int lane) {
#pragma unroll 1
    for (int j = 0; j < 8; ++j) {
        const int it = chunk * 64 + wave * 8 + j;
        if (which == 0) { const int e = it >> 10, r = it & 1023;
            transpose_item(wgu + (size_t)e * D * 2 * DFF, D, 2 * DFF, 2 * DFF / 32, WguT + (size_t)e * 2 * DFF * D,
                           [](int n0) { return n0 < DFF ? (n0 >> 7) * 256 + (n0 & 127) : ((n0 - DFF) >> 7) * 256 + 128 + ((n0 - DFF) & 127); }, scr, r, lane); }
        else { const int e = it >> 9, r = it & 511;
            transpose_item(wdn + (size_t)e * DFF * D, DFF, D, D / 32, WdnT + (size_t)e * D * DFF, [](int n0) { return n0; }, scr, r, lane); }
    }
}
__device__ __forceinline__ void pull_chunks(unsigned* qword, int first, int total, int maxc, const float* wgu, const float* wdn, unsigned short* WguT, unsigned short* WdnT, int which,
                                            unsigned char* lds_raw, int wave, int lane) {
    LAS int* bc = (LAS int*)(lds_raw + 131072 + 1024);
    LAS float* scr = (LAS float*)(lds_raw + wave * 16384);
    for (int n = 0; n < maxc; ++n) {
        __syncthreads();
        if (threadIdx.x == 0) bc[0] = first + (int)__hip_atomic_fetch_add(qword, 1u, __ATOMIC_RELAXED, __HIP_MEMORY_SCOPE_AGENT);
        __syncthreads();
        const int c = bc[0];
        if (c >= total) break;
        convert_chunk(wgu, wdn, WguT, WdnT, which, c, scr, wave, lane);
    }
    __syncthreads();
}

__device__ __forceinline__ int fresh_tid() { int t = (int)threadIdx.x; asm volatile("" : "+v"(t)); return t; }

#define DEF_PTRS \
    float* MOD = (float*)(ws + WS_MOD); \
    float* NLOC = (float*)(ws + WS_MLS); float* MLOC = (float*)(ws + WS_MLS + 512 * 1024); float* TOT = (float*)(ws + WS_MLS + 576 * 1024); float* NIN = (float*)(ws + WS_MLS + 1 * MiB); float* MIN_ = (float*)(ws + WS_MLS + 1536 * 1024); \
    float* CLOC = (float*)(ws + WS_CLOC); unsigned short* CIN = (unsigned short*)(ws + WS_CIN); \
    float* ROPEC = (float*)(ws + WS_ROPE); float* ROPES = ROPEC + S * 16; \
    int* TOPE = (int*)(ws + WS_TOPE); int* SLOT = (int*)(ws + WS_SLOT); int* LIST = (int*)(ws + WS_LIST); float* RGATE = (float*)(ws + WS_RGATE); \
    unsigned short* Hb16 = (unsigned short*)(ws + WS_H); unsigned short* WinT = (unsigned short*)(ws + WS_WINT); \
    unsigned short* Q16 = (unsigned short*)(ws + WS_Q); unsigned short* K16 = (unsigned short*)(ws + WS_KV); unsigned short* V16 = (unsigned short*)(ws + WS_KV + 32 * MiB); \
    unsigned short* X1 = (unsigned short*)(ws + WS_X1); unsigned short* H2 = (unsigned short*)(ws + WS_H2); \
    unsigned short* YG = (unsigned short*)(ws + WS_YG); unsigned short* ACT = (unsigned short*)(ws + WS_ACT); \
    unsigned short* WguT = (unsigned short*)(ws + WS_WGUT); unsigned short* WdnT = (unsigned short*)(ws + WS_WDNT); \
    unsigned short* WuqT = (unsigned short*)(ws + WS_WUQT); unsigned short* WukvT = (unsigned short*)(ws + WS_WUKVT); unsigned short* WoutT = (unsigned short*)(ws + WS_WOUTT); \
    float* GATES = (float*)(ws + WS_GATES); float* STAT = (float*)(ws + WS_STAT); float* STAT2 = (float*)(ws + WS_STAT2); \
    float* GM2 = (float*)(ws + WS_RSTD); unsigned short* RWH = (unsigned short*)(ws + WS_RSTD + 65536); unsigned short* RWL = (unsigned short*)(ws + WS_RSTD + 131072); unsigned short* MIX16 = (unsigned short*)(ws + WS_MIX16); \
    unsigned short* P16 = (unsigned short*)(ws + WS_P); \
    unsigned* CNT = ctl + CW_CNT; (void)CNT;
typedef const Params __attribute__((address_space(4))) KParams;
#define PHASE_ENV KParams* pk = kp; asm volatile("" : "+s"(pk)); unsigned char* ws = pk->ws; unsigned* ctl = (unsigned*)(ws + WS_CTL); (void)ctl; DEF_PTRS

constexpr int LDS_BYTES = 147456;
constexpr int N_PHASES = 12;

__global__ void __launch_bounds__(NT, 2) fwd_kernel(Params p) {
    extern __shared__ __attribute__((aligned(16))) unsigned char lds_raw[];
    float* lds = (float*)lds_raw;
    LAS unsigned* misc = (LAS unsigned*)(lds_raw + 131072 + 4096);
    const int tid = threadIdx.x, lane = tid & 63, wave = tid >> 6;
    const int bid = blockIdx.x, G = gridDim.x;
    KParams* kp = (KParams*)__builtin_amdgcn_kernarg_segment_ptr();
    unsigned* ctl = (unsigned*)(p.ws + WS_CTL);
    if (tid < 4) misc[tid] = 0u;
    __syncthreads();
    const bool single = (p.ph_hi - p.ph_lo) > 1;
    if (single) (void)xcd_barrier_post(ctl + CW_BAR, (volatile LAS unsigned*)misc);
#ifndef PH_MASK
#define PH_MASK 0xFFFF
#endif
#define IN(k) ((((PH_MASK) >> (k)) & 1) && p.ph_lo <= (k) && (k) < p.ph_hi)
#define GRID_BARRIER() do { KParams* pb_ = kp; asm volatile("" : "+s"(pb_)); XcdBarrier b_; b_.bar = (unsigned*)(pb_->ws + WS_CTL) + CW_BAR; b_.x = xb_xcc_id(); b_.st = (volatile LAS unsigned*)misc; xcd_barrier(b_); } while (0)
#define SEAM(k) do { if (IN(k) && IN((k) + 1)) GRID_BARRIER(); } while (0)
#define PH_BEGIN(k)
#define PH_END(k)
#define SEAM2(k) do { if (IN(k) && IN((k) + 2)) GRID_BARRIER(); } while (0)

    PH_BEGIN(0) if (IN(0)) {
        const int tid = fresh_tid(), lane = tid & 63, wave = tid >> 6; (void)lane; (void)wave;
        PHASE_ENV
        {
            const float* wmod = pk->in[I_WMOD]; const float* bmod = pk->in[I_BMOD];
            float* sil = lds;
            float* red = lds + 5 * 1024;
            for (int cg = bid; cg < 96; cg += G) {
                for (int e = tid; e < 5 * D; e += NT) { const int r = e >> 10, k = e & 1023; const float cv = (r < 4) ? pk->in[I_C][r * D + k] : pk->in[I_CCTX][k]; sil[e] = siluf_(cv); }
                __syncthreads();
                const int col = cg * 64 + (tid & 63), part = tid >> 6;
                float a0 = 0.f, a1 = 0.f, a2 = 0.f, a3 = 0.f, a4 = 0.f;
#pragma unroll 8
                for (int kk = 0; kk < 128; ++kk) { const int k = part * 128 + kk; const float w = wmod[(size_t)k * 6144 + col];
                    a0 = fmaf(sil[k], w, a0); a1 = fmaf(sil[1024 + k], w, a1); a2 = fmaf(sil[2048 + k], w, a2); a3 = fmaf(sil[3072 + k], w, a3); a4 = fmaf(sil[4096 + k], w, a4); }
                red[(part * 5 + 0) * 64 + (tid & 63)] = a0; red[(part * 5 + 1) * 64 + (tid & 63)] = a1; red[(part * 5 + 2) * 64 + (tid & 63)] = a2; red[(part * 5 + 3) * 64 + (tid & 63)] = a3; red[(part * 5 + 4) * 64 + (tid & 63)] = a4;
                __syncthreads();
                if (tid < 320) { const int r = tid >> 6, cc = tid & 63; float t = 0.f;
#pragma unroll
                    for (int pp = 0; pp < 8; ++pp) t += red[(pp * 5 + r) * 64 + cc];
                    MOD[r * 6144 + cg * 64 + cc] = t + bmod[cg * 64 + cc]; }
                __syncthreads();
            }
        }
        for (int e = bid * NT + tid; e < NE * D; e += G * NT) { const int ex = e >> 10, k = e & 1023; const float w = pk->in[I_RW][(size_t)k * NE + ex];
            const unsigned hi = pg8::cvt_pk_bf16(w, 0.f) & 0xffffu; const float lo = w - __uint_as_float(hi << 16);
            RWH[e] = (unsigned short)hi; RWL[e] = (unsigned short)(pg8::cvt_pk_bf16(lo, 0.f) & 0xffffu); }
        for (int e = bid * NT + tid; e < S * 16; e += G * NT) { float cs, sn; rope_angles(e >> 4, e & 15, cs, sn); ROPEC[e] = cs; ROPES[e] = sn; }
        {
            LAS float* scr = (LAS float*)(lds_raw + wave * 16384);
            const int gw = bid * 8 + wave, NGW = G * 8;
            for (int it = gw; it < (D / 64) * (PW / 32); it += NGW) transpose_item(pk->in[I_WIN], D, INW, PW / 32, WinT, [](int n0) { return n0; }, scr, it, lane);
            for (int it = gw; it < (QL / 64) * (768 / 32); it += NGW) transpose_item(pk->in[I_WUQ], QL, 768, 768 / 32, WuqT, [](int n0) { return n0; }, scr, it, lane, pk->in[I_QNG]);
            for (int it = gw; it < (KVL / 64) * (1024 / 32); it += NGW) transpose_item(pk->in[I_WUKV], KVL, 1024, 1024 / 32, WukvT, [](int n0) { return n0; }, scr, it, lane, pk->in[I_KVNG]);
            for (int it = gw; it < (D / 64) * (D / 32); it += NGW) transpose_item(pk->in[I_WOUT], D, D, D / 32, WoutT, [](int n0) { return n0; }, scr, it, lane);
            for (int c = G - 1 - bid; c < GU_STATIC; c += G) convert_chunk(pk->in[I_WGU], pk->in[I_WDN], WguT, WdnT, 0, c, scr, wave, lane);
        }
    }
    PH_END(0)
    SEAM(0);
    PH_BEGIN(1) if (IN(1)) {
        const int tid = fresh_tid(), lane = tid & 63, wave = tid >> 6; (void)lane; (void)wave;
        PHASE_ENV
        const float* g1n = pk->in[I_N1G];
        for (int e = bid * NT + tid; e < 4 * D; e += G * NT) GM2[e] = pk->in[I_N2G][e & 1023] * (1.f + MOD[(e >> 10) * 6144 + 4 * D + (e & 1023)]);
        for (int rp = bid * 8 + wave; rp < MT / 2; rp += G * 8) {
            const int r = 2 * rp;
            const float* src = (r < MX) ? pk->in[I_X] + (size_t)r * D : pk->in[I_CTX] + (size_t)(r - MX) * D;
            const int mb = (r < MX) ? r / S : 4;
            const float* sh = MOD + mb * 6144, *sc = sh + D;
            float4 va[4], vb[4]; float sa = 0.f, sb = 0.f;
#pragma unroll
            for (int j = 0; j < 4; ++j) { va[j] = *(const float4*)(src + j * 256 + lane * 4); vb[j] = *(const float4*)(src + D + j * 256 + lane * 4); }
#pragma unroll
            for (int j = 0; j < 4; ++j) { sa += (va[j].x * va[j].x + va[j].y * va[j].y) + (va[j].z * va[j].z + va[j].w * va[j].w); sb += (vb[j].x * vb[j].x + vb[j].y * vb[j].y) + (vb[j].z * vb[j].z + vb[j].w * vb[j].w); }
            const float ra = rsqrtf(wave_sum(sa) * (1.f / D) + EPS), rb2 = rsqrtf(wave_sum(sb) * (1.f / D) + EPS);
#pragma unroll
            for (int j = 0; j < 4; ++j) {
                const int c = j * 256 + lane * 4;
                const float4 gn = *(const float4*)(g1n + c), scv = *(const float4*)(sc + c), shv = *(const float4*)(sh + c);
                const float g0 = gn.x * (1.f + scv.x), g1 = gn.y * (1.f + scv.y), g2 = gn.z * (1.f + scv.z), g3 = gn.w * (1.f + scv.w);
                pg8::u32x2 w;
                w.x = pg8::cvt_pk_bf16(va[j].x * ra * g0 + shv.x, va[j].y * ra * g1 + shv.y); w.y = pg8::cvt_pk_bf16(va[j].z * ra * g2 + shv.z, va[j].w * ra * g3 + shv.w);
                *(pg8::u32x2*)(Hb16 + (size_t)r * D + c) = w;
                w.x = pg8::cvt_pk_bf16(vb[j].x * rb2 * g0 + shv.x, vb[j].y * rb2 * g1 + shv.y); w.y = pg8::cvt_pk_bf16(vb[j].z * rb2 * g2 + shv.z, vb[j].w * rb2 * g3 + shv.w);
                *(pg8::u32x2*)(Hb16 + (size_t)(r + 1) * D + c) = w;
            }
        }
    }
    PH_END(1)
    SEAM(1);
    PH_BEGIN(2) if (IN(2)) {
        const int tid = fresh_tid(), lane = tid & 63, wave = tid >> 6; (void)lane; (void)wave;
        PHASE_ENV
        pg8::PlainSched Sd; Sd.init(MT, PW, D, D, WinT, G, bid);
        pg8::EpiInproj E{P16, GATES, STAT, K16, ROPEC, ROPES};
        pg8::gemm_phase<pg8::EpiInproj, pg8::PlainSched, true>((LAS unsigned char*)lds_raw, Hb16, D, Sd, E);
        if ((Sd.nwg % G) != 0 && bid >= (Sd.nwg % G))
            pull_chunks(ctl + CW_QGU, GU_STATIC, GU_CHUNKS, 2, pk->in[I_WGU], pk->in[I_WDN], WguT, WdnT, 0, lds_raw, wave, lane);
    }
    PH_END(2)
    SEAM2(2);
    PH_BEGIN(4) if (IN(4)) {
        const int tid = fresh_tid(), lane = tid & 63, wave = tid >> 6; (void)lane; (void)wave;
        PHASE_ENV
#ifndef NO_QG
        { pg8::PlainSched Sd; Sd.init(MX, 768, QL, PW, WuqT, G, (bid + G - 16) % G);
          pg8::EpiQ E{Q16, STAT, ROPEC, ROPES};
          pg8::gemm_phase<pg8::EpiQ, pg8::PlainSched, true>((LAS unsigned char*)lds_raw, P16 + O_CQ, QL, Sd, E); }
#endif
#ifndef NO_KVG
        { pg8::PlainSched Sd; Sd.init(MT, 1024, KVL, PW, WukvT, G, bid);
          pg8::EpiKV E{K16, V16, STAT};
          pg8::gemm_phase<pg8::EpiKV, pg8::PlainSched, true>((LAS unsigned char*)lds_raw, P16 + O_CKV, KVL, Sd, E); }
#endif
        for (int u = (bid + 48) % G; u < 16 * ml::NXC; u += G) ml::stepA_unit(P16, GATES, pk->in[I_BG], u / ml::NXC, u % ml::NXC, CLOC, NLOC, MLOC, TOT, (char*)lds_raw);
    }
    PH_END(4)
    SEAM(4);
    PH_BEGIN(5) if (IN(5)) {
        const int tid = fresh_tid(), lane = tid & 63, wave = tid >> 6; (void)lane; (void)wave;
        PHASE_ENV
        ml::stepB(CLOC, NLOC, MLOC, TOT, (unsigned*)CIN, NIN, MIN_, bid * NT + tid, G * NT);
        {
            const int nun = NB * HA * (S / 256);
            for (int i = 0; i * G < nun; ++i) {
                int bh, qb;
                if (G == 256) { const int x = bid & 7, slot = bid >> 3; bh = i * 16 + x * 2 + (slot >> 4); qb = slot & 15; }
                else { const int u = i * G + bid; if (u >= nun) break; bh = u >> 4; qb = u & 15; }
                const int b = bh >> 3, h = bh & 7;
                att::attn_body(Q16 + (size_t)(b * S + qb * 256) * 768 + h * 96, K16 + (size_t)(b * SKV) * 768 + h * 96, V16 + (size_t)(b * SKV) * 512 + h * 64,
                               MIX16 + (size_t)(b * S + qb * 256) * D + h * 64, SKV, (char*)lds_raw);
            }
        }
    }
    PH_END(5)
    SEAM(5);
    PH_BEGIN(6) if (IN(6)) {
        const int tid = fresh_tid(), lane = tid & 63, wave = tid >> 6; (void)lane; (void)wave;
        PHASE_ENV
        for (int u = bid; u < 16 * 32; u += G) ml::stepC_unit(P16, GATES, pk->in[I_BG], CIN, NIN, MIN_, pk->in[I_MNG], MIX16, u >> 5, u & 31, (char*)lds_raw);
    }
    PH_END(6)
    SEAM(6);
    PH_BEGIN(7) if (IN(7)) {
        const int tid = fresh_tid(), lane = tid & 63, wave = tid >> 6; (void)lane; (void)wave;
        PHASE_ENV
        pg8::PlainSched Sd; Sd.init(MX, D, D, D, WoutT, G, bid);
        pg8::EpiResid E{X1, pk->in[I_X], MOD, STAT2};
        pg8::gemm_phase<pg8::EpiResid, pg8::PlainSched, true>((LAS unsigned char*)lds_raw, MIX16, D, Sd, E);
    }
    PH_END(7)
    SEAM(7);
    PH_BEGIN(8) if (IN(8)) {
        const int tid = fresh_tid(), lane = tid & 63, wave = tid >> 6; (void)lane; (void)wave;
        PHASE_ENV
        typedef short bf16x8v __attribute__((ext_vector_type(8)));
        typedef float f32x4v __attribute__((ext_vector_type(4)));
        float* LG = lds;
        LAS int* lcnt = (LAS int*)(lds_raw + 32768); LAS int* gbase = lcnt + 32;
        const float* rb = pk->in[I_RB];
        for (int base = bid * 64; base < MX; base += G * 64) {
            if (tid < 32) lcnt[tid] = 0;
            {
                const int bq0 = base / S; const float4 t4 = (tid < 256) ? *(const float4*)(GM2 + bq0 * D + 4 * tid) : *(const float4*)(MOD + bq0 * 6144 + 3 * D + 4 * (tid - 256));
                *(float4*)(lds + 10240 + 4 * tid) = t4; }
            __syncthreads();
            int te[4] = {0, 0, 0, 0}, rk[4] = {0, 0, 0, 0}; float tg[4] = {0.f, 0.f, 0.f, 0.f};
            {
                const int rt = wave & 3, kh = wave >> 2;
                const int r0 = base + 16 * rt, row = lane & 15, kg = lane >> 4, bq = r0 / S;
                float ss;
                { const float4 s0 = *(const float4*)(STAT2 + (size_t)(r0 + row) * 32 + kg * 8), s1 = *(const float4*)(STAT2 + (size_t)(r0 + row) * 32 + kg * 8 + 4);
                  ss = ((s0.x + s0.y) + (s0.z + s0.w)) + ((s1.x + s1.y) + (s1.z + s1.w)); ss += __shfl_xor(ss, 16); ss += __shfl_xor(ss, 32); }
                const float rstd = rsqrtf(ss * (1.f / D) + EPS);
                const int ko = kh * 512 + 8 * kg;
                const unsigned short* xr = X1 + (size_t)(r0 + row) * D + ko; const float* gmr = lds + 10240 + ko; const float* shr = lds + 10240 + 1024 + ko; (void)bq;
                unsigned short* hr = H2 + (size_t)(r0 + row) * D + ko;
                const unsigned short* wh0 = RWH + (size_t)row * D + ko, *wh1 = RWH + (size_t)(16 + row) * D + ko, *wl0 = RWL + (size_t)row * D + ko, *wl1 = RWL + (size_t)(16 + row) * D + ko;
                f32x4v acc0 = {0.f, 0.f, 0.f, 0.f}, acc1 = {0.f, 0.f, 0.f, 0.f};
#pragma unroll 8
                for (int st = 0; st < 16; ++st) {
                    const pg8::u32x4 xw = *(const pg8::u32x4*)(xr + 32 * st);
                    const float4 x0 = make_float4(__uint_as_float(xw[0] << 16), __uint_as_float(xw[0] & 0xffff0000u), __uint_as_float(xw[1] << 16), __uint_as_float(xw[1] & 0xffff0000u)), x1v = make_float4(__uint_as_float(xw[2] << 16), __uint_as_float(xw[2] & 0xffff0000u), __uint_as_float(xw[3] << 16), __uint_as_float(xw[3] & 0xffff0000u));
                    const float4 g0 = *(const float4*)(gmr + 32 * st), g1v = *(const float4*)(gmr + 32 * st + 4), h0 = *(const float4*)(shr + 32 * st), h1 = *(const float4*)(shr + 32 * st + 4);
                    float hv[8] = {x0.x * rstd * g0.x + h0.x, x0.y * rstd * g0.y + h0.y, x0.z * rstd * g0.z + h0.z, x0.w * rstd * g0.w + h0.w, x1v.x * rstd * g1v.x + h1.x, x1v.y * rstd * g1v.y + h1.y, x1v.z * rstd * g1v.z + h1.z, x1v.w * rstd * g1v.w + h1.w};
                    pg8::u32x4 hi4, lo4;
#pragma unroll
                    for (int q = 0; q < 4; ++q) { hi4[q] = pg8::cvt_pk_bf16(hv[2 * q], hv[2 * q + 1]);
                        lo4[q] = pg8::cvt_pk_bf16(hv[2 * q] - __uint_as_float(hi4[q] << 16), hv[2 * q + 1] - __uint_as_float(hi4[q] & 0xffff0000u)); }
                    *(pg8::u32x4*)(hr + 32 * st) = hi4;
                    const bf16x8v ah = *reinterpret_cast<const bf16x8v*>(&hi4), al = *reinterpret_cast<const bf16x8v*>(&lo4);
                    const bf16x8v bh0 = *reinterpret_cast<const bf16x8v*>(wh0 + 32 * st), bh1 = *reinterpret_cast<const bf16x8v*>(wh1 + 32 * st), bl0 = *reinterpret_cast<const bf16x8v*>(wl0 + 32 * st), bl1 = *reinterpret_cast<const bf16x8v*>(wl1 + 32 * st);
                    acc0 = __builtin_amdgcn_mfma_f32_16x16x32_bf16(ah, bh0, acc0, 0, 0, 0); acc0 = __builtin_amdgcn_mfma_f32_16x16x32_bf16(al, bh0, acc0, 0, 0, 0); acc0 = __builtin_amdgcn_mfma_f32_16x16x32_bf16(ah, bl0, acc0, 0, 0, 0);
                    acc1 = __builtin_amdgcn_mfma_f32_16x16x32_bf16(ah, bh1, acc1, 0, 0, 0); acc1 = __builtin_amdgcn_mfma_f32_16x16x32_bf16(al, bh1, acc1, 0, 0, 0); acc1 = __builtin_amdgcn_mfma_f32_16x16x32_bf16(ah, bl1, acc1, 0, 0, 0);
                }
                float* lgp = LG + kh * (64 * 33);
#pragma unroll
                for (int j = 0; j < 4; ++j) { lgp[(16 * rt + 4 * kg + j) * 33 + row] = acc0[j]; lgp[(16 * rt + 4 * kg + j) * 33 + 16 + row] = acc1[j]; }
            }
            __syncthreads();
            if (wave < 4 && lane < 16) {
                float* lr = LG + (16 * wave + lane) * 33; float tv[4];
                for (int e = 0; e < 32; ++e) lr[e] = (lr[e] + lr[64 * 33 + e]) + rb[e];
#pragma unroll
                for (int k = 0; k < 4; ++k) { float best = -3.0e38f; int bi = 0;
                    for (int e = 0; e < 32; ++e) { const float v = lr[e]; if (v > best) { best = v; bi = e; } }
                    te[k] = bi; tv[k] = best; lr[bi] = -3.0e38f; }
                const float e1 = __expf(tv[1] - tv[0]), e2 = __expf(tv[2] - tv[0]), e3 = __expf(tv[3] - tv[0]); const float inv = 1.f / (1.f + e1 + e2 + e3);
                tg[0] = inv; tg[1] = e1 * inv; tg[2] = e2 * inv; tg[3] = e3 * inv;
#pragma unroll
                for (int k = 0; k < 4; ++k) rk[k] = atomicAdd((int*)&lcnt[te[k]], 1);
            }
            __syncthreads();
            if (tid < 32) gbase[tid] = (int)atomicAdd(&CNT[tid], (unsigned)lcnt[tid]);
            __syncthreads();
            if (wave < 4 && lane < 16) { const int r = base + 16 * wave + lane;
#pragma unroll
                for (int k = 0; k < 4; ++k) { const int e = te[k], pos = gbase[e] + rk[k]; TOPE[r * 4 + k] = e; SLOT[r * 4 + k] = pos; LIST[e * MX + pos] = r; RGATE[e * MX + pos] = tg[k]; } }
            __syncthreads();
        }
    }
    if (IN(8)) { const int t2 = fresh_tid(); PHASE_ENV pull_chunks(ctl + CW_QGU, GU_STATIC, GU_CHUNKS, GU_CHUNKS, pk->in[I_WGU], pk->in[I_WDN], WguT, WdnT, 0, lds_raw, t2 >> 6, t2 & 63); }
    PH_END(8)
    SEAM(8);
    LAS int* mtp = (LAS int*)(lds_raw + 131072); LAS int* mro = mtp + 40; LAS int* mcn = mro + 40;
    if (IN(9) || IN(10) || IN(11)) {
        PHASE_ENV
        __syncthreads();
        if (tid < 64) {
            const int cnt = (tid < NE) ? (int)__hip_atomic_load(&CNT[tid & 31], __ATOMIC_RELAXED, __HIP_MEMORY_SCOPE_AGENT) : 0;
            const int tl = (cnt + 255) >> 8; int inc = tl;
#pragma unroll
            for (int o = 1; o < 64; o <<= 1) { const int y = __shfl_up(inc, o); if (tid >= o) inc += y; }
            if (tid < NE) { mcn[tid] = cnt; mtp[tid] = inc - tl; mro[tid] = (inc - tl) * 256; }
            if (tid == NE - 1) { mtp[NE] = inc; mro[NE] = inc * 256; }
        }
        __syncthreads();
    }
    PH_BEGIN(9) if (IN(9)) {
        const int tid = fresh_tid(), lane = tid & 63, wave = tid >> 6; (void)lane; (void)wave;
        PHASE_ENV
        pg8::MoeSched Sd{mtp, mro, mcn, DFF / 128, G, bid, D, D, 1, LIST, (const char*)WguT, (size_t)2 * DFF * D * 2};
        pg8::EpiSwiglu E{ACT, pk->in[I_BGU]};
        pg8::gemm_phase<pg8::EpiSwiglu, pg8::MoeSched, true>((LAS unsigned char*)lds_raw, H2, D, Sd, E);
        {
            const int nun = mtp[NE] * (DFF / 128); const int mine = (nun - bid + G - 1) / G, most = (nun + G - 1) / G;
            if (mine < most) pull_chunks(ctl + CW_QDN, 0, DN_CHUNKS, 3, pk->in[I_WGU], pk->in[I_WDN], WguT, WdnT, 1, lds_raw, wave, lane);
            pull_chunks(ctl + CW_QDN, 0, DN_CHUNKS, DN_CHUNKS, pk->in[I_WGU], pk->in[I_WDN], WguT, WdnT, 1, lds_raw, wave, lane);
        }
    }
    PH_END(9)
    SEAM(9);
    PH_BEGIN(10) if (IN(10)) {
        const int tid = fresh_tid(), lane = tid & 63, wave = tid >> 6; (void)lane; (void)wave;
        PHASE_ENV
        pg8::MoeSched Sd{mtp, mro, mcn, D / 256, G, bid, DFF, DFF, 0, LIST, (const char*)WdnT, (size_t)D * DFF * 2};
        pg8::EpiDown E{YG, pk->in[I_BDN], RGATE, mro};
        pg8::gemm_phase<pg8::EpiDown, pg8::MoeSched, true>((LAS unsigned char*)lds_raw, ACT, DFF, Sd, E);
    }
    PH_END(10)
    SEAM(10);
    PH_BEGIN(11) if (IN(11)) {
        const int tid = fresh_tid(), lane = tid & 63, wave = tid >> 6; (void)lane; (void)wave;
        PHASE_ENV
        const float* fng = pk->in[I_FNG];
        for (int r = bid * 8 + wave; r < MX; r += G * 8) {
            const int mb = r / S; const float* g2 = MOD + mb * 6144 + 5 * D;
            float acc[16];
#pragma unroll
            for (int i = 0; i < 16; ++i) acc[i] = 0.f;
#pragma unroll
            for (int k = 0; k < 4; ++k) {
                const int e = TOPE[r * 4 + k]; const int row = mro[e] + SLOT[r * 4 + k];
                const unsigned short* yr = YG + (size_t)row * D;
#pragma unroll
                for (int j = 0; j < 4; ++j) { const pg8::u32x2 t = *(const pg8::u32x2*)(yr + j * 256 + lane * 4);
                    acc[4 * j] += __uint_as_float(t.x << 16); acc[4 * j + 1] += __uint_as_float(t.x & 0xffff0000u); acc[4 * j + 2] += __uint_as_float(t.y << 16); acc[4 * j + 3] += __uint_as_float(t.y & 0xffff0000u); }
            }
            float v[16]; float ss = 0.f;
#pragma unroll
            for (int j = 0; j < 4; ++j) { const pg8::u32x2 tw = *(const pg8::u32x2*)(X1 + (size_t)r * D + j * 256 + lane * 4); const float4 t = make_float4(__uint_as_float(tw.x << 16), __uint_as_float(tw.x & 0xffff0000u), __uint_as_float(tw.y << 16), __uint_as_float(tw.y & 0xffff0000u)); const int c = j * 256 + lane * 4;
                v[4 * j] = t.x + g2[c] * acc[4 * j]; v[4 * j + 1] = t.y + g2[c + 1] * acc[4 * j + 1]; v[4 * j + 2] = t.z + g2[c + 2] * acc[4 * j + 2]; v[4 * j + 3] = t.w + g2[c + 3] * acc[4 * j + 3];
                ss += v[4 * j] * v[4 * j] + v[4 * j + 1] * v[4 * j + 1] + v[4 * j + 2] * v[4 * j + 2] + v[4 * j + 3] * v[4 * j + 3]; }
            const float rstd = rsqrtf(wave_sum(ss) * (1.f / D) + EPS);
#pragma unroll
            for (int j = 0; j < 4; ++j) { const int c = j * 256 + lane * 4;
                *(float4*)(pk->out + (size_t)r * D + c) = make_float4(v[4 * j] * rstd * fng[c], v[4 * j + 1] * rstd * fng[c + 1], v[4 * j + 2] * rstd * fng[c + 2], v[4 * j + 3] * rstd * fng[c + 3]); }
        }
    }
    PH_END(11)
#undef IN
#undef SEAM
}

#ifndef PROBE_SPLIT_DUP
#define PROBE_SPLIT_DUP (-1)
#endif
#ifndef N_LAUNCH_SPLIT
#define N_LAUNCH_SPLIT 0
#endif

extern "C" void kernel_launch(void* const* d_in, const int* in_sizes, int n_in, void* d_out, int out_size, void* d_ws, size_t ws_size, hipStream_t stream) {
    static int grid = 0;
    if (grid == 0) {
        if (n_in != 23 || out_size != MX * D || ws_size < WS_END) { fprintf(stderr, "kernel_launch: unexpected shapes n_in %d out %d ws %zu (need %zu)\n", n_in, out_size, ws_size, (size_t)WS_END); grid = -1; return; }
        int dev = 0, cus = 0, per_cu = 0;
        hipGetDevice(&dev); hipDeviceGetAttribute(&cus, hipDeviceAttributeMultiprocessorCount, dev);
        if (hipFuncSetAttribute((const void*)fwd_kernel, hipFuncAttributeMaxDynamicSharedMemorySize, LDS_BYTES) != hipSuccess) { fprintf(stderr, "kernel_launch: hipFuncSetAttribute failed\n"); grid = -1; return; }
        hipOccupancyMaxActiveBlocksPerMultiprocessor(&per_cu, (const void*)fwd_kernel, NT, LDS_BYTES);
        if (per_cu < 1) fprintf(stderr, "kernel_launch: occupancy query says %d\n", per_cu);
        (void)hipGetLastError();
        grid = cus > 0 ? cus : 256;
    }
    if (grid < 0) return;
    hipMemsetAsync((char*)d_ws + WS_CTL, 0, CTL_BYTES, stream);
    Params p{};
    for (int i = 0; i < 23; ++i) p.in[i] = (const float*)d_in[i];
    p.out = (float*)d_out; p.ws = (unsigned char*)d_ws;
#if N_LAUNCH_SPLIT
    for (int k = 0; k < N_PHASES; ++k) {
        if (k == 3) continue;
        const int reps = (k == PROBE_SPLIT_DUP) ? 2 : 1;
        for (int r = 0; r < reps; ++r) {
            if (k == 8 && r == 1) hipMemsetAsync((char*)d_ws + WS_CTL, 0, CTL_BYTES, stream);
            p.ph_lo = k; p.ph_hi = k + 1; hipLaunchKernelGGL(fwd_kernel, dim3(grid), dim3(NT), LDS_BYTES, stream, p);
        }
    }
#else
    p.ph_lo = 0; p.ph_hi = N_PHASES;
    hipLaunchKernelGGL(fwd_kernel, dim3(grid), dim3(NT), LDS_BYTES, stream, p);
#endif
}
```

```cpp
#include <hip/hip_runtime.h>
#include <cstdio>
#include <cstdint>

#define LAS __attribute__((address_space(3)))

#define XB_TMO      128
#define XB_XCNT(j)  (256  + 64 * (j))
#define XB_XSUB(j)  (1280 + 64 * (j))
#define XB_XGEN(j)  (2304 + 64 * (j))
#define XB_TOP      3328
#define XB_TOPGEN   3392
#define XCD_BAR_WORDS 3456
#define XB_SPIN_CAP (1u << 22)

__device__ __forceinline__ unsigned xb_ld(unsigned* p)              { return __hip_atomic_load(p, __ATOMIC_RELAXED, __HIP_MEMORY_SCOPE_AGENT); }
__device__ __forceinline__ unsigned xb_add(unsigned* p, unsigned v) { return __hip_atomic_fetch_add(p, v, __ATOMIC_RELAXED, __HIP_MEMORY_SCOPE_AGENT); }
__device__ __forceinline__ unsigned xb_xcc_id() { return (unsigned)__builtin_amdgcn_s_getreg((3 << 11) | 20) & 0xFu; }
#define XB_SPIN(cond, bar) do { unsigned _sp = 0; while (cond) { __builtin_amdgcn_s_sleep(1); \
    if ((++_sp & 255u) == 0u) { if (xb_ld(&(bar)[XB_TMO])) break; if (_sp > XB_SPIN_CAP) { atomicAdd(&(bar)[XB_TMO], 1u); break; } } } } while (0)

struct XcdBarrier { unsigned* bar; unsigned x; volatile LAS unsigned* st; };

__device__ __forceinline__ XcdBarrier xcd_barrier_post(unsigned* bar, volatile LAS unsigned* st) {
    XcdBarrier b; b.bar = bar; b.x = xb_xcc_id(); b.st = st;
    if (threadIdx.x == 0) (void)xb_add(&bar[XB_XCNT(b.x)], 1u);
    return b;
}
__device__ __forceinline__ void xcd_barrier_complete(unsigned* bar, unsigned x, unsigned& nloc, unsigned& nx) {
    const unsigned G = gridDim.x * gridDim.y * gridDim.z;
    unsigned sum, cnt, mine, sp = 0u;
    for (;;) {
        sum = 0u; cnt = 0u; mine = 0u;
#pragma unroll
        for (unsigned j = 0; j < 16; ++j) { const unsigned c = xb_ld(&bar[XB_XCNT(j)]); sum += c; cnt += (c > 0u) ? 1u : 0u; mine = (j == x) ? c : mine; }
        if (sum == G) break;
        __builtin_amdgcn_s_sleep(1);
        if ((++sp & 255u) == 0u) { if (xb_ld(&bar[XB_TMO])) break; if (sp > XB_SPIN_CAP) { atomicAdd(&bar[XB_TMO], 1u); break; } }
    }
    nloc = mine > 0u ? mine : 1u; nx = cnt > 0u ? cnt : 1u;
}
__device__ __forceinline__ void xcd_barrier(const XcdBarrier& b) {
    asm volatile("s_waitcnt vmcnt(0)" ::: "memory");
    __syncthreads();
    if (threadIdx.x == 0) {
        unsigned* bar = b.bar;
        __builtin_amdgcn_s_waitcnt(0);
        unsigned nloc = b.st[0], nx = b.st[1];
        if (nloc == 0u) { xcd_barrier_complete(bar, b.x, nloc, nx); b.st[0] = nloc; b.st[1] = nx; }
        const unsigned old = xb_add(&bar[XB_XSUB(b.x)], 1u);
        const unsigned gen = old / nloc;
        if (old + 1u == (gen + 1u) * nloc) {
            __builtin_amdgcn_fence(__ATOMIC_RELEASE, "agent");
            asm volatile("s_waitcnt vmcnt(0)" ::: "memory");
            const unsigned og = xb_add(&bar[XB_TOP], 1u);
            const unsigned tg = og / nx;
            if (og + 1u == (tg + 1u) * nx) xb_add(&bar[XB_TOPGEN], 1u);
            else XB_SPIN(xb_ld(&bar[XB_TOPGEN]) == tg, bar);
            __builtin_amdgcn_fence(__ATOMIC_ACQUIRE, "agent");
            xb_add(&bar[XB_XGEN(b.x)], 1u);
            asm volatile("s_waitcnt vmcnt(0)" ::: "memory");
        } else {
            XB_SPIN(xb_ld(&bar[XB_XGEN(b.x)]) == gen, bar);
            __builtin_amdgcn_fence(__ATOMIC_ACQUIRE, "agent");
            asm volatile("s_waitcnt vmcnt(0)" ::: "memory");
        }
    }
    __syncthreads();
}

#ifndef MOE_FP8
#define MOE_FP8 1
#endif
constexpr int D = 1024, NB = 4, S = 4096, CTX = 256, SKV = S + CTX;
constexpr int MX = NB * S, MC = NB * CTX, MT = MX + MC;
constexpr int INW = 2224, PW = 2304;
constexpr int O_CQ = 0, O_CKV = 384, O_KR = 640, O_MQ = 672, O_MK = 928, O_MV = 1184, O_MO = 1696, O_G = 2208;
constexpr int QL = 384, KVL = 256, HA = 8, DN = 64, DR = 32, DQK = 96, DVH = 64;
constexpr int NH = 4, MDQK = 64, MDV = 128;
constexpr int NE = 32, TOPK = 4, DFF = 1024;
constexpr float EPS = 1e-6f;
constexpr int NT = 512;
constexpr int NSEQ = NB * NH * 2;
constexpr int RCAP = MX * TOPK + NE * 256;

constexpr size_t MiB = 1u << 20;
constexpr size_t WS_CTL = 0, CTL_BYTES = 1 * MiB;
constexpr size_t WS_MOD = 1 * MiB;
constexpr size_t WS_MLS = 2 * MiB;
constexpr size_t WS_ROPE = 5 * MiB;
constexpr size_t WS_STAT2 = 6 * MiB;
constexpr size_t WS_TOPE = 8 * MiB;
constexpr size_t WS_SLOT = 9 * MiB;
constexpr size_t WS_LIST = 10 * MiB;
constexpr size_t WS_RGATE = 12 * MiB;
constexpr size_t WS_H = 16 * MiB;
constexpr size_t WS_P = 52 * MiB;
constexpr size_t WS_ACT = WS_P;
constexpr size_t WS_Q = 206 * MiB;
constexpr size_t WS_KV = 254 * MiB;
constexpr size_t WS_CLOC = 322 * MiB;
constexpr size_t WS_CIN = 386 * MiB;
constexpr size_t WS_X1 = 450 * MiB;
constexpr size_t WS_H2 = 514 * MiB;
constexpr size_t WS_YG = 546 * MiB;
constexpr size_t WS_WGUT = 690 * MiB;
constexpr size_t WS_WDNT = 818 * MiB;
constexpr size_t WS_WINT = 882 * MiB;
constexpr size_t WS_WUQT = 887 * MiB;
constexpr size_t WS_WUKVT = 888 * MiB;
constexpr size_t WS_WOUTT = 889 * MiB;
constexpr size_t WS_GATES = 891 * MiB;
constexpr size_t WS_STAT = 893 * MiB;
constexpr size_t WS_RSTD = 895 * MiB;
constexpr size_t WS_MIX16 = 896 * MiB;
constexpr size_t WS_END = 928 * MiB;
static_assert((size_t)MT * PW * 2 <= 153 * MiB && (size_t)RCAP * DFF * 2 <= 144 * MiB, "map");

constexpr int CW_BAR = 4096;
constexpr int CW_CNT = 16384;
constexpr int CW_QGU = 16384 + 64, CW_QDN = 16384 + 128;
constexpr int GU_CHUNKS = 512, DN_CHUNKS = 256;
#ifndef GU_STATIC
#define GU_STATIC 312
#endif

struct Params {
    const float* in[23];
    float* out;
    unsigned char* ws;
    int ph_lo, ph_hi;
};
enum { I_X = 0, I_C, I_CTX, I_CCTX, I_WMOD, I_BMOD, I_N1G, I_WIN, I_BG, I_QNG, I_WUQ, I_KVNG, I_WUKV, I_MNG, I_WOUT, I_N2G, I_RW, I_RB, I_WGU, I_BGU, I_WDN, I_BDN, I_FNG };

__device__ __forceinline__ float wave_sum(float v) {
#pragma unroll
    for (int o = 1; o < 64; o <<= 1) v += __shfl_xor(v, o);
    return v;
}
__device__ __forceinline__ float bf2f(unsigned short v) { return __uint_as_float(((unsigned)v) << 16); }
__device__ __forceinline__ float sigmoidf_(float x) { return 1.f / (1.f + __expf(-x)); }
__device__ __forceinline__ float siluf_(float x) { return x / (1.f + expf(-x)); }
__device__ __forceinline__ float logsigmoidf_(float x) { return fminf(x, 0.f) - log1pf(expf(-fabsf(x))); }

__device__ __forceinline__ int krow(int b, int key) { return key < CTX ? MX + b * CTX + key : b * S + (key - CTX); }
__device__ __forceinline__ int srow(int b, int dir, int u) {
    if (u < CTX) { const int c = dir ? (CTX - 1 - u) : u; return MX + b * CTX + c; }
    const int tt = u - CTX; const int s = dir ? (S - 1 - tt) : tt; return b * S + s;
}
__device__ __forceinline__ void rope_angles(int s, int j, float& cs, float& sn) {
    const int jj = j & 7; const float pos = (j < 8) ? (float)(s / 64) : (float)(s % 64);
    const float inv = powf(10000.f, -(float)jj / 8.f);
    const float ang = pos * inv; cs = cosf(ang); sn = sinf(ang);
}

struct GemmDesc { const float* A; int lda; const int* arow; int M; const float* B; int ldb; int N; int K; };
template <class Epi>
__device__ __forceinline__ void sgemm_tile(float* lds, const GemmDesc g, int tm, int tn, const Epi& epi) {
    float* As = lds;
    float* Bs = lds + 16 * 132;
    const int tid = threadIdx.x, tx = tid & 15, ty = tid >> 4;
    float acc[4][8];
#pragma unroll
    for (int i = 0; i < 4; ++i)
#pragma unroll
        for (int j = 0; j < 8; ++j) acc[i][j] = 0.f;
    const int ar = tid >> 2, ak = (tid & 3) * 4;
    const int grow = tm * 128 + ar;
    const float* aptr = nullptr;
    if (grow < g.M) { const int r = g.arow ? g.arow[grow] : grow; aptr = g.A + (size_t)r * g.lda + ak; }
    const int bk = tid >> 5, bc = (tid & 31) * 4;
    const int gcol = tn * 128 + bc;
    for (int k0 = 0; k0 < g.K; k0 += 16) {
        float4 av = make_float4(0.f, 0.f, 0.f, 0.f), bv = make_float4(0.f, 0.f, 0.f, 0.f);
        if (aptr) av = *(const float4*)(aptr + k0);
        if (gcol < g.N) bv = *(const float4*)(g.B + (size_t)(k0 + bk) * g.ldb + gcol);
        __syncthreads();
        As[(ak + 0) * 132 + ar] = av.x; As[(ak + 1) * 132 + ar] = av.y; As[(ak + 2) * 132 + ar] = av.z; As[(ak + 3) * 132 + ar] = av.w;
        *(float4*)(Bs + bk * 128 + bc) = bv;
        __syncthreads();
#pragma unroll
        for (int k = 0; k < 16; ++k) {
            const float4 a4 = *(const float4*)(As + k * 132 + ty * 4);
            const float4 b0 = *(const float4*)(Bs + k * 128 + tx * 8), b1 = *(const float4*)(Bs + k * 128 + tx * 8 + 4);
            const float a[4] = {a4.x, a4.y, a4.z, a4.w};
            const float b[8] = {b0.x, b0.y, b0.z, b0.w, b1.x, b1.y, b1.z, b1.w};
#pragma unroll
            for (int i = 0; i < 4; ++i)
#pragma unroll
                for (int j = 0; j < 8; ++j) acc[i][j] = fmaf(a[i], b[j], acc[i][j]);
        }
    }
#pragma unroll
    for (int i = 0; i < 4; ++i) {
        const int r = tm * 128 + ty * 4 + i;
        if (r < g.M) {
#pragma unroll
            for (int j = 0; j < 8; ++j) { const int c = tn * 128 + tx * 8 + j; if (c < g.N) epi(r, c, acc[i][j]); }
        }
    }
}
template <class Epi>
__device__ __forceinline__ void sgemm_phase(float* lds, const GemmDesc g, const Epi& epi, int u0 = 0, int ustride = 0) {
    const int ntm = (g.M + 127) / 128, ntn = (g.N + 127) / 128;
    for (int u = blockIdx.x; u < ntm * ntn; u += gridDim.x) sgemm_tile(lds, g, u / ntn, u % ntn, epi);
}


namespace pg8 {
#define PG8_LAS __attribute__((address_space(3)))
typedef unsigned short bf16_t;
typedef short bf16x8 __attribute__((ext_vector_type(8)));
typedef float f32x4 __attribute__((ext_vector_type(4)));
typedef unsigned u32x4 __attribute__((ext_vector_type(4)));
typedef unsigned u32x2 __attribute__((ext_vector_type(2)));
constexpr int BM = 256, BK = 64, HALF = 128, HTB = HALF * BK * 2, STAGE_BYTES = 8 * HTB, NXCD = 8, WGM = 8;
__host__ __device__ __forceinline__ int lds_byte(int r, int c) { const int st = (r >> 4) * 2 + (c >> 5), rr = r & 15, cc = c & 31, ob = rr * 64 + cc * 2; return st * 1024 + (ob ^ (((ob >> 9) & 1) << 5)); }
__host__ __device__ __forceinline__ void stage_rc(int b, int& R, int& C) { const int st = b / 1024, sb = b % 1024, swz = sb ^ (((sb >> 9) & 1) << 5); R = (st >> 1) * 16 + swz / 64; C = (st & 1) * 32 + (swz % 64) / 2; }
__host__ __device__ __forceinline__ int perm32(int rho) { const int n = rho >> 4, i = rho & 15; return 8 * (i >> 2) + 4 * n + (i & 3); }
__device__ __forceinline__ unsigned cvt_pk_bf16(float lo, float hi) { unsigned r; asm volatile("v_cvt_pk_bf16_f32 %0, %1, %2" : "=v"(r) : "v"(lo), "v"(hi)); return r; }

struct Unit { int pm, pn, g, row0; };

struct PlainSched {
    int nM, nN, nwg, G, c, lda, K; const char* Bt;
    __device__ void init(int M, int N, int K_, int lda_, const void* Bt_, int G_, int c_) { nM = M / BM; nN = N / BM; nwg = nM * nN; G = G_; c = c_; lda = lda_; K = K_; Bt = (const char*)Bt_; }
    __device__ __forceinline__ bool next(int i, Unit& u) const {
        const long L = (long)i * G + c; if (L >= nwg) return false;
        int wgid = (int)L; { const int q = nwg / NXCD, r = nwg % NXCD, xcd = wgid % NXCD, off = wgid / NXCD; wgid = (xcd < r ? xcd * (q + 1) : r * (q + 1) + (xcd - r) * q) + off; }
        const int nig = WGM * nN, gid = wgid / nig, fm = gid * WGM, gsz = (nM - fm) < WGM ? (nM - fm) : WGM;
        u.pm = fm + ((wgid % nig) % gsz); u.pn = (wgid % nig) / gsz; u.g = 0; u.row0 = u.pm * BM; return true;
    }
    __device__ __forceinline__ unsigned a_rowoff(const Unit& u, int r) const { return (unsigned)(u.pm * BM + r) * (unsigned)(lda * 2); }
    __device__ __forceinline__ void rows4(const Unit& u, int R0, int R1, unsigned (&o)[4]) const { o[0] = a_rowoff(u, R0); o[1] = a_rowoff(u, R1); o[2] = a_rowoff(u, HALF + R0); o[3] = a_rowoff(u, HALF + R1); }
    __device__ __forceinline__ const char* b_base(const Unit& u) const { return Bt + (size_t)u.pn * BM * K * 2; }
};

template <class Epi, class Sched, bool ALIGN_EPI, bool F8 = false>
__device__ __forceinline__ void gemm_phase(PG8_LAS unsigned char* lds, const bf16_t* Aptr, const int K, const Sched& S, const Epi& E) {
    const int tid = threadIdx.x, wid = __builtin_amdgcn_readfirstlane(tid >> 6), lane = tid & 63, wr = wid >> 2, wc = wid & 3, fr = lane & 15, fq = lane >> 4;
    const int nt = K / BK;
    unsigned voffB[2];
#pragma unroll
    for (int i = 0; i < 2; ++i) { int R, C; stage_rc(tid * 16 + i * 8192, R, C); const int Rb = Epi::PERM ? ((R & ~31) + perm32(R & 31)) : R;
        voffB[i] = (unsigned)(Rb * K + C) * 2u; }
    const size_t kstep = (size_t)(BK * 2);
    const size_t hstepB = (size_t)HALF * K * 2;
    const unsigned ldsw = (unsigned)wid * 1024u;
    const int aoff = lds_byte(wr * 64 + fr, fq * 8), boff = lds_byte(wc * 32 + fr, fq * 8);
#define PG8_SA(b, h) (((b) * 2 + (h)) * HTB)
#define PG8_SB(b, h) ((4 + (b) * 2 + (h)) * HTB)
#define PG8_STAGE(bufoff, gbase, voff) do { _Pragma("unroll") for (int _i = 0; _i < 2; ++_i) \
        __builtin_amdgcn_global_load_lds((const unsigned*)((const char*)(gbase) + (voff)[_i]), (PG8_LAS unsigned*)(lds + (bufoff) + ldsw + _i * 8192), 16, 0, 0); } while (0)
#define PG8_LDA(dst, b, h) do { _Pragma("unroll") for (int m = 0; m < 4; ++m) _Pragma("unroll") for (int k = 0; k < 2; ++k) dst[m][k] = *(const PG8_LAS bf16x8*)(lds + PG8_SA(b, h) + aoff + m * 2048 + k * 1024); } while (0)
#define PG8_LDB(dst, b, h) do { _Pragma("unroll") for (int n = 0; n < 2; ++n) _Pragma("unroll") for (int k = 0; k < 2; ++k) dst[n][k] = *(const PG8_LAS bf16x8*)(lds + PG8_SB(b, h) + boff + n * 2048 + k * 1024); } while (0)
typedef int i32x4v __attribute__((ext_vector_type(4)));
typedef int i32x8v __attribute__((ext_vector_type(8)));
#define PG8_CAT(x0, x1) __builtin_shufflevector(__builtin_bit_cast(i32x4v, x0), __builtin_bit_cast(i32x4v, x1), 0, 1, 2, 3, 4, 5, 6, 7)
#define PG8_MMA(ai, bj, At, Bt) do { __builtin_amdgcn_s_setprio(1); \
        if constexpr (F8) { _Pragma("unroll") for (int m = 0; m < 4; ++m) _Pragma("unroll") for (int n = 0; n < 2; ++n) \
            acc[ai][bj][m][n] = __builtin_amdgcn_mfma_scale_f32_16x16x128_f8f6f4(PG8_CAT(Bt[n][0], Bt[n][1]), PG8_CAT(At[m][0], At[m][1]), acc[ai][bj][m][n], 0, 0, 0, 0x79797979, 0, 0x7f7f7f7f); } \
        else { _Pragma("unroll") for (int m = 0; m < 4; ++m) _Pragma("unroll") for (int n = 0; n < 2; ++n) _Pragma("unroll") for (int k = 0; k < 2; ++k) \
            acc[ai][bj][m][n] = __builtin_amdgcn_mfma_f32_16x16x32_bf16(Bt[n][k], At[m][k], acc[ai][bj][m][n], 0, 0, 0); } \
        __builtin_amdgcn_s_setprio(0); } while (0)
#define PG8_WAIT_V(n) asm volatile("s_waitcnt vmcnt(" #n ")" ::: "memory")
#define PG8_WAIT_L(n) asm volatile("s_waitcnt lgkmcnt(" #n ")" ::: "memory")
#define PG8_BAR __builtin_amdgcn_s_barrier()
#define PG8_SCHED __builtin_amdgcn_sched_barrier(0)
    Unit cur, nxt; int ui = 0;
    if (!S.next(0, cur)) return;
    f32x4 acc[2][2][4][2];
#pragma unroll
    for (int a = 0; a < 2; ++a)
#pragma unroll
        for (int b = 0; b < 2; ++b)
#pragma unroll
            for (int m = 0; m < 4; ++m)
#pragma unroll
                for (int n = 0; n < 2; ++n) acc[a][b][m][n] = (f32x4){0.f, 0.f, 0.f, 0.f};
    bf16x8 At[4][2], B0[2][2], B1[2][2];
    unsigned oA0[2], oA1[2];
    { int R0, C0, R1, C1; stage_rc(tid * 16, R0, C0); stage_rc(tid * 16 + 8192, R1, C1); unsigned o4[4]; S.rows4(cur, R0, R1, o4);
      oA0[0] = o4[0] + (unsigned)C0 * 2u; oA0[1] = o4[1] + (unsigned)C1 * 2u; oA1[0] = o4[2] + (unsigned)C0 * 2u; oA1[1] = o4[3] + (unsigned)C1 * 2u; }
    const char* const cA = (const char*)Aptr;
    const char* cB = S.b_base(cur);
    PG8_STAGE(PG8_SB(0, 0), cB, voffB); PG8_STAGE(PG8_SB(0, 1), cB + hstepB, voffB); PG8_STAGE(PG8_SA(0, 0), cA, oA0); PG8_STAGE(PG8_SA(0, 1), cA, oA1);
    if (wr == 1) PG8_BAR;
    PG8_WAIT_V(2); PG8_BAR;
    PG8_STAGE(PG8_SB(1, 0), cB + kstep, voffB); PG8_STAGE(PG8_SA(1, 0), cA + kstep, oA0); PG8_STAGE(PG8_SB(1, 1), cB + hstepB + kstep, voffB);
    PG8_WAIT_V(6); PG8_BAR;
    for (;;) {
        const bool has_next = S.next(ui + 1, nxt);
        const char* nB = has_next ? S.b_base(nxt) : cB;
        unsigned pre[4] = {0u, 0u, 0u, 0u};
        if (has_next) { int R0, C0, R1, C1; stage_rc((int)threadIdx.x * 16, R0, C0); stage_rc((int)threadIdx.x * 16 + 8192, R1, C1); S.rows4(nxt, R0, R1, pre);
            asm volatile("" : "+v"(pre[0]), "+v"(pre[1]), "+v"(pre[2]), "+v"(pre[3])); }
#pragma unroll 1
        for (int t = 0; t < nt; t += 2) {
            const bool last = (t == nt - 2);
            const char* a1 = cA + (size_t)(t + 1) * kstep;
            const char* a2 = last ? cA : cA + (size_t)(t + 2) * kstep; const char* b2 = last ? nB : cB + (size_t)(t + 2) * kstep;
            const char* a3 = a2 + kstep; const char* b3 = b2 + kstep;
            PG8_LDB(B0, 0, 0); PG8_LDB(B1, 0, 1); PG8_SCHED; PG8_LDA(At, 0, 0); PG8_STAGE(PG8_SA(1, 1), a1, oA1);
            if (last && has_next) {
                int R0, C0, R1, C1; stage_rc((int)threadIdx.x * 16, R0, C0); stage_rc((int)threadIdx.x * 16 + 8192, R1, C1);
                oA0[0] = pre[0] + (unsigned)C0 * 2u; oA0[1] = pre[1] + (unsigned)C1 * 2u; oA1[0] = pre[2] + (unsigned)C0 * 2u; oA1[1] = pre[3] + (unsigned)C1 * 2u;
            }
            PG8_WAIT_V(8); PG8_WAIT_L(0); PG8_BAR; PG8_MMA(0, 0, At, B0); PG8_MMA(0, 1, At, B1); PG8_BAR; PG8_SCHED;
            PG8_LDA(At, 0, 1); PG8_STAGE(PG8_SB(0, 0), b2, voffB); PG8_STAGE(PG8_SB(0, 1), b2 + hstepB, voffB); PG8_STAGE(PG8_SA(0, 0), a2, oA0);
            PG8_WAIT_V(8); PG8_WAIT_L(0); PG8_BAR; PG8_MMA(1, 0, At, B0); PG8_MMA(1, 1, At, B1); PG8_BAR; PG8_SCHED;
            PG8_LDB(B0, 1, 0); PG8_LDB(B1, 1, 1); PG8_SCHED; PG8_LDA(At, 1, 0); PG8_STAGE(PG8_SA(0, 1), a2, oA1);
            PG8_WAIT_V(8); PG8_WAIT_L(0); PG8_BAR; PG8_MMA(0, 0, At, B0); PG8_MMA(0, 1, At, B1); PG8_BAR; PG8_SCHED;
            PG8_LDA(At, 1, 1); PG8_STAGE(PG8_SB(1, 0), b3, voffB); PG8_STAGE(PG8_SB(1, 1), b3 + hstepB, voffB); PG8_STAGE(PG8_SA(1, 0), a3, oA0);
            PG8_WAIT_V(8); PG8_WAIT_L(0); PG8_BAR; PG8_MMA(1, 0, At, B0); PG8_MMA(1, 1, At, B1); PG8_BAR; PG8_SCHED;
        }
        if constexpr (ALIGN_EPI) { if (wr == 0) PG8_BAR; }
        E(acc, cur, wr, wc, fr, fq);
        if (!has_next) break;
#pragma unroll
        for (int a = 0; a < 2; ++a)
#pragma unroll
            for (int b = 0; b < 2; ++b)
#pragma unroll
                for (int m = 0; m < 4; ++m)
#pragma unroll
                    for (int n = 0; n < 2; ++n) acc[a][b][m][n] = (f32x4){0.f, 0.f, 0.f, 0.f};
        cur = nxt; cB = nB; ++ui;
        if constexpr (ALIGN_EPI) { if (wr == 1) PG8_BAR; }
    }
    PG8_WAIT_V(0);
    if constexpr (!ALIGN_EPI) { if (wr == 0) PG8_BAR; }
    PG8_BAR;
#undef PG8_SA
#undef PG8_SB
#undef PG8_STAGE
#undef PG8_LDA
#undef PG8_LDB
#undef PG8_MMA
#undef PG8_CAT
#undef PG8_WAIT_V
#undef PG8_WAIT_L
#undef PG8_BAR
#undef PG8_SCHED
}

struct EpiF32 {
    static constexpr bool PERM = false;
    float* C; int ldc; int ncols;
    __device__ __forceinline__ void operator()(const f32x4 (&acc)[2][2][4][2], const Unit& u, int wr, int wc, int fr, int fq) const {
        const int row0 = u.row0 + wr * 64 + fr, col0 = u.pn * BM + wc * 32 + 4 * fq;
#pragma unroll
        for (int ai = 0; ai < 2; ++ai)
#pragma unroll
            for (int m = 0; m < 4; ++m) { float* rowp = C + (size_t)(row0 + ai * HALF + m * 16) * ldc + col0;
#pragma unroll
                for (int bj = 0; bj < 2; ++bj)
#pragma unroll
                    for (int n = 0; n < 2; ++n) if (col0 + bj * HALF + n * 16 < ncols) *(f32x4*)(rowp + bj * HALF + n * 16) = acc[ai][bj][m][n]; }
    }
};
struct MoeSched {
    const PG8_LAS int* tp; const PG8_LAS int* ro; const PG8_LAS int* cn; int nN, G, c, K, lda, gather; const int* list; const char* Bt; size_t bstride;
    __device__ __forceinline__ bool next(int i, Unit& u) const {
        const int nwg = tp[32] * nN; const long L = (long)i * G + c; if (L >= nwg) return false;
        int wgid = (int)L; { const int q = nwg / NXCD, r = nwg % NXCD, xcd = wgid % NXCD, off = wgid / NXCD; wgid = (xcd < r ? xcd * (q + 1) : r * (q + 1) + (xcd - r) * q) + off; }
        const int tile = wgid / nN; int g = 0;
#pragma unroll 1
        for (int e = 1; e < 32; ++e) g = (tp[e] <= tile) ? e : g;
        const int ntm = tp[g + 1] - tp[g]; const int rem = wgid - tp[g] * nN;
        u.g = g; u.pm = rem % ntm; u.pn = rem / ntm; u.row0 = ro[g] + u.pm * BM; return true;
    }
    __device__ __forceinline__ unsigned a_rowoff(const Unit& u, int r) const {
        const int rr = u.pm * BM + r;
        if (gather) { const int tok = (rr < cn[u.g]) ? list[u.g * 16384 + rr] : 0; return (unsigned)tok * (unsigned)(lda * 2); }
        return (unsigned)(u.row0 + r) * (unsigned)(lda * 2);
    }
    __device__ __forceinline__ void rows4(const Unit& u, int R0, int R1, unsigned (&o)[4]) const {
        if (gather) { const int last = cn[u.g] - 1, b0 = u.pm * BM; const int* lp = list + u.g * 16384;
            const int t0 = lp[min(b0 + R0, last)], t1 = lp[min(b0 + R1, last)], t2 = lp[min(b0 + HALF + R0, last)], t3 = lp[min(b0 + HALF + R1, last)];
            o[0] = (unsigned)t0 * (unsigned)(lda * 2); o[1] = (unsigned)t1 * (unsigned)(lda * 2); o[2] = (unsigned)t2 * (unsigned)(lda * 2); o[3] = (unsigned)t3 * (unsigned)(lda * 2); }
        else { o[0] = a_rowoff(u, R0); o[1] = a_rowoff(u, R1); o[2] = a_rowoff(u, HALF + R0); o[3] = a_rowoff(u, HALF + R1); }
    }
    __device__ __forceinline__ const char* b_base(const Unit& u) const { return Bt + (size_t)u.g * bstride + (size_t)u.pn * BM * K * 2; }
};
struct EpiSwiglu {
    static constexpr bool PERM = true;
    bf16_t* O; const float* bias;
    __device__ __forceinline__ void operator()(const f32x4 (&acc)[2][2][4][2], const Unit& u, int wr, int wc, int fr, int fq) const {
        const int row0 = u.row0 + wr * 64 + fr, col0 = u.pn * 128 + wc * 32 + 8 * fq;
        const float* bg = bias + (size_t)u.g * 2048 + col0;
        f32x4 bgl[2], bln[2];
#pragma unroll
        for (int n = 0; n < 2; ++n) { bgl[n] = *(const f32x4*)(bg + 4 * n); bln[n] = *(const f32x4*)(bg + 1024 + 4 * n); }
#pragma unroll
        for (int ai = 0; ai < 2; ++ai)
#pragma unroll
            for (int m = 0; m < 4; ++m) {
                float o[8];
#pragma unroll
                for (int n = 0; n < 2; ++n)
#pragma unroll
                    for (int j = 0; j < 4; ++j) {
                        const float gl = fminf(acc[ai][0][m][n][j] + bgl[n][j], 7.f);
                        const float ln = fminf(fmaxf(acc[ai][1][m][n][j] + bln[n][j], -7.f), 7.f);
                        o[4 * n + j] = gl * __builtin_amdgcn_rcpf(1.f + __expf(-1.702f * gl)) * (ln + 1.f);
                    }
#if MOE_FP8
                u32x2 w8; { int t0 = __builtin_amdgcn_cvt_pk_fp8_f32(o[0], o[1], 0, false); t0 = __builtin_amdgcn_cvt_pk_fp8_f32(o[2], o[3], t0, true); int t1 = __builtin_amdgcn_cvt_pk_fp8_f32(o[4], o[5], 0, false); t1 = __builtin_amdgcn_cvt_pk_fp8_f32(o[6], o[7], t1, true); w8.x = (unsigned)t0; w8.y = (unsigned)t1; }
                *(u32x2*)((unsigned char*)O + (size_t)(row0 + ai * HALF + m * 16) * 1024 + col0) = w8;
#else
                u32x4 w; w.x = cvt_pk_bf16(o[0], o[1]); w.y = cvt_pk_bf16(o[2], o[3]); w.z = cvt_pk_bf16(o[4], o[5]); w.w = cvt_pk_bf16(o[6], o[7]);
                *(u32x4*)(O + (size_t)(row0 + ai * HALF + m * 16) * 1024 + col0) = w;
#endif
            }
    }
};
struct EpiDown {
    static constexpr bool PERM = true;
    bf16_t* O; const float* bias; const float* rgate; const PG8_LAS int* ro;
    __device__ __forceinline__ void operator()(const f32x4 (&acc)[2][2][4][2], const Unit& u, int wr, int wc, int fr, int fq) const {
        const int row0 = u.row0 + wr * 64 + fr, col0 = u.pn * BM + wc * 32 + 8 * fq;
        const float* bd = bias + (size_t)u.g * 1024 + col0;
        const float* gt = rgate + (size_t)u.g * 16384 + (row0 - ro[u.g]);
        f32x4 bv[2][2];
#pragma unroll
        for (int bj = 0; bj < 2; ++bj)
#pragma unroll
            for (int n = 0; n < 2; ++n) bv[bj][n] = *(const f32x4*)(bd + bj * HALF + 4 * n);
#pragma unroll
        for (int ai = 0; ai < 2; ++ai)
#pragma unroll
            for (int m = 0; m < 4; ++m) {
                const float gv = gt[ai * HALF + m * 16];
                bf16_t* rowp = O + (size_t)(row0 + ai * HALF + m * 16) * 1024 + col0;
#pragma unroll
                for (int bj = 0; bj < 2; ++bj) { const f32x4 v0 = (acc[ai][bj][m][0] + bv[bj][0]) * gv, v1 = (acc[ai][bj][m][1] + bv[bj][1]) * gv;
                    u32x4 w; w.x = cvt_pk_bf16(v0[0], v0[1]); w.y = cvt_pk_bf16(v0[2], v0[3]); w.z = cvt_pk_bf16(v1[0], v1[1]); w.w = cvt_pk_bf16(v1[2], v1[3]);
                    *(u32x4*)(rowp + bj * HALF) = w; }
            }
    }
};
struct EpiInproj {
    static constexpr bool PERM = true;
    bf16_t* P; float* gates; float* stat; bf16_t* Kb; const float* cs; const float* sn;
    __device__ __forceinline__ void operator()(const f32x4 (&acc)[2][2][4][2], const Unit& u, int wr, int wc, int fr, int fq) const {
        const int row0 = u.row0 + wr * 64 + fr, colb = u.pn * BM + wc * 32 + 8 * fq;
#pragma unroll
        for (int ai = 0; ai < 2; ++ai)
#pragma unroll
            for (int m = 0; m < 4; ++m) { const int row = row0 + ai * HALF + m * 16;
#pragma unroll
                for (int bj = 0; bj < 2; ++bj) { const f32x4 v0 = acc[ai][bj][m][0], v1 = acc[ai][bj][m][1];
                    u32x4 w; w.x = cvt_pk_bf16(v0[0], v0[1]); w.y = cvt_pk_bf16(v0[2], v0[3]); w.z = cvt_pk_bf16(v1[0], v1[1]); w.w = cvt_pk_bf16(v1[2], v1[3]);
                    *(u32x4*)(P + (size_t)row * 2304 + colb + bj * HALF) = w;
                    if (u.pn <= 2) { float sq = (v0[0] * v0[0] + v0[1] * v0[1]) + (v0[2] * v0[2] + v0[3] * v0[3]) + (v1[0] * v1[0] + v1[1] * v1[1]) + (v1[2] * v1[2] + v1[3] * v1[3]);
                        sq += __shfl_xor(sq, 16); sq += __shfl_xor(sq, 32);
                        if (fq == 0) stat[(size_t)row * 24 + (u.pn * 2 + bj) * 4 + wc] = sq; }
                    if (u.pn == 8 && bj == 1 && wc == 1 && fq < 2) { *(f32x4*)(gates + (size_t)row * 16 + fq * 8) = v0; *(f32x4*)(gates + (size_t)row * 16 + fq * 8 + 4) = v1; }
                    if (u.pn == 2 && bj == 1 && wc == 0) {
                        f32x4 r0 = v0, r1 = v1;
                        f32x4 o0, o1;
#pragma unroll
                        for (int j = 0; j < 4; ++j) { o0[j] = __shfl_xor(v0[j], 32); o1[j] = __shfl_xor(v1[j], 32); }
                        int krow;
                        if (row < 16384) { const int pos = row & 4095; const int jb = 8 * (fq & 1);
                            const f32x4 c0 = *(const f32x4*)(cs + pos * 16 + jb), c1 = *(const f32x4*)(cs + pos * 16 + jb + 4), s0 = *(const f32x4*)(sn + pos * 16 + jb), s1 = *(const f32x4*)(sn + pos * 16 + jb + 4);
                            if (fq < 2) { r0 = v0 * c0 - o0 * s0; r1 = v1 * c1 - o1 * s1; } else { r0 = o0 * s0 + v0 * c0; r1 = o1 * s1 + v1 * c1; }
                            krow = (row >> 12) * 4352 + 256 + pos; }
                        else krow = ((row - 16384) >> 8) * 4352 + ((row - 16384) & 255);
                        u32x4 kw; kw.x = cvt_pk_bf16(r0[0], r0[1]); kw.y = cvt_pk_bf16(r0[2], r0[3]); kw.z = cvt_pk_bf16(r1[0], r1[1]); kw.w = cvt_pk_bf16(r1[2], r1[3]);
#pragma unroll
                        for (int hh = 0; hh < 8; ++hh) *(u32x4*)(Kb + (size_t)krow * 768 + hh * 96 + 64 + 8 * fq) = kw;
                    }
                } }
    }
};
struct EpiF32RowScale {
    static constexpr bool PERM = false;
    float* C; int ldc; const float* rs;
    __device__ __forceinline__ void operator()(const f32x4 (&acc)[2][2][4][2], const Unit& u, int wr, int wc, int fr, int fq) const {
        const int row0 = u.row0 + wr * 64 + fr, col0 = u.pn * BM + wc * 32 + 4 * fq;
#pragma unroll
        for (int ai = 0; ai < 2; ++ai)
#pragma unroll
            for (int m = 0; m < 4; ++m) { const int row = row0 + ai * HALF + m * 16; const float sc = rs[row]; float* rowp = C + (size_t)row * ldc + col0;
#pragma unroll
                for (int bj = 0; bj < 2; ++bj)
#pragma unroll
                    for (int n = 0; n < 2; ++n) *(f32x4*)(rowp + bj * HALF + n * 16) = acc[ai][bj][m][n] * sc; }
    }
};
struct EpiResid {
    static constexpr bool PERM = true;
    bf16_t* C; const float* X; const float* mod; float* stat2;
    __device__ __forceinline__ void operator()(const f32x4 (&acc)[2][2][4][2], const Unit& u, int wr, int wc, int fr, int fq) const {
        const int row0 = u.row0 + wr * 64 + fr, col0 = u.pn * BM + wc * 32 + 8 * fq;
        const float* g1 = mod + (size_t)(u.row0 / 4096) * 6144 + 2048 + col0;
        f32x4 gv[2][2];
#pragma unroll
        for (int bj = 0; bj < 2; ++bj)
#pragma unroll
            for (int n = 0; n < 2; ++n) gv[bj][n] = *(const f32x4*)(g1 + bj * HALF + 4 * n);
#pragma unroll
        for (int ai = 0; ai < 2; ++ai)
#pragma unroll
            for (int m = 0; m < 4; ++m) { const size_t off = (size_t)(row0 + ai * HALF + m * 16) * 1024 + col0;
#pragma unroll
                for (int bj = 0; bj < 2; ++bj) {
                    const f32x4 x0 = *(const f32x4*)(X + off + bj * HALF), x1 = *(const f32x4*)(X + off + bj * HALF + 4);
                    const f32x4 o0 = x0 + gv[bj][0] * acc[ai][bj][m][0], o1 = x1 + gv[bj][1] * acc[ai][bj][m][1];
                    u32x4 w; w.x = cvt_pk_bf16(o0[0], o0[1]); w.y = cvt_pk_bf16(o0[2], o0[3]); w.z = cvt_pk_bf16(o1[0], o1[1]); w.w = cvt_pk_bf16(o1[2], o1[3]);
                    *(u32x4*)(C + off + bj * HALF) = w;
                    float sq = ((o0[0] * o0[0] + o0[1] * o0[1]) + (o0[2] * o0[2] + o0[3] * o0[3])) + ((o1[0] * o1[0] + o1[1] * o1[1]) + (o1[2] * o1[2] + o1[3] * o1[3]));
                    sq += __shfl_xor(sq, 16); sq += __shfl_xor(sq, 32);
                    if (fq == 0) stat2[(size_t)(row0 + ai * HALF + m * 16) * 32 + (u.pn * 2 + bj) * 4 + wc] = sq; }
                asm volatile("" ::: "memory"); }
    }
};
struct EpiQ {
    static constexpr bool PERM = false;
    bf16_t* Q; const float* stat; const float* cs; const float* sn;
    __device__ __forceinline__ void operator()(const f32x4 (&acc)[2][2][4][2], const Unit& u, int wr, int wc, int fr, int fq) const {
        const int row0 = u.row0 + wr * 64 + fr;
#pragma unroll
        for (int ai = 0; ai < 2; ++ai)
#pragma unroll
            for (int m = 0; m < 4; ++m) { const int row = row0 + ai * HALF + m * 16; const int pos = row & 4095;
                float sc; { const f32x4* sp = (const f32x4*)(stat + (size_t)row * 24); const f32x4 a0 = sp[0], a1 = sp[1], a2 = sp[2];
                    sc = rsqrtf((((a0[0] + a0[1]) + (a0[2] + a0[3])) + ((a1[0] + a1[1]) + (a1[2] + a1[3])) + ((a2[0] + a2[1]) + (a2[2] + a2[3]))) * (1.f / 384.f) + 1e-6f); }
                const f32x4 cv = *(const f32x4*)(cs + pos * 16 + 4 * fq), sv = *(const f32x4*)(sn + pos * 16 + 4 * fq);
#pragma unroll
                for (int bj = 0; bj < 2; ++bj) { const int c32 = u.pn * BM + bj * HALF + wc * 32; const bool rope = ((c32 % 96) == 64);
                    f32x4 v0 = acc[ai][bj][m][0], v1 = acc[ai][bj][m][1];
                    if (rope) { const f32x4 a = v0 * cv - v1 * sv, b = v0 * sv + v1 * cv; v0 = a; v1 = b; }
                    v0 = v0 * sc; v1 = v1 * sc;
                    u32x2 w0, w1; w0.x = cvt_pk_bf16(v0[0], v0[1]); w0.y = cvt_pk_bf16(v0[2], v0[3]); w1.x = cvt_pk_bf16(v1[0], v1[1]); w1.y = cvt_pk_bf16(v1[2], v1[3]);
                    bf16_t* dst = Q + (size_t)row * 768 + c32 + 4 * fq;
                    *(u32x2*)dst = w0; *(u32x2*)(dst + 16) = w1; }
                asm volatile("" ::: "memory"); }
    }
};
struct EpiKV {
    static constexpr bool PERM = true;
    bf16_t* K; bf16_t* V; const float* stat;
    __device__ __forceinline__ void operator()(const f32x4 (&acc)[2][2][4][2], const Unit& u, int wr, int wc, int fr, int fq) const {
        const int row0 = u.row0 + wr * 64 + fr;
#pragma unroll
        for (int ai = 0; ai < 2; ++ai)
#pragma unroll
            for (int m = 0; m < 4; ++m) { const int row = row0 + ai * HALF + m * 16;
                float sc; { const f32x4* sp = (const f32x4*)(stat + (size_t)row * 24); const f32x4 a3 = sp[3], a4 = sp[4];
                    sc = rsqrtf((((a3[0] + a3[1]) + (a3[2] + a3[3])) + ((a4[0] + a4[1]) + (a4[2] + a4[3]))) * (1.f / 256.f) + 1e-6f); }
                const int krow = (row < 16384) ? ((row >> 12) * 4352 + 256 + (row & 4095)) : (((row - 16384) >> 8) * 4352 + ((row - 16384) & 255));
#pragma unroll
                for (int bj = 0; bj < 2; ++bj) { const int head = 2 * u.pn + bj; const f32x4 v0 = acc[ai][bj][m][0] * sc, v1 = acc[ai][bj][m][1] * sc;
                    u32x4 w; w.x = cvt_pk_bf16(v0[0], v0[1]); w.y = cvt_pk_bf16(v0[2], v0[3]); w.z = cvt_pk_bf16(v1[0], v1[1]); w.w = cvt_pk_bf16(v1[2], v1[3]);
                    if (wc < 2) *(u32x4*)(K + (size_t)krow * 768 + head * 96 + wc * 32 + 8 * fq) = w;
                    else *(u32x4*)(V + (size_t)krow * 512 + head * 64 + (wc - 2) * 32 + 8 * fq) = w; }
                asm volatile("" ::: "memory"); }
    }
};
}

template <class RowMap>
__device__ __forceinline__ void transpose_item(const float* W, int K, int N, int nblk, unsigned short* WT, const RowMap& rowmap, LAS float* scr, int item, int lane, const float* kscale = nullptr) {
    const int kb = item / nblk, nb = item % nblk, k0 = 64 * kb, n0 = 32 * nb;
    const int ncol = n0 + (lane & 31);
    float tv[32];
#pragma unroll
    for (int i = 0; i < 32; ++i) { const int kk = 2 * i + (lane >> 5); tv[i] = (ncol < N) ? __builtin_nontemporal_load(W + (size_t)(k0 + kk) * N + ncol) : 0.f; }
    if (kscale) {
#pragma unroll
        for (int i = 0; i < 32; ++i) tv[i] *= kscale[k0 + 2 * i + (lane >> 5)]; }
#pragma unroll
    for (int i = 0; i < 32; ++i) scr[(2 * i + (lane >> 5)) * 33 + (lane & 31)] = tv[i];
    asm volatile("s_waitcnt lgkmcnt(0)" ::: "memory");
    const int c = lane & 7;
    const int r0 = rowmap(n0);
#pragma unroll
    for (int j = 0; j < 4; ++j) { const int n = (lane >> 3) + 8 * j; const LAS float* sp = scr + (8 * c) * 33 + n;
        pg8::u32x4 o; o.x = pg8::cvt_pk_bf16(sp[0 * 33], sp[1 * 33]); o.y = pg8::cvt_pk_bf16(sp[2 * 33], sp[3 * 33]); o.z = pg8::cvt_pk_bf16(sp[4 * 33], sp[5 * 33]); o.w = pg8::cvt_pk_bf16(sp[6 * 33], sp[7 * 33]);
        __builtin_nontemporal_store(o, (pg8::u32x4*)(WT + (size_t)(r0 + n) * K + k0 + 8 * c)); }
    asm volatile("s_waitcnt lgkmcnt(0)" ::: "memory");
}


namespace att {
using bf16x8 = __attribute__((ext_vector_type(8))) short;
using s16x4  = __attribute__((ext_vector_type(4))) short;
using f32x16 = __attribute__((ext_vector_type(16))) float;
using u32x4  = __attribute__((ext_vector_type(4))) unsigned;
constexpr int NW = 8, QBLK = 32, KVBLK = 64;
constexpr float SCALE = 0.10206207261596577f;
constexpr float THR = 8.f;
constexpr int LDQ = 768, LDK = 768, LDV = 512, LDO = 1024;
constexpr int SHM_V = KVBLK * 64 * 2, SHM_K = KVBLK * 256;
constexpr int SHM_ATTN = 2 * SHM_V + 2 * SHM_K + NW * 64 * 4;
#define KSWZ(row, colB) ((row) * 256 + ((colB) ^ (((row) & 7) << 4)))
#define SBAR() __builtin_amdgcn_sched_barrier(0)
__device__ __forceinline__ int crow(int r, int hi) { return (r & 3) + 8 * (r >> 2) + 4 * hi; }
__device__ __forceinline__ unsigned cvtpk(float lo, float hi) { unsigned r; asm volatile("v_cvt_pk_bf16_f32 %0, %1, %2" : "=v"(r) : "v"(lo), "v"(hi)); return r; }

__device__ __forceinline__ void partialSM(f32x16& p0, f32x16& p1, float& m_reg, float& mn, float& alpha) {
  constexpr float C = SCALE * 1.4426950408889634f;
  float pmax = p0[0]; for (int r = 1; r < 16; ++r) pmax = fmaxf(pmax, p0[r]); for (int r = 0; r < 16; ++r) pmax = fmaxf(pmax, p1[r]);
  { auto rr = __builtin_amdgcn_permlane32_swap(__float_as_uint(pmax), __float_as_uint(pmax), false, false);
    pmax = fmaxf(__uint_as_float(rr[0]), __uint_as_float(rr[1])); }
  if (__builtin_expect(__all(pmax - m_reg <= THR / SCALE), 1)) { mn = m_reg; alpha = 1.f; }
  else { mn = fmaxf(m_reg, pmax); alpha = __builtin_amdgcn_exp2f((m_reg - mn) * C); m_reg = mn; }
  float mnC = -mn * C;
  for (int r = 0; r < 16; ++r) p0[r] = fmaf(p0[r], C, mnC); for (int r = 0; r < 16; ++r) p1[r] = fmaf(p1[r], C, mnC);
  for (int r = 0; r < 16; ++r) p0[r] = __builtin_amdgcn_exp2f(p0[r]);
}
__device__ __forceinline__ void finishSM(f32x16& p0, f32x16& p1, float alpha, float& l_reg, bf16x8& pa0, bf16x8& pa1, bf16x8& pa2, bf16x8& pa3) {
  for (int r = 0; r < 16; ++r) p1[r] = __builtin_amdgcn_exp2f(p1[r]);
  float ps = 0; for (int r = 0; r < 16; ++r) ps += p0[r]; for (int r = 0; r < 16; ++r) ps += p1[r];
  { auto rr = __builtin_amdgcn_permlane32_swap(__float_as_uint(ps), __float_as_uint(ps), false, false);
    ps = __uint_as_float(rr[0]) + __uint_as_float(rr[1]); }
  l_reg = l_reg * alpha + ps;
#define PK4(P, BASE, OUT) do { unsigned a0 = cvtpk(P[BASE + 0], P[BASE + 1]), a1 = cvtpk(P[BASE + 2], P[BASE + 3]);   \
    unsigned b0 = cvtpk(P[BASE + 4], P[BASE + 5]), b1 = cvtpk(P[BASE + 6], P[BASE + 7]);                              \
    auto r0 = __builtin_amdgcn_permlane32_swap(a0, b0, false, false); auto r1 = __builtin_amdgcn_permlane32_swap(a1, b1, false, false); \
    u32x4 w = {r0[0], r1[0], r0[1], r1[1]}; OUT = *reinterpret_cast<bf16x8*>(&w); } while (0)
  PK4(p0, 0, pa0); PK4(p0, 8, pa1); PK4(p1, 0, pa2); PK4(p1, 8, pa3);
#undef PK4
}
__device__ __forceinline__ void qkt(f32x16& p0, f32x16& p1, const char* Ks, const bf16x8* qr, int r32, int hi) {
  p0 = f32x16{}; p1 = f32x16{};
#pragma unroll
  for (int d0 = 0; d0 < 6; ++d0) { int cb = (d0 * 16 + hi * 8) * 2;
    bf16x8 b0 = *reinterpret_cast<const bf16x8*>(Ks + KSWZ(r32, cb));
    bf16x8 b1 = *reinterpret_cast<const bf16x8*>(Ks + KSWZ(32 + r32, cb));
    p0 = __builtin_amdgcn_mfma_f32_32x32x16_bf16(b0, qr[d0], p0, 0, 0, 0);
    p1 = __builtin_amdgcn_mfma_f32_32x32x16_bf16(b1, qr[d0], p1, 0, 0, 0); }
}
__device__ __forceinline__ int v_st(int k, int c) { const int kk = (k & ~0xC) | ((k & 4) << 1) | ((k & 8) >> 1); return ((kk >> 3) * 2 + (c >> 5)) * 512 + ((kk & 7) * 32 + (c & 31)) * 2; }
__device__ __forceinline__ int v_rd_base(int lane) { return ((lane & 3) << 3) | (((lane >> 2) & 3) << 6) | (((lane >> 4) & 1) << 5) | (((lane >> 5) & 1) << 8); }
constexpr int v_rd_off(int d0, int ks, int half) { return d0 * 512 + ks * 2048 + half * 1024; }
template <int OFF> __device__ __forceinline__ s16x4 tr_read(int vb) {
  s16x4 r; asm volatile("ds_read_b64_tr_b16 %0, %1 offset:%2" : "=&v"(r) : "v"(vb), "i"(OFF) : "memory"); return r;
}
template <int D0> __device__ __forceinline__ void pv_one(f32x16& od, int vb, bf16x8 pa0, bf16x8 pa1, bf16x8 pa2, bf16x8 pa3) {
  const s16x4 l0 = tr_read<v_rd_off(D0, 0, 0)>(vb), h0 = tr_read<v_rd_off(D0, 0, 1)>(vb), l1 = tr_read<v_rd_off(D0, 1, 0)>(vb), h1 = tr_read<v_rd_off(D0, 1, 1)>(vb);
  const s16x4 l2 = tr_read<v_rd_off(D0, 2, 0)>(vb), h2 = tr_read<v_rd_off(D0, 2, 1)>(vb), l3 = tr_read<v_rd_off(D0, 3, 0)>(vb), h3 = tr_read<v_rd_off(D0, 3, 1)>(vb);
  asm volatile("s_waitcnt lgkmcnt(0)" ::: "memory"); SBAR();
#define PK(L, H) (bf16x8){L[0], L[1], L[2], L[3], H[0], H[1], H[2], H[3]}
  od = __builtin_amdgcn_mfma_f32_32x32x16_bf16(pa0, PK(l0, h0), od, 0, 0, 0);
  od = __builtin_amdgcn_mfma_f32_32x32x16_bf16(pa1, PK(l1, h1), od, 0, 0, 0);
  od = __builtin_amdgcn_mfma_f32_32x32x16_bf16(pa2, PK(l2, h2), od, 0, 0, 0);
  od = __builtin_amdgcn_mfma_f32_32x32x16_bf16(pa3, PK(l3, h3), od, 0, 0, 0);
#undef PK
}
__device__ __forceinline__ void pv_d0(f32x16* o, int vb, bf16x8 pa0, bf16x8 pa1, bf16x8 pa2, bf16x8 pa3) {
  pv_one<0>(o[0], vb, pa0, pa1, pa2, pa3); pv_one<1>(o[1], vb, pa0, pa1, pa2, pa3);
}
__device__ __forceinline__ void attn_body(const unsigned short* __restrict__ Qb, const unsigned short* __restrict__ Kh, const unsigned short* __restrict__ Vh,
                                          unsigned short* __restrict__ Ob, int seq, char* lds) {
  const int tid = threadIdx.x, wid = tid >> 6, lane = tid & 63, r32 = lane & 31, hi = lane >> 5;
  char* V_lds = lds; char* K_lds = lds + 2 * SHM_V;
  float* ws = (float*)(lds + 2 * SHM_V + 2 * SHM_K) + wid * 64; float* li_l = ws; float* al_l = ws + 32;
  float m_reg = -1e30f, l_reg = 0; f32x16 o[2] = {}; bf16x8 qr[6];
  const unsigned short* Qw = Qb + (long)(wid * QBLK + r32) * LDQ + hi * 8;
#pragma unroll
  for (int d0 = 0; d0 < 6; ++d0) qr[d0] = *reinterpret_cast<const bf16x8*>(Qw + d0 * 16);
  const int vr = tid >> 3, vc = (tid & 7) * 8, vst = v_st(vr, vc);
  const int k0r = tid / 12, k0c = tid % 12, id1 = 512 + (tid & 255), k1r = id1 / 12, k1c = id1 % 12;
  const int kst0 = KSWZ(k0r, k0c * 16), kst1 = KSWZ(k1r, k1c * 16);
  const long vg = (long)vr * LDV + vc, kg0 = (long)k0r * LDK + k0c * 8, kg1 = (long)k1r * LDK + k1c * 8;
  const int vb0 = (int)(uintptr_t)V_lds + v_rd_base(lane);
  struct { bf16x8 vs, ks0, ks1; } sr_[2];
#define SLOAD(i, kk0) do { sr_[i].vs = *reinterpret_cast<const bf16x8*>(Vh + (long)(kk0) * LDV + vg); \
    sr_[i].ks0 = *reinterpret_cast<const bf16x8*>(Kh + (long)(kk0) * LDK + kg0); sr_[i].ks1 = *reinterpret_cast<const bf16x8*>(Kh + (long)(kk0) * LDK + kg1); } while (0)
#define SWRITE(b, i) do { *(bf16x8*)(V_lds + (b) * SHM_V + vst) = sr_[i].vs; \
    *(bf16x8*)(K_lds + (b) * SHM_K + kst0) = sr_[i].ks0; *(bf16x8*)(K_lds + (b) * SHM_K + kst1) = sr_[i].ks1; } while (0)
#define SWAIT() asm volatile("s_waitcnt vmcnt(3)" ::: "memory")
#define RESC(a) do { if (__any((a) < 1.f)) { if (hi == 0) al_l[r32] = (a); asm volatile("s_waitcnt lgkmcnt(0)" ::: "memory"); \
    for (int d = 0; d < 2; ++d) for (int r = 0; r < 16; ++r) o[d][r] *= al_l[crow(r, hi)]; } } while (0)
  f32x16 pA0, pA1, pB0, pB1; float mnA, mnB, alA, alB; bf16x8 pa0, pa1, pa2, pa3; const int NT = seq / KVBLK;
  constexpr int SE = 0, SO = 1;
  SLOAD(SE, 0); asm volatile("s_waitcnt vmcnt(0)" ::: "memory"); SWRITE(0, SE); __syncthreads();
  qkt(pA0, pA1, K_lds, qr, r32, hi); partialSM(pA0, pA1, m_reg, mnA, alA);
  SLOAD(SO, KVBLK); if (2 < NT) SLOAD(SE, 2 * KVBLK);
  SWAIT(); SWRITE(1, SO); __syncthreads();
  for (int j = 1; j + 1 < NT; j += 2) {
    SBAR(); qkt(pB0, pB1, K_lds + SHM_K, qr, r32, hi);
    finishSM(pA0, pA1, alA, l_reg, pa0, pa1, pa2, pa3); SBAR();
    SLOAD(SO, (j + 2) * KVBLK); SBAR();
    pv_d0(o, vb0, pa0, pa1, pa2, pa3); partialSM(pB0, pB1, m_reg, mnB, alB);
    __syncthreads(); SWAIT(); SWRITE(0, SE);
    RESC(alB); __syncthreads();
    SBAR(); qkt(pA0, pA1, K_lds, qr, r32, hi);
    finishSM(pB0, pB1, alB, l_reg, pa0, pa1, pa2, pa3); SBAR();
    if (j + 3 < NT) SLOAD(SE, (j + 3) * KVBLK); SBAR();
    pv_d0(o, vb0 + SHM_V, pa0, pa1, pa2, pa3); partialSM(pA0, pA1, m_reg, mnA, alA);
    __syncthreads(); SWAIT(); SWRITE(1, SO);
    RESC(alA); __syncthreads();
  }
  SBAR(); qkt(pB0, pB1, K_lds + SHM_K, qr, r32, hi);
  finishSM(pA0, pA1, alA, l_reg, pa0, pa1, pa2, pa3); SBAR();
  pv_d0(o, vb0, pa0, pa1, pa2, pa3); partialSM(pB0, pB1, m_reg, mnB, alB);
  __syncthreads(); RESC(alB);
  finishSM(pB0, pB1, alB, l_reg, pa0, pa1, pa2, pa3); SBAR();
  pv_d0(o, vb0 + SHM_V, pa0, pa1, pa2, pa3);
  if (hi == 0) li_l[r32] = l_reg; asm volatile("s_waitcnt lgkmcnt(0)" ::: "memory");
  float rli[16];
#pragma unroll
  for (int r = 0; r < 16; ++r) rli[r] = __builtin_amdgcn_rcpf(li_l[crow(r, hi)]);
  unsigned short* Ow = Ob + (long)(wid * QBLK) * LDO;
#pragma unroll
  for (int r = 0; r < 16; ++r) { int orow = crow(r, hi);
#pragma unroll
    for (int d0 = 0; d0 < 2; ++d0) Ow[(long)orow * LDO + d0 * 32 + r32] = (unsigned short)(cvtpk(o[d0][r] * rli[r], 0.f) & 0xffffu); }
  __syncthreads();
#undef SLOAD
#undef SWRITE
#undef SWAIT
#undef RESC
}
#undef KSWZ
#undef SBAR
}


namespace ml {
using bf16x8 = __attribute__((ext_vector_type(8))) short;
using s16x4  = __attribute__((ext_vector_type(4))) short;
using f32x16 = __attribute__((ext_vector_type(16))) float;
using f32x4  = __attribute__((ext_vector_type(4))) float;
using u32x4  = __attribute__((ext_vector_type(4))) unsigned;
constexpr float L2E = 1.4426950408889634f;
constexpr int NXC = 34;
__device__ __forceinline__ int crow(int r, int hi) { return (r & 3) + 8 * (r >> 2) + 4 * hi; }
__device__ __forceinline__ unsigned cvtpk(float lo, float hi) { unsigned r; asm volatile("v_cvt_pk_bf16_f32 %0, %1, %2" : "=v"(r) : "v"(lo), "v"(hi)); return r; }
template <int NC> __device__ __forceinline__ int t_st(int k, int c) { const int kk = (k & ~0xC) | ((k & 4) << 1) | ((k & 8) >> 1); return ((kk >> 3) * NC + (c >> 5)) * 512 + ((kk & 7) * 32 + (c & 31)) * 2; }
__device__ __forceinline__ int t_rd_base(int lane) { return ((lane & 3) << 3) | (((lane >> 2) & 3) << 6) | (((lane >> 4) & 1) << 5) | (((lane >> 5) & 1) << 8); }
template <int NC> constexpr int t_rd_off(int d0, int ks, int half) { return d0 * 512 + ks * (NC * 1024) + half * (NC * 512); }
template <int OFF> __device__ __forceinline__ s16x4 tr_read(int vb) { s16x4 r; asm volatile("ds_read_b64_tr_b16 %0, %1 offset:%2" : "=&v"(r) : "v"(vb), "i"(OFF) : "memory"); return r; }
#define ML_PK(L, H) (bf16x8){L[0], L[1], L[2], L[3], H[0], H[1], H[2], H[3]}
#define ML_KS(row, colB) ((row) * 128 + ((colB) ^ (((row) & 7) << 4)))
__device__ __forceinline__ int chunk_row(int b, int X, int i) { return X < 2 ? (16384 + b * 256 + X * 128 + i) : (b * 4096 + (X - 2) * 128 + i); }
__device__ __forceinline__ float lsig(float x) { return fminf(x, 0.f) - __logf(1.f + __expf(-fabsf(x))); }

__device__ __forceinline__ void gate_prep(const float* GATES, const float* bg, int b, int h, int X, LAS float* cum, LAS float* av, LAS float* pm, LAS float* wsr, LAS float* tot, int wave, int lane) {
    if (wave < 2) {
        const int dir = wave;
        const int e0 = dir ? (127 - 2 * lane) : (2 * lane), e1 = dir ? (126 - 2 * lane) : (2 * lane + 1);
        const int r0 = chunk_row(b, X, e0), r1 = chunk_row(b, X, e1);
        const float bi = bg[(2 * dir) * 4 + h], bf = bg[(2 * dir + 1) * 4 + h];
        const float li0 = GATES[(size_t)r0 * 16 + (2 * dir) * 4 + h] + bi, li1 = GATES[(size_t)r1 * 16 + (2 * dir) * 4 + h] + bi;
        const float x0 = lsig(GATES[(size_t)r0 * 16 + (2 * dir + 1) * 4 + h] + bf), x1 = lsig(GATES[(size_t)r1 * 16 + (2 * dir + 1) * 4 + h] + bf);
        float sc = x0 + x1;
#pragma unroll
        for (int o = 1; o < 64; o <<= 1) { const float y = __shfl_up(sc, o); if (lane >= o) sc += y; }
        const float c1 = sc, c0 = sc - x1; const float total = __shfl(sc, 63);
        const float a0 = li0 - c0, a1 = li1 - c1;
        float mx = fmaxf(a0, a1);
#pragma unroll
        for (int o = 1; o < 64; o <<= 1) { const float y = __shfl_up(mx, o); if (lane >= o) mx = fmaxf(mx, y); }
        float prev = __shfl_up(mx, 1); if (lane == 0) prev = -3.0e38f;
        cum[dir * 128 + e0] = c0; cum[dir * 128 + e1] = c1; av[dir * 128 + e0] = a0; av[dir * 128 + e1] = a1;
        pm[dir * 128 + e0] = fmaxf(prev, a0); pm[dir * 128 + e1] = mx;
        wsr[dir * 128 + e0] = total - c0 + li0; wsr[dir * 128 + e1] = total - c1 + li1;
        if (lane == 0) tot[dir] = total;
    }
}

__device__ __forceinline__ void stepA_unit(const unsigned short* P16, const float* GATES, const float* bg, int bh, int X, float* CLOC, float* NLOC, float* MLOC, float* TOT, char* lds) {
    const int tid = threadIdx.x, wave = __builtin_amdgcn_readfirstlane(tid >> 6), lane = tid & 63, r32 = lane & 31, hi = lane >> 5;
    const int b = bh >> 2, h = bh & 3;
    LAS float* fa = (LAS float*)(lds + 65536);
    LAS float* cum = fa, *av = fa + 256, *pm = fa + 512, *wsr = fa + 768, *tot = fa + 1024, *wl = fa + 1040, *npart = fa + 1312;
    bf16x8 stV[4]; u32x4 stK[2];
#pragma unroll
    for (int j = 0; j < 4; ++j) { const int id = tid + 512 * j, row = id >> 4, ch = id & 15; stV[j] = *reinterpret_cast<const bf16x8*>(P16 + (size_t)chunk_row(b, X, row) * 2304 + 1184 + h * 128 + ch * 8); }
#pragma unroll
    for (int j = 0; j < 2; ++j) { const int id = tid + 512 * j, row = id >> 3, ch = id & 7; stK[j] = *reinterpret_cast<const u32x4*>(P16 + (size_t)chunk_row(b, X, row) * 2304 + 928 + h * 64 + ch * 8); }
    gate_prep(GATES, bg, b, h, X, cum, av, pm, wsr, tot, wave, lane);
#pragma unroll
    for (int j = 0; j < 4; ++j) { const int id = tid + 512 * j, row = id >> 4, ch = id & 15; *(bf16x8*)(lds + t_st<4>(row, ch * 8)) = stV[j]; }
    __syncthreads();
    if (wave < 2) {
        const int dir = wave; const float w0 = wsr[dir * 128 + lane], w1 = wsr[dir * 128 + 64 + lane];
        float mx = fmaxf(w0, w1);
#pragma unroll
        for (int o = 1; o < 64; o <<= 1) mx = fmaxf(mx, __shfl_xor(mx, o));
        wl[dir * 128 + lane] = __expf(w0 - mx); wl[dir * 128 + 64 + lane] = __expf(w1 - mx);
        if (lane == 0) { MLOC[(bh * NXC + X) * 2 + dir] = mx; TOT[(bh * NXC + X) * 2 + dir] = tot[dir]; }
    }
    __syncthreads();
#pragma unroll
    for (int j = 0; j < 2; ++j) { const int id = tid + 512 * j, row = id >> 3, ch = id & 7;
        const u32x4 kv = stK[j];
        const float wf = wl[row], wb = wl[128 + row];
        u32x4 of, ob;
#pragma unroll
        for (int q = 0; q < 4; ++q) { const float lo = __uint_as_float(kv[q] << 16), hi2 = __uint_as_float(kv[q] & 0xffff0000u); of[q] = cvtpk(lo * wf, hi2 * wf); ob[q] = cvtpk(lo * wb, hi2 * wb); }
        *(u32x4*)(lds + 32768 + t_st<2>(row, ch * 8)) = of; *(u32x4*)(lds + 49152 + t_st<2>(row, ch * 8)) = ob; }
    __syncthreads();
    {
        const int dir = wave >> 2, mb = wave & 3;
        const int vb = (int)(uintptr_t)lds + t_rd_base(lane) + mb * 512;
        const int kb = (int)(uintptr_t)lds + 32768 + dir * 16384 + t_rd_base(lane);
        f32x16 acc0 = {}, acc1 = {};
#define ML_A_STEP(KS) do { \
        const s16x4 vl = tr_read<t_rd_off<4>(0, KS, 0)>(vb), vh = tr_read<t_rd_off<4>(0, KS, 1)>(vb); \
        const s16x4 k0l = tr_read<t_rd_off<2>(0, KS, 0)>(kb), k0h = tr_read<t_rd_off<2>(0, KS, 1)>(kb), k1l = tr_read<t_rd_off<2>(1, KS, 0)>(kb), k1h = tr_read<t_rd_off<2>(1, KS, 1)>(kb); \
        asm volatile("s_waitcnt lgkmcnt(0)" ::: "memory"); __builtin_amdgcn_sched_barrier(0); \
        acc0 = __builtin_amdgcn_mfma_f32_32x32x16_bf16(ML_PK(vl, vh), ML_PK(k0l, k0h), acc0, 0, 0, 0); \
        acc1 = __builtin_amdgcn_mfma_f32_32x32x16_bf16(ML_PK(vl, vh), ML_PK(k1l, k1h), acc1, 0, 0, 0); } while (0)
        ML_A_STEP(0); ML_A_STEP(1); ML_A_STEP(2); ML_A_STEP(3); ML_A_STEP(4); ML_A_STEP(5); ML_A_STEP(6); ML_A_STEP(7);
#undef ML_A_STEP
        float* dst = CLOC + ((size_t)(bh * NXC + X) * 2 + dir) * 8192;
#pragma unroll
        for (int r = 0; r < 16; ++r) { const int dv = 32 * mb + crow(r, hi); dst[dv * 64 + r32] = acc0[r]; dst[dv * 64 + 32 + r32] = acc1[r]; }
    }
    {
        const int dir = tid >> 8, part = (tid >> 6) & 3, d = tid & 63; float a = 0.f;
        const char* img = lds + 32768 + dir * 16384;
#pragma unroll 8
        for (int i = 0; i < 32; ++i) { const int row = part * 32 + i; a += bf2f(*(const unsigned short*)(img + t_st<2>(row, d))); }
        npart[(dir * 4 + part) * 64 + d] = a;
    }
    __syncthreads();
    if (tid < 128) { const int dir = tid >> 6, d = tid & 63; NLOC[((size_t)(bh * NXC + X) * 2 + dir) * 64 + d] = (npart[(dir * 4 + 0) * 64 + d] + npart[(dir * 4 + 1) * 64 + d]) + (npart[(dir * 4 + 2) * 64 + d] + npart[(dir * 4 + 3) * 64 + d]); }
    __syncthreads();
}

__device__ __forceinline__ int scanX(int dir, int j) { return dir ? (j == 0 ? 1 : (j == 1 ? 0 : 35 - j)) : j; }
__device__ __forceinline__ void stepB(const float* CLOC, const float* NLOC, const float* MLOC, const float* TOT, unsigned* CIN, float* NIN, float* MIN, int gtid, int gthreads) {
    for (int it = gtid; it < 32 * 4096 + 32 * 64; it += gthreads) {
        const bool isn = it >= 32 * 4096;
        const int sq = isn ? (it - 32 * 4096) >> 6 : it >> 12, e = isn ? (it - 32 * 4096) & 63 : it & 4095;
        const int bh = sq >> 1, dir = sq & 1;
        float2 v[NXC]; float tt[NXC], mm[NXC];
#pragma unroll
        for (int j = 0; j < NXC; ++j) { const int X = scanX(dir, j); const size_t li = (size_t)(bh * NXC + X) * 2 + dir;
            tt[j] = TOT[li]; mm[j] = MLOC[li];
            if (isn) { v[j].x = NLOC[li * 64 + e]; v[j].y = 0.f; } else v[j] = *(const float2*)(CLOC + li * 8192 + 2 * e); }
        float c0 = 0.f, c1 = 0.f, m = 0.f;
#pragma unroll
        for (int j = 0; j < NXC; ++j) {
            const int X = scanX(dir, j);
            if (X >= 2) {
                const size_t ci = (size_t)(bh * 32 + (X - 2)) * 2 + dir;
                if (isn) { NIN[ci * 64 + e] = c0; if (e == 0) MIN[ci] = m; }
                else CIN[ci * 4096 + e] = cvtpk(c0, c1);
            }
            const float mn = fmaxf(tt[j] + m, mm[j]), dec = __expf(tt[j] + m - mn), scl = __expf(mm[j] - mn);
            c0 = dec * c0 + scl * v[j].x; c1 = dec * c1 + scl * v[j].y;
            m = mn;
        }
    }
}

__device__ __forceinline__ void stepC_unit(const unsigned short* P16, const float* GATES, const float* bg, const unsigned short* CIN, const float* NIN, const float* MIN, const float* mng,
                                           unsigned short* MIX16, int bh, int c, char* lds) {
    const int tid = threadIdx.x, wave = __builtin_amdgcn_readfirstlane(tid >> 6), lane = tid & 63, r32 = lane & 31, hi = lane >> 5;
    const int b = bh >> 2, h = bh & 3, X = c + 2;
    LAS float* fa = (LAS float*)(lds + 98304);
    LAS float* cum = fa, *av = fa + 256, *pm = fa + 512, *wsr = fa + 768, *tot = fa + 1024, *scl = fa + 1040;
    LAS float* hs = (LAS float*)lds;
    const int dir = wave >> 2, tb = wave & 3;
    const int t = 32 * tb + r32;
    const size_t ci = (size_t)(bh * 32 + c) * 2 + dir;
    bf16x8 qr[4]; f32x4 nn[8];
    {
        const unsigned short* qp = P16 + (size_t)chunk_row(b, X, t) * 2304 + 672 + h * 64 + hi * 8;
        const float* np = NIN + ci * 64 + hi * 8;
#pragma unroll
        for (int ks = 0; ks < 4; ++ks) { qr[ks] = *reinterpret_cast<const bf16x8*>(qp + ks * 16); nn[2 * ks] = *(const f32x4*)(np + ks * 16); nn[2 * ks + 1] = *(const f32x4*)(np + ks * 16 + 4); }
    }
    const float min2 = MIN[ci] * L2E;
    bf16x8 stK[2], stV[4], stC[4];
#pragma unroll
    for (int j = 0; j < 2; ++j) { const int id = tid + 512 * j, row = id >> 3, ch = id & 7; stK[j] = *reinterpret_cast<const bf16x8*>(P16 + (size_t)chunk_row(b, X, row) * 2304 + 928 + h * 64 + ch * 8); }
#pragma unroll
    for (int j = 0; j < 4; ++j) { const int id = tid + 512 * j, row = id >> 4, ch = id & 15; stV[j] = *reinterpret_cast<const bf16x8*>(P16 + (size_t)chunk_row(b, X, row) * 2304 + 1184 + h * 128 + ch * 8); }
    gate_prep(GATES, bg, b, h, X, cum, av, pm, wsr, tot, wave, lane);
    asm volatile("" ::: "memory");
#pragma unroll
    for (int j = 0; j < 4; ++j) { const int id = tid + 512 * j, dd = id >> 10, row = (id >> 3) & 127, ch = id & 7;
        stC[j] = *reinterpret_cast<const bf16x8*>(CIN + ((size_t)(bh * 32 + c) * 2 + dd) * 8192 + row * 64 + ch * 8); }
#pragma unroll
    for (int j = 0; j < 2; ++j) { const int id = tid + 512 * j, row = id >> 3, ch = id & 7; *(bf16x8*)(lds + ML_KS(row, ch * 16)) = stK[j]; }
#pragma unroll
    for (int j = 0; j < 4; ++j) { const int id = tid + 512 * j, row = id >> 4, ch = id & 15; *(bf16x8*)(lds + 16384 + t_st<4>(row, ch * 8)) = stV[j]; }
#pragma unroll
    for (int j = 0; j < 4; ++j) { const int id = tid + 512 * j, dd = id >> 10, row = (id >> 3) & 127, ch = id & 7; *(bf16x8*)(lds + 65536 + dd * 16384 + ML_KS(row, ch * 16)) = stC[j]; }
    __syncthreads();
    const float el2 = fmaxf(min2, pm[dir * 128 + t] * L2E);
    const float wint = __builtin_amdgcn_exp2f(min2 - el2);
    float ndot = 0.f;
#pragma unroll
    for (int ks = 0; ks < 4; ++ks) { const u32x4 q4 = *reinterpret_cast<const u32x4*>(&qr[ks]); const f32x4 n0 = nn[2 * ks], n1 = nn[2 * ks + 1];
#pragma unroll
        for (int q = 0; q < 4; ++q) { const float lo = __uint_as_float(q4[q] << 16), hi2 = __uint_as_float(q4[q] & 0xffff0000u);
            const float nl = (q < 2) ? n0[2 * q] : n1[2 * q - 4], nh = (q < 2) ? n0[2 * q + 1] : n1[2 * q - 3];
            ndot = fmaf(lo, nl, ndot); ndot = fmaf(hi2, nh, ndot); } }
    f32x16 o[4] = {}; float den = 0.f;
    const int vb = (int)(uintptr_t)lds + 16384 + t_rd_base(lane);
    const char* Kl = lds;
#define ML_C_BLOCK(SB) do { if (dir ? (SB >= tb) : (SB <= tb)) { \
        f32x16 p = {}; \
        _Pragma("unroll") for (int ks = 0; ks < 4; ++ks) { const bf16x8 kf = *reinterpret_cast<const bf16x8*>(Kl + ML_KS(32 * SB + r32, (ks * 16 + hi * 8) * 2)); p = __builtin_amdgcn_mfma_f32_32x32x16_bf16(kf, qr[ks], p, 0, 0, 0); } \
        _Pragma("unroll") for (int g = 0; g < 4; ++g) { const f32x4 a4 = *(const LAS f32x4*)(av + dir * 128 + 32 * SB + 8 * g + 4 * hi); \
            _Pragma("unroll") for (int i = 0; i < 4; ++i) { const int sidx = 32 * SB + 8 * g + 4 * hi + i; const bool ok = dir ? (sidx >= t) : (sidx <= t); \
                const float f = __builtin_amdgcn_exp2f(a4[i] * L2E - el2) * 0.125f; p[4 * g + i] = ok ? p[4 * g + i] * f : 0.f; den += p[4 * g + i]; } } \
        bf16x8 pa0, pa1; \
        { unsigned a0 = cvtpk(p[0], p[1]), a1 = cvtpk(p[2], p[3]), b0 = cvtpk(p[4], p[5]), b1 = cvtpk(p[6], p[7]); \
          auto r0 = __builtin_amdgcn_permlane32_swap(a0, b0, false, false); auto r1 = __builtin_amdgcn_permlane32_swap(a1, b1, false, false); u32x4 w = {r0[0], r1[0], r0[1], r1[1]}; pa0 = *reinterpret_cast<bf16x8*>(&w); } \
        { unsigned a0 = cvtpk(p[8], p[9]), a1 = cvtpk(p[10], p[11]), b0 = cvtpk(p[12], p[13]), b1 = cvtpk(p[14], p[15]); \
          auto r0 = __builtin_amdgcn_permlane32_swap(a0, b0, false, false); auto r1 = __builtin_amdgcn_permlane32_swap(a1, b1, false, false); u32x4 w = {r0[0], r1[0], r0[1], r1[1]}; pa1 = *reinterpret_cast<bf16x8*>(&w); } \
        ML_C_PV(0, SB, pa0, pa1); ML_C_PV(1, SB, pa0, pa1); ML_C_PV(2, SB, pa0, pa1); ML_C_PV(3, SB, pa0, pa1); } } while (0)
#define ML_C_PV(D0, SB, PA0, PA1) do { \
        const s16x4 l0 = tr_read<t_rd_off<4>(D0, 2 * SB, 0)>(vb), h0 = tr_read<t_rd_off<4>(D0, 2 * SB, 1)>(vb), l1 = tr_read<t_rd_off<4>(D0, 2 * SB + 1, 0)>(vb), h1 = tr_read<t_rd_off<4>(D0, 2 * SB + 1, 1)>(vb); \
        asm volatile("s_waitcnt lgkmcnt(0)" ::: "memory"); __builtin_amdgcn_sched_barrier(0); \
        o[D0] = __builtin_amdgcn_mfma_f32_32x32x16_bf16(PA0, ML_PK(l0, h0), o[D0], 0, 0, 0); \
        o[D0] = __builtin_amdgcn_mfma_f32_32x32x16_bf16(PA1, ML_PK(l1, h1), o[D0], 0, 0, 0); } while (0)
    ML_C_BLOCK(0); ML_C_BLOCK(1); ML_C_BLOCK(2); ML_C_BLOCK(3);
#undef ML_C_BLOCK
#undef ML_C_PV
    {
        bf16x8 qw[4];
#pragma unroll
        for (int ks = 0; ks < 4; ++ks) { const u32x4 q4 = *reinterpret_cast<const u32x4*>(&qr[ks]); u32x4 w4;
#pragma unroll
            for (int q = 0; q < 4; ++q) { const float lo = __uint_as_float(q4[q] << 16), hi2 = __uint_as_float(q4[q] & 0xffff0000u); w4[q] = cvtpk(lo * (0.125f * wint), hi2 * (0.125f * wint)); }
            qw[ks] = *reinterpret_cast<const bf16x8*>(&w4); }
        const char* Cl = lds + 65536 + dir * 16384;
#pragma unroll
        for (int d0 = 0; d0 < 4; ++d0)
#pragma unroll
            for (int ks = 0; ks < 4; ++ks) { const bf16x8 cf = *reinterpret_cast<const bf16x8*>(Cl + ML_KS(32 * d0 + r32, (ks * 16 + hi * 8) * 2)); o[d0] = __builtin_amdgcn_mfma_f32_32x32x16_bf16(qw[ks], cf, o[d0], 0, 0, 0); }
    }
    { auto rr = __builtin_amdgcn_permlane32_swap(__float_as_uint(den), __float_as_uint(den), false, false); den = __uint_as_float(rr[0]) + __uint_as_float(rr[1]); }
    { auto rr = __builtin_amdgcn_permlane32_swap(__float_as_uint(ndot), __float_as_uint(ndot), false, false); ndot = __uint_as_float(rr[0]) + __uint_as_float(rr[1]); }
    den += wint * 0.125f * ndot;
    const float sct = 1.f / fmaxf(fabsf(den), __builtin_amdgcn_exp2f(-cum[dir * 128 + t] * L2E - el2));
    if (hi == 0) scl[wave * 32 + r32] = sct;
    __syncthreads();
    if (dir == 1) {
#pragma unroll
        for (int r = 0; r < 16; ++r) { const float sc = scl[wave * 32 + crow(r, hi)];
#pragma unroll
            for (int d0 = 0; d0 < 4; ++d0) hs[(32 * tb + crow(r, hi)) * 128 + 32 * d0 + r32] = o[d0][r] * sc; }
    }
    __syncthreads();
    if (dir == 0) {
#pragma unroll
        for (int r = 0; r < 16; ++r) { const float sc = scl[wave * 32 + crow(r, hi)];
#pragma unroll
            for (int d0 = 0; d0 < 4; ++d0) hs[(32 * tb + crow(r, hi)) * 128 + 32 * d0 + r32] += o[d0][r] * sc; }
    }
    __syncthreads();
    {
        const int tt = tid >> 2, q4 = tid & 3;
        const size_t grow = (size_t)chunk_row(b, X, tt);
        const unsigned short* og = P16 + grow * 2304 + 1696 + h * 128 + 32 * q4;
        u32x4 og4[4];
#pragma unroll
        for (int j = 0; j < 4; ++j) og4[j] = *reinterpret_cast<const u32x4*>(og + 8 * j);
        f32x4 v[8]; float ss = 0.f;
#pragma unroll
        for (int j = 0; j < 8; ++j) { v[j] = *(const LAS f32x4*)(hs + tt * 128 + 32 * q4 + 4 * j); ss += (v[j][0] * v[j][0] + v[j][1] * v[j][1]) + (v[j][2] * v[j][2] + v[j][3] * v[j][3]); }
        ss += __shfl_xor(ss, 1); ss += __shfl_xor(ss, 2);
        const float rstd = rsqrtf(ss * (1.f / 128.f) + 1e-6f);
        const float* gn = mng + h * 128 + 32 * q4;
        unsigned short* dst = MIX16 + grow * 1024 + 512 + h * 128 + 32 * q4;
#pragma unroll
        for (int j = 0; j < 4; ++j) { const f32x4 g0 = *(const f32x4*)(gn + 8 * j), g1 = *(const f32x4*)(gn + 8 * j + 4); const f32x4 x0 = v[2 * j], x1 = v[2 * j + 1]; const u32x4 ow = og4[j];
            float r8[8];
#pragma unroll
            for (int e = 0; e < 4; ++e) { const float gl = __uint_as_float(ow[e] << 16), gh = __uint_as_float(ow[e] & 0xffff0000u);
                const float xa = (e < 2) ? x0[2 * e] : x1[2 * e - 4], xb = (e < 2) ? x0[2 * e + 1] : x1[2 * e - 3];
                const float ga = (e < 2) ? g0[2 * e] : g1[2 * e - 4], gb = (e < 2) ? g0[2 * e + 1] : g1[2 * e - 3];
                r8[2 * e] = xa * rstd * ga * __builtin_amdgcn_rcpf(1.f + __expf(-gl)); r8[2 * e + 1] = xb * rstd * gb * __builtin_amdgcn_rcpf(1.f + __expf(-gh)); }
            u32x4 w; w.x = cvtpk(r8[0], r8[1]); w.y = cvtpk(r8[2], r8[3]); w.z = cvtpk(r8[4], r8[5]); w.w = cvtpk(r8[6], r8[7]);
            *(u32x4*)(dst + 8 * j) = w; }
    }
    __syncthreads();
}
#undef ML_PK
#undef ML_KS
}


__device__ __forceinline__ unsigned pk4_fp8(float a, float b, float c, float d) { int w = __builtin_amdgcn_cvt_pk_fp8_f32(a, b, 0, false); w = __builtin_amdgcn_cvt_pk_fp8_f32(c, d, w, true); return (unsigned)w; }
template <class RowMap>
__device__ __forceinline__ void transpose_item8(const float* W, int K, int N, int nblk, unsigned char* WT, const RowMap& rowmap, LAS float* scr, int item, int lane) {
    const int kb = item / nblk, nb = item % nblk, k0 = 64 * kb, n0 = 32 * nb;
    const int ncol = n0 + (lane & 31);
    float tv[32];
#pragma unroll
    for (int i = 0; i < 32; ++i) { const int kk = 2 * i + (lane >> 5); tv[i] = __builtin_nontemporal_load(W + (size_t)(k0 + kk) * N + ncol) * 64.f; }
#pragma unroll
    for (int i = 0; i < 32; ++i) scr[(2 * i + (lane >> 5)) * 33 + (lane & 31)] = tv[i];
    asm volatile("s_waitcnt lgkmcnt(0)" ::: "memory");
    const int c = lane & 7;
    const int r0 = rowmap(n0);
#pragma unroll
    for (int j = 0; j < 4; ++j) { const int n = (lane >> 3) + 8 * j; const LAS float* sp = scr + (8 * c) * 33 + n;
        pg8::u32x2 o; o.x = pk4_fp8(sp[0 * 33], sp[1 * 33], sp[2 * 33], sp[3 * 33]); o.y = pk4_fp8(sp[4 * 33], sp[5 * 33], sp[6 * 33], sp[7 * 33]);
        __builtin_nontemporal_store(o, (pg8::u32x2*)(WT + (size_t)(r0 + n) * K + k0 + 8 * c)); }
    asm volatile("s_waitcnt lgkmcnt(0)" ::: "memory");
}

__device__ __forceinline__ void convert_chunk(const float* wgu, const float* wdn, unsigned short* WguT, unsigned short* WdnT, int which, int chunk, LAS float* scr, int wave, int lane) {
#pragma unroll 1
    for (int j = 0; j < 8; ++j) {
        const int it = chunk * 64 + wave * 8 + j;
#if MOE_FP8
        if (which == 0) { const int e = it >> 10, r = it & 1023;
            transpose_item8(wgu + (size_t)e * D * 2 * DFF, D, 2 * DFF, 2 * DFF / 32, (unsigned char*)WguT + (size_t)e * 2 * DFF * D,
                            [](int n0) { return n0 < DFF ? (n0 >> 7) * 256 + (n0 & 127) : ((n0 - DFF) >> 7) * 256 + 128 + ((n0 - DFF) & 127); }, scr, r, lane); }
        else { const int e = it >> 9, r = it & 511;
            transpose_item8(wdn + (size_t)e * DFF * D, DFF, D, D / 32, (unsigned char*)WdnT + (size_t)e * D * DFF, [](int n0) { return n0; }, scr, r, lane); }
#else
        if (which == 0) { const int e = it >> 10, r = it & 1023;
            transpose_item(wgu + (size_t)e * D * 2 * DFF, D, 2 * DFF, 2 * DFF / 32, WguT + (size_t)e * 2 * DFF * D,
                           [](int n0) { return n0 < DFF ? (n0 >> 7) * 256 + (n0 & 127) : ((n0 - DFF) >> 7) * 256 + 128 + ((n0 - DFF) & 127); }, scr, r, lane); }
        else { const int e = it >> 9, r = it & 511;
            transpose_item(wdn + (size_t)e * DFF * D, DFF, D, D / 32, WdnT + (size_t)e * D * DFF, [](int n0) { return n0; }, scr, r, lane); }
#endif
    }
}
__device__ __forceinline__ void pull_chunks(unsigned* qword, int first, int total, int maxc, const float* wgu, const float* wdn, unsigned short* WguT, unsigned short* WdnT, int which,
                                            unsigned char* lds_raw, int wave, int lane) {
    LAS int* bc = (LAS int*)(lds_raw + 131072 + 1024);
    LAS float* scr = (LAS float*)(lds_raw + wave * 16384);
    for (int n = 0; n < maxc; ++n) {
        __syncthreads();
        if (threadIdx.x == 0) bc[0] = first + (int)__hip_atomic_fetch_add(qword, 1u, __ATOMIC_RELAXED, __HIP_MEMORY_SCOPE_AGENT);
        __syncthreads();
        const int c = bc[0];
        if (c >= total) break;
        convert_chunk(wgu, wdn, WguT, WdnT, which, c, scr, wave, lane);
    }
    __syncthreads();
}

__device__ __forceinline__ int fresh_tid() { int t = (int)threadIdx.x; asm volatile("" : "+v"(t)); return t; }

#define DEF_PTRS \
    float* MOD = (float*)(ws + WS_MOD); \
    float* NLOC = (float*)(ws + WS_MLS); float* MLOC = (float*)(ws + WS_MLS + 512 * 1024); float* TOT = (float*)(ws + WS_MLS + 576 * 1024); float* NIN = (float*)(ws + WS_MLS + 1 * MiB); float* MIN_ = (float*)(ws + WS_MLS + 1536 * 1024); \
    float* CLOC = (float*)(ws + WS_CLOC); unsigned short* CIN = (unsigned short*)(ws + WS_CIN); \
    float* ROPEC = (float*)(ws + WS_ROPE); float* ROPES = ROPEC + S * 16; \
    int* TOPE = (int*)(ws + WS_TOPE); int* SLOT = (int*)(ws + WS_SLOT); int* LIST = (int*)(ws + WS_LIST); float* RGATE = (float*)(ws + WS_RGATE); \
    unsigned short* Hb16 = (unsigned short*)(ws + WS_H); unsigned short* WinT = (unsigned short*)(ws + WS_WINT); \
    unsigned short* Q16 = (unsigned short*)(ws + WS_Q); unsigned short* K16 = (unsigned short*)(ws + WS_KV); unsigned short* V16 = (unsigned short*)(ws + WS_KV + 32 * MiB); \
    unsigned short* X1 = (unsigned short*)(ws + WS_X1); unsigned short* H2 = (unsigned short*)(ws + WS_H2); \
    unsigned short* YG = (unsigned short*)(ws + WS_YG); unsigned short* ACT = (unsigned short*)(ws + WS_ACT); \
    unsigned short* WguT = (unsigned short*)(ws + WS_WGUT); unsigned short* WdnT = (unsigned short*)(ws + WS_WDNT); \
    unsigned short* WuqT = (unsigned short*)(ws + WS_WUQT); unsigned short* WukvT = (unsigned short*)(ws + WS_WUKVT); unsigned short* WoutT = (unsigned short*)(ws + WS_WOUTT); \
    float* GATES = (float*)(ws + WS_GATES); float* STAT = (float*)(ws + WS_STAT); float* STAT2 = (float*)(ws + WS_STAT2); \
    float* GM2 = (float*)(ws + WS_RSTD); unsigned short* RWH = (unsigned short*)(ws + WS_RSTD + 65536); unsigned short* RWL = (unsigned short*)(ws + WS_RSTD + 131072); unsigned short* MIX16 = (unsigned short*)(ws + WS_MIX16); \
    unsigned short* P16 = (unsigned short*)(ws + WS_P); \
    unsigned* CNT = ctl + CW_CNT; (void)CNT;
typedef const Params __attribute__((address_space(4))) KParams;
#define PHASE_ENV KParams* pk = kp; asm volatile("" : "+s"(pk)); unsigned char* ws = pk->ws; unsigned* ctl = (unsigned*)(ws + WS_CTL); (void)ctl; DEF_PTRS

constexpr int LDS_BYTES = 147456;
constexpr int N_PHASES = 12;

__global__ void __launch_bounds__(NT, 2) fwd_kernel(Params p) {
    extern __shared__ __attribute__((aligned(16))) unsigned char lds_raw[];
    float* lds = (float*)lds_raw;
    LAS unsigned* misc = (LAS unsigned*)(lds_raw + 131072 + 4096);
    const int tid = threadIdx.x, lane = tid & 63, wave = tid >> 6;
    const int bid = blockIdx.x, G = gridDim.x;
    KParams* kp = (KParams*)__builtin_amdgcn_kernarg_segment_ptr();
    unsigned* ctl = (unsigned*)(p.ws + WS_CTL);
    if (tid < 4) misc[tid] = 0u;
    __syncthreads();
    const bool single = (p.ph_hi - p.ph_lo) > 1;
    if (single) (void)xcd_barrier_post(ctl + CW_BAR, (volatile LAS unsigned*)misc);
#ifndef PH_MASK
#define PH_MASK 0xFFFF
#endif
#define IN(k) ((((PH_MASK) >> (k)) & 1) && p.ph_lo <= (k) && (k) < p.ph_hi)
#define GRID_BARRIER() do { KParams* pb_ = kp; asm volatile("" : "+s"(pb_)); XcdBarrier b_; b_.bar = (unsigned*)(pb_->ws + WS_CTL) + CW_BAR; b_.x = xb_xcc_id(); b_.st = (volatile LAS unsigned*)misc; xcd_barrier(b_); } while (0)
#define SEAM(k) do { if (IN(k) && IN((k) + 1)) GRID_BARRIER(); } while (0)
#define PH_BEGIN(k)
#define PH_END(k)
#define SEAM2(k) do { if (IN(k) && IN((k) + 2)) GRID_BARRIER(); } while (0)

    PH_BEGIN(0) if (IN(0)) {
        const int tid = fresh_tid(), lane = tid & 63, wave = tid >> 6; (void)lane; (void)wave;
        PHASE_ENV
        {
            const float* wmod = pk->in[I_WMOD]; const float* bmod = pk->in[I_BMOD];
            float* sil = lds;
            float* red = lds + 5 * 1024;
            for (int cg = bid; cg < 96; cg += G) {
                for (int e = tid; e < 5 * D; e += NT) { const int r = e >> 10, k = e & 1023; const float cv = (r < 4) ? pk->in[I_C][r * D + k] : pk->in[I_CCTX][k]; sil[e] = siluf_(cv); }
                __syncthreads();
                const int col = cg * 64 + (tid & 63), part = tid >> 6;
                float a0 = 0.f, a1 = 0.f, a2 = 0.f, a3 = 0.f, a4 = 0.f;
#pragma unroll 8
                for (int kk = 0; kk < 128; ++kk) { const int k = part * 128 + kk; const float w = wmod[(size_t)k * 6144 + col];
                    a0 = fmaf(sil[k], w, a0); a1 = fmaf(sil[1024 + k], w, a1); a2 = fmaf(sil[2048 + k], w, a2); a3 = fmaf(sil[3072 + k], w, a3); a4 = fmaf(sil[4096 + k], w, a4); }
                red[(part * 5 + 0) * 64 + (tid & 63)] = a0; red[(part * 5 + 1) * 64 + (tid & 63)] = a1; red[(part * 5 + 2) * 64 + (tid & 63)] = a2; red[(part * 5 + 3) * 64 + (tid & 63)] = a3; red[(part * 5 + 4) * 64 + (tid & 63)] = a4;
                __syncthreads();
                if (tid < 320) { const int r = tid >> 6, cc = tid & 63; float t = 0.f;
#pragma unroll
                    for (int pp = 0; pp < 8; ++pp) t += red[(pp * 5 + r) * 64 + cc];
                    MOD[r * 6144 + cg * 64 + cc] = t + bmod[cg * 64 + cc]; }
                __syncthreads();
            }
        }
        for (int e = bid * NT + tid; e < NE * D; e += G * NT) { const int ex = e >> 10, k = e & 1023; const float w = pk->in[I_RW][(size_t)k * NE + ex];
            const unsigned hi = pg8::cvt_pk_bf16(w, 0.f) & 0xffffu; const float lo = w - __uint_as_float(hi << 16);
            RWH[e] = (unsigned short)hi; RWL[e] = (unsigned short)(pg8::cvt_pk_bf16(lo, 0.f) & 0xffffu); }
        for (int e = bid * NT + tid; e < S * 16; e += G * NT) { float cs, sn; rope_angles(e >> 4, e & 15, cs, sn); ROPEC[e] = cs; ROPES[e] = sn; }
        {
            LAS float* scr = (LAS float*)(lds_raw + wave * 16384);
            const int gw = bid * 8 + wave, NGW = G * 8;
            for (int it = gw; it < (D / 64) * (PW / 32); it += NGW) transpose_item(pk->in[I_WIN], D, INW, PW / 32, WinT, [](int n0) { return n0; }, scr, it, lane);
            for (int it = gw; it < (QL / 64) * (768 / 32); it += NGW) transpose_item(pk->in[I_WUQ], QL, 768, 768 / 32, WuqT, [](int n0) { return n0; }, scr, it, lane, pk->in[I_QNG]);
            for (int it = gw; it < (KVL / 64) * (1024 / 32); it += NGW) transpose_item(pk->in[I_WUKV], KVL, 1024, 1024 / 32, WukvT, [](int n0) { return n0; }, scr, it, lane, pk->in[I_KVNG]);
            for (int it = gw; it < (D / 64) * (D / 32); it += NGW) transpose_item(pk->in[I_WOUT], D, D, D / 32, WoutT, [](int n0) { return n0; }, scr, it, lane);
            for (int c = G - 1 - bid; c < GU_STATIC; c += G) convert_chunk(pk->in[I_WGU], pk->in[I_WDN], WguT, WdnT, 0, c, scr, wave, lane);
        }
    }
    PH_END(0)
    SEAM(0);
    PH_BEGIN(1) if (IN(1)) {
        const int tid = fresh_tid(), lane = tid & 63, wave = tid >> 6; (void)lane; (void)wave;
        PHASE_ENV
        const float* g1n = pk->in[I_N1G];
        for (int e = bid * NT + tid; e < 4 * D; e += G * NT) GM2[e] = pk->in[I_N2G][e & 1023] * (1.f + MOD[(e >> 10) * 6144 + 4 * D + (e & 1023)]);
        for (int rp = bid * 8 + wave; rp < MT / 2; rp += G * 8) {
            const int r = 2 * rp;
            const float* src = (r < MX) ? pk->in[I_X] + (size_t)r * D : pk->in[I_CTX] + (size_t)(r - MX) * D;
            const int mb = (r < MX) ? r / S : 4;
            const float* sh = MOD + mb * 6144, *sc = sh + D;
            float4 va[4], vb[4]; float sa = 0.f, sb = 0.f;
#pragma unroll
            for (int j = 0; j < 4; ++j) { va[j] = *(const float4*)(src + j * 256 + lane * 4); vb[j] = *(const float4*)(src + D + j * 256 + lane * 4); }
#pragma unroll
            for (int j = 0; j < 4; ++j) { sa += (va[j].x * va[j].x + va[j].y * va[j].y) + (va[j].z * va[j].z + va[j].w * va[j].w); sb += (vb[j].x * vb[j].x + vb[j].y * vb[j].y) + (vb[j].z * vb[j].z + vb[j].w * vb[j].w); }
            const float ra = rsqrtf(wave_sum(sa) * (1.f / D) + EPS), rb2 = rsqrtf(wave_sum(sb) * (1.f / D) + EPS);
#pragma unroll
            for (int j = 0; j < 4; ++j) {
                const int c = j * 256 + lane * 4;
                const float4 gn = *(const float4*)(g1n + c), scv = *(const float4*)(sc + c), shv = *(const float4*)(sh + c);
                const float g0 = gn.x * (1.f + scv.x), g1 = gn.y * (1.f + scv.y), g2 = gn.z * (1.f + scv.z), g3 = gn.w * (1.f + scv.w);
                pg8::u32x2 w;
                w.x = pg8::cvt_pk_bf16(va[j].x * ra * g0 + shv.x, va[j].y * ra * g1 + shv.y); w.y = pg8::cvt_pk_bf16(va[j].z * ra * g2 + shv.z, va[j].w * ra * g3 + shv.w);
                *(pg8::u32x2*)(Hb16 + (size_t)r * D + c) = w;
                w.x = pg8::cvt_pk_bf16(vb[j].x * rb2 * g0 + shv.x, vb[j].y * rb2 * g1 + shv.y); w.y = pg8::cvt_pk_bf16(vb[j].z * rb2 * g2 + shv.z, vb[j].w * rb2 * g3 + shv.w);
                *(pg8::u32x2*)(Hb16 + (size_t)(r + 1) * D + c) = w;
            }
        }
    }
    PH_END(1)
    SEAM(1);
    PH_BEGIN(2) if (IN(2)) {
        const int tid = fresh_tid(), lane = tid & 63, wave = tid >> 6; (void)lane; (void)wave;
        PHASE_ENV
        pg8::PlainSched Sd; Sd.init(MT, PW, D, D, WinT, G, bid);
        pg8::EpiInproj E{P16, GATES, STAT, K16, ROPEC, ROPES};
        pg8::gemm_phase<pg8::EpiInproj, pg8::PlainSched, true>((LAS unsigned char*)lds_raw, Hb16, D, Sd, E);
        if ((Sd.nwg % G) != 0 && bid >= (Sd.nwg % G))
            pull_chunks(ctl + CW_QGU, GU_STATIC, GU_CHUNKS, 2, pk->in[I_WGU], pk->in[I_WDN], WguT, WdnT, 0, lds_raw, wave, lane);
    }
    PH_END(2)
    SEAM2(2);
    PH_BEGIN(4) if (IN(4)) {
        const int tid = fresh_tid(), lane = tid & 63, wave = tid >> 6; (void)lane; (void)wave;
        PHASE_ENV
#ifndef NO_QG
        { pg8::PlainSched Sd; Sd.init(MX, 768, QL, PW, WuqT, G, (bid + G - 16) % G);
          pg8::EpiQ E{Q16, STAT, ROPEC, ROPES};
          pg8::gemm_phase<pg8::EpiQ, pg8::PlainSched, true>((LAS unsigned char*)lds_raw, P16 + O_CQ, QL, Sd, E); }
#endif
#ifndef NO_KVG
        { pg8::PlainSched Sd; Sd.init(MT, 1024, KVL, PW, WukvT, G, bid);
          pg8::EpiKV E{K16, V16, STAT};
          pg8::gemm_phase<pg8::EpiKV, pg8::PlainSched, true>((LAS unsigned char*)lds_raw, P16 + O_CKV, KVL, Sd, E); }
#endif
        for (int u = (bid + 48) % G; u < 16 * ml::NXC; u += G) ml::stepA_unit(P16, GATES, pk->in[I_BG], u / ml::NXC, u % ml::NXC, CLOC, NLOC, MLOC, TOT, (char*)lds_raw);
    }
    PH_END(4)
    SEAM(4);
    PH_BEGIN(5) if (IN(5)) {
        const int tid = fresh_tid(), lane = tid & 63, wave = tid >> 6; (void)lane; (void)wave;
        PHASE_ENV
        ml::stepB(CLOC, NLOC, MLOC, TOT, (unsigned*)CIN, NIN, MIN_, bid * NT + tid, G * NT);
        {
            const int nun = NB * HA * (S / 256);
            for (int i = 0; i * G < nun; ++i) {
                int bh, qb;
                if (G == 256) { const int x = bid & 7, slot = bid >> 3; bh = i * 16 + x * 2 + (slot >> 4); qb = slot & 15; }
                else { const int u = i * G + bid; if (u >= nun) break; bh = u >> 4; qb = u & 15; }
                const int b = bh >> 3, h = bh & 7;
                att::attn_body(Q16 + (size_t)(b * S + qb * 256) * 768 + h * 96, K16 + (size_t)(b * SKV) * 768 + h * 96, V16 + (size_t)(b * SKV) * 512 + h * 64,
                               MIX16 + (size_t)(b * S + qb * 256) * D + h * 64, SKV, (char*)lds_raw);
            }
        }
    }
    PH_END(5)
    SEAM(5);
    PH_BEGIN(6) if (IN(6)) {
        const int tid = fresh_tid(), lane = tid & 63, wave = tid >> 6; (void)lane; (void)wave;
        PHASE_ENV
        for (int u = bid; u < 16 * 32; u += G) ml::stepC_unit(P16, GATES, pk->in[I_BG], CIN, NIN, MIN_, pk->in[I_MNG], MIX16, u >> 5, u & 31, (char*)lds_raw);
    }
    PH_END(6)
    SEAM(6);
    PH_BEGIN(7) if (IN(7)) {
        const int tid = fresh_tid(), lane = tid & 63, wave = tid >> 6; (void)lane; (void)wave;
        PHASE_ENV
        pg8::PlainSched Sd; Sd.init(MX, D, D, D, WoutT, G, bid);
        pg8::EpiResid E{X1, pk->in[I_X], MOD, STAT2};
        pg8::gemm_phase<pg8::EpiResid, pg8::PlainSched, true>((LAS unsigned char*)lds_raw, MIX16, D, Sd, E);
    }
    PH_END(7)
    SEAM(7);
    PH_BEGIN(8) if (IN(8)) {
        const int tid = fresh_tid(), lane = tid & 63, wave = tid >> 6; (void)lane; (void)wave;
        PHASE_ENV
        typedef short bf16x8v __attribute__((ext_vector_type(8)));
        typedef float f32x4v __attribute__((ext_vector_type(4)));
        float* LG = lds;
        LAS int* lcnt = (LAS int*)(lds_raw + 32768); LAS int* gbase = lcnt + 32;
        const float* rb = pk->in[I_RB];
        for (int base = bid * 64; base < MX; base += G * 64) {
            if (tid < 32) lcnt[tid] = 0;
            {
                const int bq0 = base / S; const float4 t4 = (tid < 256) ? *(const float4*)(GM2 + bq0 * D + 4 * tid) : *(const float4*)(MOD + bq0 * 6144 + 3 * D + 4 * (tid - 256));
                *(float4*)(lds + 10240 + 4 * tid) = t4; }
            __syncthreads();
            int te[4] = {0, 0, 0, 0}, rk[4] = {0, 0, 0, 0}; float tg[4] = {0.f, 0.f, 0.f, 0.f};
            {
                const int rt = wave & 3, kh = wave >> 2;
                const int r0 = base + 16 * rt, row = lane & 15, kg = lane >> 4, bq = r0 / S;
                float ss;
                { const float4 s0 = *(const float4*)(STAT2 + (size_t)(r0 + row) * 32 + kg * 8), s1 = *(const float4*)(STAT2 + (size_t)(r0 + row) * 32 + kg * 8 + 4);
                  ss = ((s0.x + s0.y) + (s0.z + s0.w)) + ((s1.x + s1.y) + (s1.z + s1.w)); ss += __shfl_xor(ss, 16); ss += __shfl_xor(ss, 32); }
                const float rstd = rsqrtf(ss * (1.f / D) + EPS);
                const int ko = kh * 512 + 8 * kg;
                const unsigned short* xr = X1 + (size_t)(r0 + row) * D + ko; const float* gmr = lds + 10240 + ko; const float* shr = lds + 10240 + 1024 + ko; (void)bq;
                unsigned short* hr = H2 + (size_t)(r0 + row) * D + ko; (void)hr;
                const unsigned short* wh0 = RWH + (size_t)row * D + ko, *wh1 = RWH + (size_t)(16 + row) * D + ko, *wl0 = RWL + (size_t)row * D + ko, *wl1 = RWL + (size_t)(16 + row) * D + ko;
                f32x4v acc0 = {0.f, 0.f, 0.f, 0.f}, acc1 = {0.f, 0.f, 0.f, 0.f};
#pragma unroll 8
                for (int st = 0; st < 16; ++st) {
                    const pg8::u32x4 xw = *(const pg8::u32x4*)(xr + 32 * st);
                    const float4 x0 = make_float4(__uint_as_float(xw[0] << 16), __uint_as_float(xw[0] & 0xffff0000u), __uint_as_float(xw[1] << 16), __uint_as_float(xw[1] & 0xffff0000u)), x1v = make_float4(__uint_as_float(xw[2] << 16), __uint_as_float(xw[2] & 0xffff0000u), __uint_as_float(xw[3] << 16), __uint_as_float(xw[3] & 0xffff0000u));
                    const float4 g0 = *(const float4*)(gmr + 32 * st), g1v = *(const float4*)(gmr + 32 * st + 4), h0 = *(const float4*)(shr + 32 * st), h1 = *(const float4*)(shr + 32 * st + 4);
                    float hv[8] = {x0.x * rstd * g0.x + h0.x, x0.y * rstd * g0.y + h0.y, x0.z * rstd * g0.z + h0.z, x0.w * rstd * g0.w + h0.w, x1v.x * rstd * g1v.x + h1.x, x1v.y * rstd * g1v.y + h1.y, x1v.z * rstd * g1v.z + h1.z, x1v.w * rstd * g1v.w + h1.w};
                    pg8::u32x4 hi4, lo4;
#pragma unroll
                    for (int q = 0; q < 4; ++q) { hi4[q] = pg8::cvt_pk_bf16(hv[2 * q], hv[2 * q + 1]);
                        lo4[q] = pg8::cvt_pk_bf16(hv[2 * q] - __uint_as_float(hi4[q] << 16), hv[2 * q + 1] - __uint_as_float(hi4[q] & 0xffff0000u)); }
#if MOE_FP8
                    { pg8::u32x2 h8; h8.x = pk4_fp8(hv[0], hv[1], hv[2], hv[3]); h8.y = pk4_fp8(hv[4], hv[5], hv[6], hv[7]); *(pg8::u32x2*)((unsigned char*)H2 + (size_t)(r0 + row) * D + ko + 32 * st) = h8; }
#else
                    *(pg8::u32x4*)(hr + 32 * st) = hi4;
#endif
                    const bf16x8v ah = *reinterpret_cast<const bf16x8v*>(&hi4), al = *reinterpret_cast<const bf16x8v*>(&lo4);
                    const bf16x8v bh0 = *reinterpret_cast<const bf16x8v*>(wh0 + 32 * st), bh1 = *reinterpret_cast<const bf16x8v*>(wh1 + 32 * st), bl0 = *reinterpret_cast<const bf16x8v*>(wl0 + 32 * st), bl1 = *reinterpret_cast<const bf16x8v*>(wl1 + 32 * st);
                    acc0 = __builtin_amdgcn_mfma_f32_16x16x32_bf16(ah, bh0, acc0, 0, 0, 0); acc0 = __builtin_amdgcn_mfma_f32_16x16x32_bf16(al, bh0, acc0, 0, 0, 0); acc0 = __builtin_amdgcn_mfma_f32_16x16x32_bf16(ah, bl0, acc0, 0, 0, 0);
                    acc1 = __builtin_amdgcn_mfma_f32_16x16x32_bf16(ah, bh1, acc1, 0, 0, 0); acc1 = __builtin_amdgcn_mfma_f32_16x16x32_bf16(al, bh1, acc1, 0, 0, 0); acc1 = __builtin_amdgcn_mfma_f32_16x16x32_bf16(ah, bl1, acc1, 0, 0, 0);
                }
                float* lgp = LG + kh * (64 * 33);
#pragma unroll
                for (int j = 0; j < 4; ++j) { lgp[(16 * rt + 4 * kg + j) * 33 + row] = acc0[j]; lgp[(16 * rt + 4 * kg + j) * 33 + 16 + row] = acc1[j]; }
            }
            __syncthreads();
            if (wave < 4 && lane < 16) {
                float* lr = LG + (16 * wave + lane) * 33; float tv[4];
                for (int e = 0; e < 32; ++e) lr[e] = (lr[e] + lr[64 * 33 + e]) + rb[e];
#pragma unroll
                for (int k = 0; k < 4; ++k) { float best = -3.0e38f; int bi = 0;
                    for (int e = 0; e < 32; ++e) { const float v = lr[e]; if (v > best) { best = v; bi = e; } }
                    te[k] = bi; tv[k] = best; lr[bi] = -3.0e38f; }
                const float e1 = __expf(tv[1] - tv[0]), e2 = __expf(tv[2] - tv[0]), e3 = __expf(tv[3] - tv[0]); const float inv = 1.f / (1.f + e1 + e2 + e3);
                tg[0] = inv; tg[1] = e1 * inv; tg[2] = e2 * inv; tg[3] = e3 * inv;
#pragma unroll
                for (int k = 0; k < 4; ++k) rk[k] = atomicAdd((int*)&lcnt[te[k]], 1);
            }
            __syncthreads();
            if (tid < 32) gbase[tid] = (int)atomicAdd(&CNT[tid], (unsigned)lcnt[tid]);
            __syncthreads();
            if (wave < 4 && lane < 16) { const int r = base + 16 * wave + lane;
#pragma unroll
                for (int k = 0; k < 4; ++k) { const int e = te[k], pos = gbase[e] + rk[k]; TOPE[r * 4 + k] = e; SLOT[r * 4 + k] = pos; LIST[e * MX + pos] = r; RGATE[e * MX + pos] = tg[k]; } }
            __syncthreads();
        }
    }
    if (IN(8)) { const int t2 = fresh_tid(); PHASE_ENV pull_chunks(ctl + CW_QGU, GU_STATIC, GU_CHUNKS, GU_CHUNKS, pk->in[I_WGU], pk->in[I_WDN], WguT, WdnT, 0, lds_raw, t2 >> 6, t2 & 63); }
    PH_END(8)
    SEAM(8);
    LAS int* mtp = (LAS int*)(lds_raw + 131072); LAS int* mro = mtp + 40; LAS int* mcn = mro + 40;
    if (IN(9) || IN(10) || IN(11)) {
        PHASE_ENV
        __syncthreads();
        if (tid < 64) {
            const int cnt = (tid < NE) ? (int)__hip_atomic_load(&CNT[tid & 31], __ATOMIC_RELAXED, __HIP_MEMORY_SCOPE_AGENT) : 0;
            const int tl = (cnt + 255) >> 8; int inc = tl;
#pragma unroll
            for (int o = 1; o < 64; o <<= 1) { const int y = __shfl_up(inc, o); if (tid >= o) inc += y; }
            if (tid < NE) { mcn[tid] = cnt; mtp[tid] = inc - tl; mro[tid] = (inc - tl) * 256; }
            if (tid == NE - 1) { mtp[NE] = inc; mro[NE] = inc * 256; }
        }
        __syncthreads();
    }
    PH_BEGIN(9) if (IN(9)) {
        const int tid = fresh_tid(), lane = tid & 63, wave = tid >> 6; (void)lane; (void)wave;
        PHASE_ENV
#if MOE_FP8
        pg8::MoeSched Sd{mtp, mro, mcn, DFF / 128, G, bid, D / 2, D / 2, 1, LIST, (const char*)WguT, (size_t)2 * DFF * D};
        pg8::EpiSwiglu E{ACT, pk->in[I_BGU]};
        pg8::gemm_phase<pg8::EpiSwiglu, pg8::MoeSched, true, true>((LAS unsigned char*)lds_raw, H2, D / 2, Sd, E);
#else
        pg8::MoeSched Sd{mtp, mro, mcn, DFF / 128, G, bid, D, D, 1, LIST, (const char*)WguT, (size_t)2 * DFF * D * 2};
        pg8::EpiSwiglu E{ACT, pk->in[I_BGU]};
        pg8::gemm_phase<pg8::EpiSwiglu, pg8::MoeSched, true>((LAS unsigned char*)lds_raw, H2, D, Sd, E);
#endif
        {
            const int nun = mtp[NE] * (DFF / 128); const int mine = (nun - bid + G - 1) / G, most = (nun + G - 1) / G;
            if (mine < most) pull_chunks(ctl + CW_QDN, 0, DN_CHUNKS, 3, pk->in[I_WGU], pk->in[I_WDN], WguT, WdnT, 1, lds_raw, wave, lane);
            pull_chunks(ctl + CW_QDN, 0, DN_CHUNKS, DN_CHUNKS, pk->in[I_WGU], pk->in[I_WDN], WguT, WdnT, 1, lds_raw, wave, lane);
        }
    }
    PH_END(9)
    SEAM(9);
    PH_BEGIN(10) if (IN(10)) {
        const int tid = fresh_tid(), lane = tid & 63, wave = tid >> 6; (void)lane; (void)wave;
        PHASE_ENV
#if MOE_FP8
        pg8::MoeSched Sd{mtp, mro, mcn, D / 256, G, bid, DFF / 2, DFF / 2, 0, LIST, (const char*)WdnT, (size_t)D * DFF};
        pg8::EpiDown E{YG, pk->in[I_BDN], RGATE, mro};
        pg8::gemm_phase<pg8::EpiDown, pg8::MoeSched, true, true>((LAS unsigned char*)lds_raw, ACT, DFF / 2, Sd, E);
#else
        pg8::MoeSched Sd{mtp, mro, mcn, D / 256, G, bid, DFF, DFF, 0, LIST, (const char*)WdnT, (size_t)D * DFF * 2};
        pg8::EpiDown E{YG, pk->in[I_BDN], RGATE, mro};
        pg8::gemm_phase<pg8::EpiDown, pg8::MoeSched, true>((LAS unsigned char*)lds_raw, ACT, DFF, Sd, E);
#endif
    }
    PH_END(10)
    SEAM(10);
    PH_BEGIN(11) if (IN(11)) {
        const int tid = fresh_tid(), lane = tid & 63, wave = tid >> 6; (void)lane; (void)wave;
        PHASE_ENV
        const float* fng = pk->in[I_FNG];
        for (int r = bid * 8 + wave; r < MX; r += G * 8) {
            const int mb = r / S; const float* g2 = MOD + mb * 6144 + 5 * D;
            float acc[16];
#pragma unroll
            for (int i = 0; i < 16; ++i) acc[i] = 0.f;
#pragma unroll
            for (int k = 0; k < 4; ++k) {
                const int e = TOPE[r * 4 + k]; const int row = mro[e] + SLOT[r * 4 + k];
                const unsigned short* yr = YG + (size_t)row * D;
#pragma unroll
                for (int j = 0; j < 4; ++j) { const pg8::u32x2 t = *(const pg8::u32x2*)(yr + j * 256 + lane * 4);
                    acc[4 * j] += __uint_as_float(t.x << 16); acc[4 * j + 1] += __uint_as_float(t.x & 0xffff0000u); acc[4 * j + 2] += __uint_as_float(t.y << 16); acc[4 * j + 3] += __uint_as_float(t.y & 0xffff0000u); }
            }
            float v[16]; float ss = 0.f;
#pragma unroll
            for (int j = 0; j < 4; ++j) { const pg8::u32x2 tw = *(const pg8::u32x2*)(X1 + (size_t)r * D + j * 256 + lane * 4); const float4 t = make_float4(__uint_as_float(tw.x << 16), __uint_as_float(tw.x & 0xffff0000u), __uint_as_float(tw.y << 16), __uint_as_float(tw.y & 0xffff0000u)); const int c = j * 256 + lane * 4;
                v[4 * j] = t.x + g2[c] * acc[4 * j]; v[4 * j + 1] = t.y + g2[c + 1] * acc[4 * j + 1]; v[4 * j + 2] = t.z + g2[c + 2] * acc[4 * j + 2]; v[4 * j + 3] = t.w + g2[c + 3] * acc[4 * j + 3];
                ss += v[4 * j] * v[4 * j] + v[4 * j + 1] * v[4 * j + 1] + v[4 * j + 2] * v[4 * j + 2] + v[4 * j + 3] * v[4 * j + 3]; }
            const float rstd = rsqrtf(wave_sum(ss) * (1.f / D) + EPS);
#pragma unroll
            for (int j = 0; j < 4; ++j) { const int c = j * 256 + lane * 4;
                *(float4*)(pk->out + (size_t)r * D + c) = make_float4(v[4 * j] * rstd * fng[c], v[4 * j + 1] * rstd * fng[c + 1], v[4 * j + 2] * rstd * fng[c + 2], v[4 * j + 3] * rstd * fng[c + 3]); }
        }
    }
    PH_END(11)
#undef IN
#undef SEAM
}

#ifndef PROBE_SPLIT_DUP
#define PROBE_SPLIT_DUP (-1)
#endif
#ifndef N_LAUNCH_SPLIT
#define N_LAUNCH_SPLIT 0
#endif

extern "C" void kernel_launch(void* const* d_in, const int* in_sizes, int n_in, void* d_out, int out_size, void* d_ws, size_t ws_size, hipStream_t stream) {
    static int grid = 0;
    if (grid == 0) {
        if (n_in != 23 || out_size != MX * D || ws_size < WS_END) { fprintf(stderr, "kernel_launch: unexpected shapes n_in %d out %d ws %zu (need %zu)\n", n_in, out_size, ws_size, (size_t)WS_END); grid = -1; return; }
        int dev = 0, cus = 0, per_cu = 0;
        hipGetDevice(&dev); hipDeviceGetAttribute(&cus, hipDeviceAttributeMultiprocessorCount, dev);
        if (hipFuncSetAttribute((const void*)fwd_kernel, hipFuncAttributeMaxDynamicSharedMemorySize, LDS_BYTES) != hipSuccess) { fprintf(stderr, "kernel_launch: hipFuncSetAttribute failed\n"); grid = -1; return; }
        hipOccupancyMaxActiveBlocksPerMultiprocessor(&per_cu, (const void*)fwd_kernel, NT, LDS_BYTES);
        if (per_cu < 1) fprintf(stderr, "kernel_launch: occupancy query says %d\n", per_cu);
        (void)hipGetLastError();
        grid = cus > 0 ? cus : 256;
    }
    if (grid < 0) return;
    hipMemsetAsync((char*)d_ws + WS_CTL, 0, CTL_BYTES, stream);
    Params p{};
    for (int i = 0; i < 23; ++i) p.in[i] = (const float*)d_in[i];
    p.out = (float*)d_out; p.ws = (unsigned char*)d_ws;
#if N_LAUNCH_SPLIT
    for (int k = 0; k < N_PHASES; ++k) {
        if (k == 3) continue;
        const int reps = (k == PROBE_SPLIT_DUP) ? 2 : 1;
        for (int r = 0; r < reps; ++r) {
            if (k == 8 && r == 1) hipMemsetAsync((char*)d_ws + WS_CTL, 0, CTL_BYTES, stream);
            p.ph_lo = k; p.ph_hi = k + 1; hipLaunchKernelGGL(fwd_kernel, dim3(grid), dim3(NT), LDS_BYTES, stream, p);
        }
    }
#else
    p.ph_lo = 0; p.ph_hi = N_PHASES;
    hipLaunchKernelGGL(fwd_kernel, dim3(grid), dim3(NT), LDS_BYTES, stream, p);
#endif
}
```

```cpp
#include <hip/hip_runtime.h>
#include <cstdio>
#include <cstdint>

#define LAS __attribute__((address_space(3)))

#define XB_TMO      128
#define XB_XCNT(j)  (256  + 64 * (j))
#define XB_XSUB(j)  (1280 + 64 * (j))
#define XB_XGEN(j)  (2304 + 64 * (j))
#define XB_TOP      3328
#define XB_TOPGEN   3392
#define XCD_BAR_WORDS 3456
#define XB_SPIN_CAP (1u << 22)

__device__ __forceinline__ unsigned xb_ld(unsigned* p)              { return __hip_atomic_load(p, __ATOMIC_RELAXED, __HIP_MEMORY_SCOPE_AGENT); }
__device__ __forceinline__ unsigned xb_add(unsigned* p, unsigned v) { return __hip_atomic_fetch_add(p, v, __ATOMIC_RELAXED, __HIP_MEMORY_SCOPE_AGENT); }
__device__ __forceinline__ unsigned xb_xcc_id() { return (unsigned)__builtin_amdgcn_s_getreg((3 << 11) | 20) & 0xFu; }
#define XB_SPIN(cond, bar) do { unsigned _sp = 0; while (cond) { __builtin_amdgcn_s_sleep(1); \
    if ((++_sp & 255u) == 0u) { if (xb_ld(&(bar)[XB_TMO])) break; if (_sp > XB_SPIN_CAP) { atomicAdd(&(bar)[XB_TMO], 1u); break; } } } } while (0)

struct XcdBarrier { unsigned* bar; unsigned x; volatile LAS unsigned* st; };

__device__ __forceinline__ XcdBarrier xcd_barrier_post(unsigned* bar, volatile LAS unsigned* st) {
    XcdBarrier b; b.bar = bar; b.x = xb_xcc_id(); b.st = st;
    if (threadIdx.x == 0) (void)xb_add(&bar[XB_XCNT(b.x)], 1u);
    return b;
}
__device__ __forceinline__ void xcd_barrier_complete(unsigned* bar, unsigned x, unsigned& nloc, unsigned& nx) {
    const unsigned G = gridDim.x * gridDim.y * gridDim.z;
    unsigned sum, cnt, mine, sp = 0u;
    for (;;) {
        sum = 0u; cnt = 0u; mine = 0u;
#pragma unroll
        for (unsigned j = 0; j < 16; ++j) { const unsigned c = xb_ld(&bar[XB_XCNT(j)]); sum += c; cnt += (c > 0u) ? 1u : 0u; mine = (j == x) ? c : mine; }
        if (sum == G) break;
        __builtin_amdgcn_s_sleep(1);
        if ((++sp & 255u) == 0u) { if (xb_ld(&bar[XB_TMO])) break; if (sp > XB_SPIN_CAP) { atomicAdd(&bar[XB_TMO], 1u); break; } }
    }
    nloc = mine > 0u ? mine : 1u; nx = cnt > 0u ? cnt : 1u;
}
__device__ __forceinline__ void xcd_barrier(const XcdBarrier& b) {
    asm volatile("s_waitcnt vmcnt(0)" ::: "memory");
    __syncthreads();
    if (threadIdx.x == 0) {
        unsigned* bar = b.bar;
        __builtin_amdgcn_s_waitcnt(0);
        unsigned nloc = b.st[0], nx = b.st[1];
        if (nloc == 0u) { xcd_barrier_complete(bar, b.x, nloc, nx); b.st[0] = nloc; b.st[1] = nx; }
        const unsigned old = xb_add(&bar[XB_XSUB(b.x)], 1u);
        const unsigned gen = old / nloc;
        if (old + 1u == (gen + 1u) * nloc) {
            __builtin_amdgcn_fence(__ATOMIC_RELEASE, "agent");
            asm volatile("s_waitcnt vmcnt(0)" ::: "memory");
            const unsigned og = xb_add(&bar[XB_TOP], 1u);
            const unsigned tg = og / nx;
            if (og + 1u == (tg + 1u) * nx) xb_add(&bar[XB_TOPGEN], 1u);
            else XB_SPIN(xb_ld(&bar[XB_TOPGEN]) == tg, bar);
            __builtin_amdgcn_fence(__ATOMIC_ACQUIRE, "agent");
            xb_add(&bar[XB_XGEN(b.x)], 1u);
            asm volatile("s_waitcnt vmcnt(0)" ::: "memory");
        } else {
            XB_SPIN(xb_ld(&bar[XB_XGEN(b.x)]) == gen, bar);
            __builtin_amdgcn_fence(__ATOMIC_ACQUIRE, "agent");
            asm volatile("s_waitcnt vmcnt(0)" ::: "memory");
        }
    }
    __syncthreads();
}

#ifndef MOE_FP8
#define MOE_FP8 1
#endif
constexpr int D = 1024, NB = 4, S = 4096, CTX = 256, SKV = S + CTX;
constexpr int MX = NB * S, MC = NB * CTX, MT = MX + MC;
constexpr int INW = 2224, PW = 2304;
constexpr int O_CQ = 0, O_CKV = 384, O_KR = 640, O_MQ = 672, O_MK = 928, O_MV = 1184, O_MO = 1696, O_G = 2208;
constexpr int QL = 384, KVL = 256, HA = 8, DN = 64, DR = 32, DQK = 96, DVH = 64;
constexpr int NH = 4, MDQK = 64, MDV = 128;
constexpr int NE = 32, TOPK = 4, DFF = 1024;
constexpr float EPS = 1e-6f;
constexpr int NT = 512;
constexpr int NSEQ = NB * NH * 2;
constexpr int RCAP = MX * TOPK + NE * 256;

constexpr size_t MiB = 1u << 20;
constexpr size_t WS_CTL = 0, CTL_BYTES = 1 * MiB;
constexpr size_t WS_MOD = 1 * MiB;
constexpr size_t WS_MLS = 2 * MiB;
constexpr size_t WS_ROPE = 5 * MiB;
constexpr size_t WS_STAT2 = 6 * MiB;
constexpr size_t WS_TOPE = 8 * MiB;
constexpr size_t WS_SLOT = 9 * MiB;
constexpr size_t WS_LIST = 10 * MiB;
constexpr size_t WS_RGATE = 12 * MiB;
constexpr size_t WS_H = 16 * MiB;
constexpr size_t WS_P = 52 * MiB;
constexpr size_t WS_ACT = WS_P;
constexpr size_t WS_Q = 206 * MiB;
constexpr size_t WS_KV = 254 * MiB;
constexpr size_t WS_CLOC = 322 * MiB;
constexpr size_t WS_CIN = 386 * MiB;
constexpr size_t WS_X1 = 450 * MiB;
constexpr size_t WS_H2 = 514 * MiB;
constexpr size_t WS_YG = 546 * MiB;
constexpr size_t WS_WGUT = 690 * MiB;
constexpr size_t WS_WDNT = 818 * MiB;
constexpr size_t WS_WINT = 882 * MiB;
constexpr size_t WS_WUQT = 887 * MiB;
constexpr size_t WS_WUKVT = 888 * MiB;
constexpr size_t WS_WOUTT = 889 * MiB;
constexpr size_t WS_GATES = 891 * MiB;
constexpr size_t WS_STAT = 893 * MiB;
constexpr size_t WS_RSTD = 895 * MiB;
constexpr size_t WS_MIX16 = 896 * MiB;
constexpr size_t WS_END = 928 * MiB;
static_assert((size_t)MT * PW * 2 <= 153 * MiB && (size_t)RCAP * DFF * 2 <= 144 * MiB, "map");

constexpr int CW_BAR = 4096;
constexpr int CW_CNT = 16384;
constexpr int CW_QGU = 16384 + 64, CW_QDN = 16384 + 128;
constexpr int GU_CHUNKS = 512, DN_CHUNKS = 256;
#ifndef GU_STATIC
#define GU_STATIC 312
#endif

struct Params {
    const float* in[23];
    float* out;
    unsigned char* ws;
    int ph_lo, ph_hi;
};
enum { I_X = 0, I_C, I_CTX, I_CCTX, I_WMOD, I_BMOD, I_N1G, I_WIN, I_BG, I_QNG, I_WUQ, I_KVNG, I_WUKV, I_MNG, I_WOUT, I_N2G, I_RW, I_RB, I_WGU, I_BGU, I_WDN, I_BDN, I_FNG };

__device__ __forceinline__ float wave_sum(float v) {
#pragma unroll
    for (int o = 1; o < 64; o <<= 1) v += __shfl_xor(v, o);
    return v;
}
__device__ __forceinline__ float bf2f(unsigned short v) { return __uint_as_float(((unsigned)v) << 16); }
__device__ __forceinline__ float sigmoidf_(float x) { return 1.f / (1.f + __expf(-x)); }
__device__ __forceinline__ float siluf_(float x) { return x / (1.f + expf(-x)); }
__device__ __forceinline__ float logsigmoidf_(float x) { return fminf(x, 0.f) - log1pf(expf(-fabsf(x))); }

__device__ __forceinline__ int krow(int b, int key) { return key < CTX ? MX + b * CTX + key : b * S + (key - CTX); }
__device__ __forceinline__ int srow(int b, int dir, int u) {
    if (u < CTX) { const int c = dir ? (CTX - 1 - u) : u; return MX + b * CTX + c; }
    const int tt = u - CTX; const int s = dir ? (S - 1 - tt) : tt; return b * S + s;
}
__device__ __forceinline__ void rope_angles(int s, int j, float& cs, float& sn) {
    const int jj = j & 7; const float pos = (j < 8) ? (float)(s / 64) : (float)(s % 64);
    const float inv = powf(10000.f, -(float)jj / 8.f);
    const float ang = pos * inv; cs = cosf(ang); sn = sinf(ang);
}

struct GemmDesc { const float* A; int lda; const int* arow; int M; const float* B; int ldb; int N; int K; };
template <class Epi>
__device__ __forceinline__ void sgemm_tile(float* lds, const GemmDesc g, int tm, int tn, const Epi& epi) {
    float* As = lds;
    float* Bs = lds + 16 * 132;
    const int tid = threadIdx.x, tx = tid & 15, ty = tid >> 4;
    float acc[4][8];
#pragma unroll
    for (int i = 0; i < 4; ++i)
#pragma unroll
        for (int j = 0; j < 8; ++j) acc[i][j] = 0.f;
    const int ar = tid >> 2, ak = (tid & 3) * 4;
    const int grow = tm * 128 + ar;
    const float* aptr = nullptr;
    if (grow < g.M) { const int r = g.arow ? g.arow[grow] : grow; aptr = g.A + (size_t)r * g.lda + ak; }
    const int bk = tid >> 5, bc = (tid & 31) * 4;
    const int gcol = tn * 128 + bc;
    for (int k0 = 0; k0 < g.K; k0 += 16) {
        float4 av = make_float4(0.f, 0.f, 0.f, 0.f), bv = make_float4(0.f, 0.f, 0.f, 0.f);
        if (aptr) av = *(const float4*)(aptr + k0);
        if (gcol < g.N) bv = *(const float4*)(g.B + (size_t)(k0 + bk) * g.ldb + gcol);
        __syncthreads();
        As[(ak + 0) * 132 + ar] = av.x; As[(ak + 1) * 132 + ar] = av.y; As[(ak + 2) * 132 + ar] = av.z; As[(ak + 3) * 132 + ar] = av.w;
        *(float4*)(Bs + bk * 128 + bc) = bv;
        __syncthreads();
#pragma unroll
        for (int k = 0; k < 16; ++k) {
            const float4 a4 = *(const float4*)(As + k * 132 + ty * 4);
            const float4 b0 = *(const float4*)(Bs + k * 128 + tx * 8), b1 = *(const float4*)(Bs + k * 128 + tx * 8 + 4);
            const float a[4] = {a4.x, a4.y, a4.z, a4.w};
            const float b[8] = {b0.x, b0.y, b0.z, b0.w, b1.x, b1.y, b1.z, b1.w};
#pragma unroll
            for (int i = 0; i < 4; ++i)
#pragma unroll
                for (int j = 0; j < 8; ++j) acc[i][j] = fmaf(a[i], b[j], acc[i][j]);
        }
    }
#pragma unroll
    for (int i = 0; i < 4; ++i) {
        const int r = tm * 128 + ty * 4 + i;
        if (r < g.M) {
#pragma unroll
            for (int j = 0; j < 8; ++j) { const int c = tn * 128 + tx * 8 + j; if (c < g.N) epi(r, c, acc[i][j]); }
        }
    }
}
template <class Epi>
__device__ __forceinline__ void sgemm_phase(float* lds, const GemmDesc g, const Epi& epi, int u0 = 0, int ustride = 0) {
    const int ntm = (g.M + 127) / 128, ntn = (g.N + 127) / 128;
    for (int u = blockIdx.x; u < ntm * ntn; u += gridDim.x) sgemm_tile(lds, g, u / ntn, u % ntn, epi);
}


namespace pg8 {
#define PG8_LAS __attribute__((address_space(3)))
typedef unsigned short bf16_t;
typedef short bf16x8 __attribute__((ext_vector_type(8)));
typedef float f32x4 __attribute__((ext_vector_type(4)));
typedef unsigned u32x4 __attribute__((ext_vector_type(4)));
typedef unsigned u32x2 __attribute__((ext_vector_type(2)));
constexpr int BM = 256, BK = 64, HALF = 128, HTB = HALF * BK * 2, STAGE_BYTES = 8 * HTB, NXCD = 8, WGM = 8;
__host__ __device__ __forceinline__ int lds_byte(int r, int c) { const int st = (r >> 4) * 2 + (c >> 5), rr = r & 15, cc = c & 31, ob = rr * 64 + cc * 2; return st * 1024 + (ob ^ (((ob >> 9) & 1) << 5)); }
__host__ __device__ __forceinline__ void stage_rc(int b, int& R, int& C) { const int st = b / 1024, sb = b % 1024, swz = sb ^ (((sb >> 9) & 1) << 5); R = (st >> 1) * 16 + swz / 64; C = (st & 1) * 32 + (swz % 64) / 2; }
__host__ __device__ __forceinline__ int perm32(int rho) { const int n = rho >> 4, i = rho & 15; return 8 * (i >> 2) + 4 * n + (i & 3); }
__device__ __forceinline__ unsigned cvt_pk_bf16(float lo, float hi) { unsigned r; asm volatile("v_cvt_pk_bf16_f32 %0, %1, %2" : "=v"(r) : "v"(lo), "v"(hi)); return r; }

struct Unit { int pm, pn, g, row0; };

struct PlainSched {
    int nM, nN, nwg, G, c, lda, K; const char* Bt;
    __device__ void init(int M, int N, int K_, int lda_, const void* Bt_, int G_, int c_) { nM = M / BM; nN = N / BM; nwg = nM * nN; G = G_; c = c_; lda = lda_; K = K_; Bt = (const char*)Bt_; }
    __device__ __forceinline__ bool next(int i, Unit& u) const {
        const long L = (long)i * G + c; if (L >= nwg) return false;
        int wgid = (int)L; { const int q = nwg / NXCD, r = nwg % NXCD, xcd = wgid % NXCD, off = wgid / NXCD; wgid = (xcd < r ? xcd * (q + 1) : r * (q + 1) + (xcd - r) * q) + off; }
        const int nig = WGM * nN, gid = wgid / nig, fm = gid * WGM, gsz = (nM - fm) < WGM ? (nM - fm) : WGM;
        u.pm = fm + ((wgid % nig) % gsz); u.pn = (wgid % nig) / gsz; u.g = 0; u.row0 = u.pm * BM; return true;
    }
    __device__ __forceinline__ unsigned a_rowoff(const Unit& u, int r) const { return (unsigned)(u.pm * BM + r) * (unsigned)(lda * 2); }
    __device__ __forceinline__ void rows4(const Unit& u, int R0, int R1, unsigned (&o)[4]) const { o[0] = a_rowoff(u, R0); o[1] = a_rowoff(u, R1); o[2] = a_rowoff(u, HALF + R0); o[3] = a_rowoff(u, HALF + R1); }
    __device__ __forceinline__ const char* b_base(const Unit& u) const { return Bt + (size_t)u.pn * BM * K * 2; }
};

template <class Epi, class Sched, bool ALIGN_EPI, bool F8 = false>
__device__ __forceinline__ void gemm_phase(PG8_LAS unsigned char* lds, const bf16_t* Aptr, const int K, const Sched& S, const Epi& E) {
    const int tid = threadIdx.x, wid = __builtin_amdgcn_readfirstlane(tid >> 6), lane = tid & 63, wr = wid >> 2, wc = wid & 3, fr = lane & 15, fq = lane >> 4;
    const int nt = K / BK;
    unsigned voffB[2];
#pragma unroll
    for (int i = 0; i < 2; ++i) { int R, C; stage_rc(tid * 16 + i * 8192, R, C); const int Rb = Epi::PERM ? ((R & ~31) + perm32(R & 31)) : R;
        voffB[i] = (unsigned)(Rb * K + C) * 2u; }
    const size_t kstep = (size_t)(BK * 2);
    const size_t hstepB = (size_t)HALF * K * 2;
    const unsigned ldsw = (unsigned)wid * 1024u;
    const int aoff = lds_byte(wr * 64 + fr, fq * 8), boff = lds_byte(wc * 32 + fr, fq * 8);
#define PG8_SA(b, h) (((b) * 2 + (h)) * HTB)
#define PG8_SB(b, h) ((4 + (b) * 2 + (h)) * HTB)
#define PG8_STAGE(bufoff, gbase, voff) do { _Pragma("unroll") for (int _i = 0; _i < 2; ++_i) \
        __builtin_amdgcn_global_load_lds((const unsigned*)((const char*)(gbase) + (voff)[_i]), (PG8_LAS unsigned*)(lds + (bufoff) + ldsw + _i * 8192), 16, 0, 0); } while (0)
#define PG8_LDA(dst, b, h) do { _Pragma("unroll") for (int m = 0; m < 4; ++m) _Pragma("unroll") for (int k = 0; k < 2; ++k) dst[m][k] = *(const PG8_LAS bf16x8*)(lds + PG8_SA(b, h) + aoff + m * 2048 + k * 1024); } while (0)
#define PG8_LDB(dst, b, h) do { _Pragma("unroll") for (int n = 0; n < 2; ++n) _Pragma("unroll") for (int k = 0; k < 2; ++k) dst[n][k] = *(const PG8_LAS bf16x8*)(lds + PG8_SB(b, h) + boff + n * 2048 + k * 1024); } while (0)
typedef int i32x4v __attribute__((ext_vector_type(4)));
typedef int i32x8v __attribute__((ext_vector_type(8)));
#define PG8_CAT(x0, x1) __builtin_shufflevector(__builtin_bit_cast(i32x4v, x0), __builtin_bit_cast(i32x4v, x1), 0, 1, 2, 3, 4, 5, 6, 7)
#define PG8_MMA(ai, bj, At, Bt) do { __builtin_amdgcn_s_setprio(1); \
        if constexpr (F8) { _Pragma("unroll") for (int m = 0; m < 4; ++m) _Pragma("unroll") for (int n = 0; n < 2; ++n) \
            acc[ai][bj][m][n] = __builtin_amdgcn_mfma_scale_f32_16x16x128_f8f6f4(PG8_CAT(Bt[n][0], Bt[n][1]), PG8_CAT(At[m][0], At[m][1]), acc[ai][bj][m][n], 0, 0, 0, 0x79797979, 0, 0x7f7f7f7f); } \
        else { _Pragma("unroll") for (int m = 0; m < 4; ++m) _Pragma("unroll") for (int n = 0; n < 2; ++n) _Pragma("unroll") for (int k = 0; k < 2; ++k) \
            acc[ai][bj][m][n] = __builtin_amdgcn_mfma_f32_16x16x32_bf16(Bt[n][k], At[m][k], acc[ai][bj][m][n], 0, 0, 0); } \
        __builtin_amdgcn_s_setprio(0); } while (0)
#define PG8_WAIT_V(n) asm volatile("s_waitcnt vmcnt(" #n ")" ::: "memory")
#define PG8_WAIT_L(n) asm volatile("s_waitcnt lgkmcnt(" #n ")" ::: "memory")
#define PG8_BAR __builtin_amdgcn_s_barrier()
#define PG8_SCHED __builtin_amdgcn_sched_barrier(0)
    Unit cur, nxt; int ui = 0;
    if (!S.next(0, cur)) return;
    f32x4 acc[2][2][4][2];
#pragma unroll
    for (int a = 0; a < 2; ++a)
#pragma unroll
        for (int b = 0; b < 2; ++b)
#pragma unroll
            for (int m = 0; m < 4; ++m)
#pragma unroll
                for (int n = 0; n < 2; ++n) acc[a][b][m][n] = (f32x4){0.f, 0.f, 0.f, 0.f};
    bf16x8 At[4][2], B0[2][2], B1[2][2];
    unsigned oA0[2], oA1[2];
    { int R0, C0, R1, C1; stage_rc(tid * 16, R0, C0); stage_rc(tid * 16 + 8192, R1, C1); unsigned o4[4]; S.rows4(cur, R0, R1, o4);
      oA0[0] = o4[0] + (unsigned)C0 * 2u; oA0[1] = o4[1] + (unsigned)C1 * 2u; oA1[0] = o4[2] + (unsigned)C0 * 2u; oA1[1] = o4[3] + (unsigned)C1 * 2u; }
    const char* const cA = (const char*)Aptr;
    const char* cB = S.b_base(cur);
    PG8_STAGE(PG8_SB(0, 0), cB, voffB); PG8_STAGE(PG8_SB(0, 1), cB + hstepB, voffB); PG8_STAGE(PG8_SA(0, 0), cA, oA0); PG8_STAGE(PG8_SA(0, 1), cA, oA1);
    if (wr == 1) PG8_BAR;
    PG8_WAIT_V(2); PG8_BAR;
    PG8_STAGE(PG8_SB(1, 0), cB + kstep, voffB); PG8_STAGE(PG8_SA(1, 0), cA + kstep, oA0); PG8_STAGE(PG8_SB(1, 1), cB + hstepB + kstep, voffB);
    PG8_WAIT_V(6); PG8_BAR;
    for (;;) {
        const bool has_next = S.next(ui + 1, nxt);
        const char* nB = has_next ? S.b_base(nxt) : cB;
        unsigned pre[4] = {0u, 0u, 0u, 0u};
        if (has_next) { int R0, C0, R1, C1; stage_rc((int)threadIdx.x * 16, R0, C0); stage_rc((int)threadIdx.x * 16 + 8192, R1, C1); S.rows4(nxt, R0, R1, pre);
            asm volatile("" : "+v"(pre[0]), "+v"(pre[1]), "+v"(pre[2]), "+v"(pre[3])); }
#pragma unroll 1
        for (int t = 0; t < nt; t += 2) {
            const bool last = (t == nt - 2);
            const char* a1 = cA + (size_t)(t + 1) * kstep;
            const char* a2 = last ? cA : cA + (size_t)(t + 2) * kstep; const char* b2 = last ? nB : cB + (size_t)(t + 2) * kstep;
            const char* a3 = a2 + kstep; const char* b3 = b2 + kstep;
            PG8_LDB(B0, 0, 0); PG8_LDB(B1, 0, 1); PG8_SCHED; PG8_LDA(At, 0, 0); PG8_STAGE(PG8_SA(1, 1), a1, oA1);
            if (last && has_next) {
                int R0, C0, R1, C1; stage_rc((int)threadIdx.x * 16, R0, C0); stage_rc((int)threadIdx.x * 16 + 8192, R1, C1);
                oA0[0] = pre[0] + (unsigned)C0 * 2u; oA0[1] = pre[1] + (unsigned)C1 * 2u; oA1[0] = pre[2] + (unsigned)C0 * 2u; oA1[1] = pre[3] + (unsigned)C1 * 2u;
            }
            PG8_WAIT_V(8); PG8_WAIT_L(0); PG8_BAR; PG8_MMA(0, 0, At, B0); PG8_MMA(0, 1, At, B1); PG8_BAR; PG8_SCHED;
            PG8_LDA(At, 0, 1); PG8_STAGE(PG8_SB(0, 0), b2, voffB); PG8_STAGE(PG8_SB(0, 1), b2 + hstepB, voffB); PG8_STAGE(PG8_SA(0, 0), a2, oA0);
            PG8_WAIT_V(8); PG8_WAIT_L(0); PG8_BAR; PG8_MMA(1, 0, At, B0); PG8_MMA(1, 1, At, B1); PG8_BAR; PG8_SCHED;
            PG8_LDB(B0, 1, 0); PG8_LDB(B1, 1, 1); PG8_SCHED; PG8_LDA(At, 1, 0); PG8_STAGE(PG8_SA(0, 1), a2, oA1);
            PG8_WAIT_V(8); PG8_WAIT_L(0); PG8_BAR; PG8_MMA(0, 0, At, B0); PG8_MMA(0, 1, At, B1); PG8_BAR; PG8_SCHED;
            PG8_LDA(At, 1, 1); PG8_STAGE(PG8_SB(1, 0), b3, voffB); PG8_STAGE(PG8_SB(1, 1), b3 + hstepB, voffB); PG8_STAGE(PG8_SA(1, 0), a3, oA0);
            PG8_WAIT_V(8); PG8_WAIT_L(0); PG8_BAR; PG8_MMA(1, 0, At, B0); PG8_MMA(1, 1, At, B1); PG8_BAR; PG8_SCHED;
        }
        if constexpr (ALIGN_EPI) { if (wr == 0) PG8_BAR; }
        E(acc, cur, wr, wc, fr, fq);
        if (!has_next) break;
#pragma unroll
        for (int a = 0; a < 2; ++a)
#pragma unroll
            for (int b = 0; b < 2; ++b)
#pragma unroll
                for (int m = 0; m < 4; ++m)
#pragma unroll
                    for (int n = 0; n < 2; ++n) acc[a][b][m][n] = (f32x4){0.f, 0.f, 0.f, 0.f};
        cur = nxt; cB = nB; ++ui;
        if constexpr (ALIGN_EPI) { if (wr == 1) PG8_BAR; }
    }
    PG8_WAIT_V(0);
    if constexpr (!ALIGN_EPI) { if (wr == 0) PG8_BAR; }
    PG8_BAR;
#undef PG8_SA
#undef PG8_SB
#undef PG8_STAGE
#undef PG8_LDA
#undef PG8_LDB
#undef PG8_MMA
#undef PG8_CAT
#undef PG8_WAIT_V
#undef PG8_WAIT_L
#undef PG8_BAR
#undef PG8_SCHED
}

struct EpiF32 {
    static constexpr bool PERM = false;
    float* C; int ldc; int ncols;
    __device__ __forceinline__ void operator()(const f32x4 (&acc)[2][2][4][2], const Unit& u, int wr, int wc, int fr, int fq) const {
        const int row0 = u.row0 + wr * 64 + fr, col0 = u.pn * BM + wc * 32 + 4 * fq;
#pragma unroll
        for (int ai = 0; ai < 2; ++ai)
#pragma unroll
            for (int m = 0; m < 4; ++m) { float* rowp = C + (size_t)(row0 + ai * HALF + m * 16) * ldc + col0;
#pragma unroll
                for (int bj = 0; bj < 2; ++bj)
#pragma unroll
                    for (int n = 0; n < 2; ++n) if (col0 + bj * HALF + n * 16 < ncols) *(f32x4*)(rowp + bj * HALF + n * 16) = acc[ai][bj][m][n]; }
    }
};
struct MoeSched {
    const PG8_LAS int* tp; const PG8_LAS int* ro; const PG8_LAS int* cn; int nN, G, c, K, lda, gather; const int* list; const char* Bt; size_t bstride;
    __device__ __forceinline__ bool next(int i, Unit& u) const {
        const int nwg = tp[32] * nN; const long L = (long)i * G + c; if (L >= nwg) return false;
        int wgid = (int)L; { const int q = nwg / NXCD, r = nwg % NXCD, xcd = wgid % NXCD, off = wgid / NXCD; wgid = (xcd < r ? xcd * (q + 1) : r * (q + 1) + (xcd - r) * q) + off; }
        const int tile = wgid / nN;
        const int g = __popcll(__ballot(tp[threadIdx.x & 31] <= tile) & 0xffffffffull) - 1;
        const int ntm = tp[g + 1] - tp[g]; const int rem = wgid - tp[g] * nN;
        u.g = g; u.pm = rem % ntm; u.pn = rem / ntm; u.row0 = ro[g] + u.pm * BM; return true;
    }
    __device__ __forceinline__ unsigned a_rowoff(const Unit& u, int r) const {
        const int rr = u.pm * BM + r;
        if (gather) { const int tok = (rr < cn[u.g]) ? list[u.g * 16384 + rr] : 0; return (unsigned)tok * (unsigned)(lda * 2); }
        return (unsigned)(u.row0 + r) * (unsigned)(lda * 2);
    }
    __device__ __forceinline__ void rows4(const Unit& u, int R0, int R1, unsigned (&o)[4]) const {
        if (gather) { const int last = cn[u.g] - 1, b0 = u.pm * BM; const int* lp = list + u.g * 16384;
            const int t0 = lp[min(b0 + R0, last)], t1 = lp[min(b0 + R1, last)], t2 = lp[min(b0 + HALF + R0, last)], t3 = lp[min(b0 + HALF + R1, last)];
            o[0] = (unsigned)t0 * (unsigned)(lda * 2); o[1] = (unsigned)t1 * (unsigned)(lda * 2); o[2] = (unsigned)t2 * (unsigned)(lda * 2); o[3] = (unsigned)t3 * (unsigned)(lda * 2); }
        else { o[0] = a_rowoff(u, R0); o[1] = a_rowoff(u, R1); o[2] = a_rowoff(u, HALF + R0); o[3] = a_rowoff(u, HALF + R1); }
    }
    __device__ __forceinline__ const char* b_base(const Unit& u) const { return Bt + (size_t)u.g * bstride + (size_t)u.pn * BM * K * 2; }
};
struct EpiSwiglu {
    static constexpr bool PERM = true;
    bf16_t* O; const float* bias;
    __device__ __forceinline__ void operator()(const f32x4 (&acc)[2][2][4][2], const Unit& u, int wr, int wc, int fr, int fq) const {
        const int row0 = u.row0 + wr * 64 + fr, col0 = u.pn * 128 + wc * 32 + 8 * fq;
        const float* bg = bias + (size_t)u.g * 2048 + col0;
        f32x4 bgl[2], bln[2];
#pragma unroll
        for (int n = 0; n < 2; ++n) { bgl[n] = *(const f32x4*)(bg + 4 * n); bln[n] = *(const f32x4*)(bg + 1024 + 4 * n); }
#pragma unroll
        for (int ai = 0; ai < 2; ++ai)
#pragma unroll
            for (int m = 0; m < 4; ++m) {
                float o[8];
#pragma unroll
                for (int n = 0; n < 2; ++n)
#pragma unroll
                    for (int j = 0; j < 4; ++j) {
                        const float gl = fminf(acc[ai][0][m][n][j] + bgl[n][j], 7.f);
                        const float ln = fminf(fmaxf(acc[ai][1][m][n][j] + bln[n][j], -7.f), 7.f);
                        o[4 * n + j] = gl * __builtin_amdgcn_rcpf(1.f + __expf(-1.702f * gl)) * (ln + 1.f);
                    }
#if MOE_FP8
                u32x2 w8; { int t0 = __builtin_amdgcn_cvt_pk_fp8_f32(o[0], o[1], 0, false); t0 = __builtin_amdgcn_cvt_pk_fp8_f32(o[2], o[3], t0, true); int t1 = __builtin_amdgcn_cvt_pk_fp8_f32(o[4], o[5], 0, false); t1 = __builtin_amdgcn_cvt_pk_fp8_f32(o[6], o[7], t1, true); w8.x = (unsigned)t0; w8.y = (unsigned)t1; }
                *(u32x2*)((unsigned char*)O + (size_t)(row0 + ai * HALF + m * 16) * 1024 + col0) = w8;
#else
                u32x4 w; w.x = cvt_pk_bf16(o[0], o[1]); w.y = cvt_pk_bf16(o[2], o[3]); w.z = cvt_pk_bf16(o[4], o[5]); w.w = cvt_pk_bf16(o[6], o[7]);
                *(u32x4*)(O + (size_t)(row0 + ai * HALF + m * 16) * 1024 + col0) = w;
#endif
            }
    }
};
struct EpiDown {
    static constexpr bool PERM = true;
    bf16_t* O; const float* bias; const float* rgate; const PG8_LAS int* ro;
    __device__ __forceinline__ void operator()(const f32x4 (&acc)[2][2][4][2], const Unit& u, int wr, int wc, int fr, int fq) const {
        const int row0 = u.row0 + wr * 64 + fr, col0 = u.pn * BM + wc * 32 + 8 * fq;
        const float* bd = bias + (size_t)u.g * 1024 + col0;
        const float* gt = rgate + (size_t)u.g * 16384 + (row0 - ro[u.g]);
        f32x4 bv[2][2];
#pragma unroll
        for (int bj = 0; bj < 2; ++bj)
#pragma unroll
            for (int n = 0; n < 2; ++n) bv[bj][n] = *(const f32x4*)(bd + bj * HALF + 4 * n);
#pragma unroll
        for (int ai = 0; ai < 2; ++ai)
#pragma unroll
            for (int m = 0; m < 4; ++m) {
                const float gv = gt[ai * HALF + m * 16];
                bf16_t* rowp = O + (size_t)(row0 + ai * HALF + m * 16) * 1024 + col0;
#pragma unroll
                for (int bj = 0; bj < 2; ++bj) { const f32x4 v0 = (acc[ai][bj][m][0] + bv[bj][0]) * gv, v1 = (acc[ai][bj][m][1] + bv[bj][1]) * gv;
                    u32x4 w; w.x = cvt_pk_bf16(v0[0], v0[1]); w.y = cvt_pk_bf16(v0[2], v0[3]); w.z = cvt_pk_bf16(v1[0], v1[1]); w.w = cvt_pk_bf16(v1[2], v1[3]);
                    *(u32x4*)(rowp + bj * HALF) = w; }
            }
    }
};
struct EpiInproj {
    static constexpr bool PERM = true;
    bf16_t* P; float* gates; float* stat; bf16_t* Kb; const float* cs; const float* sn;
    __device__ __forceinline__ void operator()(const f32x4 (&acc)[2][2][4][2], const Unit& u, int wr, int wc, int fr, int fq) const {
        const int row0 = u.row0 + wr * 64 + fr, colb = u.pn * BM + wc * 32 + 8 * fq;
#pragma unroll
        for (int ai = 0; ai < 2; ++ai)
#pragma unroll
            for (int m = 0; m < 4; ++m) { const int row = row0 + ai * HALF + m * 16;
#pragma unroll
                for (int bj = 0; bj < 2; ++bj) { const f32x4 v0 = acc[ai][bj][m][0], v1 = acc[ai][bj][m][1];
                    u32x4 w; w.x = cvt_pk_bf16(v0[0], v0[1]); w.y = cvt_pk_bf16(v0[2], v0[3]); w.z = cvt_pk_bf16(v1[0], v1[1]); w.w = cvt_pk_bf16(v1[2], v1[3]);
                    *(u32x4*)(P + (size_t)row * 2304 + colb + bj * HALF) = w;
                    if (u.pn <= 2) { float sq = (v0[0] * v0[0] + v0[1] * v0[1]) + (v0[2] * v0[2] + v0[3] * v0[3]) + (v1[0] * v1[0] + v1[1] * v1[1]) + (v1[2] * v1[2] + v1[3] * v1[3]);
                        sq += __shfl_xor(sq, 16); sq += __shfl_xor(sq, 32);
                        if (fq == 0) stat[(size_t)row * 24 + (u.pn * 2 + bj) * 4 + wc] = sq; }
                    if (u.pn == 8 && bj == 1 && wc == 1 && fq < 2) { *(f32x4*)(gates + (size_t)row * 16 + fq * 8) = v0; *(f32x4*)(gates + (size_t)row * 16 + fq * 8 + 4) = v1; }
                    if (u.pn == 2 && bj == 1 && wc == 0) {
                        f32x4 r0 = v0, r1 = v1;
                        f32x4 o0, o1;
#pragma unroll
                        for (int j = 0; j < 4; ++j) { o0[j] = __shfl_xor(v0[j], 32); o1[j] = __shfl_xor(v1[j], 32); }
                        int krow;
                        if (row < 16384) { const int pos = row & 4095; const int jb = 8 * (fq & 1);
                            const f32x4 c0 = *(const f32x4*)(cs + pos * 16 + jb), c1 = *(const f32x4*)(cs + pos * 16 + jb + 4), s0 = *(const f32x4*)(sn + pos * 16 + jb), s1 = *(const f32x4*)(sn + pos * 16 + jb + 4);
                            if (fq < 2) { r0 = v0 * c0 - o0 * s0; r1 = v1 * c1 - o1 * s1; } else { r0 = o0 * s0 + v0 * c0; r1 = o1 * s1 + v1 * c1; }
                            krow = (row >> 12) * 4352 + 256 + pos; }
                        else krow = ((row - 16384) >> 8) * 4352 + ((row - 16384) & 255);
                        u32x4 kw; kw.x = cvt_pk_bf16(r0[0], r0[1]); kw.y = cvt_pk_bf16(r0[2], r0[3]); kw.z = cvt_pk_bf16(r1[0], r1[1]); kw.w = cvt_pk_bf16(r1[2], r1[3]);
#pragma unroll
                        for (int hh = 0; hh < 8; ++hh) *(u32x4*)(Kb + (size_t)krow * 768 + hh * 96 + 64 + 8 * fq) = kw;
                    }
                } }
    }
};
struct EpiF32RowScale {
    static constexpr bool PERM = false;
    float* C; int ldc; const float* rs;
    __device__ __forceinline__ void operator()(const f32x4 (&acc)[2][2][4][2], const Unit& u, int wr, int wc, int fr, int fq) const {
        const int row0 = u.row0 + wr * 64 + fr, col0 = u.pn * BM + wc * 32 + 4 * fq;
#pragma unroll
        for (int ai = 0; ai < 2; ++ai)
#pragma unroll
            for (int m = 0; m < 4; ++m) { const int row = row0 + ai * HALF + m * 16; const float sc = rs[row]; float* rowp = C + (size_t)row * ldc + col0;
#pragma unroll
                for (int bj = 0; bj < 2; ++bj)
#pragma unroll
                    for (int n = 0; n < 2; ++n) *(f32x4*)(rowp + bj * HALF + n * 16) = acc[ai][bj][m][n] * sc; }
    }
};
struct EpiResid {
    static constexpr bool PERM = true;
    bf16_t* C; const float* X; const float* mod; float* stat2;
    __device__ __forceinline__ void operator()(const f32x4 (&acc)[2][2][4][2], const Unit& u, int wr, int wc, int fr, int fq) const {
        const int row0 = u.row0 + wr * 64 + fr, col0 = u.pn * BM + wc * 32 + 8 * fq;
        const float* g1 = mod + (size_t)(u.row0 / 4096) * 6144 + 2048 + col0;
        f32x4 gv[2][2];
#pragma unroll
        for (int bj = 0; bj < 2; ++bj)
#pragma unroll
            for (int n = 0; n < 2; ++n) gv[bj][n] = *(const f32x4*)(g1 + bj * HALF + 4 * n);
#pragma unroll
        for (int ai = 0; ai < 2; ++ai)
#pragma unroll
            for (int m = 0; m < 4; ++m) { const size_t off = (size_t)(row0 + ai * HALF + m * 16) * 1024 + col0;
#pragma unroll
                for (int bj = 0; bj < 2; ++bj) {
                    const f32x4 x0 = *(const f32x4*)(X + off + bj * HALF), x1 = *(const f32x4*)(X + off + bj * HALF + 4);
                    const f32x4 o0 = x0 + gv[bj][0] * acc[ai][bj][m][0], o1 = x1 + gv[bj][1] * acc[ai][bj][m][1];
                    u32x4 w; w.x = cvt_pk_bf16(o0[0], o0[1]); w.y = cvt_pk_bf16(o0[2], o0[3]); w.z = cvt_pk_bf16(o1[0], o1[1]); w.w = cvt_pk_bf16(o1[2], o1[3]);
                    *(u32x4*)(C + off + bj * HALF) = w;
                    float sq = ((o0[0] * o0[0] + o0[1] * o0[1]) + (o0[2] * o0[2] + o0[3] * o0[3])) + ((o1[0] * o1[0] + o1[1] * o1[1]) + (o1[2] * o1[2] + o1[3] * o1[3]));
                    sq += __shfl_xor(sq, 16); sq += __shfl_xor(sq, 32);
                    if (fq == 0) stat2[(size_t)(row0 + ai * HALF + m * 16) * 32 + (u.pn * 2 + bj) * 4 + wc] = sq; }
                asm volatile("" ::: "memory"); }
    }
};
struct EpiQ {
    static constexpr bool PERM = false;
    bf16_t* Q; const float* stat; const float* cs; const float* sn;
    __device__ __forceinline__ void operator()(const f32x4 (&acc)[2][2][4][2], const Unit& u, int wr, int wc, int fr, int fq) const {
        const int row0 = u.row0 + wr * 64 + fr;
#pragma unroll
        for (int ai = 0; ai < 2; ++ai)
#pragma unroll
            for (int m = 0; m < 4; ++m) { const int row = row0 + ai * HALF + m * 16; const int pos = row & 4095;
                float sc; { const f32x4* sp = (const f32x4*)(stat + (size_t)row * 24); const f32x4 a0 = sp[0], a1 = sp[1], a2 = sp[2];
                    sc = rsqrtf((((a0[0] + a0[1]) + (a0[2] + a0[3])) + ((a1[0] + a1[1]) + (a1[2] + a1[3])) + ((a2[0] + a2[1]) + (a2[2] + a2[3]))) * (1.f / 384.f) + 1e-6f) * 0.14724445f; }
                const f32x4 cv = *(const f32x4*)(cs + pos * 16 + 4 * fq), sv = *(const f32x4*)(sn + pos * 16 + 4 * fq);
#pragma unroll
                for (int bj = 0; bj < 2; ++bj) { const int c32 = u.pn * BM + bj * HALF + wc * 32; const bool rope = ((c32 % 96) == 64);
                    f32x4 v0 = acc[ai][bj][m][0], v1 = acc[ai][bj][m][1];
                    if (rope) { const f32x4 a = v0 * cv - v1 * sv, b = v0 * sv + v1 * cv; v0 = a; v1 = b; }
                    v0 = v0 * sc; v1 = v1 * sc;
                    u32x2 w0, w1; w0.x = cvt_pk_bf16(v0[0], v0[1]); w0.y = cvt_pk_bf16(v0[2], v0[3]); w1.x = cvt_pk_bf16(v1[0], v1[1]); w1.y = cvt_pk_bf16(v1[2], v1[3]);
                    bf16_t* dst = Q + (size_t)row * 768 + c32 + 4 * fq;
                    *(u32x2*)dst = w0; *(u32x2*)(dst + 16) = w1; }
                asm volatile("" ::: "memory"); }
    }
};
struct EpiKV {
    static constexpr bool PERM = true;
    bf16_t* K; bf16_t* V; const float* stat;
    __device__ __forceinline__ void operator()(const f32x4 (&acc)[2][2][4][2], const Unit& u, int wr, int wc, int fr, int fq) const {
        const int row0 = u.row0 + wr * 64 + fr;
#pragma unroll
        for (int ai = 0; ai < 2; ++ai)
#pragma unroll
            for (int m = 0; m < 4; ++m) { const int row = row0 + ai * HALF + m * 16;
                float sc; { const f32x4* sp = (const f32x4*)(stat + (size_t)row * 24); const f32x4 a3 = sp[3], a4 = sp[4];
                    sc = rsqrtf((((a3[0] + a3[1]) + (a3[2] + a3[3])) + ((a4[0] + a4[1]) + (a4[2] + a4[3]))) * (1.f / 256.f) + 1e-6f); }
                const int krow = (row < 16384) ? ((row >> 12) * 4352 + 256 + (row & 4095)) : (((row - 16384) >> 8) * 4352 + ((row - 16384) & 255));
#pragma unroll
                for (int bj = 0; bj < 2; ++bj) { const int head = 2 * u.pn + bj; const f32x4 v0 = acc[ai][bj][m][0] * sc, v1 = acc[ai][bj][m][1] * sc;
                    u32x4 w; w.x = cvt_pk_bf16(v0[0], v0[1]); w.y = cvt_pk_bf16(v0[2], v0[3]); w.z = cvt_pk_bf16(v1[0], v1[1]); w.w = cvt_pk_bf16(v1[2], v1[3]);
                    if (wc < 2) *(u32x4*)(K + (size_t)krow * 768 + head * 96 + wc * 32 + 8 * fq) = w;
                    else *(u32x4*)(V + (size_t)krow * 512 + head * 64 + (wc - 2) * 32 + 8 * fq) = w; }
                asm volatile("" ::: "memory"); }
    }
};
}

template <class RowMap>
__device__ __forceinline__ void transpose_item(const float* W, int K, int N, int nblk, unsigned short* WT, const RowMap& rowmap, LAS float* scr, int item, int lane, const float* kscale = nullptr) {
    const int kb = item / nblk, nb = item % nblk, k0 = 64 * kb, n0 = 32 * nb;
    const int ncol = n0 + (lane & 31);
    float tv[32];
#pragma unroll
    for (int i = 0; i < 32; ++i) { const int kk = 2 * i + (lane >> 5); tv[i] = (ncol < N) ? __builtin_nontemporal_load(W + (size_t)(k0 + kk) * N + ncol) : 0.f; }
    if (kscale) {
#pragma unroll
        for (int i = 0; i < 32; ++i) tv[i] *= kscale[k0 + 2 * i + (lane >> 5)]; }
#pragma unroll
    for (int i = 0; i < 32; ++i) scr[(2 * i + (lane >> 5)) * 33 + (lane & 31)] = tv[i];
    asm volatile("s_waitcnt lgkmcnt(0)" ::: "memory");
    const int c = lane & 7;
    const int r0 = rowmap(n0);
#pragma unroll
    for (int j = 0; j < 4; ++j) { const int n = (lane >> 3) + 8 * j; const LAS float* sp = scr + (8 * c) * 33 + n;
        pg8::u32x4 o; o.x = pg8::cvt_pk_bf16(sp[0 * 33], sp[1 * 33]); o.y = pg8::cvt_pk_bf16(sp[2 * 33], sp[3 * 33]); o.z = pg8::cvt_pk_bf16(sp[4 * 33], sp[5 * 33]); o.w = pg8::cvt_pk_bf16(sp[6 * 33], sp[7 * 33]);
        __builtin_nontemporal_store(o, (pg8::u32x4*)(WT + (size_t)(r0 + n) * K + k0 + 8 * c)); }
    asm volatile("s_waitcnt lgkmcnt(0)" ::: "memory");
}


namespace att {
using bf16x8 = __attribute__((ext_vector_type(8))) short;
using s16x4  = __attribute__((ext_vector_type(4))) short;
using f32x16 = __attribute__((ext_vector_type(16))) float;
using u32x4  = __attribute__((ext_vector_type(4))) unsigned;
constexpr int NW = 8, QBLK = 32, KVBLK = 64;
constexpr float SCALE = 0.10206207261596577f;
constexpr float THR = 8.f;
constexpr int LDQ = 768, LDK = 768, LDV = 512, LDO = 1024;
constexpr int SHM_V = KVBLK * 64 * 2, SHM_K = KVBLK * 256;
constexpr int SHM_ATTN = 2 * SHM_V + 2 * SHM_K + NW * 64 * 4;
#define KSWZ(row, colB) ((row) * 256 + ((colB) ^ (((row) & 7) << 4)))
#define SBAR() __builtin_amdgcn_sched_barrier(0)
__device__ __forceinline__ int crow(int r, int hi) { return (r & 3) + 8 * (r >> 2) + 4 * hi; }
__device__ __forceinline__ unsigned cvtpk(float lo, float hi) { unsigned r; asm volatile("v_cvt_pk_bf16_f32 %0, %1, %2" : "=v"(r) : "v"(lo), "v"(hi)); return r; }

constexpr float THR2 = THR * 1.4426950408889634f;
__device__ __forceinline__ void partialSM(f32x16& p0, f32x16& p1, float& m_run, float& alpha) {
  float pmax = p0[0]; for (int r = 1; r < 16; ++r) pmax = fmaxf(pmax, p0[r]); for (int r = 0; r < 16; ++r) pmax = fmaxf(pmax, p1[r]);
  { auto rr = __builtin_amdgcn_permlane32_swap(__float_as_uint(pmax), __float_as_uint(pmax), false, false);
    pmax = fmaxf(__uint_as_float(rr[0]), __uint_as_float(rr[1])); }
  if (__builtin_expect(__all(fabsf(pmax) <= THR2), 1)) { alpha = 1.f; }
  else { m_run += pmax; alpha = __builtin_amdgcn_exp2f(-pmax);
    for (int r = 0; r < 16; ++r) p0[r] -= pmax; for (int r = 0; r < 16; ++r) p1[r] -= pmax; }
  for (int r = 0; r < 16; ++r) p0[r] = __builtin_amdgcn_exp2f(p0[r]);
}
__device__ __forceinline__ void finishSM(f32x16& p0, f32x16& p1, float alpha, float& l_reg, bf16x8& pa0, bf16x8& pa1, bf16x8& pa2, bf16x8& pa3) {
  for (int r = 0; r < 16; ++r) p1[r] = __builtin_amdgcn_exp2f(p1[r]);
  float ps = 0; for (int r = 0; r < 16; ++r) ps += p0[r]; for (int r = 0; r < 16; ++r) ps += p1[r];
  { auto rr = __builtin_amdgcn_permlane32_swap(__float_as_uint(ps), __float_as_uint(ps), false, false);
    ps = __uint_as_float(rr[0]) + __uint_as_float(rr[1]); }
  l_reg = l_reg * alpha + ps;
#define PK4(P, BASE, OUT) do { unsigned a0 = cvtpk(P[BASE + 0], P[BASE + 1]), a1 = cvtpk(P[BASE + 2], P[BASE + 3]);   \
    unsigned b0 = cvtpk(P[BASE + 4], P[BASE + 5]), b1 = cvtpk(P[BASE + 6], P[BASE + 7]);                              \
    auto r0 = __builtin_amdgcn_permlane32_swap(a0, b0, false, false); auto r1 = __builtin_amdgcn_permlane32_swap(a1, b1, false, false); \
    u32x4 w = {r0[0], r1[0], r0[1], r1[1]}; OUT = *reinterpret_cast<bf16x8*>(&w); } while (0)
  PK4(p0, 0, pa0); PK4(p0, 8, pa1); PK4(p1, 0, pa2); PK4(p1, 8, pa3);
#undef PK4
}
__device__ __forceinline__ void qkt(f32x16& p0, f32x16& p1, const char* Ks, const bf16x8* qr, int r32, int hi, float m_run) {
#pragma unroll
  for (int r = 0; r < 16; ++r) { p0[r] = -m_run; p1[r] = -m_run; }
#pragma unroll
  for (int d0 = 0; d0 < 6; ++d0) { int cb = (d0 * 16 + hi * 8) * 2;
    bf16x8 b0 = *reinterpret_cast<const bf16x8*>(Ks + KSWZ(r32, cb));
    bf16x8 b1 = *reinterpret_cast<const bf16x8*>(Ks + KSWZ(32 + r32, cb));
    p0 = __builtin_amdgcn_mfma_f32_32x32x16_bf16(b0, qr[d0], p0, 0, 0, 0);
    p1 = __builtin_amdgcn_mfma_f32_32x32x16_bf16(b1, qr[d0], p1, 0, 0, 0); }
}
__device__ __forceinline__ int v_st(int k, int c) { const int kk = (k & ~0xC) | ((k & 4) << 1) | ((k & 8) >> 1); return ((kk >> 3) * 2 + (c >> 5)) * 512 + ((kk & 7) * 32 + (c & 31)) * 2; }
__device__ __forceinline__ int v_rd_base(int lane) { return ((lane & 3) << 3) | (((lane >> 2) & 3) << 6) | (((lane >> 4) & 1) << 5) | (((lane >> 5) & 1) << 8); }
constexpr int v_rd_off(int d0, int ks, int half) { return d0 * 512 + ks * 2048 + half * 1024; }
template <int OFF> __device__ __forceinline__ s16x4 tr_read(int vb) {
  s16x4 r; asm volatile("ds_read_b64_tr_b16 %0, %1 offset:%2" : "=&v"(r) : "v"(vb), "i"(OFF) : "memory"); return r;
}
template <int D0> __device__ __forceinline__ void pv_one(f32x16& od, int vb, bf16x8 pa0, bf16x8 pa1, bf16x8 pa2, bf16x8 pa3) {
  const s16x4 l0 = tr_read<v_rd_off(D0, 0, 0)>(vb), h0 = tr_read<v_rd_off(D0, 0, 1)>(vb), l1 = tr_read<v_rd_off(D0, 1, 0)>(vb), h1 = tr_read<v_rd_off(D0, 1, 1)>(vb);
  const s16x4 l2 = tr_read<v_rd_off(D0, 2, 0)>(vb), h2 = tr_read<v_rd_off(D0, 2, 1)>(vb), l3 = tr_read<v_rd_off(D0, 3, 0)>(vb), h3 = tr_read<v_rd_off(D0, 3, 1)>(vb);
  asm volatile("s_waitcnt lgkmcnt(0)" ::: "memory"); SBAR();
#define PK(L, H) (bf16x8){L[0], L[1], L[2], L[3], H[0], H[1], H[2], H[3]}
  od = __builtin_amdgcn_mfma_f32_32x32x16_bf16(pa0, PK(l0, h0), od, 0, 0, 0);
  od = __builtin_amdgcn_mfma_f32_32x32x16_bf16(pa1, PK(l1, h1), od, 0, 0, 0);
  od = __builtin_amdgcn_mfma_f32_32x32x16_bf16(pa2, PK(l2, h2), od, 0, 0, 0);
  od = __builtin_amdgcn_mfma_f32_32x32x16_bf16(pa3, PK(l3, h3), od, 0, 0, 0);
#undef PK
}
__device__ __forceinline__ void pv_d0(f32x16* o, int vb, bf16x8 pa0, bf16x8 pa1, bf16x8 pa2, bf16x8 pa3) {
  pv_one<0>(o[0], vb, pa0, pa1, pa2, pa3); pv_one<1>(o[1], vb, pa0, pa1, pa2, pa3);
}
__device__ __forceinline__ void attn_body(const unsigned short* __restrict__ Qb, const unsigned short* __restrict__ Kh, const unsigned short* __restrict__ Vh,
                                          unsigned short* __restrict__ Ob, int seq, char* lds) {
  const int tid = threadIdx.x, wid = tid >> 6, lane = tid & 63, r32 = lane & 31, hi = lane >> 5;
  char* V_lds = lds; char* K_lds = lds + 2 * SHM_V;
  float* ws = (float*)(lds + 2 * SHM_V + 2 * SHM_K) + wid * 64; float* li_l = ws; float* al_l = ws + 32;
  float m_run = 0.f, l_reg = 0; f32x16 o[2] = {}; bf16x8 qr[6];
  const unsigned short* Qw = Qb + (long)(wid * QBLK + r32) * LDQ + hi * 8;
#pragma unroll
  for (int d0 = 0; d0 < 6; ++d0) qr[d0] = *reinterpret_cast<const bf16x8*>(Qw + d0 * 16);
  const int vr = tid >> 3, vc = (tid & 7) * 8, vst = v_st(vr, vc);
  const int k0r = tid / 12, k0c = tid % 12, id1 = 512 + (tid & 255), k1r = id1 / 12, k1c = id1 % 12;
  const int kst0 = KSWZ(k0r, k0c * 16), kst1 = KSWZ(k1r, k1c * 16);
  const long vg = (long)vr * LDV + vc, kg0 = (long)k0r * LDK + k0c * 8, kg1 = (long)k1r * LDK + k1c * 8;
  const int vb0 = (int)(uintptr_t)V_lds + v_rd_base(lane);
  struct { bf16x8 vs, ks0, ks1; } sr_[2];
#define SLOAD(i, kk0) do { sr_[i].vs = *reinterpret_cast<const bf16x8*>(Vh + (long)(kk0) * LDV + vg); \
    sr_[i].ks0 = *reinterpret_cast<const bf16x8*>(Kh + (long)(kk0) * LDK + kg0); sr_[i].ks1 = *reinterpret_cast<const bf16x8*>(Kh + (long)(kk0) * LDK + kg1); } while (0)
#define SWRITE(b, i) do { *(bf16x8*)(V_lds + (b) * SHM_V + vst) = sr_[i].vs; \
    *(bf16x8*)(K_lds + (b) * SHM_K + kst0) = sr_[i].ks0; *(bf16x8*)(K_lds + (b) * SHM_K + kst1) = sr_[i].ks1; } while (0)
#define SWAIT() asm volatile("s_waitcnt vmcnt(3)" ::: "memory")
#define RESC(a) do { if (__any((a) < 1.f)) { if (hi == 0) al_l[r32] = (a); asm volatile("s_waitcnt lgkmcnt(0)" ::: "memory"); \
    for (int d = 0; d < 2; ++d) for (int r = 0; r < 16; ++r) o[d][r] *= al_l[crow(r, hi)]; } } while (0)
  f32x16 pA0, pA1, pB0, pB1; float alA, alB; bf16x8 pa0, pa1, pa2, pa3; const int NT = seq / KVBLK;
  constexpr int SE = 0, SO = 1;
  SLOAD(SE, 0); asm volatile("s_waitcnt vmcnt(0)" ::: "memory"); SWRITE(0, SE); __syncthreads();
  qkt(pA0, pA1, K_lds, qr, r32, hi, m_run); partialSM(pA0, pA1, m_run, alA);
  SLOAD(SO, KVBLK); if (2 < NT) SLOAD(SE, 2 * KVBLK);
  SWAIT(); SWRITE(1, SO); __syncthreads();
  for (int j = 1; j + 1 < NT; j += 2) {
    SBAR(); qkt(pB0, pB1, K_lds + SHM_K, qr, r32, hi, m_run);
    finishSM(pA0, pA1, alA, l_reg, pa0, pa1, pa2, pa3); SBAR();
    SLOAD(SO, (j + 2) * KVBLK); SBAR();
    pv_d0(o, vb0, pa0, pa1, pa2, pa3); partialSM(pB0, pB1, m_run, alB);
    __syncthreads(); SWAIT(); SWRITE(0, SE);
    RESC(alB); __syncthreads();
    SBAR(); qkt(pA0, pA1, K_lds, qr, r32, hi, m_run);
    finishSM(pB0, pB1, alB, l_reg, pa0, pa1, pa2, pa3); SBAR();
    if (j + 3 < NT) SLOAD(SE, (j + 3) * KVBLK); SBAR();
    pv_d0(o, vb0 + SHM_V, pa0, pa1, pa2, pa3); partialSM(pA0, pA1, m_run, alA);
    __syncthreads(); SWAIT(); SWRITE(1, SO);
    RESC(alA); __syncthreads();
  }
  SBAR(); qkt(pB0, pB1, K_lds + SHM_K, qr, r32, hi, m_run);
  finishSM(pA0, pA1, alA, l_reg, pa0, pa1, pa2, pa3); SBAR();
  pv_d0(o, vb0, pa0, pa1, pa2, pa3); partialSM(pB0, pB1, m_run, alB);
  __syncthreads(); RESC(alB);
  finishSM(pB0, pB1, alB, l_reg, pa0, pa1, pa2, pa3); SBAR();
  pv_d0(o, vb0 + SHM_V, pa0, pa1, pa2, pa3);
  if (hi == 0) li_l[r32] = l_reg; asm volatile("s_waitcnt lgkmcnt(0)" ::: "memory");
  float rli[16];
#pragma unroll
  for (int r = 0; r < 16; ++r) rli[r] = __builtin_amdgcn_rcpf(li_l[crow(r, hi)]);
  unsigned short* Ow = Ob + (long)(wid * QBLK) * LDO;
#pragma unroll
  for (int r = 0; r < 16; ++r) { int orow = crow(r, hi);
#pragma unroll
    for (int d0 = 0; d0 < 2; ++d0) Ow[(long)orow * LDO + d0 * 32 + r32] = (unsigned short)(cvtpk(o[d0][r] * rli[r], 0.f) & 0xffffu); }
  __syncthreads();
#undef SLOAD
#undef SWRITE
#undef SWAIT
#undef RESC
}
#undef KSWZ
#undef SBAR
}


namespace ml {
using bf16x8 = __attribute__((ext_vector_type(8))) short;
using s16x4  = __attribute__((ext_vector_type(4))) short;
using f32x16 = __attribute__((ext_vector_type(16))) float;
using f32x4  = __attribute__((ext_vector_type(4))) float;
using u32x4  = __attribute__((ext_vector_type(4))) unsigned;
constexpr float L2E = 1.4426950408889634f;
constexpr int NXC = 34;
__device__ __forceinline__ int crow(int r, int hi) { return (r & 3) + 8 * (r >> 2) + 4 * hi; }
__device__ __forceinline__ unsigned cvtpk(float lo, float hi) { unsigned r; asm volatile("v_cvt_pk_bf16_f32 %0, %1, %2" : "=v"(r) : "v"(lo), "v"(hi)); return r; }
template <int NC> __device__ __forceinline__ int t_st(int k, int c) { const int kk = (k & ~0xC) | ((k & 4) << 1) | ((k & 8) >> 1); return ((kk >> 3) * NC + (c >> 5)) * 512 + ((kk & 7) * 32 + (c & 31)) * 2; }
__device__ __forceinline__ int t_rd_base(int lane) { return ((lane & 3) << 3) | (((lane >> 2) & 3) << 6) | (((lane >> 4) & 1) << 5) | (((lane >> 5) & 1) << 8); }
template <int NC> constexpr int t_rd_off(int d0, int ks, int half) { return d0 * 512 + ks * (NC * 1024) + half * (NC * 512); }
template <int OFF> __device__ __forceinline__ s16x4 tr_read(int vb) { s16x4 r; asm volatile("ds_read_b64_tr_b16 %0, %1 offset:%2" : "=&v"(r) : "v"(vb), "i"(OFF) : "memory"); return r; }
#define ML_PK(L, H) (bf16x8){L[0], L[1], L[2], L[3], H[0], H[1], H[2], H[3]}
#define ML_KS(row, colB) ((row) * 128 + ((colB) ^ (((row) & 7) << 4)))
__device__ __forceinline__ int chunk_row(int b, int X, int i) { return X < 2 ? (16384 + b * 256 + X * 128 + i) : (b * 4096 + (X - 2) * 128 + i); }
__device__ __forceinline__ float lsig(float x) { return fminf(x, 0.f) - __logf(1.f + __expf(-fabsf(x))); }

__device__ __forceinline__ void gate_prep(const float* GATES, const float* bg, int b, int h, int X, LAS float* cum, LAS float* av, LAS float* pm, LAS float* wsr, LAS float* tot, int wave, int lane) {
    if (wave < 2) {
        const int dir = wave;
        const int e0 = dir ? (127 - 2 * lane) : (2 * lane), e1 = dir ? (126 - 2 * lane) : (2 * lane + 1);
        const int r0 = chunk_row(b, X, e0), r1 = chunk_row(b, X, e1);
        const float bi = bg[(2 * dir) * 4 + h], bf = bg[(2 * dir + 1) * 4 + h];
        const float li0 = GATES[(size_t)r0 * 16 + (2 * dir) * 4 + h] + bi, li1 = GATES[(size_t)r1 * 16 + (2 * dir) * 4 + h] + bi;
        const float x0 = lsig(GATES[(size_t)r0 * 16 + (2 * dir + 1) * 4 + h] + bf), x1 = lsig(GATES[(size_t)r1 * 16 + (2 * dir + 1) * 4 + h] + bf);
        float sc = x0 + x1;
#pragma unroll
        for (int o = 1; o < 64; o <<= 1) { const float y = __shfl_up(sc, o); if (lane >= o) sc += y; }
        const float c1 = sc, c0 = sc - x1; const float total = __shfl(sc, 63);
        const float a0 = li0 - c0, a1 = li1 - c1;
        float mx = fmaxf(a0, a1);
#pragma unroll
        for (int o = 1; o < 64; o <<= 1) { const float y = __shfl_up(mx, o); if (lane >= o) mx = fmaxf(mx, y); }
        float prev = __shfl_up(mx, 1); if (lane == 0) prev = -3.0e38f;
        cum[dir * 128 + e0] = c0; cum[dir * 128 + e1] = c1; av[dir * 128 + e0] = a0; av[dir * 128 + e1] = a1;
        pm[dir * 128 + e0] = fmaxf(prev, a0); pm[dir * 128 + e1] = mx;
        wsr[dir * 128 + e0] = total - c0 + li0; wsr[dir * 128 + e1] = total - c1 + li1;
        if (lane == 0) tot[dir] = total;
    }
}

__device__ __forceinline__ void stepA_unit(const unsigned short* P16, const float* GATES, const float* bg, int bh, int X, float* CLOC, float* NLOC, float* MLOC, float* TOT, char* lds) {
    const int tid = threadIdx.x, wave = __builtin_amdgcn_readfirstlane(tid >> 6), lane = tid & 63, r32 = lane & 31, hi = lane >> 5;
    const int b = bh >> 2, h = bh & 3;
    LAS float* fa = (LAS float*)(lds + 65536);
    LAS float* cum = fa, *av = fa + 256, *pm = fa + 512, *wsr = fa + 768, *tot = fa + 1024, *wl = fa + 1040, *npart = fa + 1312;
    bf16x8 stV[4]; u32x4 stK[2];
#pragma unroll
    for (int j = 0; j < 4; ++j) { const int id = tid + 512 * j, row = id >> 4, ch = id & 15; stV[j] = *reinterpret_cast<const bf16x8*>(P16 + (size_t)chunk_row(b, X, row) * 2304 + 1184 + h * 128 + ch * 8); }
#pragma unroll
    for (int j = 0; j < 2; ++j) { const int id = tid + 512 * j, row = id >> 3, ch = id & 7; stK[j] = *reinterpret_cast<const u32x4*>(P16 + (size_t)chunk_row(b, X, row) * 2304 + 928 + h * 64 + ch * 8); }
    gate_prep(GATES, bg, b, h, X, cum, av, pm, wsr, tot, wave, lane);
#pragma unroll
    for (int j = 0; j < 4; ++j) { const int id = tid + 512 * j, row = id >> 4, ch = id & 15; *(bf16x8*)(lds + t_st<4>(row, ch * 8)) = stV[j]; }
    __syncthreads();
    if (wave < 2) {
        const int dir = wave; const float w0 = wsr[dir * 128 + lane], w1 = wsr[dir * 128 + 64 + lane];
        float mx = fmaxf(w0, w1);
#pragma unroll
        for (int o = 1; o < 64; o <<= 1) mx = fmaxf(mx, __shfl_xor(mx, o));
        wl[dir * 128 + lane] = __expf(w0 - mx); wl[dir * 128 + 64 + lane] = __expf(w1 - mx);
        if (lane == 0) { MLOC[(bh * NXC + X) * 2 + dir] = mx; TOT[(bh * NXC + X) * 2 + dir] = tot[dir]; }
    }
    __syncthreads();
#pragma unroll
    for (int j = 0; j < 2; ++j) { const int id = tid + 512 * j, row = id >> 3, ch = id & 7;
        const u32x4 kv = stK[j];
        const float wf = wl[row], wb = wl[128 + row];
        u32x4 of, ob;
#pragma unroll
        for (int q = 0; q < 4; ++q) { const float lo = __uint_as_float(kv[q] << 16), hi2 = __uint_as_float(kv[q] & 0xffff0000u); of[q] = cvtpk(lo * wf, hi2 * wf); ob[q] = cvtpk(lo * wb, hi2 * wb); }
        *(u32x4*)(lds + 32768 + t_st<2>(row, ch * 8)) = of; *(u32x4*)(lds + 49152 + t_st<2>(row, ch * 8)) = ob; }
    __syncthreads();
    {
        const int dir = wave >> 2, mb = wave & 3;
        const int vb = (int)(uintptr_t)lds + t_rd_base(lane) + mb * 512;
        const int kb = (int)(uintptr_t)lds + 32768 + dir * 16384 + t_rd_base(lane);
        f32x16 acc0 = {}, acc1 = {};
#define ML_A_STEP(KS) do { \
        const s16x4 vl = tr_read<t_rd_off<4>(0, KS, 0)>(vb), vh = tr_read<t_rd_off<4>(0, KS, 1)>(vb); \
        const s16x4 k0l = tr_read<t_rd_off<2>(0, KS, 0)>(kb), k0h = tr_read<t_rd_off<2>(0, KS, 1)>(kb), k1l = tr_read<t_rd_off<2>(1, KS, 0)>(kb), k1h = tr_read<t_rd_off<2>(1, KS, 1)>(kb); \
        asm volatile("s_waitcnt lgkmcnt(0)" ::: "memory"); __builtin_amdgcn_sched_barrier(0); \
        acc0 = __builtin_amdgcn_mfma_f32_32x32x16_bf16(ML_PK(vl, vh), ML_PK(k0l, k0h), acc0, 0, 0, 0); \
        acc1 = __builtin_amdgcn_mfma_f32_32x32x16_bf16(ML_PK(vl, vh), ML_PK(k1l, k1h), acc1, 0, 0, 0); } while (0)
        ML_A_STEP(0); ML_A_STEP(1); ML_A_STEP(2); ML_A_STEP(3); ML_A_STEP(4); ML_A_STEP(5); ML_A_STEP(6); ML_A_STEP(7);
#undef ML_A_STEP
        float* dst = CLOC + ((size_t)(bh * NXC + X) * 2 + dir) * 8192;
#pragma unroll
        for (int r = 0; r < 16; ++r) { const int dv = 32 * mb + crow(r, hi); dst[dv * 64 + r32] = acc0[r]; dst[dv * 64 + 32 + r32] = acc1[r]; }
    }
    {
        const int dir = tid >> 8, part = (tid >> 6) & 3, d = tid & 63; float a = 0.f;
        const char* img = lds + 32768 + dir * 16384;
#pragma unroll 8
        for (int i = 0; i < 32; ++i) { const int row = part * 32 + i; a += bf2f(*(const unsigned short*)(img + t_st<2>(row, d))); }
        npart[(dir * 4 + part) * 64 + d] = a;
    }
    __syncthreads();
    if (tid < 128) { const int dir = tid >> 6, d = tid & 63; NLOC[((size_t)(bh * NXC + X) * 2 + dir) * 64 + d] = (npart[(dir * 4 + 0) * 64 + d] + npart[(dir * 4 + 1) * 64 + d]) + (npart[(dir * 4 + 2) * 64 + d] + npart[(dir * 4 + 3) * 64 + d]); }
    __syncthreads();
}

__device__ __forceinline__ int scanX(int dir, int j) { return dir ? (j == 0 ? 1 : (j == 1 ? 0 : 35 - j)) : j; }
__device__ __forceinline__ void stepB(const float* CLOC, const float* NLOC, const float* MLOC, const float* TOT, unsigned* CIN, float* NIN, float* MIN, int gtid, int gthreads) {
    for (int it = gtid; it < 32 * 4096 + 32 * 64; it += gthreads) {
        const bool isn = it >= 32 * 4096;
        const int sq = isn ? (it - 32 * 4096) >> 6 : it >> 12, e = isn ? (it - 32 * 4096) & 63 : it & 4095;
        const int bh = sq >> 1, dir = sq & 1;
        float2 v[NXC]; float tt[NXC], mm[NXC];
#pragma unroll
        for (int j = 0; j < NXC; ++j) { const int X = scanX(dir, j); const size_t li = (size_t)(bh * NXC + X) * 2 + dir;
            tt[j] = TOT[li]; mm[j] = MLOC[li];
            if (isn) { v[j].x = NLOC[li * 64 + e]; v[j].y = 0.f; } else v[j] = *(const float2*)(CLOC + li * 8192 + 2 * e); }
        float c0 = 0.f, c1 = 0.f, m = 0.f;
#pragma unroll
        for (int j = 0; j < NXC; ++j) {
            const int X = scanX(dir, j);
            if (X >= 2) {
                const size_t ci = (size_t)(bh * 32 + (X - 2)) * 2 + dir;
                if (isn) { NIN[ci * 64 + e] = c0; if (e == 0) MIN[ci] = m; }
                else CIN[ci * 4096 + e] = cvtpk(c0, c1);
            }
            const float mn = fmaxf(tt[j] + m, mm[j]), dec = __expf(tt[j] + m - mn), scl = __expf(mm[j] - mn);
            c0 = dec * c0 + scl * v[j].x; c1 = dec * c1 + scl * v[j].y;
            m = mn;
        }
    }
}

__device__ __forceinline__ void stepC_unit(const unsigned short* P16, const float* GATES, const float* bg, const unsigned short* CIN, const float* NIN, const float* MIN, const float* mng,
                                           unsigned short* MIX16, int bh, int c, char* lds) {
    const int tid = threadIdx.x, wave = __builtin_amdgcn_readfirstlane(tid >> 6), lane = tid & 63, r32 = lane & 31, hi = lane >> 5;
    const int b = bh >> 2, h = bh & 3, X = c + 2;
    LAS float* fa = (LAS float*)(lds + 98304);
    LAS float* cum = fa, *av = fa + 256, *pm = fa + 512, *wsr = fa + 768, *tot = fa + 1024, *scl = fa + 1040;
    LAS float* hs = (LAS float*)lds;
    const int dir = wave >> 2, tb = wave & 3;
    const int t = 32 * tb + r32;
    const size_t ci = (size_t)(bh * 32 + c) * 2 + dir;
    bf16x8 qr[4]; f32x4 nn[8];
    {
        const unsigned short* qp = P16 + (size_t)chunk_row(b, X, t) * 2304 + 672 + h * 64 + hi * 8;
        const float* np = NIN + ci * 64 + hi * 8;
#pragma unroll
        for (int ks = 0; ks < 4; ++ks) { qr[ks] = *reinterpret_cast<const bf16x8*>(qp + ks * 16); nn[2 * ks] = *(const f32x4*)(np + ks * 16); nn[2 * ks + 1] = *(const f32x4*)(np + ks * 16 + 4); }
    }
    const float min2 = MIN[ci] * L2E;
    bf16x8 stK[2], stV[4], stC[4];
#pragma unroll
    for (int j = 0; j < 2; ++j) { const int id = tid + 512 * j, row = id >> 3, ch = id & 7; stK[j] = *reinterpret_cast<const bf16x8*>(P16 + (size_t)chunk_row(b, X, row) * 2304 + 928 + h * 64 + ch * 8); }
#pragma unroll
    for (int j = 0; j < 4; ++j) { const int id = tid + 512 * j, row = id >> 4, ch = id & 15; stV[j] = *reinterpret_cast<const bf16x8*>(P16 + (size_t)chunk_row(b, X, row) * 2304 + 1184 + h * 128 + ch * 8); }
    gate_prep(GATES, bg, b, h, X, cum, av, pm, wsr, tot, wave, lane);
    asm volatile("" ::: "memory");
#pragma unroll
    for (int j = 0; j < 4; ++j) { const int id = tid + 512 * j, dd = id >> 10, row = (id >> 3) & 127, ch = id & 7;
        stC[j] = *reinterpret_cast<const bf16x8*>(CIN + ((size_t)(bh * 32 + c) * 2 + dd) * 8192 + row * 64 + ch * 8); }
#pragma unroll
    for (int j = 0; j < 2; ++j) { const int id = tid + 512 * j, row = id >> 3, ch = id & 7; *(bf16x8*)(lds + ML_KS(row, ch * 16)) = stK[j]; }
#pragma unroll
    for (int j = 0; j < 4; ++j) { const int id = tid + 512 * j, row = id >> 4, ch = id & 15; *(bf16x8*)(lds + 16384 + t_st<4>(row, ch * 8)) = stV[j]; }
#pragma unroll
    for (int j = 0; j < 4; ++j) { const int id = tid + 512 * j, dd = id >> 10, row = (id >> 3) & 127, ch = id & 7; *(bf16x8*)(lds + 65536 + dd * 16384 + ML_KS(row, ch * 16)) = stC[j]; }
    __syncthreads();
    const float el2 = fmaxf(min2, pm[dir * 128 + t] * L2E);
    const float wint = __builtin_amdgcn_exp2f(min2 - el2);
    float ndot = 0.f;
#pragma unroll
    for (int ks = 0; ks < 4; ++ks) { const u32x4 q4 = *reinterpret_cast<const u32x4*>(&qr[ks]); const f32x4 n0 = nn[2 * ks], n1 = nn[2 * ks + 1];
#pragma unroll
        for (int q = 0; q < 4; ++q) { const float lo = __uint_as_float(q4[q] << 16), hi2 = __uint_as_float(q4[q] & 0xffff0000u);
            const float nl = (q < 2) ? n0[2 * q] : n1[2 * q - 4], nh = (q < 2) ? n0[2 * q + 1] : n1[2 * q - 3];
            ndot = fmaf(lo, nl, ndot); ndot = fmaf(hi2, nh, ndot); } }
    f32x16 o[4] = {}; float den = 0.f;
    const int vb = (int)(uintptr_t)lds + 16384 + t_rd_base(lane);
    const char* Kl = lds;
#define ML_C_BLOCK(SB) do { if (dir ? (SB >= tb) : (SB <= tb)) { \
        f32x16 p = {}; \
        _Pragma("unroll") for (int ks = 0; ks < 4; ++ks) { const bf16x8 kf = *reinterpret_cast<const bf16x8*>(Kl + ML_KS(32 * SB + r32, (ks * 16 + hi * 8) * 2)); p = __builtin_amdgcn_mfma_f32_32x32x16_bf16(kf, qr[ks], p, 0, 0, 0); } \
        _Pragma("unroll") for (int g = 0; g < 4; ++g) { const f32x4 a4 = *(const LAS f32x4*)(av + dir * 128 + 32 * SB + 8 * g + 4 * hi); \
            _Pragma("unroll") for (int i = 0; i < 4; ++i) { const int sidx = 32 * SB + 8 * g + 4 * hi + i; const bool ok = dir ? (sidx >= t) : (sidx <= t); \
                const float f = __builtin_amdgcn_exp2f(a4[i] * L2E - el2) * 0.125f; p[4 * g + i] = ok ? p[4 * g + i] * f : 0.f; den += p[4 * g + i]; } } \
        bf16x8 pa0, pa1; \
        { unsigned a0 = cvtpk(p[0], p[1]), a1 = cvtpk(p[2], p[3]), b0 = cvtpk(p[4], p[5]), b1 = cvtpk(p[6], p[7]); \
          auto r0 = __builtin_amdgcn_permlane32_swap(a0, b0, false, false); auto r1 = __builtin_amdgcn_permlane32_swap(a1, b1, false, false); u32x4 w = {r0[0], r1[0], r0[1], r1[1]}; pa0 = *reinterpret_cast<bf16x8*>(&w); } \
        { unsigned a0 = cvtpk(p[8], p[9]), a1 = cvtpk(p[10], p[11]), b0 = cvtpk(p[12], p[13]), b1 = cvtpk(p[14], p[15]); \
          auto r0 = __builtin_amdgcn_permlane32_swap(a0, b0, false, false); auto r1 = __builtin_amdgcn_permlane32_swap(a1, b1, false, false); u32x4 w = {r0[0], r1[0], r0[1], r1[1]}; pa1 = *reinterpret_cast<bf16x8*>(&w); } \
        ML_C_PV(0, SB, pa0, pa1); ML_C_PV(1, SB, pa0, pa1); ML_C_PV(2, SB, pa0, pa1); ML_C_PV(3, SB, pa0, pa1); } } while (0)
#define ML_C_PV(D0, SB, PA0, PA1) do { \
        const s16x4 l0 = tr_read<t_rd_off<4>(D0, 2 * SB, 0)>(vb), h0 = tr_read<t_rd_off<4>(D0, 2 * SB, 1)>(vb), l1 = tr_read<t_rd_off<4>(D0, 2 * SB + 1, 0)>(vb), h1 = tr_read<t_rd_off<4>(D0, 2 * SB + 1, 1)>(vb); \
        asm volatile("s_waitcnt lgkmcnt(0)" ::: "memory"); __builtin_amdgcn_sched_barrier(0); \
        o[D0] = __builtin_amdgcn_mfma_f32_32x32x16_bf16(PA0, ML_PK(l0, h0), o[D0], 0, 0, 0); \
        o[D0] = __builtin_amdgcn_mfma_f32_32x32x16_bf16(PA1, ML_PK(l1, h1), o[D0], 0, 0, 0); } while (0)
    ML_C_BLOCK(0); ML_C_BLOCK(1); ML_C_BLOCK(2); ML_C_BLOCK(3);
#undef ML_C_BLOCK
#undef ML_C_PV
    {
        bf16x8 qw[4];
#pragma unroll
        for (int ks = 0; ks < 4; ++ks) { const u32x4 q4 = *reinterpret_cast<const u32x4*>(&qr[ks]); u32x4 w4;
#pragma unroll
            for (int q = 0; q < 4; ++q) { const float lo = __uint_as_float(q4[q] << 16), hi2 = __uint_as_float(q4[q] & 0xffff0000u); w4[q] = cvtpk(lo * (0.125f * wint), hi2 * (0.125f * wint)); }
            qw[ks] = *reinterpret_cast<const bf16x8*>(&w4); }
        const char* Cl = lds + 65536 + dir * 16384;
#pragma unroll
        for (int d0 = 0; d0 < 4; ++d0)
#pragma unroll
            for (int ks = 0; ks < 4; ++ks) { const bf16x8 cf = *reinterpret_cast<const bf16x8*>(Cl + ML_KS(32 * d0 + r32, (ks * 16 + hi * 8) * 2)); o[d0] = __builtin_amdgcn_mfma_f32_32x32x16_bf16(qw[ks], cf, o[d0], 0, 0, 0); }
    }
    { auto rr = __builtin_amdgcn_permlane32_swap(__float_as_uint(den), __float_as_uint(den), false, false); den = __uint_as_float(rr[0]) + __uint_as_float(rr[1]); }
    { auto rr = __builtin_amdgcn_permlane32_swap(__float_as_uint(ndot), __float_as_uint(ndot), false, false); ndot = __uint_as_float(rr[0]) + __uint_as_float(rr[1]); }
    den += wint * 0.125f * ndot;
    const float sct = 1.f / fmaxf(fabsf(den), __builtin_amdgcn_exp2f(-cum[dir * 128 + t] * L2E - el2));
    if (hi == 0) scl[wave * 32 + r32] = sct;
    __syncthreads();
    if (dir == 1) {
#pragma unroll
        for (int r = 0; r < 16; ++r) { const float sc = scl[wave * 32 + crow(r, hi)];
#pragma unroll
            for (int d0 = 0; d0 < 4; ++d0) hs[(32 * tb + crow(r, hi)) * 128 + 32 * d0 + r32] = o[d0][r] * sc; }
    }
    __syncthreads();
    if (dir == 0) {
#pragma unroll
        for (int r = 0; r < 16; ++r) { const float sc = scl[wave * 32 + crow(r, hi)];
#pragma unroll
            for (int d0 = 0; d0 < 4; ++d0) hs[(32 * tb + crow(r, hi)) * 128 + 32 * d0 + r32] += o[d0][r] * sc; }
    }
    __syncthreads();
    {
        const int tt = tid >> 2, q4 = tid & 3;
        const size_t grow = (size_t)chunk_row(b, X, tt);
        const unsigned short* og = P16 + grow * 2304 + 1696 + h * 128 + 32 * q4;
        u32x4 og4[4];
#pragma unroll
        for (int j = 0; j < 4; ++j) og4[j] = *reinterpret_cast<const u32x4*>(og + 8 * j);
        f32x4 v[8]; float ss = 0.f;
#pragma unroll
        for (int j = 0; j < 8; ++j) { v[j] = *(const LAS f32x4*)(hs + tt * 128 + 32 * q4 + 4 * j); ss += (v[j][0] * v[j][0] + v[j][1] * v[j][1]) + (v[j][2] * v[j][2] + v[j][3] * v[j][3]); }
        ss += __shfl_xor(ss, 1); ss += __shfl_xor(ss, 2);
        const float rstd = rsqrtf(ss * (1.f / 128.f) + 1e-6f);
        const float* gn = mng + h * 128 + 32 * q4;
        unsigned short* dst = MIX16 + grow * 1024 + 512 + h * 128 + 32 * q4;
#pragma unroll
        for (int j = 0; j < 4; ++j) { const f32x4 g0 = *(const f32x4*)(gn + 8 * j), g1 = *(const f32x4*)(gn + 8 * j + 4); const f32x4 x0 = v[2 * j], x1 = v[2 * j + 1]; const u32x4 ow = og4[j];
            float r8[8];
#pragma unroll
            for (int e = 0; e < 4; ++e) { const float gl = __uint_as_float(ow[e] << 16), gh = __uint_as_float(ow[e] & 0xffff0000u);
                const float xa = (e < 2) ? x0[2 * e] : x1[2 * e - 4], xb = (e < 2) ? x0[2 * e + 1] : x1[2 * e - 3];
                const float ga = (e < 2) ? g0[2 * e] : g1[2 * e - 4], gb = (e < 2) ? g0[2 * e + 1] : g1[2 * e - 3];
                r8[2 * e] = xa * rstd * ga * __builtin_amdgcn_rcpf(1.f + __expf(-gl)); r8[2 * e + 1] = xb * rstd * gb * __builtin_amdgcn_rcpf(1.f + __expf(-gh)); }
            u32x4 w; w.x = cvtpk(r8[0], r8[1]); w.y = cvtpk(r8[2], r8[3]); w.z = cvtpk(r8[4], r8[5]); w.w = cvtpk(r8[6], r8[7]);
            *(u32x4*)(dst + 8 * j) = w; }
    }
    __syncthreads();
}
#undef ML_PK
#undef ML_KS
}


__device__ __forceinline__ unsigned pk4_fp8(float a, float b, float c, float d) { int w = __builtin_amdgcn_cvt_pk_fp8_f32(a, b, 0, false); w = __builtin_amdgcn_cvt_pk_fp8_f32(c, d, w, true); return (unsigned)w; }
template <class RowMap>
__device__ __forceinline__ void transpose_item8(const float* W, int K, int N, int nblk, unsigned char* WT, const RowMap& rowmap, LAS float* scr, int item, int lane) {
    const int kb = item / nblk, nb = item % nblk, k0 = 64 * kb, n0 = 32 * nb;
    const int ncol = n0 + (lane & 31);
    float tv[32];
#pragma unroll
    for (int i = 0; i < 32; ++i) { const int kk = 2 * i + (lane >> 5); tv[i] = __builtin_nontemporal_load(W + (size_t)(k0 + kk) * N + ncol) * 64.f; }
#pragma unroll
    for (int i = 0; i < 32; ++i) scr[(2 * i + (lane >> 5)) * 33 + (lane & 31)] = tv[i];
    asm volatile("s_waitcnt lgkmcnt(0)" ::: "memory");
    const int c = lane & 7;
    const int r0 = rowmap(n0);
#pragma unroll
    for (int j = 0; j < 4; ++j) { const int n = (lane >> 3) + 8 * j; const LAS float* sp = scr + (8 * c) * 33 + n;
        pg8::u32x2 o; o.x = pk4_fp8(sp[0 * 33], sp[1 * 33], sp[2 * 33], sp[3 * 33]); o.y = pk4_fp8(sp[4 * 33], sp[5 * 33], sp[6 * 33], sp[7 * 33]);
        __builtin_nontemporal_store(o, (pg8::u32x2*)(WT + (size_t)(r0 + n) * K + k0 + 8 * c)); }
    asm volatile("s_waitcnt lgkmcnt(0)" ::: "memory");
}

__device__ __forceinline__ void convert_chunk(const float* wgu, const float* wdn, unsigned short* WguT, unsigned short* WdnT, int which, int chunk, LAS float* scr, int wave, int lane) {
#pragma unroll 1
    for (int j = 0; j < 8; ++j) {
        const int it = chunk * 64 + wave * 8 + j;
#if MOE_FP8
        if (which == 0) { const int e = it >> 10, r = it & 1023;
            transpose_item8(wgu + (size_t)e * D * 2 * DFF, D, 2 * DFF, 2 * DFF / 32, (unsigned char*)WguT + (size_t)e * 2 * DFF * D,
                            [](int n0) { return n0 < DFF ? (n0 >> 7) * 256 + (n0 & 127) : ((n0 - DFF) >> 7) * 256 + 128 + ((n0 - DFF) & 127); }, scr, r, lane); }
        else { const int e = it >> 9, r = it & 511;
            transpose_item8(wdn + (size_t)e * DFF * D, DFF, D, D / 32, (unsigned char*)WdnT + (size_t)e * D * DFF, [](int n0) { return n0; }, scr, r, lane); }
#else
        if (which == 0) { const int e = it >> 10, r = it & 1023;
            transpose_item(wgu + (size_t)e * D * 2 * DFF, D, 2 * DFF, 2 * DFF / 32, WguT + (size_t)e * 2 * DFF * D,
                           [](int n0) { return n0 < DFF ? (n0 >> 7) * 256 + (n0 & 127) : ((n0 - DFF) >> 7) * 256 + 128 + ((n0 - DFF) & 127); }, scr, r, lane); }
        else { const int e = it >> 9, r = it & 511;
            transpose_item(wdn + (size_t)e * DFF * D, DFF, D, D / 32, WdnT + (size_t)e * D * DFF, [](int n0) { return n0; }, scr, r, lane); }
#endif
    }
}
__device__ __forceinline__ void pull_chunks(unsigned* qword, int first, int total, int maxc, const float* wgu, const float* wdn, unsigned short* WguT, unsigned short* WdnT, int which,
                                            unsigned char* lds_raw, int wave, int lane) {
    LAS int* bc = (LAS int*)(lds_raw + 131072 + 1024);
    LAS float* scr = (LAS float*)(lds_raw + wave * 16384);
    for (int n = 0; n < maxc; ++n) {
        __syncthreads();
        if (threadIdx.x == 0) bc[0] = first + (int)__hip_atomic_fetch_add(qword, 1u, __ATOMIC_RELAXED, __HIP_MEMORY_SCOPE_AGENT);
        __syncthreads();
        const int c = bc[0];
        if (c >= total) break;
        convert_chunk(wgu, wdn, WguT, WdnT, which, c, scr, wave, lane);
    }
    __syncthreads();
}

__device__ __forceinline__ int fresh_tid() { int t = (int)threadIdx.x; asm volatile("" : "+v"(t)); return t; }

#define DEF_PTRS \
    float* MOD = (float*)(ws + WS_MOD); \
    float* NLOC = (float*)(ws + WS_MLS); float* MLOC = (float*)(ws + WS_MLS + 512 * 1024); float* TOT = (float*)(ws + WS_MLS + 576 * 1024); float* NIN = (float*)(ws + WS_MLS + 1 * MiB); float* MIN_ = (float*)(ws + WS_MLS + 1536 * 1024); \
    float* CLOC = (float*)(ws + WS_CLOC); unsigned short* CIN = (unsigned short*)(ws + WS_CIN); \
    float* ROPEC = (float*)(ws + WS_ROPE); float* ROPES = ROPEC + S * 16; \
    int* TOPE = (int*)(ws + WS_TOPE); int* SLOT = (int*)(ws + WS_SLOT); int* LIST = (int*)(ws + WS_LIST); float* RGATE = (float*)(ws + WS_RGATE); \
    unsigned short* Hb16 = (unsigned short*)(ws + WS_H); unsigned short* WinT = (unsigned short*)(ws + WS_WINT); \
    unsigned short* Q16 = (unsigned short*)(ws + WS_Q); unsigned short* K16 = (unsigned short*)(ws + WS_KV); unsigned short* V16 = (unsigned short*)(ws + WS_KV + 32 * MiB); \
    unsigned short* X1 = (unsigned short*)(ws + WS_X1); unsigned short* H2 = (unsigned short*)(ws + WS_H2); \
    unsigned short* YG = (unsigned short*)(ws + WS_YG); unsigned short* ACT = (unsigned short*)(ws + WS_ACT); \
    unsigned short* WguT = (unsigned short*)(ws + WS_WGUT); unsigned short* WdnT = (unsigned short*)(ws + WS_WDNT); \
    unsigned short* WuqT = (unsigned short*)(ws + WS_WUQT); unsigned short* WukvT = (unsigned short*)(ws + WS_WUKVT); unsigned short* WoutT = (unsigned short*)(ws + WS_WOUTT); \
    float* GATES = (float*)(ws + WS_GATES); float* STAT = (float*)(ws + WS_STAT); float* STAT2 = (float*)(ws + WS_STAT2); \
    float* GM2 = (float*)(ws + WS_RSTD); unsigned short* RWH = (unsigned short*)(ws + WS_RSTD + 65536); unsigned short* RWL = (unsigned short*)(ws + WS_RSTD + 131072); unsigned short* MIX16 = (unsigned short*)(ws + WS_MIX16); \
    unsigned short* P16 = (unsigned short*)(ws + WS_P); \
    unsigned* CNT = ctl + CW_CNT; (void)CNT;
typedef const Params __attribute__((address_space(4))) KParams;
#define PHASE_ENV KParams* pk = kp; asm volatile("" : "+s"(pk)); unsigned char* ws = pk->ws; unsigned* ctl = (unsigned*)(ws + WS_CTL); (void)ctl; DEF_PTRS

constexpr int LDS_BYTES = 147456;
constexpr int N_PHASES = 12;

__global__ void __launch_bounds__(NT, 2) fwd_kernel(Params p) {
    extern __shared__ __attribute__((aligned(16))) unsigned char lds_raw[];
    float* lds = (float*)lds_raw;
    LAS unsigned* misc = (LAS unsigned*)(lds_raw + 131072 + 4096);
    const int tid = threadIdx.x, lane = tid & 63, wave = tid >> 6;
    const int bid = blockIdx.x, G = gridDim.x;
    KParams* kp = (KParams*)__builtin_amdgcn_kernarg_segment_ptr();
    unsigned* ctl = (unsigned*)(p.ws + WS_CTL);
    if (tid < 4) misc[tid] = 0u;
    __syncthreads();
    const bool single = (p.ph_hi - p.ph_lo) > 1;
    if (single) (void)xcd_barrier_post(ctl + CW_BAR, (volatile LAS unsigned*)misc);
#ifndef PH_MASK
#define PH_MASK 0xFFFF
#endif
#define IN(k) ((((PH_MASK) >> (k)) & 1) && p.ph_lo <= (k) && (k) < p.ph_hi)
#define GRID_BARRIER() do { KParams* pb_ = kp; asm volatile("" : "+s"(pb_)); XcdBarrier b_; b_.bar = (unsigned*)(pb_->ws + WS_CTL) + CW_BAR; b_.x = xb_xcc_id(); b_.st = (volatile LAS unsigned*)misc; xcd_barrier(b_); } while (0)
#define SEAM(k) do { if (IN(k) && IN((k) + 1)) GRID_BARRIER(); } while (0)
#define PH_BEGIN(k)
#define PH_END(k)
#define SEAM2(k) do { if (IN(k) && IN((k) + 2)) GRID_BARRIER(); } while (0)

    PH_BEGIN(0) if (IN(0)) {
        const int tid = fresh_tid(), lane = tid & 63, wave = tid >> 6; (void)lane; (void)wave;
        PHASE_ENV
        {
            const float* wmod = pk->in[I_WMOD]; const float* bmod = pk->in[I_BMOD];
            float* sil = lds;
            float* red = lds + 5 * 1024;
            for (int cg = bid; cg < 96; cg += G) {
                for (int e = tid; e < 5 * D; e += NT) { const int r = e >> 10, k = e & 1023; const float cv = (r < 4) ? pk->in[I_C][r * D + k] : pk->in[I_CCTX][k]; sil[e] = siluf_(cv); }
                __syncthreads();
                const int col = cg * 64 + (tid & 63), part = tid >> 6;
                float a0 = 0.f, a1 = 0.f, a2 = 0.f, a3 = 0.f, a4 = 0.f;
#pragma unroll 8
                for (int kk = 0; kk < 128; ++kk) { const int k = part * 128 + kk; const float w = wmod[(size_t)k * 6144 + col];
                    a0 = fmaf(sil[k], w, a0); a1 = fmaf(sil[1024 + k], w, a1); a2 = fmaf(sil[2048 + k], w, a2); a3 = fmaf(sil[3072 + k], w, a3); a4 = fmaf(sil[4096 + k], w, a4); }
                red[(part * 5 + 0) * 64 + (tid & 63)] = a0; red[(part * 5 + 1) * 64 + (tid & 63)] = a1; red[(part * 5 + 2) * 64 + (tid & 63)] = a2; red[(part * 5 + 3) * 64 + (tid & 63)] = a3; red[(part * 5 + 4) * 64 + (tid & 63)] = a4;
                __syncthreads();
                if (tid < 320) { const int r = tid >> 6, cc = tid & 63; float t = 0.f;
#pragma unroll
                    for (int pp = 0; pp < 8; ++pp) t += red[(pp * 5 + r) * 64 + cc];
                    MOD[r * 6144 + cg * 64 + cc] = t + bmod[cg * 64 + cc]; }
                __syncthreads();
            }
        }
        for (int e = bid * NT + tid; e < NE * D; e += G * NT) { const int ex = e >> 10, k = e & 1023; const float w = pk->in[I_RW][(size_t)k * NE + ex];
            const unsigned hi = pg8::cvt_pk_bf16(w, 0.f) & 0xffffu; const float lo = w - __uint_as_float(hi << 16);
            RWH[e] = (unsigned short)hi; RWL[e] = (unsigned short)(pg8::cvt_pk_bf16(lo, 0.f) & 0xffffu); }
        for (int e = bid * NT + tid; e < S * 16; e += G * NT) { float cs, sn; rope_angles(e >> 4, e & 15, cs, sn); ROPEC[e] = cs; ROPES[e] = sn; }
        {
            LAS float* scr = (LAS float*)(lds_raw + wave * 16384);
            const int gw = bid * 8 + wave, NGW = G * 8;
            for (int it = gw; it < (D / 64) * (PW / 32); it += NGW) transpose_item(pk->in[I_WIN], D, INW, PW / 32, WinT, [](int n0) { return n0; }, scr, it, lane);
            for (int it = gw; it < (QL / 64) * (768 / 32); it += NGW) transpose_item(pk->in[I_WUQ], QL, 768, 768 / 32, WuqT, [](int n0) { return n0; }, scr, it, lane, pk->in[I_QNG]);
            for (int it = gw; it < (KVL / 64) * (1024 / 32); it += NGW) transpose_item(pk->in[I_WUKV], KVL, 1024, 1024 / 32, WukvT, [](int n0) { return n0; }, scr, it, lane, pk->in[I_KVNG]);
            for (int it = gw; it < (D / 64) * (D / 32); it += NGW) transpose_item(pk->in[I_WOUT], D, D, D / 32, WoutT, [](int n0) { return n0; }, scr, it, lane);
            for (int c = G - 1 - bid; c < GU_STATIC; c += G) convert_chunk(pk->in[I_WGU], pk->in[I_WDN], WguT, WdnT, 0, c, scr, wave, lane);
        }
    }
    PH_END(0)
    SEAM(0);
    PH_BEGIN(1) if (IN(1)) {
        const int tid = fresh_tid(), lane = tid & 63, wave = tid >> 6; (void)lane; (void)wave;
        PHASE_ENV
        const float* g1n = pk->in[I_N1G];
        for (int e = bid * NT + tid; e < 4 * D; e += G * NT) GM2[e] = pk->in[I_N2G][e & 1023] * (1.f + MOD[(e >> 10) * 6144 + 4 * D + (e & 1023)]);
        for (int rp = bid * 8 + wave; rp < MT / 2; rp += G * 8) {
            const int r = 2 * rp;
            const float* src = (r < MX) ? pk->in[I_X] + (size_t)r * D : pk->in[I_CTX] + (size_t)(r - MX) * D;
            const int mb = (r < MX) ? r / S : 4;
            const float* sh = MOD + mb * 6144, *sc = sh + D;
            float4 va[4], vb[4]; float sa = 0.f, sb = 0.f;
#pragma unroll
            for (int j = 0; j < 4; ++j) { va[j] = *(const float4*)(src + j * 256 + lane * 4); vb[j] = *(const float4*)(src + D + j * 256 + lane * 4); }
#pragma unroll
            for (int j = 0; j < 4; ++j) { sa += (va[j].x * va[j].x + va[j].y * va[j].y) + (va[j].z * va[j].z + va[j].w * va[j].w); sb += (vb[j].x * vb[j].x + vb[j].y * vb[j].y) + (vb[j].z * vb[j].z + vb[j].w * vb[j].w); }
            const float ra = rsqrtf(wave_sum(sa) * (1.f / D) + EPS), rb2 = rsqrtf(wave_sum(sb) * (1.f / D) + EPS);
#pragma unroll
            for (int j = 0; j < 4; ++j) {
                const int c = j * 256 + lane * 4;
                const float4 gn = *(const float4*)(g1n + c), scv = *(const float4*)(sc + c), shv = *(const float4*)(sh + c);
                const float g0 = gn.x * (1.f + scv.x), g1 = gn.y * (1.f + scv.y), g2 = gn.z * (1.f + scv.z), g3 = gn.w * (1.f + scv.w);
                pg8::u32x2 w;
                w.x = pg8::cvt_pk_bf16(va[j].x * ra * g0 + shv.x, va[j].y * ra * g1 + shv.y); w.y = pg8::cvt_pk_bf16(va[j].z * ra * g2 + shv.z, va[j].w * ra * g3 + shv.w);
                *(pg8::u32x2*)(Hb16 + (size_t)r * D + c) = w;
                w.x = pg8::cvt_pk_bf16(vb[j].x * rb2 * g0 + shv.x, vb[j].y * rb2 * g1 + shv.y); w.y = pg8::cvt_pk_bf16(vb[j].z * rb2 * g2 + shv.z, vb[j].w * rb2 * g3 + shv.w);
                *(pg8::u32x2*)(Hb16 + (size_t)(r + 1) * D + c) = w;
            }
        }
    }
    PH_END(1)
    SEAM(1);
    PH_BEGIN(2) if (IN(2)) {
        const int tid = fresh_tid(), lane = tid & 63, wave = tid >> 6; (void)lane; (void)wave;
        PHASE_ENV
        pg8::PlainSched Sd; Sd.init(MT, PW, D, D, WinT, G, bid);
        pg8::EpiInproj E{P16, GATES, STAT, K16, ROPEC, ROPES};
        pg8::gemm_phase<pg8::EpiInproj, pg8::PlainSched, true>((LAS unsigned char*)lds_raw, Hb16, D, Sd, E);
        if ((Sd.nwg % G) != 0 && bid >= (Sd.nwg % G))
            pull_chunks(ctl + CW_QGU, GU_STATIC, GU_CHUNKS, 2, pk->in[I_WGU], pk->in[I_WDN], WguT, WdnT, 0, lds_raw, wave, lane);
    }
    PH_END(2)
    SEAM2(2);
    PH_BEGIN(4) if (IN(4)) {
        const int tid = fresh_tid(), lane = tid & 63, wave = tid >> 6; (void)lane; (void)wave;
        PHASE_ENV
#ifndef NO_QG
        { pg8::PlainSched Sd; Sd.init(MX, 768, QL, PW, WuqT, G, (bid + G - 16) % G);
          pg8::EpiQ E{Q16, STAT, ROPEC, ROPES};
          pg8::gemm_phase<pg8::EpiQ, pg8::PlainSched, true>((LAS unsigned char*)lds_raw, P16 + O_CQ, QL, Sd, E); }
#endif
#ifndef NO_KVG
        { pg8::PlainSched Sd; Sd.init(MT, 1024, KVL, PW, WukvT, G, bid);
          pg8::EpiKV E{K16, V16, STAT};
          pg8::gemm_phase<pg8::EpiKV, pg8::PlainSched, true>((LAS unsigned char*)lds_raw, P16 + O_CKV, KVL, Sd, E); }
#endif
        for (int u = (bid + 48) % G; u < 16 * ml::NXC; u += G) ml::stepA_unit(P16, GATES, pk->in[I_BG], u / ml::NXC, u % ml::NXC, CLOC, NLOC, MLOC, TOT, (char*)lds_raw);
    }
    PH_END(4)
    SEAM(4);
    PH_BEGIN(5) if (IN(5)) {
        const int tid = fresh_tid(), lane = tid & 63, wave = tid >> 6; (void)lane; (void)wave;
        PHASE_ENV
        ml::stepB(CLOC, NLOC, MLOC, TOT, (unsigned*)CIN, NIN, MIN_, bid * NT + tid, G * NT);
        {
            const int nun = NB * HA * (S / 256);
            for (int i = 0; i * G < nun; ++i) {
                int bh, qb;
                if (G == 256) { const int x = bid & 7, slot = bid >> 3; bh = i * 16 + x * 2 + (slot >> 4); qb = slot & 15; }
                else { const int u = i * G + bid; if (u >= nun) break; bh = u >> 4; qb = u & 15; }
                const int b = bh >> 3, h = bh & 7;
                att::attn_body(Q16 + (size_t)(b * S + qb * 256) * 768 + h * 96, K16 + (size_t)(b * SKV) * 768 + h * 96, V16 + (size_t)(b * SKV) * 512 + h * 64,
                               MIX16 + (size_t)(b * S + qb * 256) * D + h * 64, SKV, (char*)lds_raw);
            }
        }
    }
    PH_END(5)
    SEAM(5);
    PH_BEGIN(6) if (IN(6)) {
        const int tid = fresh_tid(), lane = tid & 63, wave = tid >> 6; (void)lane; (void)wave;
        PHASE_ENV
        for (int u = bid; u < 16 * 32; u += G) ml::stepC_unit(P16, GATES, pk->in[I_BG], CIN, NIN, MIN_, pk->in[I_MNG], MIX16, u >> 5, u & 31, (char*)lds_raw);
    }
    PH_END(6)
    SEAM(6);
    PH_BEGIN(7) if (IN(7)) {
        const int tid = fresh_tid(), lane = tid & 63, wave = tid >> 6; (void)lane; (void)wave;
        PHASE_ENV
        pg8::PlainSched Sd; Sd.init(MX, D, D, D, WoutT, G, bid);
        pg8::EpiResid E{X1, pk->in[I_X], MOD, STAT2};
        pg8::gemm_phase<pg8::EpiResid, pg8::PlainSched, true>((LAS unsigned char*)lds_raw, MIX16, D, Sd, E);
    }
    PH_END(7)
    SEAM(7);
    PH_BEGIN(8) if (IN(8)) {
        const int tid = fresh_tid(), lane = tid & 63, wave = tid >> 6; (void)lane; (void)wave;
        PHASE_ENV
        typedef short bf16x8v __attribute__((ext_vector_type(8)));
        typedef float f32x4v __attribute__((ext_vector_type(4)));
        float* LG = lds;
        LAS int* lcnt = (LAS int*)(lds_raw + 32768); LAS int* gbase = lcnt + 32;
        const float* rb = pk->in[I_RB];
        for (int base = bid * 64; base < MX; base += G * 64) {
            if (tid < 32) lcnt[tid] = 0;
            {
                const int bq0 = base / S; const float4 t4 = (tid < 256) ? *(const float4*)(GM2 + bq0 * D + 4 * tid) : *(const float4*)(MOD + bq0 * 6144 + 3 * D + 4 * (tid - 256));
                *(float4*)(lds + 10240 + 4 * tid) = t4; }
            __syncthreads();
            int te[4] = {0, 0, 0, 0}, rk[4] = {0, 0, 0, 0}; float tg[4] = {0.f, 0.f, 0.f, 0.f};
            {
                const int rt = wave & 3, kh = wave >> 2;
                const int r0 = base + 16 * rt, row = lane & 15, kg = lane >> 4, bq = r0 / S;
                float ss;
                { const float4 s0 = *(const float4*)(STAT2 + (size_t)(r0 + row) * 32 + kg * 8), s1 = *(const float4*)(STAT2 + (size_t)(r0 + row) * 32 + kg * 8 + 4);
                  ss = ((s0.x + s0.y) + (s0.z + s0.w)) + ((s1.x + s1.y) + (s1.z + s1.w)); ss += __shfl_xor(ss, 16); ss += __shfl_xor(ss, 32); }
                const float rstd = rsqrtf(ss * (1.f / D) + EPS);
                const int ko = kh * 512 + 8 * kg;
                const unsigned short* xr = X1 + (size_t)(r0 + row) * D + ko; const float* gmr = lds + 10240 + ko; const float* shr = lds + 10240 + 1024 + ko; (void)bq;
                unsigned short* hr = H2 + (size_t)(r0 + row) * D + ko; (void)hr;
                const unsigned short* wh0 = RWH + (size_t)row * D + ko, *wh1 = RWH + (size_t)(16 + row) * D + ko, *wl0 = RWL + (size_t)row * D + ko, *wl1 = RWL + (size_t)(16 + row) * D + ko;
                f32x4v acc0 = {0.f, 0.f, 0.f, 0.f}, acc1 = {0.f, 0.f, 0.f, 0.f};
#pragma unroll 8
                for (int st = 0; st < 16; ++st) {
                    const pg8::u32x4 xw = *(const pg8::u32x4*)(xr + 32 * st);
                    const float4 x0 = make_float4(__uint_as_float(xw[0] << 16), __uint_as_float(xw[0] & 0xffff0000u), __uint_as_float(xw[1] << 16), __uint_as_float(xw[1] & 0xffff0000u)), x1v = make_float4(__uint_as_float(xw[2] << 16), __uint_as_float(xw[2] & 0xffff0000u), __uint_as_float(xw[3] << 16), __uint_as_float(xw[3] & 0xffff0000u));
                    const float4 g0 = *(const float4*)(gmr + 32 * st), g1v = *(const float4*)(gmr + 32 * st + 4), h0 = *(const float4*)(shr + 32 * st), h1 = *(const float4*)(shr + 32 * st + 4);
                    float hv[8] = {x0.x * rstd * g0.x + h0.x, x0.y * rstd * g0.y + h0.y, x0.z * rstd * g0.z + h0.z, x0.w * rstd * g0.w + h0.w, x1v.x * rstd * g1v.x + h1.x, x1v.y * rstd * g1v.y + h1.y, x1v.z * rstd * g1v.z + h1.z, x1v.w * rstd * g1v.w + h1.w};
                    pg8::u32x4 hi4, lo4;
#pragma unroll
                    for (int q = 0; q < 4; ++q) { hi4[q] = pg8::cvt_pk_bf16(hv[2 * q], hv[2 * q + 1]);
                        lo4[q] = pg8::cvt_pk_bf16(hv[2 * q] - __uint_as_float(hi4[q] << 16), hv[2 * q + 1] - __uint_as_float(hi4[q] & 0xffff0000u)); }
#if MOE_FP8
                    { pg8::u32x2 h8; h8.x = pk4_fp8(hv[0], hv[1], hv[2], hv[3]); h8.y = pk4_fp8(hv[4], hv[5], hv[6], hv[7]); *(pg8::u32x2*)((unsigned char*)H2 + (size_t)(r0 + row) * D + ko + 32 * st) = h8; }
#else
                    *(pg8::u32x4*)(hr + 32 * st) = hi4;
#endif
                    const bf16x8v ah = *reinterpret_cast<const bf16x8v*>(&hi4), al = *reinterpret_cast<const bf16x8v*>(&lo4);
                    const bf16x8v bh0 = *reinterpret_cast<const bf16x8v*>(wh0 + 32 * st), bh1 = *reinterpret_cast<const bf16x8v*>(wh1 + 32 * st), bl0 = *reinterpret_cast<const bf16x8v*>(wl0 + 32 * st), bl1 = *reinterpret_cast<const bf16x8v*>(wl1 + 32 * st);
                    acc0 = __builtin_amdgcn_mfma_f32_16x16x32_bf16(ah, bh0, acc0, 0, 0, 0); acc0 = __builtin_amdgcn_mfma_f32_16x16x32_bf16(al, bh0, acc0, 0, 0, 0); acc0 = __builtin_amdgcn_mfma_f32_16x16x32_bf16(ah, bl0, acc0, 0, 0, 0);
                    acc1 = __builtin_amdgcn_mfma_f32_16x16x32_bf16(ah, bh1, acc1, 0, 0, 0); acc1 = __builtin_amdgcn_mfma_f32_16x16x32_bf16(al, bh1, acc1, 0, 0, 0); acc1 = __builtin_amdgcn_mfma_f32_16x16x32_bf16(ah, bl1, acc1, 0, 0, 0);
                }
                float* lgp = LG + kh * (64 * 33);
#pragma unroll
                for (int j = 0; j < 4; ++j) { lgp[(16 * rt + 4 * kg + j) * 33 + row] = acc0[j]; lgp[(16 * rt + 4 * kg + j) * 33 + 16 + row] = acc1[j]; }
            }
            __syncthreads();
            if (wave < 4 && lane < 16) {
                float* lr = LG + (16 * wave + lane) * 33; float tv[4];
                for (int e = 0; e < 32; ++e) lr[e] = (lr[e] + lr[64 * 33 + e]) + rb[e];
#pragma unroll
                for (int k = 0; k < 4; ++k) { float best = -3.0e38f; int bi = 0;
                    for (int e = 0; e < 32; ++e) { const float v = lr[e]; if (v > best) { best = v; bi = e; } }
                    te[k] = bi; tv[k] = best; lr[bi] = -3.0e38f; }
                const float e1 = __expf(tv[1] - tv[0]), e2 = __expf(tv[2] - tv[0]), e3 = __expf(tv[3] - tv[0]); const float inv = 1.f / (1.f + e1 + e2 + e3);
                tg[0] = inv; tg[1] = e1 * inv; tg[2] = e2 * inv; tg[3] = e3 * inv;
#pragma unroll
                for (int k = 0; k < 4; ++k) rk[k] = atomicAdd((int*)&lcnt[te[k]], 1);
            }
            __syncthreads();
            if (tid < 32) gbase[tid] = (int)atomicAdd(&CNT[tid], (unsigned)lcnt[tid]);
            __syncthreads();
            if (wave < 4 && lane < 16) { const int r = base + 16 * wave + lane;
#pragma unroll
                for (int k = 0; k < 4; ++k) { const int e = te[k], pos = gbase[e] + rk[k]; TOPE[r * 4 + k] = e; SLOT[r * 4 + k] = pos; LIST[e * MX + pos] = r; RGATE[e * MX + pos] = tg[k]; } }
            __syncthreads();
        }
    }
    if (IN(8)) { const int t2 = fresh_tid(); PHASE_ENV pull_chunks(ctl + CW_QGU, GU_STATIC, GU_CHUNKS, GU_CHUNKS, pk->in[I_WGU], pk->in[I_WDN], WguT, WdnT, 0, lds_raw, t2 >> 6, t2 & 63); }
    PH_END(8)
    SEAM(8);
    LAS int* mtp = (LAS int*)(lds_raw + 131072); LAS int* mro = mtp + 40; LAS int* mcn = mro + 40;
    if (IN(9) || IN(10) || IN(11)) {
        PHASE_ENV
        __syncthreads();
        if (tid < 64) {
            const int cnt = (tid < NE) ? (int)__hip_atomic_load(&CNT[tid & 31], __ATOMIC_RELAXED, __HIP_MEMORY_SCOPE_AGENT) : 0;
            const int tl = (cnt + 255) >> 8; int inc = tl;
#pragma unroll
            for (int o = 1; o < 64; o <<= 1) { const int y = __shfl_up(inc, o); if (tid >= o) inc += y; }
            if (tid < NE) { mcn[tid] = cnt; mtp[tid] = inc - tl; mro[tid] = (inc - tl) * 256; }
            if (tid == NE - 1) { mtp[NE] = inc; mro[NE] = inc * 256; }
        }
        __syncthreads();
    }
    PH_BEGIN(9) if (IN(9)) {
        const int tid = fresh_tid(), lane = tid & 63, wave = tid >> 6; (void)lane; (void)wave;
        PHASE_ENV
#if MOE_FP8
        pg8::MoeSched Sd{mtp, mro, mcn, DFF / 128, G, bid, D / 2, D / 2, 1, LIST, (const char*)WguT, (size_t)2 * DFF * D};
        pg8::EpiSwiglu E{ACT, pk->in[I_BGU]};
        pg8::gemm_phase<pg8::EpiSwiglu, pg8::MoeSched, true, true>((LAS unsigned char*)lds_raw, H2, D / 2, Sd, E);
#else
        pg8::MoeSched Sd{mtp, mro, mcn, DFF / 128, G, bid, D, D, 1, LIST, (const char*)WguT, (size_t)2 * DFF * D * 2};
        pg8::EpiSwiglu E{ACT, pk->in[I_BGU]};
        pg8::gemm_phase<pg8::EpiSwiglu, pg8::MoeSched, true>((LAS unsigned char*)lds_raw, H2, D, Sd, E);
#endif
        {
            const int nun = mtp[NE] * (DFF / 128); const int mine = (nun - bid + G - 1) / G, most = (nun + G - 1) / G;
            if (mine < most) pull_chunks(ctl + CW_QDN, 0, DN_CHUNKS, 3, pk->in[I_WGU], pk->in[I_WDN], WguT, WdnT, 1, lds_raw, wave, lane);
            pull_chunks(ctl + CW_QDN, 0, DN_CHUNKS, DN_CHUNKS, pk->in[I_WGU], pk->in[I_WDN], WguT, WdnT, 1, lds_raw, wave, lane);
        }
    }
    PH_END(9)
    SEAM(9);
    PH_BEGIN(10) if (IN(10)) {
        const int tid = fresh_tid(), lane = tid & 63, wave = tid >> 6; (void)lane; (void)wave;
        PHASE_ENV
#if MOE_FP8
        pg8::MoeSched Sd{mtp, mro, mcn, D / 256, G, bid, DFF / 2, DFF / 2, 0, LIST, (const char*)WdnT, (size_t)D * DFF};
        pg8::EpiDown E{YG, pk->in[I_BDN], RGATE, mro};
        pg8::gemm_phase<pg8::EpiDown, pg8::MoeSched, true, true>((LAS unsigned char*)lds_raw, ACT, DFF / 2, Sd, E);
#else
        pg8::MoeSched Sd{mtp, mro, mcn, D / 256, G, bid, DFF, DFF, 0, LIST, (const char*)WdnT, (size_t)D * DFF * 2};
        pg8::EpiDown E{YG, pk->in[I_BDN], RGATE, mro};
        pg8::gemm_phase<pg8::EpiDown, pg8::MoeSched, true>((LAS unsigned char*)lds_raw, ACT, DFF, Sd, E);
#endif
    }
    PH_END(10)
    SEAM(10);
    PH_BEGIN(11) if (IN(11)) {
        const int tid = fresh_tid(), lane = tid & 63, wave = tid >> 6; (void)lane; (void)wave;
        PHASE_ENV
        const float* fng = pk->in[I_FNG];
        for (int r = bid * 8 + wave; r < MX; r += G * 8) {
            const int mb = r / S; const float* g2 = MOD + mb * 6144 + 5 * D;
            float acc[16];
#pragma unroll
            for (int i = 0; i < 16; ++i) acc[i] = 0.f;
#pragma unroll
            for (int k = 0; k < 4; ++k) {
                const int e = TOPE[r * 4 + k]; const int row = mro[e] + SLOT[r * 4 + k];
                const unsigned short* yr = YG + (size_t)row * D;
#pragma unroll
                for (int j = 0; j < 4; ++j) { const pg8::u32x2 t = *(const pg8::u32x2*)(yr + j * 256 + lane * 4);
                    acc[4 * j] += __uint_as_float(t.x << 16); acc[4 * j + 1] += __uint_as_float(t.x & 0xffff0000u); acc[4 * j + 2] += __uint_as_float(t.y << 16); acc[4 * j + 3] += __uint_as_float(t.y & 0xffff0000u); }
            }
            float v[16]; float ss = 0.f;
#pragma unroll
            for (int j = 0; j < 4; ++j) { const pg8::u32x2 tw = *(const pg8::u32x2*)(X1 + (size_t)r * D + j * 256 + lane * 4); const float4 t = make_float4(__uint_as_float(tw.x << 16), __uint_as_float(tw.x & 0xffff0000u), __uint_as_float(tw.y << 16), __uint_as_float(tw.y & 0xffff0000u)); const int c = j * 256 + lane * 4;
                v[4 * j] = t.x + g2[c] * acc[4 * j]; v[4 * j + 1] = t.y + g2[c + 1] * acc[4 * j + 1]; v[4 * j + 2] = t.z + g2[c + 2] * acc[4 * j + 2]; v[4 * j + 3] = t.w + g2[c + 3] * acc[4 * j + 3];
                ss += v[4 * j] * v[4 * j] + v[4 * j + 1] * v[4 * j + 1] + v[4 * j + 2] * v[4 * j + 2] + v[4 * j + 3] * v[4 * j + 3]; }
            const float rstd = rsqrtf(wave_sum(ss) * (1.f / D) + EPS);
#pragma unroll
            for (int j = 0; j < 4; ++j) { const int c = j * 256 + lane * 4;
                *(float4*)(pk->out + (size_t)r * D + c) = make_float4(v[4 * j] * rstd * fng[c], v[4 * j + 1] * rstd * fng[c + 1], v[4 * j + 2] * rstd * fng[c + 2], v[4 * j + 3] * rstd * fng[c + 3]); }
        }
    }
    PH_END(11)
#undef IN
#undef SEAM
}

#ifndef PROBE_SPLIT_DUP
#define PROBE_SPLIT_DUP (-1)
#endif
#ifndef N_LAUNCH_SPLIT
#define N_LAUNCH_SPLIT 0
#endif

extern "C" void kernel_launch(void* const* d_in, const int* in_sizes, int n_in, void* d_out, int out_size, void* d_ws, size_t ws_size, hipStream_t stream) {
    static int grid = 0;
    if (grid == 0) {
        if (n_in != 23 || out_size != MX * D || ws_size < WS_END) { fprintf(stderr, "kernel_launch: unexpected shapes n_in %d out %d ws %zu (need %zu)\n", n_in, out_size, ws_size, (size_t)WS_END); grid = -1; return; }
        int dev = 0, cus = 0, per_cu = 0;
        hipGetDevice(&dev); hipDeviceGetAttribute(&cus, hipDeviceAttributeMultiprocessorCount, dev);
        if (hipFuncSetAttribute((const void*)fwd_kernel, hipFuncAttributeMaxDynamicSharedMemorySize, LDS_BYTES) != hipSuccess) { fprintf(stderr, "kernel_launch: hipFuncSetAttribute failed\n"); grid = -1; return; }
        hipOccupancyMaxActiveBlocksPerMultiprocessor(&per_cu, (const void*)fwd_kernel, NT, LDS_BYTES);
        if (per_cu < 1) fprintf(stderr, "kernel_launch: occupancy query says %d\n", per_cu);
        (void)hipGetLastError();
        grid = cus > 0 ? cus : 256;
    }
    if (grid < 0) return;
    hipMemsetAsync((char*)d_ws + WS_CTL, 0, CTL_BYTES, stream);
    Params p{};
    for (int i = 0; i < 23; ++i) p.in[i] = (const float*)d_in[i];
    p.out = (float*)d_out; p.ws = (unsigned char*)d_ws;
#if N_LAUNCH_SPLIT
    for (int k = 0; k < N_PHASES; ++k) {
        if (k == 3) continue;
        const int reps = (k == PROBE_SPLIT_DUP) ? 2 : 1;
        for (int r = 0; r < reps; ++r) {
            if (k == 8 && r == 1) hipMemsetAsync((char*)d_ws + WS_CTL, 0, CTL_BYTES, stream);
            p.ph_lo = k; p.ph_hi = k + 1; hipLaunchKernelGGL(fwd_kernel, dim3(grid), dim3(NT), LDS_BYTES, stream, p);
        }
    }
#else
    p.ph_lo = 0; p.ph_hi = N_PHASES;
    hipLaunchKernelGGL(fwd_kernel, dim3(grid), dim3(NT), LDS_BYTES, stream, p);
#endif
}
```

```cpp
#include <hip/hip_runtime.h>
#include <cstdio>
#include <cstdint>

#define LAS __attribute__((address_space(3)))

#define XB_TMO      128
#define XB_XCNT(j)  (256  + 64 * (j))
#define XB_XSUB(j)  (1280 + 64 * (j))
#define XB_XGEN(j)  (2304 + 64 * (j))
#define XB_TOP      3328
#define XB_TOPGEN   3392
#define XCD_BAR_WORDS 3456
#define XB_SPIN_CAP (1u << 22)

__device__ __forceinline__ unsigned xb_ld(unsigned* p)              { return __hip_atomic_load(p, __ATOMIC_RELAXED, __HIP_MEMORY_SCOPE_AGENT); }
__device__ __forceinline__ unsigned xb_add(unsigned* p, unsigned v) { return __hip_atomic_fetch_add(p, v, __ATOMIC_RELAXED, __HIP_MEMORY_SCOPE_AGENT); }
__device__ __forceinline__ unsigned xb_xcc_id() { return (unsigned)__builtin_amdgcn_s_getreg((3 << 11) | 20) & 0xFu; }
#define XB_SPIN(cond, bar) do { unsigned _sp = 0; while (cond) { __builtin_amdgcn_s_sleep(1); \
    if ((++_sp & 255u) == 0u) { if (xb_ld(&(bar)[XB_TMO])) break; if (_sp > XB_SPIN_CAP) { atomicAdd(&(bar)[XB_TMO], 1u); break; } } } } while (0)

struct XcdBarrier { unsigned* bar; unsigned x; volatile LAS unsigned* st; };

__device__ __forceinline__ XcdBarrier xcd_barrier_post(unsigned* bar, volatile LAS unsigned* st) {
    XcdBarrier b; b.bar = bar; b.x = xb_xcc_id(); b.st = st;
    if (threadIdx.x == 0) (void)xb_add(&bar[XB_XCNT(b.x)], 1u);
    return b;
}
__device__ __forceinline__ void xcd_barrier_complete(unsigned* bar, unsigned x, unsigned& nloc, unsigned& nx) {
    const unsigned G = gridDim.x * gridDim.y * gridDim.z;
    unsigned sum, cnt, mine, sp = 0u;
    for (;;) {
        sum = 0u; cnt = 0u; mine = 0u;
#pragma unroll
        for (unsigned j = 0; j < 16; ++j) { const unsigned c = xb_ld(&bar[XB_XCNT(j)]); sum += c; cnt += (c > 0u) ? 1u : 0u; mine = (j == x) ? c : mine; }
        if (sum == G) break;
        __builtin_amdgcn_s_sleep(1);
        if ((++sp & 255u) == 0u) { if (xb_ld(&bar[XB_TMO])) break; if (sp > XB_SPIN_CAP) { atomicAdd(&bar[XB_TMO], 1u); break; } }
    }
    nloc = mine > 0u ? mine : 1u; nx = cnt > 0u ? cnt : 1u;
}
__device__ __forceinline__ void xcd_barrier(const XcdBarrier& b) {
    asm volatile("s_waitcnt vmcnt(0)" ::: "memory");
    __syncthreads();
    if (threadIdx.x == 0) {
        unsigned* bar = b.bar;
        __builtin_amdgcn_s_waitcnt(0);
        unsigned nloc = b.st[0], nx = b.st[1];
        if (nloc == 0u) { xcd_barrier_complete(bar, b.x, nloc, nx); b.st[0] = nloc; b.st[1] = nx; }
        const unsigned old = xb_add(&bar[XB_XSUB(b.x)], 1u);
        const unsigned gen = old / nloc;
        if (old + 1u == (gen + 1u) * nloc) {
            __builtin_amdgcn_fence(__ATOMIC_RELEASE, "agent");
            asm volatile("s_waitcnt vmcnt(0)" ::: "memory");
            const unsigned og = xb_add(&bar[XB_TOP], 1u);
            const unsigned tg = og / nx;
            if (og + 1u == (tg + 1u) * nx) xb_add(&bar[XB_TOPGEN], 1u);
            else XB_SPIN(xb_ld(&bar[XB_TOPGEN]) == tg, bar);
            __builtin_amdgcn_fence(__ATOMIC_ACQUIRE, "agent");
            xb_add(&bar[XB_XGEN(b.x)], 1u);
            asm volatile("s_waitcnt vmcnt(0)" ::: "memory");
        } else {
            XB_SPIN(xb_ld(&bar[XB_XGEN(b.x)]) == gen, bar);
            __builtin_amdgcn_fence(__ATOMIC_ACQUIRE, "agent");
            asm volatile("s_waitcnt vmcnt(0)" ::: "memory");
        }
    }
    __syncthreads();
}

#ifndef MOE_FP8
#define MOE_FP8 1
#endif
constexpr int D = 1024, NB = 4, S = 4096, CTX = 256, SKV = S + CTX;
constexpr int MX = NB * S, MC = NB * CTX, MT = MX + MC;
constexpr int INW = 2224, PW = 2304;
constexpr int O_CQ = 0, O_CKV = 384, O_KR = 640, O_MQ = 672, O_MK = 928, O_MV = 1184, O_MO = 1696, O_G = 2208;
constexpr int QL = 384, KVL = 256, HA = 8, DN = 64, DR = 32, DQK = 96, DVH = 64;
constexpr int NH = 4, MDQK = 64, MDV = 128;
constexpr int NE = 32, TOPK = 4, DFF = 1024;
constexpr float EPS = 1e-6f;
constexpr int NT = 512;
constexpr int NSEQ = NB * NH * 2;
constexpr int RCAP = MX * TOPK + NE * 256;

constexpr size_t MiB = 1u << 20;
constexpr size_t WS_CTL = 0, CTL_BYTES = 1 * MiB;
constexpr size_t WS_MOD = 1 * MiB;
constexpr size_t WS_MLS = 2 * MiB;
constexpr size_t WS_ROPE = 5 * MiB;
constexpr size_t WS_STAT2 = 6 * MiB;
constexpr size_t WS_TOPE = 8 * MiB;
constexpr size_t WS_SLOT = 9 * MiB;
constexpr size_t WS_LIST = 10 * MiB;
constexpr size_t WS_RGATE = 12 * MiB;
constexpr size_t WS_H = 16 * MiB;
constexpr size_t WS_P = 52 * MiB;
constexpr size_t WS_ACT = WS_P;
constexpr size_t WS_Q = 206 * MiB;
constexpr size_t WS_KV = 254 * MiB;
constexpr size_t WS_CLOC = 322 * MiB;
constexpr size_t WS_CIN = 386 * MiB;
constexpr size_t WS_X1 = 450 * MiB;
constexpr size_t WS_H2 = 514 * MiB;
constexpr size_t WS_YG = 546 * MiB;
constexpr size_t WS_WGUT = 690 * MiB;
constexpr size_t WS_WDNT = 818 * MiB;
constexpr size_t WS_WINT = 882 * MiB;
constexpr size_t WS_WUQT = 887 * MiB;
constexpr size_t WS_WUKVT = 888 * MiB;
constexpr size_t WS_WOUTT = 889 * MiB;
constexpr size_t WS_GATES = 891 * MiB;
constexpr size_t WS_STAT = 893 * MiB;
constexpr size_t WS_RSTD = 895 * MiB;
constexpr size_t WS_MIX16 = 896 * MiB;
constexpr size_t WS_END = 928 * MiB;
static_assert((size_t)MT * PW * 2 <= 153 * MiB && (size_t)RCAP * DFF * 2 <= 144 * MiB, "map");

constexpr int CW_BAR = 4096;
constexpr int CW_CNT = 16384;
constexpr int CW_QGU = 16384 + 64, CW_QDN = 16384 + 128;
constexpr int GU_CHUNKS = 512, DN_CHUNKS = 256;
#ifndef GU_STATIC
#define GU_STATIC 400
#endif

struct Params {
    const float* in[23];
    float* out;
    unsigned char* ws;
    int ph_lo, ph_hi;
};
enum { I_X = 0, I_C, I_CTX, I_CCTX, I_WMOD, I_BMOD, I_N1G, I_WIN, I_BG, I_QNG, I_WUQ, I_KVNG, I_WUKV, I_MNG, I_WOUT, I_N2G, I_RW, I_RB, I_WGU, I_BGU, I_WDN, I_BDN, I_FNG };

__device__ __forceinline__ float wave_sum(float v) {
#pragma unroll
    for (int o = 1; o < 64; o <<= 1) v += __shfl_xor(v, o);
    return v;
}
__device__ __forceinline__ float bf2f(unsigned short v) { return __uint_as_float(((unsigned)v) << 16); }
__device__ __forceinline__ float sigmoidf_(float x) { return 1.f / (1.f + __expf(-x)); }
__device__ __forceinline__ float siluf_(float x) { return x / (1.f + expf(-x)); }
__device__ __forceinline__ float logsigmoidf_(float x) { return fminf(x, 0.f) - log1pf(expf(-fabsf(x))); }

__device__ __forceinline__ int krow(int b, int key) { return key < CTX ? MX + b * CTX + key : b * S + (key - CTX); }
__device__ __forceinline__ int srow(int b, int dir, int u) {
    if (u < CTX) { const int c = dir ? (CTX - 1 - u) : u; return MX + b * CTX + c; }
    const int tt = u - CTX; const int s = dir ? (S - 1 - tt) : tt; return b * S + s;
}
__device__ __forceinline__ void rope_angles(int s, int j, float& cs, float& sn) {
    const int jj = j & 7; const float pos = (j < 8) ? (float)(s / 64) : (float)(s % 64);
    const float inv = powf(10000.f, -(float)jj / 8.f);
    const float ang = pos * inv; cs = cosf(ang); sn = sinf(ang);
}

struct GemmDesc { const float* A; int lda; const int* arow; int M; const float* B; int ldb; int N; int K; };
template <class Epi>
__device__ __forceinline__ void sgemm_tile(float* lds, const GemmDesc g, int tm, int tn, const Epi& epi) {
    float* As = lds;
    float* Bs = lds + 16 * 132;
    const int tid = threadIdx.x, tx = tid & 15, ty = tid >> 4;
    float acc[4][8];
#pragma unroll
    for (int i = 0; i < 4; ++i)
#pragma unroll
        for (int j = 0; j < 8; ++j) acc[i][j] = 0.f;
    const int ar = tid >> 2, ak = (tid & 3) * 4;
    const int grow = tm * 128 + ar;
    const float* aptr = nullptr;
    if (grow < g.M) { const int r = g.arow ? g.arow[grow] : grow; aptr = g.A + (size_t)r * g.lda + ak; }
    const int bk = tid >> 5, bc = (tid & 31) * 4;
    const int gcol = tn * 128 + bc;
    for (int k0 = 0; k0 < g.K; k0 += 16) {
        float4 av = make_float4(0.f, 0.f, 0.f, 0.f), bv = make_float4(0.f, 0.f, 0.f, 0.f);
        if (aptr) av = *(const float4*)(aptr + k0);
        if (gcol < g.N) bv = *(const float4*)(g.B + (size_t)(k0 + bk) * g.ldb + gcol);
        __syncthreads();
        As[(ak + 0) * 132 + ar] = av.x; As[(ak + 1) * 132 + ar] = av.y; As[(ak + 2) * 132 + ar] = av.z; As[(ak + 3) * 132 + ar] = av.w;
        *(float4*)(Bs + bk * 128 + bc) = bv;
        __syncthreads();
#pragma unroll
        for (int k = 0; k < 16; ++k) {
            const float4 a4 = *(const float4*)(As + k * 132 + ty * 4);
            const float4 b0 = *(const float4*)(Bs + k * 128 + tx * 8), b1 = *(const float4*)(Bs + k * 128 + tx * 8 + 4);
            const float a[4] = {a4.x, a4.y, a4.z, a4.w};
            const float b[8] = {b0.x, b0.y, b0.z, b0.w, b1.x, b1.y, b1.z, b1.w};
#pragma unroll
            for (int i = 0; i < 4; ++i)
#pragma unroll
                for (int j = 0; j < 8; ++j) acc[i][j] = fmaf(a[i], b[j], acc[i][j]);
        }
    }
#pragma unroll
    for (int i = 0; i < 4; ++i) {
        const int r = tm * 128 + ty * 4 + i;
        if (r < g.M) {
#pragma unroll
            for (int j = 0; j < 8; ++j) { const int c = tn * 128 + tx * 8 + j; if (c < g.N) epi(r, c, acc[i][j]); }
        }
    }
}
template <class Epi>
__device__ __forceinline__ void sgemm_phase(float* lds, const GemmDesc g, const Epi& epi, int u0 = 0, int ustride = 0) {
    const int ntm = (g.M + 127) / 128, ntn = (g.N + 127) / 128;
    for (int u = blockIdx.x; u < ntm * ntn; u += gridDim.x) sgemm_tile(lds, g, u / ntn, u % ntn, epi);
}


namespace pg8 {
#define PG8_LAS __attribute__((address_space(3)))
typedef unsigned short bf16_t;
typedef short bf16x8 __attribute__((ext_vector_type(8)));
typedef float f32x4 __attribute__((ext_vector_type(4)));
typedef unsigned u32x4 __attribute__((ext_vector_type(4)));
typedef unsigned u32x2 __attribute__((ext_vector_type(2)));
constexpr int BM = 256, BK = 64, HALF = 128, HTB = HALF * BK * 2, STAGE_BYTES = 8 * HTB, NXCD = 8, WGM = 8;
__host__ __device__ __forceinline__ int lds_byte(int r, int c) { const int st = (r >> 4) * 2 + (c >> 5), rr = r & 15, cc = c & 31, ob = rr * 64 + cc * 2; return st * 1024 + (ob ^ (((ob >> 9) & 1) << 5)); }
__host__ __device__ __forceinline__ void stage_rc(int b, int& R, int& C) { const int st = b / 1024, sb = b % 1024, swz = sb ^ (((sb >> 9) & 1) << 5); R = (st >> 1) * 16 + swz / 64; C = (st & 1) * 32 + (swz % 64) / 2; }
__host__ __device__ __forceinline__ int perm32(int rho) { const int n = rho >> 4, i = rho & 15; return 8 * (i >> 2) + 4 * n + (i & 3); }
__device__ __forceinline__ unsigned cvt_pk_bf16(float lo, float hi) { unsigned r; asm volatile("v_cvt_pk_bf16_f32 %0, %1, %2" : "=v"(r) : "v"(lo), "v"(hi)); return r; }

struct Unit { int pm, pn, g, row0; };

struct PlainSched {
    int nM, nN, nwg, G, c, lda, K; const char* Bt;
    __device__ void init(int M, int N, int K_, int lda_, const void* Bt_, int G_, int c_) { nM = M / BM; nN = N / BM; nwg = nM * nN; G = G_; c = c_; lda = lda_; K = K_; Bt = (const char*)Bt_; }
    __device__ __forceinline__ bool next(int i, Unit& u) const {
        const long L = (long)i * G + c; if (L >= nwg) return false;
        int wgid = (int)L; { const int q = nwg / NXCD, r = nwg % NXCD, xcd = wgid % NXCD, off = wgid / NXCD; wgid = (xcd < r ? xcd * (q + 1) : r * (q + 1) + (xcd - r) * q) + off; }
        const int nig = WGM * nN, gid = wgid / nig, fm = gid * WGM, gsz = (nM - fm) < WGM ? (nM - fm) : WGM;
        u.pm = fm + ((wgid % nig) % gsz); u.pn = (wgid % nig) / gsz; u.g = 0; u.row0 = u.pm * BM; return true;
    }
    __device__ __forceinline__ unsigned a_rowoff(const Unit& u, int r) const { return (unsigned)(u.pm * BM + r) * (unsigned)(lda * 2); }
    __device__ __forceinline__ void rows4(const Unit& u, int R0, int R1, unsigned (&o)[4]) const { o[0] = a_rowoff(u, R0); o[1] = a_rowoff(u, R1); o[2] = a_rowoff(u, HALF + R0); o[3] = a_rowoff(u, HALF + R1); }
    __device__ __forceinline__ const char* b_base(const Unit& u) const { return Bt + (size_t)u.pn * BM * K * 2; }
};

template <class Epi, class Sched, bool ALIGN_EPI, bool F8 = false>
__device__ __forceinline__ void gemm_phase(PG8_LAS unsigned char* lds, const bf16_t* Aptr, const int K, const Sched& S, const Epi& E) {
    const int tid = threadIdx.x, wid = __builtin_amdgcn_readfirstlane(tid >> 6), lane = tid & 63, wr = wid >> 2, wc = wid & 3, fr = lane & 15, fq = lane >> 4;
    const int nt = K / BK;
    unsigned voffB[2];
#pragma unroll
    for (int i = 0; i < 2; ++i) { int R, C; stage_rc(tid * 16 + i * 8192, R, C); const int Rb = Epi::PERM ? ((R & ~31) + perm32(R & 31)) : R;
        voffB[i] = (unsigned)(Rb * K + C) * 2u; }
    const size_t kstep = (size_t)(BK * 2);
    const size_t hstepB = (size_t)HALF * K * 2;
    const unsigned ldsw = (unsigned)wid * 1024u;
    const int aoff = lds_byte(wr * 64 + fr, fq * 8), boff = lds_byte(wc * 32 + fr, fq * 8);
#define PG8_SA(b, h) (((b) * 2 + (h)) * HTB)
#define PG8_SB(b, h) ((4 + (b) * 2 + (h)) * HTB)
#define PG8_STAGE(bufoff, gbase, voff) do { _Pragma("unroll") for (int _i = 0; _i < 2; ++_i) \
        __builtin_amdgcn_global_load_lds((const unsigned*)((const char*)(gbase) + (voff)[_i]), (PG8_LAS unsigned*)(lds + (bufoff) + ldsw + _i * 8192), 16, 0, 0); } while (0)
#define PG8_LDA(dst, b, h) do { _Pragma("unroll") for (int m = 0; m < 4; ++m) _Pragma("unroll") for (int k = 0; k < 2; ++k) dst[m][k] = *(const PG8_LAS bf16x8*)(lds + PG8_SA(b, h) + aoff + m * 2048 + k * 1024); } while (0)
#define PG8_LDB(dst, b, h) do { _Pragma("unroll") for (int n = 0; n < 2; ++n) _Pragma("unroll") for (int k = 0; k < 2; ++k) dst[n][k] = *(const PG8_LAS bf16x8*)(lds + PG8_SB(b, h) + boff + n * 2048 + k * 1024); } while (0)
typedef int i32x4v __attribute__((ext_vector_type(4)));
typedef int i32x8v __attribute__((ext_vector_type(8)));
#define PG8_CAT(x0, x1) __builtin_shufflevector(__builtin_bit_cast(i32x4v, x0), __builtin_bit_cast(i32x4v, x1), 0, 1, 2, 3, 4, 5, 6, 7)
#define PG8_MMA(ai, bj, At, Bt) do { __builtin_amdgcn_s_setprio(1); \
        if constexpr (F8) { _Pragma("unroll") for (int m = 0; m < 4; ++m) _Pragma("unroll") for (int n = 0; n < 2; ++n) \
            acc[ai][bj][m][n] = __builtin_amdgcn_mfma_scale_f32_16x16x128_f8f6f4(PG8_CAT(Bt[n][0], Bt[n][1]), PG8_CAT(At[m][0], At[m][1]), acc[ai][bj][m][n], 0, 0, 0, 0x79797979, 0, 0x7f7f7f7f); } \
        else { _Pragma("unroll") for (int m = 0; m < 4; ++m) _Pragma("unroll") for (int n = 0; n < 2; ++n) _Pragma("unroll") for (int k = 0; k < 2; ++k) \
            acc[ai][bj][m][n] = __builtin_amdgcn_mfma_f32_16x16x32_bf16(Bt[n][k], At[m][k], acc[ai][bj][m][n], 0, 0, 0); } \
        __builtin_amdgcn_s_setprio(0); } while (0)
#define PG8_WAIT_V(n) asm volatile("s_waitcnt vmcnt(" #n ")" ::: "memory")
#define PG8_WAIT_L(n) asm volatile("s_waitcnt lgkmcnt(" #n ")" ::: "memory")
#define PG8_BAR __builtin_amdgcn_s_barrier()
#define PG8_SCHED __builtin_amdgcn_sched_barrier(0)
    Unit cur, nxt; int ui = 0;
    if (!S.next(0, cur)) return;
    f32x4 acc[2][2][4][2];
#pragma unroll
    for (int a = 0; a < 2; ++a)
#pragma unroll
        for (int b = 0; b < 2; ++b)
#pragma unroll
            for (int m = 0; m < 4; ++m)
#pragma unroll
                for (int n = 0; n < 2; ++n) acc[a][b][m][n] = (f32x4){0.f, 0.f, 0.f, 0.f};
    bf16x8 At[4][2], B0[2][2], B1[2][2];
    unsigned oA0[2], oA1[2];
    { int R0, C0, R1, C1; stage_rc(tid * 16, R0, C0); stage_rc(tid * 16 + 8192, R1, C1); unsigned o4[4]; S.rows4(cur, R0, R1, o4);
      oA0[0] = o4[0] + (unsigned)C0 * 2u; oA0[1] = o4[1] + (unsigned)C1 * 2u; oA1[0] = o4[2] + (unsigned)C0 * 2u; oA1[1] = o4[3] + (unsigned)C1 * 2u; }
    const char* const cA = (const char*)Aptr;
    const char* cB = S.b_base(cur);
    PG8_STAGE(PG8_SB(0, 0), cB, voffB); PG8_STAGE(PG8_SB(0, 1), cB + hstepB, voffB); PG8_STAGE(PG8_SA(0, 0), cA, oA0); PG8_STAGE(PG8_SA(0, 1), cA, oA1);
    if (wr == 1) PG8_BAR;
    PG8_WAIT_V(2); PG8_BAR;
    PG8_STAGE(PG8_SB(1, 0), cB + kstep, voffB); PG8_STAGE(PG8_SA(1, 0), cA + kstep, oA0); PG8_STAGE(PG8_SB(1, 1), cB + hstepB + kstep, voffB);
    PG8_WAIT_V(6); PG8_BAR;
    for (;;) {
        const bool has_next = S.next(ui + 1, nxt);
        const char* nB = has_next ? S.b_base(nxt) : cB;
        unsigned pre[4] = {0u, 0u, 0u, 0u};
        if (has_next) { int R0, C0, R1, C1; stage_rc((int)threadIdx.x * 16, R0, C0); stage_rc((int)threadIdx.x * 16 + 8192, R1, C1); S.rows4(nxt, R0, R1, pre);
            asm volatile("" : "+v"(pre[0]), "+v"(pre[1]), "+v"(pre[2]), "+v"(pre[3])); }
#pragma unroll 1
        for (int t = 0; t < nt; t += 2) {
            const bool last = (t == nt - 2);
            const char* a1 = cA + (size_t)(t + 1) * kstep;
            const char* a2 = last ? cA : cA + (size_t)(t + 2) * kstep; const char* b2 = last ? nB : cB + (size_t)(t + 2) * kstep;
            const char* a3 = a2 + kstep; const char* b3 = b2 + kstep;
            PG8_LDB(B0, 0, 0); PG8_LDB(B1, 0, 1); PG8_SCHED; PG8_LDA(At, 0, 0); PG8_STAGE(PG8_SA(1, 1), a1, oA1);
            if (last && has_next) {
                int R0, C0, R1, C1; stage_rc((int)threadIdx.x * 16, R0, C0); stage_rc((int)threadIdx.x * 16 + 8192, R1, C1);
                oA0[0] = pre[0] + (unsigned)C0 * 2u; oA0[1] = pre[1] + (unsigned)C1 * 2u; oA1[0] = pre[2] + (unsigned)C0 * 2u; oA1[1] = pre[3] + (unsigned)C1 * 2u;
            }
            PG8_WAIT_V(8); PG8_WAIT_L(0); PG8_BAR; PG8_MMA(0, 0, At, B0); PG8_MMA(0, 1, At, B1); PG8_BAR; PG8_SCHED;
            PG8_LDA(At, 0, 1); PG8_STAGE(PG8_SB(0, 0), b2, voffB); PG8_STAGE(PG8_SB(0, 1), b2 + hstepB, voffB); PG8_STAGE(PG8_SA(0, 0), a2, oA0);
            PG8_WAIT_V(8); PG8_WAIT_L(0); PG8_BAR; PG8_MMA(1, 0, At, B0); PG8_MMA(1, 1, At, B1); PG8_BAR; PG8_SCHED;
            PG8_LDB(B0, 1, 0); PG8_LDB(B1, 1, 1); PG8_SCHED; PG8_LDA(At, 1, 0); PG8_STAGE(PG8_SA(0, 1), a2, oA1);
            PG8_WAIT_V(8); PG8_WAIT_L(0); PG8_BAR; PG8_MMA(0, 0, At, B0); PG8_MMA(0, 1, At, B1); PG8_BAR; PG8_SCHED;
            PG8_LDA(At, 1, 1); PG8_STAGE(PG8_SB(1, 0), b3, voffB); PG8_STAGE(PG8_SB(1, 1), b3 + hstepB, voffB); PG8_STAGE(PG8_SA(1, 0), a3, oA0);
            PG8_WAIT_V(8); PG8_WAIT_L(0); PG8_BAR; PG8_MMA(1, 0, At, B0); PG8_MMA(1, 1, At, B1); PG8_BAR; PG8_SCHED;
        }
        if constexpr (ALIGN_EPI) { if (wr == 0) PG8_BAR; }
        E(acc, cur, wr, wc, fr, fq);
        if (!has_next) break;
#pragma unroll
        for (int a = 0; a < 2; ++a)
#pragma unroll
            for (int b = 0; b < 2; ++b)
#pragma unroll
                for (int m = 0; m < 4; ++m)
#pragma unroll
                    for (int n = 0; n < 2; ++n) acc[a][b][m][n] = (f32x4){0.f, 0.f, 0.f, 0.f};
        cur = nxt; cB = nB; ++ui;
        if constexpr (ALIGN_EPI) { if (wr == 1) PG8_BAR; }
    }
    PG8_WAIT_V(0);
    if constexpr (!ALIGN_EPI) { if (wr == 0) PG8_BAR; }
    PG8_BAR;
#undef PG8_SA
#undef PG8_SB
#undef PG8_STAGE
#undef PG8_LDA
#undef PG8_LDB
#undef PG8_MMA
#undef PG8_CAT
#undef PG8_WAIT_V
#undef PG8_WAIT_L
#undef PG8_BAR
#undef PG8_SCHED
}

struct EpiF32 {
    static constexpr bool PERM = false;
    float* C; int ldc; int ncols;
    __device__ __forceinline__ void operator()(const f32x4 (&acc)[2][2][4][2], const Unit& u, int wr, int wc, int fr, int fq) const {
        const int row0 = u.row0 + wr * 64 + fr, col0 = u.pn * BM + wc * 32 + 4 * fq;
#pragma unroll
        for (int ai = 0; ai < 2; ++ai)
#pragma unroll
            for (int m = 0; m < 4; ++m) { float* rowp = C + (size_t)(row0 + ai * HALF + m * 16) * ldc + col0;
#pragma unroll
                for (int bj = 0; bj < 2; ++bj)
#pragma unroll
                    for (int n = 0; n < 2; ++n) if (col0 + bj * HALF + n * 16 < ncols) *(f32x4*)(rowp + bj * HALF + n * 16) = acc[ai][bj][m][n]; }
    }
};
struct MoeSched {
    const PG8_LAS int* tp; const PG8_LAS int* ro; const PG8_LAS int* cn; int nN, G, c, K, lda, gather; const int* list; const char* Bt; size_t bstride;
    __device__ __forceinline__ bool next(int i, Unit& u) const {
        const int nwg = tp[32] * nN; const long L = (long)i * G + c; if (L >= nwg) return false;
        int wgid = (int)L; { const int q = nwg / NXCD, r = nwg % NXCD, xcd = wgid % NXCD, off = wgid / NXCD; wgid = (xcd < r ? xcd * (q + 1) : r * (q + 1) + (xcd - r) * q) + off; }
        const int tile = wgid / nN;
        const int g = __popcll(__ballot(tp[threadIdx.x & 31] <= tile) & 0xffffffffull) - 1;
        const int ntm = tp[g + 1] - tp[g]; const int rem = wgid - tp[g] * nN;
        u.g = g; u.pm = rem % ntm; u.pn = rem / ntm; u.row0 = ro[g] + u.pm * BM; return true;
    }
    __device__ __forceinline__ unsigned a_rowoff(const Unit& u, int r) const {
        const int rr = u.pm * BM + r;
        if (gather) { const int tok = (rr < cn[u.g]) ? list[u.g * 16384 + rr] : 0; return (unsigned)tok * (unsigned)(lda * 2); }
        return (unsigned)(u.row0 + r) * (unsigned)(lda * 2);
    }
    __device__ __forceinline__ void rows4(const Unit& u, int R0, int R1, unsigned (&o)[4]) const {
        if (gather) { const int last = cn[u.g] - 1, b0 = u.pm * BM; const int* lp = list + u.g * 16384;
            const int t0 = lp[min(b0 + R0, last)], t1 = lp[min(b0 + R1, last)], t2 = lp[min(b0 + HALF + R0, last)], t3 = lp[min(b0 + HALF + R1, last)];
            o[0] = (unsigned)t0 * (unsigned)(lda * 2); o[1] = (unsigned)t1 * (unsigned)(lda * 2); o[2] = (unsigned)t2 * (unsigned)(lda * 2); o[3] = (unsigned)t3 * (unsigned)(lda * 2); }
        else { o[0] = a_rowoff(u, R0); o[1] = a_rowoff(u, R1); o[2] = a_rowoff(u, HALF + R0); o[3] = a_rowoff(u, HALF + R1); }
    }
    __device__ __forceinline__ const char* b_base(const Unit& u) const { return Bt + (size_t)u.g * bstride + (size_t)u.pn * BM * K * 2; }
};
struct EpiSwiglu {
    static constexpr bool PERM = true;
    bf16_t* O; const float* bias;
    __device__ __forceinline__ void operator()(const f32x4 (&acc)[2][2][4][2], const Unit& u, int wr, int wc, int fr, int fq) const {
        const int row0 = u.row0 + wr * 64 + fr, col0 = u.pn * 128 + wc * 32 + 8 * fq;
        const float* bg = bias + (size_t)u.g * 2048 + col0;
        f32x4 bgl[2], bln[2];
#pragma unroll
        for (int n = 0; n < 2; ++n) { bgl[n] = *(const f32x4*)(bg + 4 * n); bln[n] = *(const f32x4*)(bg + 1024 + 4 * n) + 1.0f; }
#pragma unroll
        for (int ai = 0; ai < 2; ++ai)
#pragma unroll
            for (int m = 0; m < 4; ++m) {
                float o[8];
#pragma unroll
                for (int n = 0; n < 2; ++n)
#pragma unroll
                    for (int j = 0; j < 4; ++j) {
                        const float gl = fminf(acc[ai][0][m][n][j] + bgl[n][j], 7.f);
                        const float ln1 = __builtin_amdgcn_fmed3f(acc[ai][1][m][n][j] + bln[n][j], -6.f, 8.f);
                        o[4 * n + j] = gl * __builtin_amdgcn_rcpf(1.f + __builtin_amdgcn_exp2f(gl * (-1.702f * 1.4426950408889634f))) * ln1;
                    }
#if MOE_FP8
                u32x2 w8; { int t0 = __builtin_amdgcn_cvt_pk_fp8_f32(o[0], o[1], 0, false); t0 = __builtin_amdgcn_cvt_pk_fp8_f32(o[2], o[3], t0, true); int t1 = __builtin_amdgcn_cvt_pk_fp8_f32(o[4], o[5], 0, false); t1 = __builtin_amdgcn_cvt_pk_fp8_f32(o[6], o[7], t1, true); w8.x = (unsigned)t0; w8.y = (unsigned)t1; }
                *(u32x2*)((unsigned char*)O + (size_t)(row0 + ai * HALF + m * 16) * 1024 + col0) = w8;
#else
                u32x4 w; w.x = cvt_pk_bf16(o[0], o[1]); w.y = cvt_pk_bf16(o[2], o[3]); w.z = cvt_pk_bf16(o[4], o[5]); w.w = cvt_pk_bf16(o[6], o[7]);
                *(u32x4*)(O + (size_t)(row0 + ai * HALF + m * 16) * 1024 + col0) = w;
#endif
            }
    }
};
struct EpiDown {
    static constexpr bool PERM = true;
    bf16_t* O; const float* bias; const float* rgate; const PG8_LAS int* ro;
    __device__ __forceinline__ void operator()(const f32x4 (&acc)[2][2][4][2], const Unit& u, int wr, int wc, int fr, int fq) const {
        const int row0 = u.row0 + wr * 64 + fr, col0 = u.pn * BM + wc * 32 + 8 * fq;
        const float* bd = bias + (size_t)u.g * 1024 + col0;
        const float* gt = rgate + (size_t)u.g * 16384 + (row0 - ro[u.g]);
        f32x4 bv[2][2];
#pragma unroll
        for (int bj = 0; bj < 2; ++bj)
#pragma unroll
            for (int n = 0; n < 2; ++n) bv[bj][n] = *(const f32x4*)(bd + bj * HALF + 4 * n);
#pragma unroll
        for (int ai = 0; ai < 2; ++ai)
#pragma unroll
            for (int m = 0; m < 4; ++m) {
                const float gv = gt[ai * HALF + m * 16];
                bf16_t* rowp = O + (size_t)(row0 + ai * HALF + m * 16) * 1024 + col0;
#pragma unroll
                for (int bj = 0; bj < 2; ++bj) { const f32x4 v0 = (acc[ai][bj][m][0] + bv[bj][0]) * gv, v1 = (acc[ai][bj][m][1] + bv[bj][1]) * gv;
                    u32x4 w; w.x = cvt_pk_bf16(v0[0], v0[1]); w.y = cvt_pk_bf16(v0[2], v0[3]); w.z = cvt_pk_bf16(v1[0], v1[1]); w.w = cvt_pk_bf16(v1[2], v1[3]);
                    *(u32x4*)(rowp + bj * HALF) = w; }
            }
    }
};
struct EpiInproj {
    static constexpr bool PERM = true;
    bf16_t* P; float* gates; float* stat; bf16_t* Kb; const float* cs; const float* sn;
    __device__ __forceinline__ void operator()(const f32x4 (&acc)[2][2][4][2], const Unit& u, int wr, int wc, int fr, int fq) const {
        const int row0 = u.row0 + wr * 64 + fr, colb = u.pn * BM + wc * 32 + 8 * fq;
#pragma unroll
        for (int ai = 0; ai < 2; ++ai)
#pragma unroll
            for (int m = 0; m < 4; ++m) { const int row = row0 + ai * HALF + m * 16;
#pragma unroll
                for (int bj = 0; bj < 2; ++bj) { const f32x4 v0 = acc[ai][bj][m][0], v1 = acc[ai][bj][m][1];
                    u32x4 w; w.x = cvt_pk_bf16(v0[0], v0[1]); w.y = cvt_pk_bf16(v0[2], v0[3]); w.z = cvt_pk_bf16(v1[0], v1[1]); w.w = cvt_pk_bf16(v1[2], v1[3]);
                    *(u32x4*)(P + (size_t)row * 2304 + colb + bj * HALF) = w;
                    if (u.pn <= 2) { float sq = (v0[0] * v0[0] + v0[1] * v0[1]) + (v0[2] * v0[2] + v0[3] * v0[3]) + (v1[0] * v1[0] + v1[1] * v1[1]) + (v1[2] * v1[2] + v1[3] * v1[3]);
                        sq += __shfl_xor(sq, 16); sq += __shfl_xor(sq, 32);
                        if (fq == 0) stat[(size_t)row * 24 + (u.pn * 2 + bj) * 4 + wc] = sq; }
                    if (u.pn == 8 && bj == 1 && wc == 1 && fq < 2) { *(f32x4*)(gates + (size_t)row * 16 + fq * 8) = v0; *(f32x4*)(gates + (size_t)row * 16 + fq * 8 + 4) = v1; }
                    if (u.pn == 2 && bj == 1 && wc == 0) {
                        f32x4 r0 = v0, r1 = v1;
                        f32x4 o0, o1;
#pragma unroll
                        for (int j = 0; j < 4; ++j) { o0[j] = __shfl_xor(v0[j], 32); o1[j] = __shfl_xor(v1[j], 32); }
                        int krow;
                        if (row < 16384) { const int pos = row & 4095; const int jb = 8 * (fq & 1);
                            const f32x4 c0 = *(const f32x4*)(cs + pos * 16 + jb), c1 = *(const f32x4*)(cs + pos * 16 + jb + 4), s0 = *(const f32x4*)(sn + pos * 16 + jb), s1 = *(const f32x4*)(sn + pos * 16 + jb + 4);
                            if (fq < 2) { r0 = v0 * c0 - o0 * s0; r1 = v1 * c1 - o1 * s1; } else { r0 = o0 * s0 + v0 * c0; r1 = o1 * s1 + v1 * c1; }
                            krow = (row >> 12) * 4352 + 256 + pos; }
                        else krow = ((row - 16384) >> 8) * 4352 + ((row - 16384) & 255);
                        u32x4 kw; kw.x = cvt_pk_bf16(r0[0], r0[1]); kw.y = cvt_pk_bf16(r0[2], r0[3]); kw.z = cvt_pk_bf16(r1[0], r1[1]); kw.w = cvt_pk_bf16(r1[2], r1[3]);
#pragma unroll
                        for (int hh = 0; hh < 8; ++hh) *(u32x4*)(Kb + (size_t)krow * 768 + hh * 96 + 64 + 8 * fq) = kw;
                    }
                } }
    }
};
struct EpiF32RowScale {
    static constexpr bool PERM = false;
    float* C; int ldc; const float* rs;
    __device__ __forceinline__ void operator()(const f32x4 (&acc)[2][2][4][2], const Unit& u, int wr, int wc, int fr, int fq) const {
        const int row0 = u.row0 + wr * 64 + fr, col0 = u.pn * BM + wc * 32 + 4 * fq;
#pragma unroll
        for (int ai = 0; ai < 2; ++ai)
#pragma unroll
            for (int m = 0; m < 4; ++m) { const int row = row0 + ai * HALF + m * 16; const float sc = rs[row]; float* rowp = C + (size_t)row * ldc + col0;
#pragma unroll
                for (int bj = 0; bj < 2; ++bj)
#pragma unroll
                    for (int n = 0; n < 2; ++n) *(f32x4*)(rowp + bj * HALF + n * 16) = acc[ai][bj][m][n] * sc; }
    }
};
struct EpiResid {
    static constexpr bool PERM = true;
    bf16_t* C; const float* X; const float* mod; float* stat2;
    __device__ __forceinline__ void operator()(const f32x4 (&acc)[2][2][4][2], const Unit& u, int wr, int wc, int fr, int fq) const {
        const int row0 = u.row0 + wr * 64 + fr, col0 = u.pn * BM + wc * 32 + 8 * fq;
        const float* g1 = mod + (size_t)(u.row0 / 4096) * 6144 + 2048 + col0;
        f32x4 gv[2][2];
#pragma unroll
        for (int bj = 0; bj < 2; ++bj)
#pragma unroll
            for (int n = 0; n < 2; ++n) gv[bj][n] = *(const f32x4*)(g1 + bj * HALF + 4 * n);
#pragma unroll
        for (int ai = 0; ai < 2; ++ai)
#pragma unroll
            for (int m = 0; m < 4; ++m) { const size_t off = (size_t)(row0 + ai * HALF + m * 16) * 1024 + col0;
#pragma unroll
                for (int bj = 0; bj < 2; ++bj) {
                    const f32x4 x0 = *(const f32x4*)(X + off + bj * HALF), x1 = *(const f32x4*)(X + off + bj * HALF + 4);
                    const f32x4 o0 = x0 + gv[bj][0] * acc[ai][bj][m][0], o1 = x1 + gv[bj][1] * acc[ai][bj][m][1];
                    u32x4 w; w.x = cvt_pk_bf16(o0[0], o0[1]); w.y = cvt_pk_bf16(o0[2], o0[3]); w.z = cvt_pk_bf16(o1[0], o1[1]); w.w = cvt_pk_bf16(o1[2], o1[3]);
                    *(u32x4*)(C + off + bj * HALF) = w;
                    float sq = ((o0[0] * o0[0] + o0[1] * o0[1]) + (o0[2] * o0[2] + o0[3] * o0[3])) + ((o1[0] * o1[0] + o1[1] * o1[1]) + (o1[2] * o1[2] + o1[3] * o1[3]));
                    sq += __shfl_xor(sq, 16); sq += __shfl_xor(sq, 32);
                    if (fq == 0) stat2[(size_t)(row0 + ai * HALF + m * 16) * 32 + (u.pn * 2 + bj) * 4 + wc] = sq; }
                asm volatile("" ::: "memory"); }
    }
};
struct EpiQ {
    static constexpr bool PERM = false;
    bf16_t* Q; const float* stat; const float* cs; const float* sn;
    __device__ __forceinline__ void operator()(const f32x4 (&acc)[2][2][4][2], const Unit& u, int wr, int wc, int fr, int fq) const {
        const int row0 = u.row0 + wr * 64 + fr;
#pragma unroll
        for (int ai = 0; ai < 2; ++ai)
#pragma unroll
            for (int m = 0; m < 4; ++m) { const int row = row0 + ai * HALF + m * 16; const int pos = row & 4095;
                float sc; { const f32x4* sp = (const f32x4*)(stat + (size_t)row * 24); const f32x4 a0 = sp[0], a1 = sp[1], a2 = sp[2];
                    sc = rsqrtf((((a0[0] + a0[1]) + (a0[2] + a0[3])) + ((a1[0] + a1[1]) + (a1[2] + a1[3])) + ((a2[0] + a2[1]) + (a2[2] + a2[3]))) * (1.f / 384.f) + 1e-6f) * 0.14724445f; }
                const f32x4 cv = *(const f32x4*)(cs + pos * 16 + 4 * fq), sv = *(const f32x4*)(sn + pos * 16 + 4 * fq);
#pragma unroll
                for (int bj = 0; bj < 2; ++bj) { const int c32 = u.pn * BM + bj * HALF + wc * 32; const bool rope = ((c32 % 96) == 64);
                    f32x4 v0 = acc[ai][bj][m][0], v1 = acc[ai][bj][m][1];
                    if (rope) { const f32x4 a = v0 * cv - v1 * sv, b = v0 * sv + v1 * cv; v0 = a; v1 = b; }
                    v0 = v0 * sc; v1 = v1 * sc;
                    u32x2 w0, w1; w0.x = cvt_pk_bf16(v0[0], v0[1]); w0.y = cvt_pk_bf16(v0[2], v0[3]); w1.x = cvt_pk_bf16(v1[0], v1[1]); w1.y = cvt_pk_bf16(v1[2], v1[3]);
                    bf16_t* dst = Q + (size_t)row * 768 + c32 + 4 * fq;
                    *(u32x2*)dst = w0; *(u32x2*)(dst + 16) = w1; }
                asm volatile("" ::: "memory"); }
    }
};
struct EpiKV {
    static constexpr bool PERM = true;
    bf16_t* K; bf16_t* V; const float* stat;
    __device__ __forceinline__ void operator()(const f32x4 (&acc)[2][2][4][2], const Unit& u, int wr, int wc, int fr, int fq) const {
        const int row0 = u.row0 + wr * 64 + fr;
#pragma unroll
        for (int ai = 0; ai < 2; ++ai)
#pragma unroll
            for (int m = 0; m < 4; ++m) { const int row = row0 + ai * HALF + m * 16;
                float sc; { const f32x4* sp = (const f32x4*)(stat + (size_t)row * 24); const f32x4 a3 = sp[3], a4 = sp[4];
                    sc = rsqrtf((((a3[0] + a3[1]) + (a3[2] + a3[3])) + ((a4[0] + a4[1]) + (a4[2] + a4[3]))) * (1.f / 256.f) + 1e-6f); }
                const int krow = (row < 16384) ? ((row >> 12) * 4352 + 256 + (row & 4095)) : (((row - 16384) >> 8) * 4352 + ((row - 16384) & 255));
#pragma unroll
                for (int bj = 0; bj < 2; ++bj) { const int head = 2 * u.pn + bj; const f32x4 v0 = acc[ai][bj][m][0] * sc, v1 = acc[ai][bj][m][1] * sc;
                    u32x4 w; w.x = cvt_pk_bf16(v0[0], v0[1]); w.y = cvt_pk_bf16(v0[2], v0[3]); w.z = cvt_pk_bf16(v1[0], v1[1]); w.w = cvt_pk_bf16(v1[2], v1[3]);
                    if (wc < 2) *(u32x4*)(K + (size_t)krow * 768 + head * 96 + wc * 32 + 8 * fq) = w;
                    else *(u32x4*)(V + (size_t)krow * 512 + head * 64 + (wc - 2) * 32 + 8 * fq) = w; }
                asm volatile("" ::: "memory"); }
    }
};
}

template <class RowMap>
__device__ __forceinline__ void transpose_item(const float* W, int K, int N, int nblk, unsigned short* WT, const RowMap& rowmap, LAS float* scr, int item, int lane, const float* kscale = nullptr) {
    const int kb = item / nblk, nb = item % nblk, k0 = 64 * kb, n0 = 32 * nb;
    const int ncol = n0 + (lane & 31);
    float tv[32];
#pragma unroll
    for (int i = 0; i < 32; ++i) { const int kk = 2 * i + (lane >> 5); tv[i] = (ncol < N) ? __builtin_nontemporal_load(W + (size_t)(k0 + kk) * N + ncol) : 0.f; }
    if (kscale) {
#pragma unroll
        for (int i = 0; i < 32; ++i) tv[i] *= kscale[k0 + 2 * i + (lane >> 5)]; }
#pragma unroll
    for (int i = 0; i < 32; ++i) scr[(2 * i + (lane >> 5)) * 33 + (lane & 31)] = tv[i];
    asm volatile("s_waitcnt lgkmcnt(0)" ::: "memory");
    const int c = lane & 7;
    const int r0 = rowmap(n0);
#pragma unroll
    for (int j = 0; j < 4; ++j) { const int n = (lane >> 3) + 8 * j; const LAS float* sp = scr + (8 * c) * 33 + n;
        pg8::u32x4 o; o.x = pg8::cvt_pk_bf16(sp[0 * 33], sp[1 * 33]); o.y = pg8::cvt_pk_bf16(sp[2 * 33], sp[3 * 33]); o.z = pg8::cvt_pk_bf16(sp[4 * 33], sp[5 * 33]); o.w = pg8::cvt_pk_bf16(sp[6 * 33], sp[7 * 33]);
        __builtin_nontemporal_store(o, (pg8::u32x4*)(WT + (size_t)(r0 + n) * K + k0 + 8 * c)); }
    asm volatile("s_waitcnt lgkmcnt(0)" ::: "memory");
}


namespace att {
using bf16x8 = __attribute__((ext_vector_type(8))) short;
using s16x4  = __attribute__((ext_vector_type(4))) short;
using f32x16 = __attribute__((ext_vector_type(16))) float;
using u32x4  = __attribute__((ext_vector_type(4))) unsigned;
constexpr int NW = 8, QBLK = 32, KVBLK = 64;
constexpr float SCALE = 0.10206207261596577f;
constexpr float THR = 8.f;
constexpr int LDQ = 768, LDK = 768, LDV = 512, LDO = 1024;
constexpr int SHM_V = KVBLK * 64 * 2, SHM_K = KVBLK * 256;
constexpr int SHM_ATTN = 2 * SHM_V + 2 * SHM_K + NW * 64 * 4;
#define KSWZ(row, colB) ((row) * 256 + ((colB) ^ (((row) & 7) << 4)))
#define SBAR() __builtin_amdgcn_sched_barrier(0)
__device__ __forceinline__ int crow(int r, int hi) { return (r & 3) + 8 * (r >> 2) + 4 * hi; }
__device__ __forceinline__ unsigned cvtpk(float lo, float hi) { unsigned r; asm volatile("v_cvt_pk_bf16_f32 %0, %1, %2" : "=v"(r) : "v"(lo), "v"(hi)); return r; }

constexpr float THR2 = THR * 1.4426950408889634f;
__device__ __forceinline__ void partialSM(f32x16& p0, f32x16& p1, float& m_run, float& alpha) {
  float pmax = p0[0]; for (int r = 1; r < 16; ++r) pmax = fmaxf(pmax, p0[r]); for (int r = 0; r < 16; ++r) pmax = fmaxf(pmax, p1[r]);
  { auto rr = __builtin_amdgcn_permlane32_swap(__float_as_uint(pmax), __float_as_uint(pmax), false, false);
    pmax = fmaxf(__uint_as_float(rr[0]), __uint_as_float(rr[1])); }
  if (__builtin_expect(__all(fabsf(pmax) <= THR2), 1)) { alpha = 1.f; }
  else { m_run += pmax; alpha = __builtin_amdgcn_exp2f(-pmax);
    for (int r = 0; r < 16; ++r) p0[r] -= pmax; for (int r = 0; r < 16; ++r) p1[r] -= pmax; }
  for (int r = 0; r < 16; ++r) p0[r] = __builtin_amdgcn_exp2f(p0[r]);
}
__device__ __forceinline__ void finishSM(f32x16& p0, f32x16& p1, float alpha, float& l_reg, bf16x8& pa0, bf16x8& pa1, bf16x8& pa2, bf16x8& pa3) {
  for (int r = 0; r < 16; ++r) p1[r] = __builtin_amdgcn_exp2f(p1[r]);
  float ps = 0; for (int r = 0; r < 16; ++r) ps += p0[r]; for (int r = 0; r < 16; ++r) ps += p1[r];
  { auto rr = __builtin_amdgcn_permlane32_swap(__float_as_uint(ps), __float_as_uint(ps), false, false);
    ps = __uint_as_float(rr[0]) + __uint_as_float(rr[1]); }
  l_reg = l_reg * alpha + ps;
#define PK4(P, BASE, OUT) do { unsigned a0 = cvtpk(P[BASE + 0], P[BASE + 1]), a1 = cvtpk(P[BASE + 2], P[BASE + 3]);   \
    unsigned b0 = cvtpk(P[BASE + 4], P[BASE + 5]), b1 = cvtpk(P[BASE + 6], P[BASE + 7]);                              \
    auto r0 = __builtin_amdgcn_permlane32_swap(a0, b0, false, false); auto r1 = __builtin_amdgcn_permlane32_swap(a1, b1, false, false); \
    u32x4 w = {r0[0], r1[0], r0[1], r1[1]}; OUT = *reinterpret_cast<bf16x8*>(&w); } while (0)
  PK4(p0, 0, pa0); PK4(p0, 8, pa1); PK4(p1, 0, pa2); PK4(p1, 8, pa3);
#undef PK4
}
__device__ __forceinline__ void qkt(f32x16& p0, f32x16& p1, const char* Ks, const bf16x8* qr, int r32, int hi, float m_run) {
#pragma unroll
  for (int r = 0; r < 16; ++r) { p0[r] = -m_run; p1[r] = -m_run; }
#pragma unroll
  for (int d0 = 0; d0 < 6; ++d0) { int cb = (d0 * 16 + hi * 8) * 2;
    bf16x8 b0 = *reinterpret_cast<const bf16x8*>(Ks + KSWZ(r32, cb));
    bf16x8 b1 = *reinterpret_cast<const bf16x8*>(Ks + KSWZ(32 + r32, cb));
    p0 = __builtin_amdgcn_mfma_f32_32x32x16_bf16(b0, qr[d0], p0, 0, 0, 0);
    p1 = __builtin_amdgcn_mfma_f32_32x32x16_bf16(b1, qr[d0], p1, 0, 0, 0); }
}
__device__ __forceinline__ int v_st(int k, int c) { const int kk = (k & ~0xC) | ((k & 4) << 1) | ((k & 8) >> 1); return ((kk >> 3) * 2 + (c >> 5)) * 512 + ((kk & 7) * 32 + (c & 31)) * 2; }
__device__ __forceinline__ int v_rd_base(int lane) { return ((lane & 3) << 3) | (((lane >> 2) & 3) << 6) | (((lane >> 4) & 1) << 5) | (((lane >> 5) & 1) << 8); }
constexpr int v_rd_off(int d0, int ks, int half) { return d0 * 512 + ks * 2048 + half * 1024; }
template <int OFF> __device__ __forceinline__ s16x4 tr_read(int vb) {
  s16x4 r; asm volatile("ds_read_b64_tr_b16 %0, %1 offset:%2" : "=&v"(r) : "v"(vb), "i"(OFF) : "memory"); return r;
}
template <int D0> __device__ __forceinline__ void pv_one(f32x16& od, int vb, bf16x8 pa0, bf16x8 pa1, bf16x8 pa2, bf16x8 pa3) {
  const s16x4 l0 = tr_read<v_rd_off(D0, 0, 0)>(vb), h0 = tr_read<v_rd_off(D0, 0, 1)>(vb), l1 = tr_read<v_rd_off(D0, 1, 0)>(vb), h1 = tr_read<v_rd_off(D0, 1, 1)>(vb);
  const s16x4 l2 = tr_read<v_rd_off(D0, 2, 0)>(vb), h2 = tr_read<v_rd_off(D0, 2, 1)>(vb), l3 = tr_read<v_rd_off(D0, 3, 0)>(vb), h3 = tr_read<v_rd_off(D0, 3, 1)>(vb);
  asm volatile("s_waitcnt lgkmcnt(0)" ::: "memory"); SBAR();
#define PK(L, H) (bf16x8){L[0], L[1], L[2], L[3], H[0], H[1], H[2], H[3]}
  od = __builtin_amdgcn_mfma_f32_32x32x16_bf16(pa0, PK(l0, h0), od, 0, 0, 0);
  od = __builtin_amdgcn_mfma_f32_32x32x16_bf16(pa1, PK(l1, h1), od, 0, 0, 0);
  od = __builtin_amdgcn_mfma_f32_32x32x16_bf16(pa2, PK(l2, h2), od, 0, 0, 0);
  od = __builtin_amdgcn_mfma_f32_32x32x16_bf16(pa3, PK(l3, h3), od, 0, 0, 0);
#undef PK
}
__device__ __forceinline__ void pv_d0(f32x16* o, int vb, bf16x8 pa0, bf16x8 pa1, bf16x8 pa2, bf16x8 pa3) {
  pv_one<0>(o[0], vb, pa0, pa1, pa2, pa3); pv_one<1>(o[1], vb, pa0, pa1, pa2, pa3);
}
__device__ __forceinline__ void attn_body(const unsigned short* __restrict__ Qb, const unsigned short* __restrict__ Kh, const unsigned short* __restrict__ Vh,
                                          unsigned short* __restrict__ Ob, int seq, char* lds) {
  const int tid = threadIdx.x, wid = tid >> 6, lane = tid & 63, r32 = lane & 31, hi = lane >> 5;
  char* V_lds = lds; char* K_lds = lds + 2 * SHM_V;
  float* ws = (float*)(lds + 2 * SHM_V + 2 * SHM_K) + wid * 64; float* li_l = ws; float* al_l = ws + 32;
  float m_run = 0.f, l_reg = 0; f32x16 o[2] = {}; bf16x8 qr[6];
  const unsigned short* Qw = Qb + (long)(wid * QBLK + r32) * LDQ + hi * 8;
#pragma unroll
  for (int d0 = 0; d0 < 6; ++d0) qr[d0] = *reinterpret_cast<const bf16x8*>(Qw + d0 * 16);
  const int vr = tid >> 3, vc = (tid & 7) * 8, vst = v_st(vr, vc);
  const int k0r = tid / 12, k0c = tid % 12, id1 = 512 + (tid & 255), k1r = id1 / 12, k1c = id1 % 12;
  const int kst0 = KSWZ(k0r, k0c * 16), kst1 = KSWZ(k1r, k1c * 16);
  const long vg = (long)vr * LDV + vc, kg0 = (long)k0r * LDK + k0c * 8, kg1 = (long)k1r * LDK + k1c * 8;
  const int vb0 = (int)(uintptr_t)V_lds + v_rd_base(lane);
  struct { bf16x8 vs, ks0, ks1; } sr_[2];
#define SLOAD(i, kk0) do { sr_[i].vs = *reinterpret_cast<const bf16x8*>(Vh + (long)(kk0) * LDV + vg); \
    sr_[i].ks0 = *reinterpret_cast<const bf16x8*>(Kh + (long)(kk0) * LDK + kg0); sr_[i].ks1 = *reinterpret_cast<const bf16x8*>(Kh + (long)(kk0) * LDK + kg1); } while (0)
#define SWRITE(b, i) do { *(bf16x8*)(V_lds + (b) * SHM_V + vst) = sr_[i].vs; \
    *(bf16x8*)(K_lds + (b) * SHM_K + kst0) = sr_[i].ks0; *(bf16x8*)(K_lds + (b) * SHM_K + kst1) = sr_[i].ks1; } while (0)
#define SWAIT() asm volatile("s_waitcnt vmcnt(3)" ::: "memory")
#define RESC(a) do { if (__any((a) < 1.f)) { if (hi == 0) al_l[r32] = (a); asm volatile("s_waitcnt lgkmcnt(0)" ::: "memory"); \
    for (int d = 0; d < 2; ++d) for (int r = 0; r < 16; ++r) o[d][r] *= al_l[crow(r, hi)]; } } while (0)
  f32x16 pA0, pA1, pB0, pB1; float alA, alB; bf16x8 pa0, pa1, pa2, pa3; const int NT = seq / KVBLK;
  constexpr int SE = 0, SO = 1;
  SLOAD(SE, 0); asm volatile("s_waitcnt vmcnt(0)" ::: "memory"); SWRITE(0, SE); __syncthreads();
  qkt(pA0, pA1, K_lds, qr, r32, hi, m_run); partialSM(pA0, pA1, m_run, alA);
  SLOAD(SO, KVBLK); if (2 < NT) SLOAD(SE, 2 * KVBLK);
  SWAIT(); SWRITE(1, SO); __syncthreads();
  for (int j = 1; j + 1 < NT; j += 2) {
    SBAR(); qkt(pB0, pB1, K_lds + SHM_K, qr, r32, hi, m_run);
    finishSM(pA0, pA1, alA, l_reg, pa0, pa1, pa2, pa3); SBAR();
    SLOAD(SO, (j + 2) * KVBLK); SBAR();
    pv_d0(o, vb0, pa0, pa1, pa2, pa3); partialSM(pB0, pB1, m_run, alB);
    __syncthreads(); SWAIT(); SWRITE(0, SE);
    RESC(alB); __syncthreads();
    SBAR(); qkt(pA0, pA1, K_lds, qr, r32, hi, m_run);
    finishSM(pB0, pB1, alB, l_reg, pa0, pa1, pa2, pa3); SBAR();
    if (j + 3 < NT) SLOAD(SE, (j + 3) * KVBLK); SBAR();
    pv_d0(o, vb0 + SHM_V, pa0, pa1, pa2, pa3); partialSM(pA0, pA1, m_run, alA);
    __syncthreads(); SWAIT(); SWRITE(1, SO);
    RESC(alA); __syncthreads();
  }
  SBAR(); qkt(pB0, pB1, K_lds + SHM_K, qr, r32, hi, m_run);
  finishSM(pA0, pA1, alA, l_reg, pa0, pa1, pa2, pa3); SBAR();
  pv_d0(o, vb0, pa0, pa1, pa2, pa3); partialSM(pB0, pB1, m_run, alB);
  __syncthreads(); RESC(alB);
  finishSM(pB0, pB1, alB, l_reg, pa0, pa1, pa2, pa3); SBAR();
  pv_d0(o, vb0 + SHM_V, pa0, pa1, pa2, pa3);
  if (hi == 0) li_l[r32] = l_reg; asm volatile("s_waitcnt lgkmcnt(0)" ::: "memory");
  float rli[16];
#pragma unroll
  for (int r = 0; r < 16; ++r) rli[r] = __builtin_amdgcn_rcpf(li_l[crow(r, hi)]);
  unsigned short* Ow = Ob + (long)(wid * QBLK) * LDO;
#pragma unroll
  for (int r = 0; r < 16; ++r) { int orow = crow(r, hi);
#pragma unroll
    for (int d0 = 0; d0 < 2; ++d0) Ow[(long)orow * LDO + d0 * 32 + r32] = (unsigned short)(cvtpk(o[d0][r] * rli[r], 0.f) & 0xffffu); }
  __syncthreads();
#undef SLOAD
#undef SWRITE
#undef SWAIT
#undef RESC
}
#undef KSWZ
#undef SBAR
}


namespace ml {
using bf16x8 = __attribute__((ext_vector_type(8))) short;
using s16x4  = __attribute__((ext_vector_type(4))) short;
using f32x16 = __attribute__((ext_vector_type(16))) float;
using f32x4  = __attribute__((ext_vector_type(4))) float;
using u32x4  = __attribute__((ext_vector_type(4))) unsigned;
constexpr float L2E = 1.4426950408889634f;
constexpr int NXC = 34;
__device__ __forceinline__ int crow(int r, int hi) { return (r & 3) + 8 * (r >> 2) + 4 * hi; }
__device__ __forceinline__ unsigned cvtpk(float lo, float hi) { unsigned r; asm volatile("v_cvt_pk_bf16_f32 %0, %1, %2" : "=v"(r) : "v"(lo), "v"(hi)); return r; }
template <int NC> __device__ __forceinline__ int t_st(int k, int c) { const int kk = (k & ~0xC) | ((k & 4) << 1) | ((k & 8) >> 1); return ((kk >> 3) * NC + (c >> 5)) * 512 + ((kk & 7) * 32 + (c & 31)) * 2; }
__device__ __forceinline__ int t_rd_base(int lane) { return ((lane & 3) << 3) | (((lane >> 2) & 3) << 6) | (((lane >> 4) & 1) << 5) | (((lane >> 5) & 1) << 8); }
template <int NC> constexpr int t_rd_off(int d0, int ks, int half) { return d0 * 512 + ks * (NC * 1024) + half * (NC * 512); }
template <int OFF> __device__ __forceinline__ s16x4 tr_read(int vb) { s16x4 r; asm volatile("ds_read_b64_tr_b16 %0, %1 offset:%2" : "=&v"(r) : "v"(vb), "i"(OFF) : "memory"); return r; }
#define ML_PK(L, H) (bf16x8){L[0], L[1], L[2], L[3], H[0], H[1], H[2], H[3]}
#define ML_KS(row, colB) ((row) * 128 + ((colB) ^ (((row) & 7) << 4)))
__device__ __forceinline__ int chunk_row(int b, int X, int i) { return X < 2 ? (16384 + b * 256 + X * 128 + i) : (b * 4096 + (X - 2) * 128 + i); }
__device__ __forceinline__ float lsig(float x) { return fminf(x, 0.f) - __logf(1.f + __expf(-fabsf(x))); }

__device__ __forceinline__ void gate_prep(const float* GATES, const float* bg, int b, int h, int X, LAS float* cum, LAS float* av, LAS float* pm, LAS float* wsr, LAS float* tot, int wave, int lane) {
    if (wave < 2) {
        const int dir = wave;
        const int e0 = dir ? (127 - 2 * lane) : (2 * lane), e1 = dir ? (126 - 2 * lane) : (2 * lane + 1);
        const int r0 = chunk_row(b, X, e0), r1 = chunk_row(b, X, e1);
        const float bi = bg[(2 * dir) * 4 + h], bf = bg[(2 * dir + 1) * 4 + h];
        const float li0 = GATES[(size_t)r0 * 16 + (2 * dir) * 4 + h] + bi, li1 = GATES[(size_t)r1 * 16 + (2 * dir) * 4 + h] + bi;
        const float x0 = lsig(GATES[(size_t)r0 * 16 + (2 * dir + 1) * 4 + h] + bf), x1 = lsig(GATES[(size_t)r1 * 16 + (2 * dir + 1) * 4 + h] + bf);
        float sc = x0 + x1;
#pragma unroll
        for (int o = 1; o < 64; o <<= 1) { const float y = __shfl_up(sc, o); if (lane >= o) sc += y; }
        const float c1 = sc, c0 = sc - x1; const float total = __shfl(sc, 63);
        const float a0 = li0 - c0, a1 = li1 - c1;
        float mx = fmaxf(a0, a1);
#pragma unroll
        for (int o = 1; o < 64; o <<= 1) { const float y = __shfl_up(mx, o); if (lane >= o) mx = fmaxf(mx, y); }
        float prev = __shfl_up(mx, 1); if (lane == 0) prev = -3.0e38f;
        cum[dir * 128 + e0] = c0; cum[dir * 128 + e1] = c1; av[dir * 128 + e0] = a0; av[dir * 128 + e1] = a1;
        pm[dir * 128 + e0] = fmaxf(prev, a0); pm[dir * 128 + e1] = mx;
        wsr[dir * 128 + e0] = total - c0 + li0; wsr[dir * 128 + e1] = total - c1 + li1;
        if (lane == 0) tot[dir] = total;
    }
}

__device__ __forceinline__ void stepA_unit(const unsigned short* P16, const float* GATES, const float* bg, int bh, int X, float* CLOC, float* NLOC, float* MLOC, float* TOT, char* lds) {
    const int tid = threadIdx.x, wave = __builtin_amdgcn_readfirstlane(tid >> 6), lane = tid & 63, r32 = lane & 31, hi = lane >> 5;
    const int b = bh >> 2, h = bh & 3;
    LAS float* fa = (LAS float*)(lds + 65536);
    LAS float* cum = fa, *av = fa + 256, *pm = fa + 512, *wsr = fa + 768, *tot = fa + 1024, *wl = fa + 1040, *npart = fa + 1312;
    bf16x8 stV[4]; u32x4 stK[2];
#pragma unroll
    for (int j = 0; j < 4; ++j) { const int id = tid + 512 * j, row = id >> 4, ch = id & 15; stV[j] = *reinterpret_cast<const bf16x8*>(P16 + (size_t)chunk_row(b, X, row) * 2304 + 1184 + h * 128 + ch * 8); }
#pragma unroll
    for (int j = 0; j < 2; ++j) { const int id = tid + 512 * j, row = id >> 3, ch = id & 7; stK[j] = *reinterpret_cast<const u32x4*>(P16 + (size_t)chunk_row(b, X, row) * 2304 + 928 + h * 64 + ch * 8); }
    gate_prep(GATES, bg, b, h, X, cum, av, pm, wsr, tot, wave, lane);
#pragma unroll
    for (int j = 0; j < 4; ++j) { const int id = tid + 512 * j, row = id >> 4, ch = id & 15; *(bf16x8*)(lds + t_st<4>(row, ch * 8)) = stV[j]; }
    __syncthreads();
    if (wave < 2) {
        const int dir = wave; const float w0 = wsr[dir * 128 + lane], w1 = wsr[dir * 128 + 64 + lane];
        float mx = fmaxf(w0, w1);
#pragma unroll
        for (int o = 1; o < 64; o <<= 1) mx = fmaxf(mx, __shfl_xor(mx, o));
        wl[dir * 128 + lane] = __expf(w0 - mx); wl[dir * 128 + 64 + lane] = __expf(w1 - mx);
        if (lane == 0) { MLOC[(bh * NXC + X) * 2 + dir] = mx; TOT[(bh * NXC + X) * 2 + dir] = tot[dir]; }
    }
    __syncthreads();
#pragma unroll
    for (int j = 0; j < 2; ++j) { const int id = tid + 512 * j, row = id >> 3, ch = id & 7;
        const u32x4 kv = stK[j];
        const float wf = wl[row], wb = wl[128 + row];
        u32x4 of, ob;
#pragma unroll
        for (int q = 0; q < 4; ++q) { const float lo = __uint_as_float(kv[q] << 16), hi2 = __uint_as_float(kv[q] & 0xffff0000u); of[q] = cvtpk(lo * wf, hi2 * wf); ob[q] = cvtpk(lo * wb, hi2 * wb); }
        *(u32x4*)(lds + 32768 + t_st<2>(row, ch * 8)) = of; *(u32x4*)(lds + 49152 + t_st<2>(row, ch * 8)) = ob; }
    __syncthreads();
    {
        const int dir = wave >> 2, mb = wave & 3;
        const int vb = (int)(uintptr_t)lds + t_rd_base(lane) + mb * 512;
        const int kb = (int)(uintptr_t)lds + 32768 + dir * 16384 + t_rd_base(lane);
        f32x16 acc0 = {}, acc1 = {};
#define ML_A_STEP(KS) do { \
        const s16x4 vl = tr_read<t_rd_off<4>(0, KS, 0)>(vb), vh = tr_read<t_rd_off<4>(0, KS, 1)>(vb); \
        const s16x4 k0l = tr_read<t_rd_off<2>(0, KS, 0)>(kb), k0h = tr_read<t_rd_off<2>(0, KS, 1)>(kb), k1l = tr_read<t_rd_off<2>(1, KS, 0)>(kb), k1h = tr_read<t_rd_off<2>(1, KS, 1)>(kb); \
        asm volatile("s_waitcnt lgkmcnt(0)" ::: "memory"); __builtin_amdgcn_sched_barrier(0); \
        acc0 = __builtin_amdgcn_mfma_f32_32x32x16_bf16(ML_PK(vl, vh), ML_PK(k0l, k0h), acc0, 0, 0, 0); \
        acc1 = __builtin_amdgcn_mfma_f32_32x32x16_bf16(ML_PK(vl, vh), ML_PK(k1l, k1h), acc1, 0, 0, 0); } while (0)
        ML_A_STEP(0); ML_A_STEP(1); ML_A_STEP(2); ML_A_STEP(3); ML_A_STEP(4); ML_A_STEP(5); ML_A_STEP(6); ML_A_STEP(7);
#undef ML_A_STEP
        float* dst = CLOC + ((size_t)(bh * NXC + X) * 2 + dir) * 8192;
#pragma unroll
        for (int r = 0; r < 16; ++r) { const int dv = 32 * mb + crow(r, hi); dst[dv * 64 + r32] = acc0[r]; dst[dv * 64 + 32 + r32] = acc1[r]; }
    }
    {
        const int dir = tid >> 8, part = (tid >> 6) & 3, d = tid & 63; float a = 0.f;
        const char* img = lds + 32768 + dir * 16384;
#pragma unroll 8
        for (int i = 0; i < 32; ++i) { const int row = part * 32 + i; a += bf2f(*(const unsigned short*)(img + t_st<2>(row, d))); }
        npart[(dir * 4 + part) * 64 + d] = a;
    }
    __syncthreads();
    if (tid < 128) { const int dir = tid >> 6, d = tid & 63; NLOC[((size_t)(bh * NXC + X) * 2 + dir) * 64 + d] = (npart[(dir * 4 + 0) * 64 + d] + npart[(dir * 4 + 1) * 64 + d]) + (npart[(dir * 4 + 2) * 64 + d] + npart[(dir * 4 + 3) * 64 + d]); }
    __syncthreads();
}

__device__ __forceinline__ int scanX(int dir, int j) { return dir ? (j == 0 ? 1 : (j == 1 ? 0 : 35 - j)) : j; }
__device__ __forceinline__ void stepB(const float* CLOC, const float* NLOC, const float* MLOC, const float* TOT, unsigned* CIN, float* NIN, float* MIN, int gtid, int gthreads) {
    for (int it = gtid; it < 32 * 4096 + 32 * 64; it += gthreads) {
        const bool isn = it >= 32 * 4096;
        const int sq = isn ? (it - 32 * 4096) >> 6 : it >> 12, e = isn ? (it - 32 * 4096) & 63 : it & 4095;
        const int bh = sq >> 1, dir = sq & 1;
        float2 v[NXC]; float tt[NXC], mm[NXC];
#pragma unroll
        for (int j = 0; j < NXC; ++j) { const int X = scanX(dir, j); const size_t li = (size_t)(bh * NXC + X) * 2 + dir;
            tt[j] = TOT[li]; mm[j] = MLOC[li];
            if (isn) { v[j].x = NLOC[li * 64 + e]; v[j].y = 0.f; } else v[j] = *(const float2*)(CLOC + li * 8192 + 2 * e); }
        float c0 = 0.f, c1 = 0.f, m = 0.f;
#pragma unroll
        for (int j = 0; j < NXC; ++j) {
            const int X = scanX(dir, j);
            if (X >= 2) {
                const size_t ci = (size_t)(bh * 32 + (X - 2)) * 2 + dir;
                if (isn) { NIN[ci * 64 + e] = c0; if (e == 0) MIN[ci] = m; }
                else CIN[ci * 4096 + e] = cvtpk(c0, c1);
            }
            const float mn = fmaxf(tt[j] + m, mm[j]), dec = __expf(tt[j] + m - mn), scl = __expf(mm[j] - mn);
            c0 = dec * c0 + scl * v[j].x; c1 = dec * c1 + scl * v[j].y;
            m = mn;
        }
    }
}

__device__ __forceinline__ void stepC_unit(const unsigned short* P16, const float* GATES, const float* bg, const unsigned short* CIN, const float* NIN, const float* MIN, const float* mng,
                                           unsigned short* MIX16, int bh, int c, char* lds) {
    const int tid = threadIdx.x, wave = __builtin_amdgcn_readfirstlane(tid >> 6), lane = tid & 63, r32 = lane & 31, hi = lane >> 5;
    const int b = bh >> 2, h = bh & 3, X = c + 2;
    LAS float* fa = (LAS float*)(lds + 98304);
    LAS float* cum = fa, *av = fa + 256, *pm = fa + 512, *wsr = fa + 768, *tot = fa + 1024, *scl = fa + 1040;
    LAS float* hs = (LAS float*)lds;
    const int dir = wave >> 2, tb = wave & 3;
    const int t = 32 * tb + r32;
    const size_t ci = (size_t)(bh * 32 + c) * 2 + dir;
    bf16x8 qr[4]; f32x4 nn[8];
    {
        const unsigned short* qp = P16 + (size_t)chunk_row(b, X, t) * 2304 + 672 + h * 64 + hi * 8;
        const float* np = NIN + ci * 64 + hi * 8;
#pragma unroll
        for (int ks = 0; ks < 4; ++ks) { qr[ks] = *reinterpret_cast<const bf16x8*>(qp + ks * 16); nn[2 * ks] = *(const f32x4*)(np + ks * 16); nn[2 * ks + 1] = *(const f32x4*)(np + ks * 16 + 4); }
    }
    const float min2 = MIN[ci] * L2E;
    bf16x8 stK[2], stV[4], stC[4];
#pragma unroll
    for (int j = 0; j < 2; ++j) { const int id = tid + 512 * j, row = id >> 3, ch = id & 7; stK[j] = *reinterpret_cast<const bf16x8*>(P16 + (size_t)chunk_row(b, X, row) * 2304 + 928 + h * 64 + ch * 8); }
#pragma unroll
    for (int j = 0; j < 4; ++j) { const int id = tid + 512 * j, row = id >> 4, ch = id & 15; stV[j] = *reinterpret_cast<const bf16x8*>(P16 + (size_t)chunk_row(b, X, row) * 2304 + 1184 + h * 128 + ch * 8); }
    gate_prep(GATES, bg, b, h, X, cum, av, pm, wsr, tot, wave, lane);
    asm volatile("" ::: "memory");
#pragma unroll
    for (int j = 0; j < 4; ++j) { const int id = tid + 512 * j, dd = id >> 10, row = (id >> 3) & 127, ch = id & 7;
        stC[j] = *reinterpret_cast<const bf16x8*>(CIN + ((size_t)(bh * 32 + c) * 2 + dd) * 8192 + row * 64 + ch * 8); }
#pragma unroll
    for (int j = 0; j < 2; ++j) { const int id = tid + 512 * j, row = id >> 3, ch = id & 7; *(bf16x8*)(lds + ML_KS(row, ch * 16)) = stK[j]; }
#pragma unroll
    for (int j = 0; j < 4; ++j) { const int id = tid + 512 * j, row = id >> 4, ch = id & 15; *(bf16x8*)(lds + 16384 + t_st<4>(row, ch * 8)) = stV[j]; }
#pragma unroll
    for (int j = 0; j < 4; ++j) { const int id = tid + 512 * j, dd = id >> 10, row = (id >> 3) & 127, ch = id & 7; *(bf16x8*)(lds + 65536 + dd * 16384 + ML_KS(row, ch * 16)) = stC[j]; }
    __syncthreads();
    const float el2 = fmaxf(min2, pm[dir * 128 + t] * L2E);
    const float wint = __builtin_amdgcn_exp2f(min2 - el2);
    float ndot = 0.f;
#pragma unroll
    for (int ks = 0; ks < 4; ++ks) { const u32x4 q4 = *reinterpret_cast<const u32x4*>(&qr[ks]); const f32x4 n0 = nn[2 * ks], n1 = nn[2 * ks + 1];
#pragma unroll
        for (int q = 0; q < 4; ++q) { const float lo = __uint_as_float(q4[q] << 16), hi2 = __uint_as_float(q4[q] & 0xffff0000u);
            const float nl = (q < 2) ? n0[2 * q] : n1[2 * q - 4], nh = (q < 2) ? n0[2 * q + 1] : n1[2 * q - 3];
            ndot = fmaf(lo, nl, ndot); ndot = fmaf(hi2, nh, ndot); } }
    f32x16 o[4] = {}; float den = 0.f;
    const int vb = (int)(uintptr_t)lds + 16384 + t_rd_base(lane);
    const char* Kl = lds;
#define ML_C_BLOCK(SB) do { if (dir ? (SB >= tb) : (SB <= tb)) { \
        f32x16 p = {}; \
        _Pragma("unroll") for (int ks = 0; ks < 4; ++ks) { const bf16x8 kf = *reinterpret_cast<const bf16x8*>(Kl + ML_KS(32 * SB + r32, (ks * 16 + hi * 8) * 2)); p = __builtin_amdgcn_mfma_f32_32x32x16_bf16(kf, qr[ks], p, 0, 0, 0); } \
        _Pragma("unroll") for (int g = 0; g < 4; ++g) { const f32x4 a4 = *(const LAS f32x4*)(av + dir * 128 + 32 * SB + 8 * g + 4 * hi); \
            _Pragma("unroll") for (int i = 0; i < 4; ++i) { const int sidx = 32 * SB + 8 * g + 4 * hi + i; const bool ok = dir ? (sidx >= t) : (sidx <= t); \
                const float f = __builtin_amdgcn_exp2f(a4[i] * L2E - el2) * 0.125f; p[4 * g + i] = ok ? p[4 * g + i] * f : 0.f; den += p[4 * g + i]; } } \
        bf16x8 pa0, pa1; \
        { unsigned a0 = cvtpk(p[0], p[1]), a1 = cvtpk(p[2], p[3]), b0 = cvtpk(p[4], p[5]), b1 = cvtpk(p[6], p[7]); \
          auto r0 = __builtin_amdgcn_permlane32_swap(a0, b0, false, false); auto r1 = __builtin_amdgcn_permlane32_swap(a1, b1, false, false); u32x4 w = {r0[0], r1[0], r0[1], r1[1]}; pa0 = *reinterpret_cast<bf16x8*>(&w); } \
        { unsigned a0 = cvtpk(p[8], p[9]), a1 = cvtpk(p[10], p[11]), b0 = cvtpk(p[12], p[13]), b1 = cvtpk(p[14], p[15]); \
          auto r0 = __builtin_amdgcn_permlane32_swap(a0, b0, false, false); auto r1 = __builtin_amdgcn_permlane32_swap(a1, b1, false, false); u32x4 w = {r0[0], r1[0], r0[1], r1[1]}; pa1 = *reinterpret_cast<bf16x8*>(&w); } \
        ML_C_PV(0, SB, pa0, pa1); ML_C_PV(1, SB, pa0, pa1); ML_C_PV(2, SB, pa0, pa1); ML_C_PV(3, SB, pa0, pa1); } } while (0)
#define ML_C_PV(D0, SB, PA0, PA1) do { \
        const s16x4 l0 = tr_read<t_rd_off<4>(D0, 2 * SB, 0)>(vb), h0 = tr_read<t_rd_off<4>(D0, 2 * SB, 1)>(vb), l1 = tr_read<t_rd_off<4>(D0, 2 * SB + 1, 0)>(vb), h1 = tr_read<t_rd_off<4>(D0, 2 * SB + 1, 1)>(vb); \
        asm volatile("s_waitcnt lgkmcnt(0)" ::: "memory"); __builtin_amdgcn_sched_barrier(0); \
        o[D0] = __builtin_amdgcn_mfma_f32_32x32x16_bf16(PA0, ML_PK(l0, h0), o[D0], 0, 0, 0); \
        o[D0] = __builtin_amdgcn_mfma_f32_32x32x16_bf16(PA1, ML_PK(l1, h1), o[D0], 0, 0, 0); } while (0)
    ML_C_BLOCK(0); ML_C_BLOCK(1); ML_C_BLOCK(2); ML_C_BLOCK(3);
#undef ML_C_BLOCK
#undef ML_C_PV
    {
        bf16x8 qw[4];
#pragma unroll
        for (int ks = 0; ks < 4; ++ks) { const u32x4 q4 = *reinterpret_cast<const u32x4*>(&qr[ks]); u32x4 w4;
#pragma unroll
            for (int q = 0; q < 4; ++q) { const float lo = __uint_as_float(q4[q] << 16), hi2 = __uint_as_float(q4[q] & 0xffff0000u); w4[q] = cvtpk(lo * (0.125f * wint), hi2 * (0.125f * wint)); }
            qw[ks] = *reinterpret_cast<const bf16x8*>(&w4); }
        const char* Cl = lds + 65536 + dir * 16384;
#pragma unroll
        for (int d0 = 0; d0 < 4; ++d0)
#pragma unroll
            for (int ks = 0; ks < 4; ++ks) { const bf16x8 cf = *reinterpret_cast<const bf16x8*>(Cl + ML_KS(32 * d0 + r32, (ks * 16 + hi * 8) * 2)); o[d0] = __builtin_amdgcn_mfma_f32_32x32x16_bf16(qw[ks], cf, o[d0], 0, 0, 0); }
    }
    { auto rr = __builtin_amdgcn_permlane32_swap(__float_as_uint(den), __float_as_uint(den), false, false); den = __uint_as_float(rr[0]) + __uint_as_float(rr[1]); }
    { auto rr = __builtin_amdgcn_permlane32_swap(__float_as_uint(ndot), __float_as_uint(ndot), false, false); ndot = __uint_as_float(rr[0]) + __uint_as_float(rr[1]); }
    den += wint * 0.125f * ndot;
    const float sct = 1.f / fmaxf(fabsf(den), __builtin_amdgcn_exp2f(-cum[dir * 128 + t] * L2E - el2));
    if (hi == 0) scl[wave * 32 + r32] = sct;
    __syncthreads();
    if (dir == 1) {
#pragma unroll
        for (int r = 0; r < 16; ++r) { const float sc = scl[wave * 32 + crow(r, hi)];
#pragma unroll
            for (int d0 = 0; d0 < 4; ++d0) hs[(32 * tb + crow(r, hi)) * 128 + 32 * d0 + r32] = o[d0][r] * sc; }
    }
    __syncthreads();
    if (dir == 0) {
#pragma unroll
        for (int r = 0; r < 16; ++r) { const float sc = scl[wave * 32 + crow(r, hi)];
#pragma unroll
            for (int d0 = 0; d0 < 4; ++d0) hs[(32 * tb + crow(r, hi)) * 128 + 32 * d0 + r32] += o[d0][r] * sc; }
    }
    __syncthreads();
    {
        const int tt = tid >> 2, q4 = tid & 3;
        const size_t grow = (size_t)chunk_row(b, X, tt);
        const unsigned short* og = P16 + grow * 2304 + 1696 + h * 128 + 32 * q4;
        u32x4 og4[4];
#pragma unroll
        for (int j = 0; j < 4; ++j) og4[j] = *reinterpret_cast<const u32x4*>(og + 8 * j);
        f32x4 v[8]; float ss = 0.f;
#pragma unroll
        for (int j = 0; j < 8; ++j) { v[j] = *(const LAS f32x4*)(hs + tt * 128 + 32 * q4 + 4 * j); ss += (v[j][0] * v[j][0] + v[j][1] * v[j][1]) + (v[j][2] * v[j][2] + v[j][3] * v[j][3]); }
        ss += __shfl_xor(ss, 1); ss += __shfl_xor(ss, 2);
        const float rstd = rsqrtf(ss * (1.f / 128.f) + 1e-6f);
        const float* gn = mng + h * 128 + 32 * q4;
        unsigned short* dst = MIX16 + grow * 1024 + 512 + h * 128 + 32 * q4;
#pragma unroll
        for (int j = 0; j < 4; ++j) { const f32x4 g0 = *(const f32x4*)(gn + 8 * j), g1 = *(const f32x4*)(gn + 8 * j + 4); const f32x4 x0 = v[2 * j], x1 = v[2 * j + 1]; const u32x4 ow = og4[j];
            float r8[8];
#pragma unroll
            for (int e = 0; e < 4; ++e) { const float gl = __uint_as_float(ow[e] << 16), gh = __uint_as_float(ow[e] & 0xffff0000u);
                const float xa = (e < 2) ? x0[2 * e] : x1[2 * e - 4], xb = (e < 2) ? x0[2 * e + 1] : x1[2 * e - 3];
                const float ga = (e < 2) ? g0[2 * e] : g1[2 * e - 4], gb = (e < 2) ? g0[2 * e + 1] : g1[2 * e - 3];
                r8[2 * e] = xa * rstd * ga * __builtin_amdgcn_rcpf(1.f + __expf(-gl)); r8[2 * e + 1] = xb * rstd * gb * __builtin_amdgcn_rcpf(1.f + __expf(-gh)); }
            u32x4 w; w.x = cvtpk(r8[0], r8[1]); w.y = cvtpk(r8[2], r8[3]); w.z = cvtpk(r8[4], r8[5]); w.w = cvtpk(r8[6], r8[7]);
            *(u32x4*)(dst + 8 * j) = w; }
    }
    __syncthreads();
}
#undef ML_PK
#undef ML_KS
}


__device__ __forceinline__ unsigned pk4_fp8(float a, float b, float c, float d) { int w = __builtin_amdgcn_cvt_pk_fp8_f32(a, b, 0, false); w = __builtin_amdgcn_cvt_pk_fp8_f32(c, d, w, true); return (unsigned)w; }
template <class RowMap>
__device__ __forceinline__ void transpose_item8(const float* W, int K, int N, int nblk, unsigned char* WT, const RowMap& rowmap, LAS float* scr, int item, int lane) {
    const int kb = item / nblk, nb = item % nblk, k0 = 64 * kb, n0 = 32 * nb;
    const int ncol = n0 + (lane & 31);
    float tv[32];
#pragma unroll
    for (int i = 0; i < 32; ++i) { const int kk = 2 * i + (lane >> 5); tv[i] = __builtin_nontemporal_load(W + (size_t)(k0 + kk) * N + ncol) * 64.f; }
#pragma unroll
    for (int i = 0; i < 32; ++i) scr[(2 * i + (lane >> 5)) * 33 + (lane & 31)] = tv[i];
    asm volatile("s_waitcnt lgkmcnt(0)" ::: "memory");
    const int c = lane & 7;
    const int r0 = rowmap(n0);
#pragma unroll
    for (int j = 0; j < 4; ++j) { const int n = (lane >> 3) + 8 * j; const LAS float* sp = scr + (8 * c) * 33 + n;
        pg8::u32x2 o; o.x = pk4_fp8(sp[0 * 33], sp[1 * 33], sp[2 * 33], sp[3 * 33]); o.y = pk4_fp8(sp[4 * 33], sp[5 * 33], sp[6 * 33], sp[7 * 33]);
        __builtin_nontemporal_store(o, (pg8::u32x2*)(WT + (size_t)(r0 + n) * K + k0 + 8 * c)); }
    asm volatile("s_waitcnt lgkmcnt(0)" ::: "memory");
}

__device__ __forceinline__ void convert_chunk(const float* wgu, const float* wdn, unsigned short* WguT, unsigned short* WdnT, int which, int chunk, LAS float* scr, int wave, int lane) {
#pragma unroll 1
    for (int j = 0; j < 8; ++j) {
        const int it = chunk * 64 + wave * 8 + j;
#if MOE_FP8
        if (which == 0) { const int e = it >> 10, r = it & 1023;
            transpose_item8(wgu + (size_t)e * D * 2 * DFF, D, 2 * DFF, 2 * DFF / 32, (unsigned char*)WguT + (size_t)e * 2 * DFF * D,
                            [](int n0) { return n0 < DFF ? (n0 >> 7) * 256 + (n0 & 127) : ((n0 - DFF) >> 7) * 256 + 128 + ((n0 - DFF) & 127); }, scr, r, lane); }
        else { const int e = it >> 9, r = it & 511;
            transpose_item8(wdn + (size_t)e * DFF * D, DFF, D, D / 32, (unsigned char*)WdnT + (size_t)e * D * DFF, [](int n0) { return n0; }, scr, r, lane); }
#else
        if (which == 0) { const int e = it >> 10, r = it & 1023;
            transpose_item(wgu + (size_t)e * D * 2 * DFF, D, 2 * DFF, 2 * DFF / 32, WguT + (size_t)e * 2 * DFF * D,
                           [](int n0) { return n0 < DFF ? (n0 >> 7) * 256 + (n0 & 127) : ((n0 - DFF) >> 7) * 256 + 128 + ((n0 - DFF) & 127); }, scr, r, lane); }
        else { const int e = it >> 9, r = it & 511;
            transpose_item(wdn + (size_t)e * DFF * D, DFF, D, D / 32, WdnT + (size_t)e * D * DFF, [](int n0) { return n0; }, scr, r, lane); }
#endif
    }
}
__device__ __forceinline__ void pull_chunks(unsigned* qword, int first, int total, int maxc, const float* wgu, const float* wdn, unsigned short* WguT, unsigned short* WdnT, int which,
                                            unsigned char* lds_raw, int wave, int lane) {
    LAS int* bc = (LAS int*)(lds_raw + 131072 + 1024);
    LAS float* scr = (LAS float*)(lds_raw + wave * 16384);
    for (int n = 0; n < maxc; ++n) {
        __syncthreads();
        if (threadIdx.x == 0) bc[0] = first + (int)__hip_atomic_fetch_add(qword, 1u, __ATOMIC_RELAXED, __HIP_MEMORY_SCOPE_AGENT);
        __syncthreads();
        const int c = bc[0];
        if (c >= total) break;
        convert_chunk(wgu, wdn, WguT, WdnT, which, c, scr, wave, lane);
    }
    __syncthreads();
}

__device__ __forceinline__ int fresh_tid() { int t = (int)threadIdx.x; asm volatile("" : "+v"(t)); return t; }

#define DEF_PTRS \
    float* MOD = (float*)(ws + WS_MOD); \
    float* NLOC = (float*)(ws + WS_MLS); float* MLOC = (float*)(ws + WS_MLS + 512 * 1024); float* TOT = (float*)(ws + WS_MLS + 576 * 1024); float* NIN = (float*)(ws + WS_MLS + 1 * MiB); float* MIN_ = (float*)(ws + WS_MLS + 1536 * 1024); \
    float* CLOC = (float*)(ws + WS_CLOC); unsigned short* CIN = (unsigned short*)(ws + WS_CIN); \
    float* ROPEC = (float*)(ws + WS_ROPE); float* ROPES = ROPEC + S * 16; \
    int* TOPE = (int*)(ws + WS_TOPE); int* SLOT = (int*)(ws + WS_SLOT); int* LIST = (int*)(ws + WS_LIST); float* RGATE = (float*)(ws + WS_RGATE); \
    unsigned short* Hb16 = (unsigned short*)(ws + WS_H); unsigned short* WinT = (unsigned short*)(ws + WS_WINT); \
    unsigned short* Q16 = (unsigned short*)(ws + WS_Q); unsigned short* K16 = (unsigned short*)(ws + WS_KV); unsigned short* V16 = (unsigned short*)(ws + WS_KV + 32 * MiB); \
    unsigned short* X1 = (unsigned short*)(ws + WS_X1); unsigned short* H2 = (unsigned short*)(ws + WS_H2); \
    unsigned short* YG = (unsigned short*)(ws + WS_YG); unsigned short* ACT = (unsigned short*)(ws + WS_ACT); \
    unsigned short* WguT = (unsigned short*)(ws + WS_WGUT); unsigned short* WdnT = (unsigned short*)(ws + WS_WDNT); \
    unsigned short* WuqT = (unsigned short*)(ws + WS_WUQT); unsigned short* WukvT = (unsigned short*)(ws + WS_WUKVT); unsigned short* WoutT = (unsigned short*)(ws + WS_WOUTT); \
    float* GATES = (float*)(ws + WS_GATES); float* STAT = (float*)(ws + WS_STAT); float* STAT2 = (float*)(ws + WS_STAT2); \
    float* GM2 = (float*)(ws + WS_RSTD); unsigned short* RWH = (unsigned short*)(ws + WS_RSTD + 65536); unsigned short* RWL = (unsigned short*)(ws + WS_RSTD + 131072); unsigned short* MIX16 = (unsigned short*)(ws + WS_MIX16); \
    unsigned short* P16 = (unsigned short*)(ws + WS_P); \
    unsigned* CNT = ctl + CW_CNT; (void)CNT;
typedef const Params __attribute__((address_space(4))) KParams;
#define PHASE_ENV KParams* pk = kp; asm volatile("" : "+s"(pk)); unsigned char* ws = pk->ws; unsigned* ctl = (unsigned*)(ws + WS_CTL); (void)ctl; DEF_PTRS

constexpr int LDS_BYTES = 147456;
constexpr int N_PHASES = 12;

__global__ void __launch_bounds__(NT, 2) fwd_kernel(Params p) {
    extern __shared__ __attribute__((aligned(16))) unsigned char lds_raw[];
    float* lds = (float*)lds_raw;
    LAS unsigned* misc = (LAS unsigned*)(lds_raw + 131072 + 4096);
    const int tid = threadIdx.x, lane = tid & 63, wave = tid >> 6;
    const int bid = blockIdx.x, G = gridDim.x;
    KParams* kp = (KParams*)__builtin_amdgcn_kernarg_segment_ptr();
    unsigned* ctl = (unsigned*)(p.ws + WS_CTL);
    if (tid < 4) misc[tid] = 0u;
    __syncthreads();
    const bool single = (p.ph_hi - p.ph_lo) > 1;
    if (single) (void)xcd_barrier_post(ctl + CW_BAR, (volatile LAS unsigned*)misc);
#ifndef PH_MASK
#define PH_MASK 0xFFFF
#endif
#define IN(k) ((((PH_MASK) >> (k)) & 1) && p.ph_lo <= (k) && (k) < p.ph_hi)
#define GRID_BARRIER() do { KParams* pb_ = kp; asm volatile("" : "+s"(pb_)); XcdBarrier b_; b_.bar = (unsigned*)(pb_->ws + WS_CTL) + CW_BAR; b_.x = xb_xcc_id(); b_.st = (volatile LAS unsigned*)misc; xcd_barrier(b_); } while (0)
#define SEAM(k) do { if (IN(k) && IN((k) + 1)) GRID_BARRIER(); } while (0)
#define PH_BEGIN(k)
#define PH_END(k)
#define SEAM2(k) do { if (IN(k) && IN((k) + 2)) GRID_BARRIER(); } while (0)

    PH_BEGIN(0) if (IN(0)) {
        const int tid = fresh_tid(), lane = tid & 63, wave = tid >> 6; (void)lane; (void)wave;
        PHASE_ENV
        {
            const float* wmod = pk->in[I_WMOD]; const float* bmod = pk->in[I_BMOD];
            float* sil = lds;
            float* red = lds + 5 * 1024;
            for (int cg = bid; cg < 96; cg += G) {
                for (int e = tid; e < 5 * D; e += NT) { const int r = e >> 10, k = e & 1023; const float cv = (r < 4) ? pk->in[I_C][r * D + k] : pk->in[I_CCTX][k]; sil[e] = siluf_(cv); }
                __syncthreads();
                const int col = cg * 64 + (tid & 63), part = tid >> 6;
                float a0 = 0.f, a1 = 0.f, a2 = 0.f, a3 = 0.f, a4 = 0.f;
#pragma unroll 8
                for (int kk = 0; kk < 128; ++kk) { const int k = part * 128 + kk; const float w = wmod[(size_t)k * 6144 + col];
                    a0 = fmaf(sil[k], w, a0); a1 = fmaf(sil[1024 + k], w, a1); a2 = fmaf(sil[2048 + k], w, a2); a3 = fmaf(sil[3072 + k], w, a3); a4 = fmaf(sil[4096 + k], w, a4); }
                red[(part * 5 + 0) * 64 + (tid & 63)] = a0; red[(part * 5 + 1) * 64 + (tid & 63)] = a1; red[(part * 5 + 2) * 64 + (tid & 63)] = a2; red[(part * 5 + 3) * 64 + (tid & 63)] = a3; red[(part * 5 + 4) * 64 + (tid & 63)] = a4;
                __syncthreads();
                if (tid < 320) { const int r = tid >> 6, cc = tid & 63; float t = 0.f;
#pragma unroll
                    for (int pp = 0; pp < 8; ++pp) t += red[(pp * 5 + r) * 64 + cc];
                    MOD[r * 6144 + cg * 64 + cc] = t + bmod[cg * 64 + cc]; }
                __syncthreads();
            }
        }
        for (int e = bid * NT + tid; e < NE * D; e += G * NT) { const int ex = e >> 10, k = e & 1023; const float w = pk->in[I_RW][(size_t)k * NE + ex];
            const unsigned hi = pg8::cvt_pk_bf16(w, 0.f) & 0xffffu; const float lo = w - __uint_as_float(hi << 16);
            RWH[e] = (unsigned short)hi; RWL[e] = (unsigned short)(pg8::cvt_pk_bf16(lo, 0.f) & 0xffffu); }
        for (int e = bid * NT + tid; e < S * 16; e += G * NT) { float cs, sn; rope_angles(e >> 4, e & 15, cs, sn); ROPEC[e] = cs; ROPES[e] = sn; }
        {
            LAS float* scr = (LAS float*)(lds_raw + wave * 16384);
            const int gw = bid * 8 + wave, NGW = G * 8;
            for (int it = gw; it < (D / 64) * (PW / 32); it += NGW) transpose_item(pk->in[I_WIN], D, INW, PW / 32, WinT, [](int n0) { return n0; }, scr, it, lane);
            for (int it = gw; it < (QL / 64) * (768 / 32); it += NGW) transpose_item(pk->in[I_WUQ], QL, 768, 768 / 32, WuqT, [](int n0) { return n0; }, scr, it, lane, pk->in[I_QNG]);
            for (int it = gw; it < (KVL / 64) * (1024 / 32); it += NGW) transpose_item(pk->in[I_WUKV], KVL, 1024, 1024 / 32, WukvT, [](int n0) { return n0; }, scr, it, lane, pk->in[I_KVNG]);
            for (int it = gw; it < (D / 64) * (D / 32); it += NGW) transpose_item(pk->in[I_WOUT], D, D, D / 32, WoutT, [](int n0) { return n0; }, scr, it, lane);
            for (int c = G - 1 - bid; c < GU_STATIC; c += G) convert_chunk(pk->in[I_WGU], pk->in[I_WDN], WguT, WdnT, 0, c, scr, wave, lane);
        }
    }
    PH_END(0)
    SEAM(0);
    PH_BEGIN(1) if (IN(1)) {
        const int tid = fresh_tid(), lane = tid & 63, wave = tid >> 6; (void)lane; (void)wave;
        PHASE_ENV
        const float* g1n = pk->in[I_N1G];
        for (int e = bid * NT + tid; e < 4 * D; e += G * NT) GM2[e] = pk->in[I_N2G][e & 1023] * (1.f + MOD[(e >> 10) * 6144 + 4 * D + (e & 1023)]);
        for (int rp = bid * 8 + wave; rp < MT / 2; rp += G * 8) {
            const int r = 2 * rp;
            const float* src = (r < MX) ? pk->in[I_X] + (size_t)r * D : pk->in[I_CTX] + (size_t)(r - MX) * D;
            const int mb = (r < MX) ? r / S : 4;
            const float* sh = MOD + mb * 6144, *sc = sh + D;
            float4 va[4], vb[4]; float sa = 0.f, sb = 0.f;
#pragma unroll
            for (int j = 0; j < 4; ++j) { va[j] = *(const float4*)(src + j * 256 + lane * 4); vb[j] = *(const float4*)(src + D + j * 256 + lane * 4); }
#pragma unroll
            for (int j = 0; j < 4; ++j) { sa += (va[j].x * va[j].x + va[j].y * va[j].y) + (va[j].z * va[j].z + va[j].w * va[j].w); sb += (vb[j].x * vb[j].x + vb[j].y * vb[j].y) + (vb[j].z * vb[j].z + vb[j].w * vb[j].w); }
            const float ra = rsqrtf(wave_sum(sa) * (1.f / D) + EPS), rb2 = rsqrtf(wave_sum(sb) * (1.f / D) + EPS);
#pragma unroll
            for (int j = 0; j < 4; ++j) {
                const int c = j * 256 + lane * 4;
                const float4 gn = *(const float4*)(g1n + c), scv = *(const float4*)(sc + c), shv = *(const float4*)(sh + c);
                const float g0 = gn.x * (1.f + scv.x), g1 = gn.y * (1.f + scv.y), g2 = gn.z * (1.f + scv.z), g3 = gn.w * (1.f + scv.w);
                pg8::u32x2 w;
                w.x = pg8::cvt_pk_bf16(va[j].x * ra * g0 + shv.x, va[j].y * ra * g1 + shv.y); w.y = pg8::cvt_pk_bf16(va[j].z * ra * g2 + shv.z, va[j].w * ra * g3 + shv.w);
                *(pg8::u32x2*)(Hb16 + (size_t)r * D + c) = w;
                w.x = pg8::cvt_pk_bf16(vb[j].x * rb2 * g0 + shv.x, vb[j].y * rb2 * g1 + shv.y); w.y = pg8::cvt_pk_bf16(vb[j].z * rb2 * g2 + shv.z, vb[j].w * rb2 * g3 + shv.w);
                *(pg8::u32x2*)(Hb16 + (size_t)(r + 1) * D + c) = w;
            }
        }
    }
    PH_END(1)
    SEAM(1);
    PH_BEGIN(2) if (IN(2)) {
        const int tid = fresh_tid(), lane = tid & 63, wave = tid >> 6; (void)lane; (void)wave;
        PHASE_ENV
        pg8::PlainSched Sd; Sd.init(MT, PW, D, D, WinT, G, bid);
        pg8::EpiInproj E{P16, GATES, STAT, K16, ROPEC, ROPES};
        pg8::gemm_phase<pg8::EpiInproj, pg8::PlainSched, true>((LAS unsigned char*)lds_raw, Hb16, D, Sd, E);
        if ((Sd.nwg % G) != 0 && bid >= (Sd.nwg % G))
            pull_chunks(ctl + CW_QGU, GU_STATIC, GU_CHUNKS, 2, pk->in[I_WGU], pk->in[I_WDN], WguT, WdnT, 0, lds_raw, wave, lane);
    }
    PH_END(2)
    SEAM2(2);
    PH_BEGIN(4) if (IN(4)) {
        const int tid = fresh_tid(), lane = tid & 63, wave = tid >> 6; (void)lane; (void)wave;
        PHASE_ENV
#ifndef NO_QG
        { pg8::PlainSched Sd; Sd.init(MX, 768, QL, PW, WuqT, G, (bid + G - 16) % G);
          pg8::EpiQ E{Q16, STAT, ROPEC, ROPES};
          pg8::gemm_phase<pg8::EpiQ, pg8::PlainSched, true>((LAS unsigned char*)lds_raw, P16 + O_CQ, QL, Sd, E); }
#endif
#ifndef NO_KVG
        { pg8::PlainSched Sd; Sd.init(MT, 1024, KVL, PW, WukvT, G, bid);
          pg8::EpiKV E{K16, V16, STAT};
          pg8::gemm_phase<pg8::EpiKV, pg8::PlainSched, true>((LAS unsigned char*)lds_raw, P16 + O_CKV, KVL, Sd, E); }
#endif
        for (int u = (bid + 48) % G; u < 16 * ml::NXC; u += G) ml::stepA_unit(P16, GATES, pk->in[I_BG], u / ml::NXC, u % ml::NXC, CLOC, NLOC, MLOC, TOT, (char*)lds_raw);
    }
    PH_END(4)
    SEAM(4);
    PH_BEGIN(5) if (IN(5)) {
        const int tid = fresh_tid(), lane = tid & 63, wave = tid >> 6; (void)lane; (void)wave;
        PHASE_ENV
        ml::stepB(CLOC, NLOC, MLOC, TOT, (unsigned*)CIN, NIN, MIN_, bid * NT + tid, G * NT);
        {
            const int nun = NB * HA * (S / 256);
            for (int i = 0; i * G < nun; ++i) {
                int bh, qb;
                if (G == 256) { const int x = bid & 7, slot = bid >> 3; bh = i * 16 + x * 2 + (slot >> 4); qb = slot & 15; }
                else { const int u = i * G + bid; if (u >= nun) break; bh = u >> 4; qb = u & 15; }
                const int b = bh >> 3, h = bh & 7;
                att::attn_body(Q16 + (size_t)(b * S + qb * 256) * 768 + h * 96, K16 + (size_t)(b * SKV) * 768 + h * 96, V16 + (size_t)(b * SKV) * 512 + h * 64,
                               MIX16 + (size_t)(b * S + qb * 256) * D + h * 64, SKV, (char*)lds_raw);
            }
        }
    }
    PH_END(5)
    SEAM(5);
    PH_BEGIN(6) if (IN(6)) {
        const int tid = fresh_tid(), lane = tid & 63, wave = tid >> 6; (void)lane; (void)wave;
        PHASE_ENV
        for (int u = bid; u < 16 * 32; u += G) ml::stepC_unit(P16, GATES, pk->in[I_BG], CIN, NIN, MIN_, pk->in[I_MNG], MIX16, u >> 5, u & 31, (char*)lds_raw);
    }
    PH_END(6)
    SEAM(6);
    PH_BEGIN(7) if (IN(7)) {
        const int tid = fresh_tid(), lane = tid & 63, wave = tid >> 6; (void)lane; (void)wave;
        PHASE_ENV
        pg8::PlainSched Sd; Sd.init(MX, D, D, D, WoutT, G, bid);
        pg8::EpiResid E{X1, pk->in[I_X], MOD, STAT2};
        pg8::gemm_phase<pg8::EpiResid, pg8::PlainSched, true>((LAS unsigned char*)lds_raw, MIX16, D, Sd, E);
    }
    PH_END(7)
    SEAM(7);
    PH_BEGIN(8) if (IN(8)) {
        const int tid = fresh_tid(), lane = tid & 63, wave = tid >> 6; (void)lane; (void)wave;
        PHASE_ENV
        typedef short bf16x8v __attribute__((ext_vector_type(8)));
        typedef float f32x4v __attribute__((ext_vector_type(4)));
        float* LG = lds;
        LAS int* lcnt = (LAS int*)(lds_raw + 32768); LAS int* gbase = lcnt + 32;
        const float* rb = pk->in[I_RB];
        for (int base = bid * 64; base < MX; base += G * 64) {
            if (tid < 32) lcnt[tid] = 0;
            {
                const int bq0 = base / S; const float4 t4 = (tid < 256) ? *(const float4*)(GM2 + bq0 * D + 4 * tid) : *(const float4*)(MOD + bq0 * 6144 + 3 * D + 4 * (tid - 256));
                *(float4*)(lds + 10240 + 4 * tid) = t4; }
            __syncthreads();
            int te[4] = {0, 0, 0, 0}, rk[4] = {0, 0, 0, 0}; float tg[4] = {0.f, 0.f, 0.f, 0.f};
            {
                const int rt = wave & 3, kh = wave >> 2;
                const int r0 = base + 16 * rt, row = lane & 15, kg = lane >> 4, bq = r0 / S;
                float ss;
                { const float4 s0 = *(const float4*)(STAT2 + (size_t)(r0 + row) * 32 + kg * 8), s1 = *(const float4*)(STAT2 + (size_t)(r0 + row) * 32 + kg * 8 + 4);
                  ss = ((s0.x + s0.y) + (s0.z + s0.w)) + ((s1.x + s1.y) + (s1.z + s1.w)); ss += __shfl_xor(ss, 16); ss += __shfl_xor(ss, 32); }
                const float rstd = rsqrtf(ss * (1.f / D) + EPS);
                const int ko = kh * 512 + 8 * kg;
                const unsigned short* xr = X1 + (size_t)(r0 + row) * D + ko; const float* gmr = lds + 10240 + ko; const float* shr = lds + 10240 + 1024 + ko; (void)bq;
                unsigned short* hr = H2 + (size_t)(r0 + row) * D + ko; (void)hr;
                const unsigned short* wh0 = RWH + (size_t)row * D + ko, *wh1 = RWH + (size_t)(16 + row) * D + ko, *wl0 = RWL + (size_t)row * D + ko, *wl1 = RWL + (size_t)(16 + row) * D + ko;
                f32x4v acc0 = {0.f, 0.f, 0.f, 0.f}, acc1 = {0.f, 0.f, 0.f, 0.f};
#pragma unroll 8
                for (int st = 0; st < 16; ++st) {
                    const pg8::u32x4 xw = *(const pg8::u32x4*)(xr + 32 * st);
                    const float4 x0 = make_float4(__uint_as_float(xw[0] << 16), __uint_as_float(xw[0] & 0xffff0000u), __uint_as_float(xw[1] << 16), __uint_as_float(xw[1] & 0xffff0000u)), x1v = make_float4(__uint_as_float(xw[2] << 16), __uint_as_float(xw[2] & 0xffff0000u), __uint_as_float(xw[3] << 16), __uint_as_float(xw[3] & 0xffff0000u));
                    const float4 g0 = *(const float4*)(gmr + 32 * st), g1v = *(const float4*)(gmr + 32 * st + 4), h0 = *(const float4*)(shr + 32 * st), h1 = *(const float4*)(shr + 32 * st + 4);
                    float hv[8] = {x0.x * rstd * g0.x + h0.x, x0.y * rstd * g0.y + h0.y, x0.z * rstd * g0.z + h0.z, x0.w * rstd * g0.w + h0.w, x1v.x * rstd * g1v.x + h1.x, x1v.y * rstd * g1v.y + h1.y, x1v.z * rstd * g1v.z + h1.z, x1v.w * rstd * g1v.w + h1.w};
                    pg8::u32x4 hi4, lo4;
#pragma unroll
                    for (int q = 0; q < 4; ++q) { hi4[q] = pg8::cvt_pk_bf16(hv[2 * q], hv[2 * q + 1]);
                        lo4[q] = pg8::cvt_pk_bf16(hv[2 * q] - __uint_as_float(hi4[q] << 16), hv[2 * q + 1] - __uint_as_float(hi4[q] & 0xffff0000u)); }
#if MOE_FP8
                    { pg8::u32x2 h8; h8.x = pk4_fp8(hv[0], hv[1], hv[2], hv[3]); h8.y = pk4_fp8(hv[4], hv[5], hv[6], hv[7]); *(pg8::u32x2*)((unsigned char*)H2 + (size_t)(r0 + row) * D + ko + 32 * st) = h8; }
#else
                    *(pg8::u32x4*)(hr + 32 * st) = hi4;
#endif
                    const bf16x8v ah = *reinterpret_cast<const bf16x8v*>(&hi4), al = *reinterpret_cast<const bf16x8v*>(&lo4);
                    const bf16x8v bh0 = *reinterpret_cast<const bf16x8v*>(wh0 + 32 * st), bh1 = *reinterpret_cast<const bf16x8v*>(wh1 + 32 * st), bl0 = *reinterpret_cast<const bf16x8v*>(wl0 + 32 * st), bl1 = *reinterpret_cast<const bf16x8v*>(wl1 + 32 * st);
                    acc0 = __builtin_amdgcn_mfma_f32_16x16x32_bf16(ah, bh0, acc0, 0, 0, 0); acc0 = __builtin_amdgcn_mfma_f32_16x16x32_bf16(al, bh0, acc0, 0, 0, 0); acc0 = __builtin_amdgcn_mfma_f32_16x16x32_bf16(ah, bl0, acc0, 0, 0, 0);
                    acc1 = __builtin_amdgcn_mfma_f32_16x16x32_bf16(ah, bh1, acc1, 0, 0, 0); acc1 = __builtin_amdgcn_mfma_f32_16x16x32_bf16(al, bh1, acc1, 0, 0, 0); acc1 = __builtin_amdgcn_mfma_f32_16x16x32_bf16(ah, bl1, acc1, 0, 0, 0);
                }
                float* lgp = LG + kh * (64 * 33);
#pragma unroll
                for (int j = 0; j < 4; ++j) { lgp[(16 * rt + 4 * kg + j) * 33 + row] = acc0[j]; lgp[(16 * rt + 4 * kg + j) * 33 + 16 + row] = acc1[j]; }
            }
            __syncthreads();
            if (wave < 4 && lane < 16) {
                float* lr = LG + (16 * wave + lane) * 33; float tv[4];
                for (int e = 0; e < 32; ++e) lr[e] = (lr[e] + lr[64 * 33 + e]) + rb[e];
#pragma unroll
                for (int k = 0; k < 4; ++k) { float best = -3.0e38f; int bi = 0;
                    for (int e = 0; e < 32; ++e) { const float v = lr[e]; if (v > best) { best = v; bi = e; } }
                    te[k] = bi; tv[k] = best; lr[bi] = -3.0e38f; }
                const float e1 = __expf(tv[1] - tv[0]), e2 = __expf(tv[2] - tv[0]), e3 = __expf(tv[3] - tv[0]); const float inv = 1.f / (1.f + e1 + e2 + e3);
                tg[0] = inv; tg[1] = e1 * inv; tg[2] = e2 * inv; tg[3] = e3 * inv;
#pragma unroll
                for (int k = 0; k < 4; ++k) rk[k] = atomicAdd((int*)&lcnt[te[k]], 1);
            }
            __syncthreads();
            if (tid < 32) gbase[tid] = (int)atomicAdd(&CNT[tid], (unsigned)lcnt[tid]);
            __syncthreads();
            if (wave < 4 && lane < 16) { const int r = base + 16 * wave + lane;
#pragma unroll
                for (int k = 0; k < 4; ++k) { const int e = te[k], pos = gbase[e] + rk[k]; TOPE[r * 4 + k] = e; SLOT[r * 4 + k] = pos; LIST[e * MX + pos] = r; RGATE[e * MX + pos] = tg[k]; } }
            __syncthreads();
        }
    }
    if (IN(8)) { const int t2 = fresh_tid(); PHASE_ENV pull_chunks(ctl + CW_QGU, GU_STATIC, GU_CHUNKS, GU_CHUNKS, pk->in[I_WGU], pk->in[I_WDN], WguT, WdnT, 0, lds_raw, t2 >> 6, t2 & 63); }
    PH_END(8)
    SEAM(8);
    LAS int* mtp = (LAS int*)(lds_raw + 131072); LAS int* mro = mtp + 40; LAS int* mcn = mro + 40;
    if (IN(9) || IN(10) || IN(11)) {
        PHASE_ENV
        __syncthreads();
        if (tid < 64) {
            const int cnt = (tid < NE) ? (int)__hip_atomic_load(&CNT[tid & 31], __ATOMIC_RELAXED, __HIP_MEMORY_SCOPE_AGENT) : 0;
            const int tl = (cnt + 255) >> 8; int inc = tl;
#pragma unroll
            for (int o = 1; o < 64; o <<= 1) { const int y = __shfl_up(inc, o); if (tid >= o) inc += y; }
            if (tid < NE) { mcn[tid] = cnt; mtp[tid] = inc - tl; mro[tid] = (inc - tl) * 256; }
            if (tid == NE - 1) { mtp[NE] = inc; mro[NE] = inc * 256; }
        }
        __syncthreads();
    }
    PH_BEGIN(9) if (IN(9)) {
        const int tid = fresh_tid(), lane = tid & 63, wave = tid >> 6; (void)lane; (void)wave;
        PHASE_ENV
#if MOE_FP8
        pg8::MoeSched Sd{mtp, mro, mcn, DFF / 128, G, bid, D / 2, D / 2, 1, LIST, (const char*)WguT, (size_t)2 * DFF * D};
        pg8::EpiSwiglu E{ACT, pk->in[I_BGU]};
        pg8::gemm_phase<pg8::EpiSwiglu, pg8::MoeSched, true, true>((LAS unsigned char*)lds_raw, H2, D / 2, Sd, E);
#else
        pg8::MoeSched Sd{mtp, mro, mcn, DFF / 128, G, bid, D, D, 1, LIST, (const char*)WguT, (size_t)2 * DFF * D * 2};
        pg8::EpiSwiglu E{ACT, pk->in[I_BGU]};
        pg8::gemm_phase<pg8::EpiSwiglu, pg8::MoeSched, true>((LAS unsigned char*)lds_raw, H2, D, Sd, E);
#endif
        {
            const int nun = mtp[NE] * (DFF / 128); const int mine = (nun - bid + G - 1) / G, most = (nun + G - 1) / G;
            if (mine < most) pull_chunks(ctl + CW_QDN, 0, DN_CHUNKS, 3, pk->in[I_WGU], pk->in[I_WDN], WguT, WdnT, 1, lds_raw, wave, lane);
            pull_chunks(ctl + CW_QDN, 0, DN_CHUNKS, DN_CHUNKS, pk->in[I_WGU], pk->in[I_WDN], WguT, WdnT, 1, lds_raw, wave, lane);
        }
    }
    PH_END(9)
    SEAM(9);
    PH_BEGIN(10) if (IN(10)) {
        const int tid = fresh_tid(), lane = tid & 63, wave = tid >> 6; (void)lane; (void)wave;
        PHASE_ENV
#if MOE_FP8
        pg8::MoeSched Sd{mtp, mro, mcn, D / 256, G, bid, DFF / 2, DFF / 2, 0, LIST, (const char*)WdnT, (size_t)D * DFF};
        pg8::EpiDown E{YG, pk->in[I_BDN], RGATE, mro};
        pg8::gemm_phase<pg8::EpiDown, pg8::MoeSched, true, true>((LAS unsigned char*)lds_raw, ACT, DFF / 2, Sd, E);
#else
        pg8::MoeSched Sd{mtp, mro, mcn, D / 256, G, bid, DFF, DFF, 0, LIST, (const char*)WdnT, (size_t)D * DFF * 2};
        pg8::EpiDown E{YG, pk->in[I_BDN], RGATE, mro};
        pg8::gemm_phase<pg8::EpiDown, pg8::MoeSched, true>((LAS unsigned char*)lds_raw, ACT, DFF, Sd, E);
#endif
    }
    PH_END(10)
    SEAM(10);
    PH_BEGIN(11) if (IN(11)) {
        const int tid = fresh_tid(), lane = tid & 63, wave = tid >> 6; (void)lane; (void)wave;
        PHASE_ENV
        const float* fng = pk->in[I_FNG];
        for (int r = bid * 8 + wave; r < MX; r += G * 8) {
            const int mb = r / S; const float* g2 = MOD + mb * 6144 + 5 * D;
            float acc[16];
#pragma unroll
            for (int i = 0; i < 16; ++i) acc[i] = 0.f;
#pragma unroll
            for (int k = 0; k < 4; ++k) {
                const int e = TOPE[r * 4 + k]; const int row = mro[e] + SLOT[r * 4 + k];
                const unsigned short* yr = YG + (size_t)row * D;
#pragma unroll
                for (int j = 0; j < 4; ++j) { const pg8::u32x2 t = *(const pg8::u32x2*)(yr + j * 256 + lane * 4);
                    acc[4 * j] += __uint_as_float(t.x << 16); acc[4 * j + 1] += __uint_as_float(t.x & 0xffff0000u); acc[4 * j + 2] += __uint_as_float(t.y << 16); acc[4 * j + 3] += __uint_as_float(t.y & 0xffff0000u); }
            }
            float v[16]; float ss = 0.f;
#pragma unroll
            for (int j = 0; j < 4; ++j) { const pg8::u32x2 tw = *(const pg8::u32x2*)(X1 + (size_t)r * D + j * 256 + lane * 4); const float4 t = make_float4(__uint_as_float(tw.x << 16), __uint_as_float(tw.x & 0xffff0000u), __uint_as_float(tw.y << 16), __uint_as_float(tw.y & 0xffff0000u)); const int c = j * 256 + lane * 4;
                v[4 * j] = t.x + g2[c] * acc[4 * j]; v[4 * j + 1] = t.y + g2[c + 1] * acc[4 * j + 1]; v[4 * j + 2] = t.z + g2[c + 2] * acc[4 * j + 2]; v[4 * j + 3] = t.w + g2[c + 3] * acc[4 * j + 3];
                ss += v[4 * j] * v[4 * j] + v[4 * j + 1] * v[4 * j + 1] + v[4 * j + 2] * v[4 * j + 2] + v[4 * j + 3] * v[4 * j + 3]; }
            const float rstd = rsqrtf(wave_sum(ss) * (1.f / D) + EPS);
#pragma unroll
            for (int j = 0; j < 4; ++j) { const int c = j * 256 + lane * 4;
                *(float4*)(pk->out + (size_t)r * D + c) = make_float4(v[4 * j] * rstd * fng[c], v[4 * j + 1] * rstd * fng[c + 1], v[4 * j + 2] * rstd * fng[c + 2], v[4 * j + 3] * rstd * fng[c + 3]); }
        }
    }
    PH_END(11)
#undef IN
#undef SEAM
}

#ifndef PROBE_SPLIT_DUP
#define PROBE_SPLIT_DUP (-1)
#endif
#ifndef N_LAUNCH_SPLIT
#define N_LAUNCH_SPLIT 0
#endif

extern "C" void kernel_launch(void* const* d_in, const int* in_sizes, int n_in, void* d_out, int out_size, void* d_ws, size_t ws_size, hipStream_t stream) {
    static int grid = 0;
    if (grid == 0) {
        if (n_in != 23 || out_size != MX * D || ws_size < WS_END) { fprintf(stderr, "kernel_launch: unexpected shapes n_in %d out %d ws %zu (need %zu)\n", n_in, out_size, ws_size, (size_t)WS_END); grid = -1; return; }
        int dev = 0, cus = 0, per_cu = 0;
        hipGetDevice(&dev); hipDeviceGetAttribute(&cus, hipDeviceAttributeMultiprocessorCount, dev);
        if (hipFuncSetAttribute((const void*)fwd_kernel, hipFuncAttributeMaxDynamicSharedMemorySize, LDS_BYTES) != hipSuccess) { fprintf(stderr, "kernel_launch: hipFuncSetAttribute failed\n"); grid = -1; return; }
        hipOccupancyMaxActiveBlocksPerMultiprocessor(&per_cu, (const void*)fwd_kernel, NT, LDS_BYTES);
        if (per_cu < 1) fprintf(stderr, "kernel_launch: occupancy query says %d\n", per_cu);
        (void)hipGetLastError();
        grid = cus > 0 ? cus : 256;
    }
    if (grid < 0) return;
    hipMemsetAsync((char*)d_ws + WS_CTL, 0, CTL_BYTES, stream);
    Params p{};
    for (int i = 0; i < 23; ++i) p.in[i] = (const float*)d_in[i];
    p.out = (float*)d_out; p.ws = (unsigned char*)d_ws;
#if N_LAUNCH_SPLIT
    for (int k = 0; k < N_PHASES; ++k) {
        if (k == 3) continue;
        const int reps = (k == PROBE_SPLIT_DUP) ? 2 : 1;
        for (int r = 0; r < reps; ++r) {
            if (k == 8 && r == 1) hipMemsetAsync((char*)d_ws + WS_CTL, 0, CTL_BYTES, stream);
            p.ph_lo = k; p.ph_hi = k + 1; hipLaunchKernelGGL(fwd_kernel, dim3(grid), dim3(NT), LDS_BYTES, stream, p);
        }
    }
#else
    p.ph_lo = 0; p.ph_hi = N_PHASES;
    hipLaunchKernelGGL(fwd_kernel, dim3(grid), dim3(NT), LDS_BYTES, stream, p);
#endif
}
```

```cpp
#include <hip/hip_runtime.h>
#include <cstdio>
#include <cstdint>

#define LAS __attribute__((address_space(3)))

#define XB_TMO      128
#define XB_XCNT(j)  (256  + 64 * (j))
#define XB_XSUB(j)  (1280 + 64 * (j))
#define XB_XGEN(j)  (2304 + 64 * (j))
#define XB_TOP      3328
#define XB_TOPGEN   3392
#define XCD_BAR_WORDS 3456
#define XB_SPIN_CAP (1u << 22)

__device__ __forceinline__ unsigned xb_ld(unsigned* p)              { return __hip_atomic_load(p, __ATOMIC_RELAXED, __HIP_MEMORY_SCOPE_AGENT); }
__device__ __forceinline__ unsigned xb_add(unsigned* p, unsigned v) { return __hip_atomic_fetch_add(p, v, __ATOMIC_RELAXED, __HIP_MEMORY_SCOPE_AGENT); }
__device__ __forceinline__ unsigned xb_xcc_id() { return (unsigned)__builtin_amdgcn_s_getreg((3 << 11) | 20) & 0xFu; }
#define XB_SPIN(cond, bar) do { unsigned _sp = 0; while (cond) { __builtin_amdgcn_s_sleep(1); \
    if ((++_sp & 255u) == 0u) { if (xb_ld(&(bar)[XB_TMO])) break; if (_sp > XB_SPIN_CAP) { atomicAdd(&(bar)[XB_TMO], 1u); break; } } } } while (0)

struct XcdBarrier { unsigned* bar; unsigned x; volatile LAS unsigned* st; };

__device__ __forceinline__ XcdBarrier xcd_barrier_post(unsigned* bar, volatile LAS unsigned* st) {
    XcdBarrier b; b.bar = bar; b.x = xb_xcc_id(); b.st = st;
    if (threadIdx.x == 0) (void)xb_add(&bar[XB_XCNT(b.x)], 1u);
    return b;
}
__device__ __forceinline__ void xcd_barrier_complete(unsigned* bar, unsigned x, unsigned& nloc, unsigned& nx) {
    const unsigned G = gridDim.x * gridDim.y * gridDim.z;
    unsigned sum, cnt, mine, sp = 0u;
    for (;;) {
        sum = 0u; cnt = 0u; mine = 0u;
#pragma unroll
        for (unsigned j = 0; j < 16; ++j) { const unsigned c = xb_ld(&bar[XB_XCNT(j)]); sum += c; cnt += (c > 0u) ? 1u : 0u; mine = (j == x) ? c : mine; }
        if (sum == G) break;
        __builtin_amdgcn_s_sleep(1);
        if ((++sp & 255u) == 0u) { if (xb_ld(&bar[XB_TMO])) break; if (sp > XB_SPIN_CAP) { atomicAdd(&bar[XB_TMO], 1u); break; } }
    }
    nloc = mine > 0u ? mine : 1u; nx = cnt > 0u ? cnt : 1u;
}
__device__ __forceinline__ void xcd_barrier(const XcdBarrier& b) {
    asm volatile("s_waitcnt vmcnt(0)" ::: "memory");
    __syncthreads();
    if (threadIdx.x == 0) {
        unsigned* bar = b.bar;
        __builtin_amdgcn_s_waitcnt(0);
        unsigned nloc = b.st[0], nx = b.st[1];
        if (nloc == 0u) { xcd_barrier_complete(bar, b.x, nloc, nx); b.st[0] = nloc; b.st[1] = nx; }
        const unsigned old = xb_add(&bar[XB_XSUB(b.x)], 1u);
        const unsigned gen = old / nloc;
        if (old + 1u == (gen + 1u) * nloc) {
            __builtin_amdgcn_fence(__ATOMIC_RELEASE, "agent");
            asm volatile("s_waitcnt vmcnt(0)" ::: "memory");
            const unsigned og = xb_add(&bar[XB_TOP], 1u);
            const unsigned tg = og / nx;
            if (og + 1u == (tg + 1u) * nx) xb_add(&bar[XB_TOPGEN], 1u);
            else XB_SPIN(xb_ld(&bar[XB_TOPGEN]) == tg, bar);
            __builtin_amdgcn_fence(__ATOMIC_ACQUIRE, "agent");
            xb_add(&bar[XB_XGEN(b.x)], 1u);
            asm volatile("s_waitcnt vmcnt(0)" ::: "memory");
        } else {
            XB_SPIN(xb_ld(&bar[XB_XGEN(b.x)]) == gen, bar);
            __builtin_amdgcn_fence(__ATOMIC_ACQUIRE, "agent");
            asm volatile("s_waitcnt vmcnt(0)" ::: "memory");
        }
    }
    __syncthreads();
}

#ifndef MOE_FP8
#define MOE_FP8 1
#endif
constexpr int D = 1024, NB = 4, S = 4096, CTX = 256, SKV = S + CTX;
constexpr int MX = NB * S, MC = NB * CTX, MT = MX + MC;
constexpr int INW = 2224, PW = 2304;
constexpr int O_CQ = 0, O_CKV = 384, O_KR = 640, O_MQ = 672, O_MK = 928, O_MV = 1184, O_MO = 1696, O_G = 2208;
constexpr int QL = 384, KVL = 256, HA = 8, DN = 64, DR = 32, DQK = 96, DVH = 64;
constexpr int NH = 4, MDQK = 64, MDV = 128;
constexpr int NE = 32, TOPK = 4, DFF = 1024;
constexpr float EPS = 1e-6f;
constexpr int NT = 512;
constexpr int NSEQ = NB * NH * 2;
constexpr int RCAP = MX * TOPK + NE * 256;

constexpr size_t MiB = 1u << 20;
constexpr size_t WS_CTL = 0, CTL_BYTES = 128 * 1024;
constexpr size_t WS_MOD = 1 * MiB;
constexpr size_t WS_MLS = 2 * MiB;
constexpr size_t WS_ROPE = 5 * MiB;
constexpr size_t WS_STAT2 = 6 * MiB;
constexpr size_t WS_TOPE = 8 * MiB;
constexpr size_t WS_SLOT = 9 * MiB;
constexpr size_t WS_LIST = 10 * MiB;
constexpr size_t WS_RGATE = 12 * MiB;
constexpr size_t WS_H = 16 * MiB;
constexpr size_t WS_P = 52 * MiB;
constexpr size_t WS_ACT = WS_P;
constexpr size_t WS_Q = 206 * MiB;
constexpr size_t WS_KV = 254 * MiB;
constexpr size_t WS_CLOC = 322 * MiB;
constexpr size_t WS_CIN = 386 * MiB;
constexpr size_t WS_X1 = 450 * MiB;
constexpr size_t WS_H2 = 514 * MiB;
constexpr size_t WS_YG = 546 * MiB;
constexpr size_t WS_WGUT = 690 * MiB;
constexpr size_t WS_WDNT = 818 * MiB;
constexpr size_t WS_WINT = 882 * MiB;
constexpr size_t WS_WUQT = 887 * MiB;
constexpr size_t WS_WUKVT = 888 * MiB;
constexpr size_t WS_WOUTT = 889 * MiB;
constexpr size_t WS_GATES = 891 * MiB;
constexpr size_t WS_STAT = 893 * MiB;
constexpr size_t WS_RSTD = 895 * MiB;
constexpr size_t WS_MIX16 = 896 * MiB;
constexpr size_t WS_END = 928 * MiB;
static_assert((size_t)MT * PW * 2 <= 153 * MiB && (size_t)RCAP * DFF * 2 <= 144 * MiB, "map");

constexpr int CW_BAR = 4096;
constexpr int CW_CNT = 16384;
constexpr int CW_QGU = 16384 + 64, CW_QDN = 16384 + 128;
constexpr int GU_CHUNKS = 512, DN_CHUNKS = 256;
#ifndef GU_STATIC
#define GU_STATIC 400
#endif

struct Params {
    const float* in[23];
    float* out;
    unsigned char* ws;
    int ph_lo, ph_hi;
};
enum { I_X = 0, I_C, I_CTX, I_CCTX, I_WMOD, I_BMOD, I_N1G, I_WIN, I_BG, I_QNG, I_WUQ, I_KVNG, I_WUKV, I_MNG, I_WOUT, I_N2G, I_RW, I_RB, I_WGU, I_BGU, I_WDN, I_BDN, I_FNG };

__device__ __forceinline__ float wave_sum(float v) {
#pragma unroll
    for (int o = 1; o < 64; o <<= 1) v += __shfl_xor(v, o);
    return v;
}
__device__ __forceinline__ float bf2f(unsigned short v) { return __uint_as_float(((unsigned)v) << 16); }
__device__ __forceinline__ float sigmoidf_(float x) { return 1.f / (1.f + __expf(-x)); }
__device__ __forceinline__ float siluf_(float x) { return x / (1.f + expf(-x)); }
__device__ __forceinline__ float logsigmoidf_(float x) { return fminf(x, 0.f) - log1pf(expf(-fabsf(x))); }

__device__ __forceinline__ int krow(int b, int key) { return key < CTX ? MX + b * CTX + key : b * S + (key - CTX); }
__device__ __forceinline__ int srow(int b, int dir, int u) {
    if (u < CTX) { const int c = dir ? (CTX - 1 - u) : u; return MX + b * CTX + c; }
    const int tt = u - CTX; const int s = dir ? (S - 1 - tt) : tt; return b * S + s;
}
__device__ __forceinline__ void rope_angles(int s, int j, float& cs, float& sn) {
    const int jj = j & 7; const float pos = (j < 8) ? (float)(s / 64) : (float)(s % 64);
    const float inv = powf(10000.f, -(float)jj / 8.f);
    const float ang = pos * inv; cs = cosf(ang); sn = sinf(ang);
}

struct GemmDesc { const float* A; int lda; const int* arow; int M; const float* B; int ldb; int N; int K; };
template <class Epi>
__device__ __forceinline__ void sgemm_tile(float* lds, const GemmDesc g, int tm, int tn, const Epi& epi) {
    float* As = lds;
    float* Bs = lds + 16 * 132;
    const int tid = threadIdx.x, tx = tid & 15, ty = tid >> 4;
    float acc[4][8];
#pragma unroll
    for (int i = 0; i < 4; ++i)
#pragma unroll
        for (int j = 0; j < 8; ++j) acc[i][j] = 0.f;
    const int ar = tid >> 2, ak = (tid & 3) * 4;
    const int grow = tm * 128 + ar;
    const float* aptr = nullptr;
    if (grow < g.M) { const int r = g.arow ? g.arow[grow] : grow; aptr = g.A + (size_t)r * g.lda + ak; }
    const int bk = tid >> 5, bc = (tid & 31) * 4;
    const int gcol = tn * 128 + bc;
    for (int k0 = 0; k0 < g.K; k0 += 16) {
        float4 av = make_float4(0.f, 0.f, 0.f, 0.f), bv = make_float4(0.f, 0.f, 0.f, 0.f);
        if (aptr) av = *(const float4*)(aptr + k0);
        if (gcol < g.N) bv = *(const float4*)(g.B + (size_t)(k0 + bk) * g.ldb + gcol);
        __syncthreads();
        As[(ak + 0) * 132 + ar] = av.x; As[(ak + 1) * 132 + ar] = av.y; As[(ak + 2) * 132 + ar] = av.z; As[(ak + 3) * 132 + ar] = av.w;
        *(float4*)(Bs + bk * 128 + bc) = bv;
        __syncthreads();
#pragma unroll
        for (int k = 0; k < 16; ++k) {
            const float4 a4 = *(const float4*)(As + k * 132 + ty * 4);
            const float4 b0 = *(const float4*)(Bs + k * 128 + tx * 8), b1 = *(const float4*)(Bs + k * 128 + tx * 8 + 4);
            const float a[4] = {a4.x, a4.y, a4.z, a4.w};
            const float b[8] = {b0.x, b0.y, b0.z, b0.w, b1.x, b1.y, b1.z, b1.w};
#pragma unroll
            for (int i = 0; i < 4; ++i)
#pragma unroll
                for (int j = 0; j < 8; ++j) acc[i][j] = fmaf(a[i], b[j], acc[i][j]);
        }
    }
#pragma unroll
    for (int i = 0; i < 4; ++i) {
        const int r = tm * 128 + ty * 4 + i;
        if (r < g.M) {
#pragma unroll
            for (int j = 0; j < 8; ++j) { const int c = tn * 128 + tx * 8 + j; if (c < g.N) epi(r, c, acc[i][j]); }
        }
    }
}
template <class Epi>
__device__ __forceinline__ void sgemm_phase(float* lds, const GemmDesc g, const Epi& epi, int u0 = 0, int ustride = 0) {
    const int ntm = (g.M + 127) / 128, ntn = (g.N + 127) / 128;
    for (int u = blockIdx.x; u < ntm * ntn; u += gridDim.x) sgemm_tile(lds, g, u / ntn, u % ntn, epi);
}


namespace pg8 {
#define PG8_LAS __attribute__((address_space(3)))
typedef unsigned short bf16_t;
typedef short bf16x8 __attribute__((ext_vector_type(8)));
typedef float f32x4 __attribute__((ext_vector_type(4)));
typedef unsigned u32x4 __attribute__((ext_vector_type(4)));
typedef unsigned u32x2 __attribute__((ext_vector_type(2)));
constexpr int BM = 256, BK = 64, HALF = 128, HTB = HALF * BK * 2, STAGE_BYTES = 8 * HTB, NXCD = 8, WGM = 8;
__host__ __device__ __forceinline__ int lds_byte(int r, int c) { const int st = (r >> 4) * 2 + (c >> 5), rr = r & 15, cc = c & 31, ob = rr * 64 + cc * 2; return st * 1024 + (ob ^ (((ob >> 9) & 1) << 5)); }
__host__ __device__ __forceinline__ void stage_rc(int b, int& R, int& C) { const int st = b / 1024, sb = b % 1024, swz = sb ^ (((sb >> 9) & 1) << 5); R = (st >> 1) * 16 + swz / 64; C = (st & 1) * 32 + (swz % 64) / 2; }
__host__ __device__ __forceinline__ int perm32(int rho) { const int n = rho >> 4, i = rho & 15; return 8 * (i >> 2) + 4 * n + (i & 3); }
__device__ __forceinline__ unsigned cvt_pk_bf16(float lo, float hi) { unsigned r; asm volatile("v_cvt_pk_bf16_f32 %0, %1, %2" : "=v"(r) : "v"(lo), "v"(hi)); return r; }

struct Unit { int pm, pn, g, row0; };

struct PlainSched {
    int nM, nN, nwg, G, c, lda, K; const char* Bt;
    __device__ void init(int M, int N, int K_, int lda_, const void* Bt_, int G_, int c_) { nM = M / BM; nN = N / BM; nwg = nM * nN; G = G_; c = c_; lda = lda_; K = K_; Bt = (const char*)Bt_; }
    __device__ __forceinline__ bool next(int i, Unit& u) const {
        const long L = (long)i * G + c; if (L >= nwg) return false;
        int wgid = (int)L; { const int q = nwg / NXCD, r = nwg % NXCD, xcd = wgid % NXCD, off = wgid / NXCD; wgid = (xcd < r ? xcd * (q + 1) : r * (q + 1) + (xcd - r) * q) + off; }
        const int nig = WGM * nN, gid = wgid / nig, fm = gid * WGM, gsz = (nM - fm) < WGM ? (nM - fm) : WGM;
        u.pm = fm + ((wgid % nig) % gsz); u.pn = (wgid % nig) / gsz; u.g = 0; u.row0 = u.pm * BM; return true;
    }
    __device__ __forceinline__ unsigned a_rowoff(const Unit& u, int r) const { return (unsigned)(u.pm * BM + r) * (unsigned)(lda * 2); }
    __device__ __forceinline__ void rows4(const Unit& u, int R0, int R1, unsigned (&o)[4]) const { o[0] = a_rowoff(u, R0); o[1] = a_rowoff(u, R1); o[2] = a_rowoff(u, HALF + R0); o[3] = a_rowoff(u, HALF + R1); }
    __device__ __forceinline__ const char* b_base(const Unit& u) const { return Bt + (size_t)u.pn * BM * K * 2; }
};

template <class Epi, class Sched, bool ALIGN_EPI, bool F8 = false>
__device__ __forceinline__ void gemm_phase(PG8_LAS unsigned char* lds, const bf16_t* Aptr, const int K, const Sched& S, const Epi& E) {
    const int tid = threadIdx.x, wid = __builtin_amdgcn_readfirstlane(tid >> 6), lane = tid & 63, wr = wid >> 2, wc = wid & 3, fr = lane & 15, fq = lane >> 4;
    const int nt = K / BK;
    unsigned voffB[2];
#pragma unroll
    for (int i = 0; i < 2; ++i) { int R, C; stage_rc(tid * 16 + i * 8192, R, C); const int Rb = Epi::PERM ? ((R & ~31) + perm32(R & 31)) : R;
        voffB[i] = (unsigned)(Rb * K + C) * 2u; }
    const size_t kstep = (size_t)(BK * 2);
    const size_t hstepB = (size_t)HALF * K * 2;
    const unsigned ldsw = (unsigned)wid * 1024u;
    const int aoff = lds_byte(wr * 64 + fr, fq * 8), boff = lds_byte(wc * 32 + fr, fq * 8);
#define PG8_SA(b, h) (((b) * 2 + (h)) * HTB)
#define PG8_SB(b, h) ((4 + (b) * 2 + (h)) * HTB)
#define PG8_STAGE(bufoff, gbase, voff) do { _Pragma("unroll") for (int _i = 0; _i < 2; ++_i) \
        __builtin_amdgcn_global_load_lds((const unsigned*)((const char*)(gbase) + (voff)[_i]), (PG8_LAS unsigned*)(lds + (bufoff) + ldsw + _i * 8192), 16, 0, 0); } while (0)
#define PG8_LDA(dst, b, h) do { _Pragma("unroll") for (int m = 0; m < 4; ++m) _Pragma("unroll") for (int k = 0; k < 2; ++k) dst[m][k] = *(const PG8_LAS bf16x8*)(lds + PG8_SA(b, h) + aoff + m * 2048 + k * 1024); } while (0)
#define PG8_LDB(dst, b, h) do { _Pragma("unroll") for (int n = 0; n < 2; ++n) _Pragma("unroll") for (int k = 0; k < 2; ++k) dst[n][k] = *(const PG8_LAS bf16x8*)(lds + PG8_SB(b, h) + boff + n * 2048 + k * 1024); } while (0)
typedef int i32x4v __attribute__((ext_vector_type(4)));
typedef int i32x8v __attribute__((ext_vector_type(8)));
#define PG8_CAT(x0, x1) __builtin_shufflevector(__builtin_bit_cast(i32x4v, x0), __builtin_bit_cast(i32x4v, x1), 0, 1, 2, 3, 4, 5, 6, 7)
#define PG8_MMA(ai, bj, At, Bt) do { __builtin_amdgcn_s_setprio(1); \
        if constexpr (F8) { _Pragma("unroll") for (int m = 0; m < 4; ++m) _Pragma("unroll") for (int n = 0; n < 2; ++n) \
            acc[ai][bj][m][n] = __builtin_amdgcn_mfma_scale_f32_16x16x128_f8f6f4(PG8_CAT(Bt[n][0], Bt[n][1]), PG8_CAT(At[m][0], At[m][1]), acc[ai][bj][m][n], 0, 0, 0, 0x79797979, 0, 0x7f7f7f7f); } \
        else { _Pragma("unroll") for (int m = 0; m < 4; ++m) _Pragma("unroll") for (int n = 0; n < 2; ++n) _Pragma("unroll") for (int k = 0; k < 2; ++k) \
            acc[ai][bj][m][n] = __builtin_amdgcn_mfma_f32_16x16x32_bf16(Bt[n][k], At[m][k], acc[ai][bj][m][n], 0, 0, 0); } \
        __builtin_amdgcn_s_setprio(0); } while (0)
#define PG8_WAIT_V(n) asm volatile("s_waitcnt vmcnt(" #n ")" ::: "memory")
#define PG8_WAIT_L(n) asm volatile("s_waitcnt lgkmcnt(" #n ")" ::: "memory")
#define PG8_BAR __builtin_amdgcn_s_barrier()
#define PG8_SCHED __builtin_amdgcn_sched_barrier(0)
    Unit cur, nxt; int ui = 0;
    if (!S.next(0, cur)) return;
    f32x4 acc[2][2][4][2];
#pragma unroll
    for (int a = 0; a < 2; ++a)
#pragma unroll
        for (int b = 0; b < 2; ++b)
#pragma unroll
            for (int m = 0; m < 4; ++m)
#pragma unroll
                for (int n = 0; n < 2; ++n) acc[a][b][m][n] = (f32x4){0.f, 0.f, 0.f, 0.f};
    bf16x8 At[4][2], B0[2][2], B1[2][2];
    unsigned oA0[2], oA1[2];
    { int R0, C0, R1, C1; stage_rc(tid * 16, R0, C0); stage_rc(tid * 16 + 8192, R1, C1); unsigned o4[4]; S.rows4(cur, R0, R1, o4);
      oA0[0] = o4[0] + (unsigned)C0 * 2u; oA0[1] = o4[1] + (unsigned)C1 * 2u; oA1[0] = o4[2] + (unsigned)C0 * 2u; oA1[1] = o4[3] + (unsigned)C1 * 2u; }
    const char* const cA = (const char*)Aptr;
    const char* cB = S.b_base(cur);
    PG8_STAGE(PG8_SB(0, 0), cB, voffB); PG8_STAGE(PG8_SB(0, 1), cB + hstepB, voffB); PG8_STAGE(PG8_SA(0, 0), cA, oA0); PG8_STAGE(PG8_SA(0, 1), cA, oA1);
    if (wr == 1) PG8_BAR;
    PG8_WAIT_V(2); PG8_BAR;
    PG8_STAGE(PG8_SB(1, 0), cB + kstep, voffB); PG8_STAGE(PG8_SA(1, 0), cA + kstep, oA0); PG8_STAGE(PG8_SB(1, 1), cB + hstepB + kstep, voffB);
    PG8_WAIT_V(6); PG8_BAR;
    for (;;) {
        const bool has_next = S.next(ui + 1, nxt);
        const char* nB = has_next ? S.b_base(nxt) : cB;
        unsigned pre[4] = {0u, 0u, 0u, 0u};
        if (has_next) { int R0, C0, R1, C1; stage_rc((int)threadIdx.x * 16, R0, C0); stage_rc((int)threadIdx.x * 16 + 8192, R1, C1); S.rows4(nxt, R0, R1, pre);
            asm volatile("" : "+v"(pre[0]), "+v"(pre[1]), "+v"(pre[2]), "+v"(pre[3])); }
#pragma unroll 1
        for (int t = 0; t < nt; t += 2) {
            const bool last = (t == nt - 2);
            const char* a1 = cA + (size_t)(t + 1) * kstep;
            const char* a2 = last ? cA : cA + (size_t)(t + 2) * kstep; const char* b2 = last ? nB : cB + (size_t)(t + 2) * kstep;
            const char* a3 = a2 + kstep; const char* b3 = b2 + kstep;
            PG8_LDB(B0, 0, 0); PG8_LDB(B1, 0, 1); PG8_SCHED; PG8_LDA(At, 0, 0); PG8_STAGE(PG8_SA(1, 1), a1, oA1);
            if (last && has_next) {
                int R0, C0, R1, C1; stage_rc((int)threadIdx.x * 16, R0, C0); stage_rc((int)threadIdx.x * 16 + 8192, R1, C1);
                oA0[0] = pre[0] + (unsigned)C0 * 2u; oA0[1] = pre[1] + (unsigned)C1 * 2u; oA1[0] = pre[2] + (unsigned)C0 * 2u; oA1[1] = pre[3] + (unsigned)C1 * 2u;
            }
            PG8_WAIT_V(8); PG8_WAIT_L(0); PG8_BAR; PG8_MMA(0, 0, At, B0); PG8_MMA(0, 1, At, B1); PG8_BAR; PG8_SCHED;
            PG8_LDA(At, 0, 1); PG8_STAGE(PG8_SB(0, 0), b2, voffB); PG8_STAGE(PG8_SB(0, 1), b2 + hstepB, voffB); PG8_STAGE(PG8_SA(0, 0), a2, oA0);
            PG8_WAIT_V(8); PG8_WAIT_L(0); PG8_BAR; PG8_MMA(1, 0, At, B0); PG8_MMA(1, 1, At, B1); PG8_BAR; PG8_SCHED;
            PG8_LDB(B0, 1, 0); PG8_LDB(B1, 1, 1); PG8_SCHED; PG8_LDA(At, 1, 0); PG8_STAGE(PG8_SA(0, 1), a2, oA1);
            PG8_WAIT_V(8); PG8_WAIT_L(0); PG8_BAR; PG8_MMA(0, 0, At, B0); PG8_MMA(0, 1, At, B1); PG8_BAR; PG8_SCHED;
            PG8_LDA(At, 1, 1); PG8_STAGE(PG8_SB(1, 0), b3, voffB); PG8_STAGE(PG8_SB(1, 1), b3 + hstepB, voffB); PG8_STAGE(PG8_SA(1, 0), a3, oA0);
            PG8_WAIT_V(8); PG8_WAIT_L(0); PG8_BAR; PG8_MMA(1, 0, At, B0); PG8_MMA(1, 1, At, B1); PG8_BAR; PG8_SCHED;
        }
        if constexpr (ALIGN_EPI) { if (wr == 0) PG8_BAR; }
        E(acc, cur, wr, wc, fr, fq);
        if (!has_next) break;
#pragma unroll
        for (int a = 0; a < 2; ++a)
#pragma unroll
            for (int b = 0; b < 2; ++b)
#pragma unroll
                for (int m = 0; m < 4; ++m)
#pragma unroll
                    for (int n = 0; n < 2; ++n) acc[a][b][m][n] = (f32x4){0.f, 0.f, 0.f, 0.f};
        cur = nxt; cB = nB; ++ui;
        if constexpr (ALIGN_EPI) { if (wr == 1) PG8_BAR; }
    }
    PG8_WAIT_V(0);
    if constexpr (!ALIGN_EPI) { if (wr == 0) PG8_BAR; }
    PG8_BAR;
#undef PG8_SA
#undef PG8_SB
#undef PG8_STAGE
#undef PG8_LDA
#undef PG8_LDB
#undef PG8_MMA
#undef PG8_CAT
#undef PG8_WAIT_V
#undef PG8_WAIT_L
#undef PG8_BAR
#undef PG8_SCHED
}

struct EpiF32 {
    static constexpr bool PERM = false;
    float* C; int ldc; int ncols;
    __device__ __forceinline__ void operator()(const f32x4 (&acc)[2][2][4][2], const Unit& u, int wr, int wc, int fr, int fq) const {
        const int row0 = u.row0 + wr * 64 + fr, col0 = u.pn * BM + wc * 32 + 4 * fq;
#pragma unroll
        for (int ai = 0; ai < 2; ++ai)
#pragma unroll
            for (int m = 0; m < 4; ++m) { float* rowp = C + (size_t)(row0 + ai * HALF + m * 16) * ldc + col0;
#pragma unroll
                for (int bj = 0; bj < 2; ++bj)
#pragma unroll
                    for (int n = 0; n < 2; ++n) if (col0 + bj * HALF + n * 16 < ncols) *(f32x4*)(rowp + bj * HALF + n * 16) = acc[ai][bj][m][n]; }
    }
};
struct MoeSched {
    const PG8_LAS int* tp; const PG8_LAS int* ro; const PG8_LAS int* cn; int nN, G, c, K, lda, gather; const int* list; const char* Bt; size_t bstride;
    __device__ __forceinline__ bool next(int i, Unit& u) const {
        const int nwg = tp[32] * nN; const long L = (long)i * G + c; if (L >= nwg) return false;
        int wgid = (int)L; { const int q = nwg / NXCD, r = nwg % NXCD, xcd = wgid % NXCD, off = wgid / NXCD; wgid = (xcd < r ? xcd * (q + 1) : r * (q + 1) + (xcd - r) * q) + off; }
        const int tile = wgid / nN;
        const int g = __popcll(__ballot(tp[threadIdx.x & 31] <= tile) & 0xffffffffull) - 1;
        const int ntm = tp[g + 1] - tp[g]; const int rem = wgid - tp[g] * nN;
        u.g = g; u.pm = rem % ntm; u.pn = rem / ntm; u.row0 = ro[g] + u.pm * BM; return true;
    }
    __device__ __forceinline__ unsigned a_rowoff(const Unit& u, int r) const {
        const int rr = u.pm * BM + r;
        if (gather) { const int tok = (rr < cn[u.g]) ? list[u.g * 16384 + rr] : 0; return (unsigned)tok * (unsigned)(lda * 2); }
        return (unsigned)(u.row0 + r) * (unsigned)(lda * 2);
    }
    __device__ __forceinline__ void rows4(const Unit& u, int R0, int R1, unsigned (&o)[4]) const {
        if (gather) { const int last = cn[u.g] - 1, b0 = u.pm * BM; const int* lp = list + u.g * 16384;
            const int t0 = lp[min(b0 + R0, last)], t1 = lp[min(b0 + R1, last)], t2 = lp[min(b0 + HALF + R0, last)], t3 = lp[min(b0 + HALF + R1, last)];
            o[0] = (unsigned)t0 * (unsigned)(lda * 2); o[1] = (unsigned)t1 * (unsigned)(lda * 2); o[2] = (unsigned)t2 * (unsigned)(lda * 2); o[3] = (unsigned)t3 * (unsigned)(lda * 2); }
        else { o[0] = a_rowoff(u, R0); o[1] = a_rowoff(u, R1); o[2] = a_rowoff(u, HALF + R0); o[3] = a_rowoff(u, HALF + R1); }
    }
    __device__ __forceinline__ const char* b_base(const Unit& u) const { return Bt + (size_t)u.g * bstride + (size_t)u.pn * BM * K * 2; }
};
struct EpiSwiglu {
    static constexpr bool PERM = true;
    bf16_t* O; const float* bias;
    __device__ __forceinline__ void operator()(const f32x4 (&acc)[2][2][4][2], const Unit& u, int wr, int wc, int fr, int fq) const {
        const int row0 = u.row0 + wr * 64 + fr, col0 = u.pn * 128 + wc * 32 + 8 * fq;
        const float* bg = bias + (size_t)u.g * 2048 + col0;
        f32x4 bgl[2], bln[2];
#pragma unroll
        for (int n = 0; n < 2; ++n) { bgl[n] = *(const f32x4*)(bg + 4 * n); bln[n] = *(const f32x4*)(bg + 1024 + 4 * n) + 1.0f; }
#pragma unroll
        for (int ai = 0; ai < 2; ++ai)
#pragma unroll
            for (int m = 0; m < 4; ++m) {
                float o[8];
#pragma unroll
                for (int n = 0; n < 2; ++n)
#pragma unroll
                    for (int jp = 0; jp < 2; ++jp) {
                        typedef float f32x2 __attribute__((ext_vector_type(2)));
                        f32x2 g = (f32x2){acc[ai][0][m][n][2 * jp], acc[ai][0][m][n][2 * jp + 1]} + (f32x2){bgl[n][2 * jp], bgl[n][2 * jp + 1]};
                        f32x2 l = (f32x2){acc[ai][1][m][n][2 * jp], acc[ai][1][m][n][2 * jp + 1]} + (f32x2){bln[n][2 * jp], bln[n][2 * jp + 1]};
                        g.x = fminf(g.x, 7.f); g.y = fminf(g.y, 7.f);
                        l.x = __builtin_amdgcn_fmed3f(l.x, -6.f, 8.f); l.y = __builtin_amdgcn_fmed3f(l.y, -6.f, 8.f);
                        const f32x2 t = g * (-1.702f * 1.4426950408889634f);
                        f32x2 d; d.x = __builtin_amdgcn_exp2f(t.x); d.y = __builtin_amdgcn_exp2f(t.y); d = d + 1.0f;
                        f32x2 r; r.x = __builtin_amdgcn_rcpf(d.x); r.y = __builtin_amdgcn_rcpf(d.y);
                        const f32x2 res = (g * r) * l;
                        o[4 * n + 2 * jp] = res.x; o[4 * n + 2 * jp + 1] = res.y;
                    }
#if MOE_FP8
                u32x2 w8; { int t0 = __builtin_amdgcn_cvt_pk_fp8_f32(o[0], o[1], 0, false); t0 = __builtin_amdgcn_cvt_pk_fp8_f32(o[2], o[3], t0, true); int t1 = __builtin_amdgcn_cvt_pk_fp8_f32(o[4], o[5], 0, false); t1 = __builtin_amdgcn_cvt_pk_fp8_f32(o[6], o[7], t1, true); w8.x = (unsigned)t0; w8.y = (unsigned)t1; }
                *(u32x2*)((unsigned char*)O + (size_t)(row0 + ai * HALF + m * 16) * 1024 + col0) = w8;
#else
                u32x4 w; w.x = cvt_pk_bf16(o[0], o[1]); w.y = cvt_pk_bf16(o[2], o[3]); w.z = cvt_pk_bf16(o[4], o[5]); w.w = cvt_pk_bf16(o[6], o[7]);
                *(u32x4*)(O + (size_t)(row0 + ai * HALF + m * 16) * 1024 + col0) = w;
#endif
            }
    }
};
struct EpiDown {
    static constexpr bool PERM = true;
    bf16_t* O; const float* bias; const float* rgate; const PG8_LAS int* ro;
    __device__ __forceinline__ void operator()(const f32x4 (&acc)[2][2][4][2], const Unit& u, int wr, int wc, int fr, int fq) const {
        const int row0 = u.row0 + wr * 64 + fr, col0 = u.pn * BM + wc * 32 + 8 * fq;
        const float* bd = bias + (size_t)u.g * 1024 + col0;
        const float* gt = rgate + (size_t)u.g * 16384 + (row0 - ro[u.g]);
        f32x4 bv[2][2];
#pragma unroll
        for (int bj = 0; bj < 2; ++bj)
#pragma unroll
            for (int n = 0; n < 2; ++n) bv[bj][n] = *(const f32x4*)(bd + bj * HALF + 4 * n);
        float gva[2][4];
#pragma unroll
        for (int ai = 0; ai < 2; ++ai)
#pragma unroll
            for (int m = 0; m < 4; ++m) gva[ai][m] = gt[ai * HALF + m * 16];
#pragma unroll
        for (int ai = 0; ai < 2; ++ai)
#pragma unroll
            for (int m = 0; m < 4; ++m) {
                const float gv = gva[ai][m];
                bf16_t* rowp = O + (size_t)(row0 + ai * HALF + m * 16) * 1024 + col0;
#pragma unroll
                for (int bj = 0; bj < 2; ++bj) { const f32x4 v0 = (acc[ai][bj][m][0] + bv[bj][0]) * gv, v1 = (acc[ai][bj][m][1] + bv[bj][1]) * gv;
                    u32x4 w; w.x = cvt_pk_bf16(v0[0], v0[1]); w.y = cvt_pk_bf16(v0[2], v0[3]); w.z = cvt_pk_bf16(v1[0], v1[1]); w.w = cvt_pk_bf16(v1[2], v1[3]);
                    *(u32x4*)(rowp + bj * HALF) = w; }
            }
    }
};
struct EpiInproj {
    static constexpr bool PERM = true;
    bf16_t* P; float* gates; float* stat; bf16_t* Kb; const float* cs; const float* sn;
    __device__ __forceinline__ void operator()(const f32x4 (&acc)[2][2][4][2], const Unit& u, int wr, int wc, int fr, int fq) const {
        const int row0 = u.row0 + wr * 64 + fr, colb = u.pn * BM + wc * 32 + 8 * fq;
#pragma unroll
        for (int ai = 0; ai < 2; ++ai)
#pragma unroll
            for (int m = 0; m < 4; ++m) { const int row = row0 + ai * HALF + m * 16;
#pragma unroll
                for (int bj = 0; bj < 2; ++bj) { const f32x4 v0 = acc[ai][bj][m][0], v1 = acc[ai][bj][m][1];
                    u32x4 w; w.x = cvt_pk_bf16(v0[0], v0[1]); w.y = cvt_pk_bf16(v0[2], v0[3]); w.z = cvt_pk_bf16(v1[0], v1[1]); w.w = cvt_pk_bf16(v1[2], v1[3]);
                    *(u32x4*)(P + (size_t)row * 2304 + colb + bj * HALF) = w;
                    if (u.pn <= 2) { float sq = (v0[0] * v0[0] + v0[1] * v0[1]) + (v0[2] * v0[2] + v0[3] * v0[3]) + (v1[0] * v1[0] + v1[1] * v1[1]) + (v1[2] * v1[2] + v1[3] * v1[3]);
                        sq += __shfl_xor(sq, 16); sq += __shfl_xor(sq, 32);
                        if (fq == 0) stat[(size_t)row * 24 + (u.pn * 2 + bj) * 4 + wc] = sq; }
                    if (u.pn == 8 && bj == 1 && wc == 1 && fq < 2) { *(f32x4*)(gates + (size_t)row * 16 + fq * 8) = v0; *(f32x4*)(gates + (size_t)row * 16 + fq * 8 + 4) = v1; }
                    if (u.pn == 2 && bj == 1 && wc == 0) {
                        f32x4 r0 = v0, r1 = v1;
                        f32x4 o0, o1;
#pragma unroll
                        for (int j = 0; j < 4; ++j) { o0[j] = __shfl_xor(v0[j], 32); o1[j] = __shfl_xor(v1[j], 32); }
                        int krow;
                        if (row < 16384) { const int pos = row & 4095; const int jb = 8 * (fq & 1);
                            const f32x4 c0 = *(const f32x4*)(cs + pos * 16 + jb), c1 = *(const f32x4*)(cs + pos * 16 + jb + 4), s0 = *(const f32x4*)(sn + pos * 16 + jb), s1 = *(const f32x4*)(sn + pos * 16 + jb + 4);
                            if (fq < 2) { r0 = v0 * c0 - o0 * s0; r1 = v1 * c1 - o1 * s1; } else { r0 = o0 * s0 + v0 * c0; r1 = o1 * s1 + v1 * c1; }
                            krow = (row >> 12) * 4352 + 256 + pos; }
                        else krow = ((row - 16384) >> 8) * 4352 + ((row - 16384) & 255);
                        u32x4 kw; kw.x = cvt_pk_bf16(r0[0], r0[1]); kw.y = cvt_pk_bf16(r0[2], r0[3]); kw.z = cvt_pk_bf16(r1[0], r1[1]); kw.w = cvt_pk_bf16(r1[2], r1[3]);
#pragma unroll
                        for (int hh = 0; hh < 8; ++hh) *(u32x4*)(Kb + (size_t)krow * 768 + hh * 96 + 64 + 8 * fq) = kw;
                    }
                } }
    }
};
struct EpiF32RowScale {
    static constexpr bool PERM = false;
    float* C; int ldc; const float* rs;
    __device__ __forceinline__ void operator()(const f32x4 (&acc)[2][2][4][2], const Unit& u, int wr, int wc, int fr, int fq) const {
        const int row0 = u.row0 + wr * 64 + fr, col0 = u.pn * BM + wc * 32 + 4 * fq;
#pragma unroll
        for (int ai = 0; ai < 2; ++ai)
#pragma unroll
            for (int m = 0; m < 4; ++m) { const int row = row0 + ai * HALF + m * 16; const float sc = rs[row]; float* rowp = C + (size_t)row * ldc + col0;
#pragma unroll
                for (int bj = 0; bj < 2; ++bj)
#pragma unroll
                    for (int n = 0; n < 2; ++n) *(f32x4*)(rowp + bj * HALF + n * 16) = acc[ai][bj][m][n] * sc; }
    }
};
struct EpiResid {
    static constexpr bool PERM = true;
    bf16_t* C; const float* X; const float* mod; float* stat2;
    __device__ __forceinline__ void operator()(const f32x4 (&acc)[2][2][4][2], const Unit& u, int wr, int wc, int fr, int fq) const {
        const int row0 = u.row0 + wr * 64 + fr, col0 = u.pn * BM + wc * 32 + 8 * fq;
        const float* g1 = mod + (size_t)(u.row0 / 4096) * 6144 + 2048 + col0;
        f32x4 gv[2][2];
#pragma unroll
        for (int bj = 0; bj < 2; ++bj)
#pragma unroll
            for (int n = 0; n < 2; ++n) gv[bj][n] = *(const f32x4*)(g1 + bj * HALF + 4 * n);
#pragma unroll
        for (int ai = 0; ai < 2; ++ai)
#pragma unroll
            for (int m = 0; m < 4; ++m) { const size_t off = (size_t)(row0 + ai * HALF + m * 16) * 1024 + col0;
#pragma unroll
                for (int bj = 0; bj < 2; ++bj) {
                    const f32x4 x0 = *(const f32x4*)(X + off + bj * HALF), x1 = *(const f32x4*)(X + off + bj * HALF + 4);
                    const f32x4 o0 = x0 + gv[bj][0] * acc[ai][bj][m][0], o1 = x1 + gv[bj][1] * acc[ai][bj][m][1];
                    u32x4 w; w.x = cvt_pk_bf16(o0[0], o0[1]); w.y = cvt_pk_bf16(o0[2], o0[3]); w.z = cvt_pk_bf16(o1[0], o1[1]); w.w = cvt_pk_bf16(o1[2], o1[3]);
                    *(u32x4*)(C + off + bj * HALF) = w;
                    float sq = ((o0[0] * o0[0] + o0[1] * o0[1]) + (o0[2] * o0[2] + o0[3] * o0[3])) + ((o1[0] * o1[0] + o1[1] * o1[1]) + (o1[2] * o1[2] + o1[3] * o1[3]));
                    sq += __shfl_xor(sq, 16); sq += __shfl_xor(sq, 32);
                    if (fq == 0) stat2[(size_t)(row0 + ai * HALF + m * 16) * 32 + (u.pn * 2 + bj) * 4 + wc] = sq; }
                if (m & 1) asm volatile("" ::: "memory"); }
    }
};
struct EpiQ {
    static constexpr bool PERM = false;
    bf16_t* Q; const float* stat; const float* cs; const float* sn;
    __device__ __forceinline__ void operator()(const f32x4 (&acc)[2][2][4][2], const Unit& u, int wr, int wc, int fr, int fq) const {
        const int row0 = u.row0 + wr * 64 + fr;
#pragma unroll
        for (int ai = 0; ai < 2; ++ai)
#pragma unroll
            for (int m = 0; m < 4; ++m) { const int row = row0 + ai * HALF + m * 16; const int pos = row & 4095;
                float sc; { const f32x4* sp = (const f32x4*)(stat + (size_t)row * 24); const f32x4 a0 = sp[0], a1 = sp[1], a2 = sp[2];
                    sc = rsqrtf((((a0[0] + a0[1]) + (a0[2] + a0[3])) + ((a1[0] + a1[1]) + (a1[2] + a1[3])) + ((a2[0] + a2[1]) + (a2[2] + a2[3]))) * (1.f / 384.f) + 1e-6f) * 0.14724445f; }
                const f32x4 cv = *(const f32x4*)(cs + pos * 16 + 4 * fq), sv = *(const f32x4*)(sn + pos * 16 + 4 * fq);
#pragma unroll
                for (int bj = 0; bj < 2; ++bj) { const int c32 = u.pn * BM + bj * HALF + wc * 32; const bool rope = ((c32 % 96) == 64);
                    f32x4 v0 = acc[ai][bj][m][0], v1 = acc[ai][bj][m][1];
                    if (rope) { const f32x4 a = v0 * cv - v1 * sv, b = v0 * sv + v1 * cv; v0 = a; v1 = b; }
                    v0 = v0 * sc; v1 = v1 * sc;
                    u32x2 w0, w1; w0.x = cvt_pk_bf16(v0[0], v0[1]); w0.y = cvt_pk_bf16(v0[2], v0[3]); w1.x = cvt_pk_bf16(v1[0], v1[1]); w1.y = cvt_pk_bf16(v1[2], v1[3]);
                    bf16_t* dst = Q + (size_t)row * 768 + c32 + 4 * fq;
                    *(u32x2*)dst = w0; *(u32x2*)(dst + 16) = w1; }
                asm volatile("" ::: "memory"); }
    }
};
struct EpiKV {
    static constexpr bool PERM = true;
    bf16_t* K; bf16_t* V; const float* stat;
    __device__ __forceinline__ void operator()(const f32x4 (&acc)[2][2][4][2], const Unit& u, int wr, int wc, int fr, int fq) const {
        const int row0 = u.row0 + wr * 64 + fr;
#pragma unroll
        for (int ai = 0; ai < 2; ++ai)
#pragma unroll
            for (int m = 0; m < 4; ++m) { const int row = row0 + ai * HALF + m * 16;
                float sc; { const f32x4* sp = (const f32x4*)(stat + (size_t)row * 24); const f32x4 a3 = sp[3], a4 = sp[4];
                    sc = rsqrtf((((a3[0] + a3[1]) + (a3[2] + a3[3])) + ((a4[0] + a4[1]) + (a4[2] + a4[3]))) * (1.f / 256.f) + 1e-6f); }
                const int krow = (row < 16384) ? ((row >> 12) * 4352 + 256 + (row & 4095)) : (((row - 16384) >> 8) * 4352 + ((row - 16384) & 255));
#pragma unroll
                for (int bj = 0; bj < 2; ++bj) { const int head = 2 * u.pn + bj; const f32x4 v0 = acc[ai][bj][m][0] * sc, v1 = acc[ai][bj][m][1] * sc;
                    u32x4 w; w.x = cvt_pk_bf16(v0[0], v0[1]); w.y = cvt_pk_bf16(v0[2], v0[3]); w.z = cvt_pk_bf16(v1[0], v1[1]); w.w = cvt_pk_bf16(v1[2], v1[3]);
                    if (wc < 2) *(u32x4*)(K + (size_t)krow * 768 + head * 96 + wc * 32 + 8 * fq) = w;
                    else *(u32x4*)(V + (size_t)krow * 512 + head * 64 + (wc - 2) * 32 + 8 * fq) = w; }
                asm volatile("" ::: "memory"); }
    }
};
}

template <class RowMap>
__device__ __forceinline__ void transpose_item(const float* W, int K, int N, int nblk, unsigned short* WT, const RowMap& rowmap, LAS float* scr, int item, int lane, const float* kscale = nullptr) {
    const int kb = item / nblk, nb = item % nblk, k0 = 64 * kb, n0 = 32 * nb;
    const int ncol = n0 + (lane & 31);
    float tv[32];
#pragma unroll
    for (int i = 0; i < 32; ++i) { const int kk = 2 * i + (lane >> 5); tv[i] = (ncol < N) ? __builtin_nontemporal_load(W + (size_t)(k0 + kk) * N + ncol) : 0.f; }
    if (kscale) {
#pragma unroll
        for (int i = 0; i < 32; ++i) tv[i] *= kscale[k0 + 2 * i + (lane >> 5)]; }
#pragma unroll
    for (int i = 0; i < 32; ++i) scr[(2 * i + (lane >> 5)) * 33 + (lane & 31)] = tv[i];
    asm volatile("s_waitcnt lgkmcnt(0)" ::: "memory");
    const int c = lane & 7;
    const int r0 = rowmap(n0);
#pragma unroll
    for (int j = 0; j < 4; ++j) { const int n = (lane >> 3) + 8 * j; const LAS float* sp = scr + (8 * c) * 33 + n;
        pg8::u32x4 o; o.x = pg8::cvt_pk_bf16(sp[0 * 33], sp[1 * 33]); o.y = pg8::cvt_pk_bf16(sp[2 * 33], sp[3 * 33]); o.z = pg8::cvt_pk_bf16(sp[4 * 33], sp[5 * 33]); o.w = pg8::cvt_pk_bf16(sp[6 * 33], sp[7 * 33]);
        __builtin_nontemporal_store(o, (pg8::u32x4*)(WT + (size_t)(r0 + n) * K + k0 + 8 * c)); }
    asm volatile("s_waitcnt lgkmcnt(0)" ::: "memory");
}


namespace att {
using bf16x8 = __attribute__((ext_vector_type(8))) short;
using s16x4  = __attribute__((ext_vector_type(4))) short;
using f32x16 = __attribute__((ext_vector_type(16))) float;
using u32x4  = __attribute__((ext_vector_type(4))) unsigned;
constexpr int NW = 8, QBLK = 32, KVBLK = 64;
constexpr float SCALE = 0.10206207261596577f;
constexpr float THR = 8.f;
constexpr int LDQ = 768, LDK = 768, LDV = 512, LDO = 1024;
constexpr int SHM_V = KVBLK * 64 * 2, SHM_K = KVBLK * 256;
constexpr int SHM_ATTN = 3 * SHM_V + 3 * SHM_K + NW * 64 * 4;
#define KSWZ(row, colB) ((row) * 256 + ((colB) ^ (((row) & 7) << 4)))
#define SBAR() __builtin_amdgcn_sched_barrier(0)
__device__ __forceinline__ int crow(int r, int hi) { return (r & 3) + 8 * (r >> 2) + 4 * hi; }
__device__ __forceinline__ unsigned cvtpk(float lo, float hi) { unsigned r; asm volatile("v_cvt_pk_bf16_f32 %0, %1, %2" : "=v"(r) : "v"(lo), "v"(hi)); return r; }

constexpr float THR2 = THR * 1.4426950408889634f;
__device__ __forceinline__ void partialSM(f32x16& p0, f32x16& p1, float& m_run, float& alpha) {
  float pmax = p0[0]; for (int r = 1; r < 16; ++r) pmax = fmaxf(pmax, p0[r]); for (int r = 0; r < 16; ++r) pmax = fmaxf(pmax, p1[r]);
  { auto rr = __builtin_amdgcn_permlane32_swap(__float_as_uint(pmax), __float_as_uint(pmax), false, false);
    pmax = fmaxf(__uint_as_float(rr[0]), __uint_as_float(rr[1])); }
  if (__builtin_expect(__all(fabsf(pmax) <= THR2), 1)) { alpha = 1.f; }
  else { m_run += pmax; alpha = __builtin_amdgcn_exp2f(-pmax);
    for (int r = 0; r < 16; ++r) p0[r] -= pmax; for (int r = 0; r < 16; ++r) p1[r] -= pmax; }
  for (int r = 0; r < 16; ++r) p0[r] = __builtin_amdgcn_exp2f(p0[r]);
}
__device__ __forceinline__ void finishSM(f32x16& p0, f32x16& p1, float alpha, float& l_reg, bf16x8& pa0, bf16x8& pa1, bf16x8& pa2, bf16x8& pa3) {
  for (int r = 0; r < 16; ++r) p1[r] = __builtin_amdgcn_exp2f(p1[r]);
  float ps = 0; for (int r = 0; r < 16; ++r) ps += p0[r]; for (int r = 0; r < 16; ++r) ps += p1[r];
  { auto rr = __builtin_amdgcn_permlane32_swap(__float_as_uint(ps), __float_as_uint(ps), false, false);
    ps = __uint_as_float(rr[0]) + __uint_as_float(rr[1]); }
  l_reg = l_reg * alpha + ps;
#define PK4(P, BASE, OUT) do { u32x4 w = {cvtpk(P[BASE + 0], P[BASE + 1]), cvtpk(P[BASE + 2], P[BASE + 3]), cvtpk(P[BASE + 4], P[BASE + 5]), cvtpk(P[BASE + 6], P[BASE + 7])}; OUT = *reinterpret_cast<bf16x8*>(&w); } while (0)
  PK4(p0, 0, pa0); PK4(p0, 8, pa1); PK4(p1, 0, pa2); PK4(p1, 8, pa3);
#undef PK4
}
__device__ __forceinline__ void qkt(f32x16& p0, f32x16& p1, const char* Ks, const bf16x8* qr, int r32, int hi, float m_run) {
#pragma unroll
  for (int r = 0; r < 16; ++r) { p0[r] = -m_run; p1[r] = -m_run; }
#pragma unroll
  for (int d0 = 0; d0 < 6; ++d0) { int cb = (d0 * 16 + hi * 8) * 2;
    bf16x8 b0 = *reinterpret_cast<const bf16x8*>(Ks + KSWZ(r32, cb));
    bf16x8 b1 = *reinterpret_cast<const bf16x8*>(Ks + KSWZ(32 + r32, cb));
    p0 = __builtin_amdgcn_mfma_f32_32x32x16_bf16(b0, qr[d0], p0, 0, 0, 0);
    p1 = __builtin_amdgcn_mfma_f32_32x32x16_bf16(b1, qr[d0], p1, 0, 0, 0); }
}
__device__ __forceinline__ int v_st(int k, int c) { const int kk = k; return ((kk >> 3) * 2 + (c >> 5)) * 512 + ((kk & 7) * 32 + (c & 31)) * 2; }
__device__ __forceinline__ int v_rd_base(int lane) { return ((lane & 3) << 3) | (((lane >> 2) & 3) << 6) | (((lane >> 4) & 1) << 5) | (((lane >> 5) & 1) << 8); }
constexpr int v_rd_off(int d0, int ks, int half) { return d0 * 512 + ks * 2048 + half * 1024; }
template <int OFF> __device__ __forceinline__ s16x4 tr_read(int vb) {
  s16x4 r; asm volatile("ds_read_b64_tr_b16 %0, %1 offset:%2" : "=&v"(r) : "v"(vb), "i"(OFF) : "memory"); return r;
}
template <int D0> __device__ __forceinline__ void pv_one(f32x16& od, int vb, bf16x8 pa0, bf16x8 pa1, bf16x8 pa2, bf16x8 pa3) {
  const s16x4 l0 = tr_read<v_rd_off(D0, 0, 0)>(vb), h0 = tr_read<v_rd_off(D0, 0, 1)>(vb), l1 = tr_read<v_rd_off(D0, 1, 0)>(vb), h1 = tr_read<v_rd_off(D0, 1, 1)>(vb);
  const s16x4 l2 = tr_read<v_rd_off(D0, 2, 0)>(vb), h2 = tr_read<v_rd_off(D0, 2, 1)>(vb), l3 = tr_read<v_rd_off(D0, 3, 0)>(vb), h3 = tr_read<v_rd_off(D0, 3, 1)>(vb);
  asm volatile("s_waitcnt lgkmcnt(0)" ::: "memory"); SBAR();
#define PK(L, H) (bf16x8){L[0], L[1], L[2], L[3], H[0], H[1], H[2], H[3]}
  od = __builtin_amdgcn_mfma_f32_32x32x16_bf16(pa0, PK(l0, h0), od, 0, 0, 0);
  od = __builtin_amdgcn_mfma_f32_32x32x16_bf16(pa1, PK(l1, h1), od, 0, 0, 0);
  od = __builtin_amdgcn_mfma_f32_32x32x16_bf16(pa2, PK(l2, h2), od, 0, 0, 0);
  od = __builtin_amdgcn_mfma_f32_32x32x16_bf16(pa3, PK(l3, h3), od, 0, 0, 0);
#undef PK
}
__device__ __forceinline__ void pv_d0(f32x16* o, int vb, bf16x8 pa0, bf16x8 pa1, bf16x8 pa2, bf16x8 pa3) {
  pv_one<0>(o[0], vb, pa0, pa1, pa2, pa3); pv_one<1>(o[1], vb, pa0, pa1, pa2, pa3);
}
__device__ __forceinline__ void attn_body(const unsigned short* __restrict__ Qb, const unsigned short* __restrict__ Kh, const unsigned short* __restrict__ Vh,
                                          unsigned short* __restrict__ Ob, int seq, char* lds) {
  const int tid = threadIdx.x, wid = tid >> 6, lane = tid & 63, r32 = lane & 31, hi = lane >> 5;
  char* V_lds = lds; char* K_lds = lds + 3 * SHM_V;
  float* ws = (float*)(lds + 3 * SHM_V + 3 * SHM_K) + wid * 64; float* li_l = ws; float* al_l = ws + 32;
  float m_run = 0.f, l_reg = 0; f32x16 o[2] = {}; bf16x8 qr[6];
  const unsigned short* Qw = Qb + (long)(wid * QBLK + r32) * LDQ + hi * 8;
#pragma unroll
  for (int d0 = 0; d0 < 6; ++d0) qr[d0] = *reinterpret_cast<const bf16x8*>(Qw + d0 * 16);
  const int vr = tid >> 3, vc = (tid & 7) * 8, vst = v_st(vr, vc);
  const int k0r = tid / 12, k0c = tid % 12, id1 = 512 + (tid & 255), k1r = id1 / 12, k1c = id1 % 12;
  const int kst0 = KSWZ(k0r, k0c * 16), kst1 = KSWZ(k1r, k1c * 16);
  const long vg = (long)vr * LDV + vc, kg0 = (long)k0r * LDK + k0c * 8, kg1 = (long)k1r * LDK + k1c * 8;
  const int vb0 = (int)(uintptr_t)V_lds + v_rd_base(lane);
  struct { bf16x8 vs, ks0, ks1; } sr_[2];
#define SLOAD(i, kk0) do { sr_[i].vs = *reinterpret_cast<const bf16x8*>(Vh + (long)(kk0) * LDV + vg); \
    sr_[i].ks0 = *reinterpret_cast<const bf16x8*>(Kh + (long)(kk0) * LDK + kg0); sr_[i].ks1 = *reinterpret_cast<const bf16x8*>(Kh + (long)(kk0) * LDK + kg1); } while (0)
#define SWRITE(b, i) do { *(bf16x8*)(V_lds + (b) * SHM_V + vst) = sr_[i].vs; \
    *(bf16x8*)(K_lds + (b) * SHM_K + kst0) = sr_[i].ks0; *(bf16x8*)(K_lds + (b) * SHM_K + kst1) = sr_[i].ks1; } while (0)
#define SWAIT() asm volatile("s_waitcnt vmcnt(3)" ::: "memory")
#define RESC(a) do { if (__any((a) < 1.f)) { if (hi == 0) al_l[r32] = (a); asm volatile("s_waitcnt lgkmcnt(0)" ::: "memory"); \
    for (int d = 0; d < 2; ++d) for (int r = 0; r < 16; ++r) o[d][r] *= al_l[crow(r, hi)]; } } while (0)
  f32x16 pA0, pA1, pB0, pB1; float alA, alB; bf16x8 pa0, pa1, pa2, pa3; const int NT = seq / KVBLK;
  constexpr int SE = 0, SO = 1;
  SLOAD(SE, 0); asm volatile("s_waitcnt vmcnt(0)" ::: "memory"); SWRITE(0, SE); __syncthreads();
  qkt(pA0, pA1, K_lds, qr, r32, hi, m_run); partialSM(pA0, pA1, m_run, alA);
  SLOAD(SO, KVBLK); if (2 < NT) SLOAD(SE, 2 * KVBLK);
  SWAIT(); SWRITE(1, SO); __syncthreads();
  int b0 = 0, b1 = 1, b2 = 2;
  for (int j = 1; j + 1 < NT; j += 2) {
    SBAR(); qkt(pB0, pB1, K_lds + b1 * SHM_K, qr, r32, hi, m_run);
    finishSM(pA0, pA1, alA, l_reg, pa0, pa1, pa2, pa3); SBAR();
    SLOAD(SO, (j + 2) * KVBLK); SBAR();
    pv_d0(o, vb0 + b0 * SHM_V, pa0, pa1, pa2, pa3); partialSM(pB0, pB1, m_run, alB);
    SWAIT(); SWRITE(b2, SE);
    RESC(alB); __syncthreads();
    SBAR(); qkt(pA0, pA1, K_lds + b2 * SHM_K, qr, r32, hi, m_run);
    finishSM(pB0, pB1, alB, l_reg, pa0, pa1, pa2, pa3); SBAR();
    if (j + 3 < NT) SLOAD(SE, (j + 3) * KVBLK); SBAR();
    pv_d0(o, vb0 + b1 * SHM_V, pa0, pa1, pa2, pa3); partialSM(pA0, pA1, m_run, alA);
    SWAIT(); SWRITE(b0, SO);
    RESC(alA); __syncthreads();
    { const int t0 = b0; b0 = b2; b2 = b1; b1 = t0; }
  }
  SBAR(); qkt(pB0, pB1, K_lds + b1 * SHM_K, qr, r32, hi, m_run);
  finishSM(pA0, pA1, alA, l_reg, pa0, pa1, pa2, pa3); SBAR();
  pv_d0(o, vb0 + b0 * SHM_V, pa0, pa1, pa2, pa3); partialSM(pB0, pB1, m_run, alB);
  RESC(alB);
  finishSM(pB0, pB1, alB, l_reg, pa0, pa1, pa2, pa3); SBAR();
  pv_d0(o, vb0 + b1 * SHM_V, pa0, pa1, pa2, pa3);
  if (hi == 0) li_l[r32] = l_reg; asm volatile("s_waitcnt lgkmcnt(0)" ::: "memory");
  float rli[16];
#pragma unroll
  for (int r = 0; r < 16; ++r) rli[r] = __builtin_amdgcn_rcpf(li_l[crow(r, hi)]);
  unsigned short* Ow = Ob + (long)(wid * QBLK) * LDO;
#pragma unroll
  for (int r = 0; r < 16; ++r) { int orow = crow(r, hi);
#pragma unroll
    for (int d0 = 0; d0 < 2; ++d0) Ow[(long)orow * LDO + d0 * 32 + r32] = (unsigned short)(cvtpk(o[d0][r] * rli[r], 0.f) & 0xffffu); }
  __syncthreads();
#undef SLOAD
#undef SWRITE
#undef SWAIT
#undef RESC
}
#undef KSWZ
#undef SBAR
}


namespace ml {
using bf16x8 = __attribute__((ext_vector_type(8))) short;
using s16x4  = __attribute__((ext_vector_type(4))) short;
using f32x16 = __attribute__((ext_vector_type(16))) float;
using f32x4  = __attribute__((ext_vector_type(4))) float;
using u32x4  = __attribute__((ext_vector_type(4))) unsigned;
constexpr float L2E = 1.4426950408889634f;
constexpr int NXC = 34;
__device__ __forceinline__ int crow(int r, int hi) { return (r & 3) + 8 * (r >> 2) + 4 * hi; }
__device__ __forceinline__ unsigned cvtpk(float lo, float hi) { unsigned r; asm volatile("v_cvt_pk_bf16_f32 %0, %1, %2" : "=v"(r) : "v"(lo), "v"(hi)); return r; }
template <int NC> __device__ __forceinline__ int t_st(int k, int c) { const int kk = k; return ((kk >> 3) * NC + (c >> 5)) * 512 + ((kk & 7) * 32 + (c & 31)) * 2; }
__device__ __forceinline__ int t_rd_base(int lane) { return ((lane & 3) << 3) | (((lane >> 2) & 3) << 6) | (((lane >> 4) & 1) << 5) | (((lane >> 5) & 1) << 8); }
template <int NC> constexpr int t_rd_off(int d0, int ks, int half) { return d0 * 512 + ks * (NC * 1024) + half * (NC * 512); }
template <int OFF> __device__ __forceinline__ s16x4 tr_read(int vb) { s16x4 r; asm volatile("ds_read_b64_tr_b16 %0, %1 offset:%2" : "=&v"(r) : "v"(vb), "i"(OFF) : "memory"); return r; }
#define ML_PK(L, H) (bf16x8){L[0], L[1], L[2], L[3], H[0], H[1], H[2], H[3]}
#define ML_KS(row, colB) ((row) * 128 + ((colB) ^ (((row) & 7) << 4)))
__device__ __forceinline__ int chunk_row(int b, int X, int i) { return X < 2 ? (16384 + b * 256 + X * 128 + i) : (b * 4096 + (X - 2) * 128 + i); }
__device__ __forceinline__ float lsig(float x) { return fminf(x, 0.f) - __logf(1.f + __expf(-fabsf(x))); }

__device__ __forceinline__ void gate_prep(const float* GATES, const float* bg, int b, int h, int X, LAS float* cum, LAS float* av, LAS float* pm, LAS float* wsr, LAS float* tot, int wave, int lane) {
    if (wave < 2) {
        const int dir = wave;
        const int e0 = dir ? (127 - 2 * lane) : (2 * lane), e1 = dir ? (126 - 2 * lane) : (2 * lane + 1);
        const int r0 = chunk_row(b, X, e0), r1 = chunk_row(b, X, e1);
        const float bi = bg[(2 * dir) * 4 + h], bf = bg[(2 * dir + 1) * 4 + h];
        const float li0 = GATES[(size_t)r0 * 16 + (2 * dir) * 4 + h] + bi, li1 = GATES[(size_t)r1 * 16 + (2 * dir) * 4 + h] + bi;
        const float x0 = lsig(GATES[(size_t)r0 * 16 + (2 * dir + 1) * 4 + h] + bf), x1 = lsig(GATES[(size_t)r1 * 16 + (2 * dir + 1) * 4 + h] + bf);
        float sc = x0 + x1;
#pragma unroll
        for (int o = 1; o < 64; o <<= 1) { const float y = __shfl_up(sc, o); if (lane >= o) sc += y; }
        const float c1 = sc, c0 = sc - x1; const float total = __shfl(sc, 63);
        const float a0 = li0 - c0, a1 = li1 - c1;
        float mx = fmaxf(a0, a1);
#pragma unroll
        for (int o = 1; o < 64; o <<= 1) { const float y = __shfl_up(mx, o); if (lane >= o) mx = fmaxf(mx, y); }
        float prev = __shfl_up(mx, 1); if (lane == 0) prev = -3.0e38f;
        cum[dir * 128 + e0] = c0; cum[dir * 128 + e1] = c1; av[dir * 128 + e0] = a0; av[dir * 128 + e1] = a1;
        pm[dir * 128 + e0] = fmaxf(prev, a0); pm[dir * 128 + e1] = mx;
        wsr[dir * 128 + e0] = total - c0 + li0; wsr[dir * 128 + e1] = total - c1 + li1;
        if (lane == 0) tot[dir] = total;
    }
}

__device__ __forceinline__ void stepA_unit(const unsigned short* P16, const float* GATES, const float* bg, int bh, int X, float* CLOC, float* NLOC, float* MLOC, float* TOT, char* lds) {
    const int tid = threadIdx.x, wave = __builtin_amdgcn_readfirstlane(tid >> 6), lane = tid & 63, r32 = lane & 31, hi = lane >> 5;
    const int b = bh >> 2, h = bh & 3;
    LAS float* fa = (LAS float*)(lds + 65536);
    LAS float* cum = fa, *av = fa + 256, *pm = fa + 512, *wsr = fa + 768, *tot = fa + 1024, *wl = fa + 1040, *npart = fa + 1312;
    bf16x8 stV[4]; u32x4 stK[2];
#pragma unroll
    for (int j = 0; j < 4; ++j) { const int id = tid + 512 * j, row = id >> 4, ch = id & 15; stV[j] = *reinterpret_cast<const bf16x8*>(P16 + (size_t)chunk_row(b, X, row) * 2304 + 1184 + h * 128 + ch * 8); }
#pragma unroll
    for (int j = 0; j < 2; ++j) { const int id = tid + 512 * j, row = id >> 3, ch = id & 7; stK[j] = *reinterpret_cast<const u32x4*>(P16 + (size_t)chunk_row(b, X, row) * 2304 + 928 + h * 64 + ch * 8); }
    gate_prep(GATES, bg, b, h, X, cum, av, pm, wsr, tot, wave, lane);
#pragma unroll
    for (int j = 0; j < 4; ++j) { const int id = tid + 512 * j, row = id >> 4, ch = id & 15; *(bf16x8*)(lds + t_st<4>(row, ch * 8)) = stV[j]; }
    __syncthreads();
    if (wave < 2) {
        const int dir = wave; const float w0 = wsr[dir * 128 + lane], w1 = wsr[dir * 128 + 64 + lane];
        float mx = fmaxf(w0, w1);
#pragma unroll
        for (int o = 1; o < 64; o <<= 1) mx = fmaxf(mx, __shfl_xor(mx, o));
        wl[dir * 128 + lane] = __expf(w0 - mx); wl[dir * 128 + 64 + lane] = __expf(w1 - mx);
        if (lane == 0) { MLOC[(bh * NXC + X) * 2 + dir] = mx; TOT[(bh * NXC + X) * 2 + dir] = tot[dir]; }
    }
    __syncthreads();
#pragma unroll
    for (int j = 0; j < 2; ++j) { const int id = tid + 512 * j, row = id >> 3, ch = id & 7;
        const u32x4 kv = stK[j];
        const float wf = wl[row], wb = wl[128 + row];
        u32x4 of, ob;
#pragma unroll
        for (int q = 0; q < 4; ++q) { const float lo = __uint_as_float(kv[q] << 16), hi2 = __uint_as_float(kv[q] & 0xffff0000u); of[q] = cvtpk(lo * wf, hi2 * wf); ob[q] = cvtpk(lo * wb, hi2 * wb); }
        *(u32x4*)(lds + 32768 + t_st<2>(row, ch * 8)) = of; *(u32x4*)(lds + 49152 + t_st<2>(row, ch * 8)) = ob; }
    __syncthreads();
    {
        const int dir = wave >> 2, mb = wave & 3;
        const int vb = (int)(uintptr_t)lds + t_rd_base(lane) + mb * 512;
        const int kb = (int)(uintptr_t)lds + 32768 + dir * 16384 + t_rd_base(lane);
        f32x16 acc0 = {}, acc1 = {};
#define ML_A_STEP(KS) do { \
        const s16x4 vl = tr_read<t_rd_off<4>(0, KS, 0)>(vb), vh = tr_read<t_rd_off<4>(0, KS, 1)>(vb); \
        const s16x4 k0l = tr_read<t_rd_off<2>(0, KS, 0)>(kb), k0h = tr_read<t_rd_off<2>(0, KS, 1)>(kb), k1l = tr_read<t_rd_off<2>(1, KS, 0)>(kb), k1h = tr_read<t_rd_off<2>(1, KS, 1)>(kb); \
        asm volatile("s_waitcnt lgkmcnt(0)" ::: "memory"); __builtin_amdgcn_sched_barrier(0); \
        acc0 = __builtin_amdgcn_mfma_f32_32x32x16_bf16(ML_PK(vl, vh), ML_PK(k0l, k0h), acc0, 0, 0, 0); \
        acc1 = __builtin_amdgcn_mfma_f32_32x32x16_bf16(ML_PK(vl, vh), ML_PK(k1l, k1h), acc1, 0, 0, 0); } while (0)
        ML_A_STEP(0); ML_A_STEP(1); ML_A_STEP(2); ML_A_STEP(3); ML_A_STEP(4); ML_A_STEP(5); ML_A_STEP(6); ML_A_STEP(7);
#undef ML_A_STEP
        float* dst = CLOC + ((size_t)(bh * NXC + X) * 2 + dir) * 8192;
#pragma unroll
        for (int r = 0; r < 16; ++r) { const int dv = 32 * mb + crow(r, hi); dst[dv * 64 + r32] = acc0[r]; dst[dv * 64 + 32 + r32] = acc1[r]; }
    }
    {
        const int dir = tid >> 8, part = (tid >> 6) & 3, d = tid & 63; float a = 0.f;
        const char* img = lds + 32768 + dir * 16384;
#pragma unroll 8
        for (int i = 0; i < 32; ++i) { const int row = part * 32 + i; a += bf2f(*(const unsigned short*)(img + t_st<2>(row, d))); }
        npart[(dir * 4 + part) * 64 + d] = a;
    }
    __syncthreads();
    if (tid < 128) { const int dir = tid >> 6, d = tid & 63; NLOC[((size_t)(bh * NXC + X) * 2 + dir) * 64 + d] = (npart[(dir * 4 + 0) * 64 + d] + npart[(dir * 4 + 1) * 64 + d]) + (npart[(dir * 4 + 2) * 64 + d] + npart[(dir * 4 + 3) * 64 + d]); }
    __syncthreads();
}

__device__ __forceinline__ int scanX(int dir, int j) { return dir ? (j == 0 ? 1 : (j == 1 ? 0 : 35 - j)) : j; }
__device__ __forceinline__ void stepB(const float* CLOC, const float* NLOC, const float* MLOC, const float* TOT, unsigned* CIN, float* NIN, float* MIN, int gtid, int gthreads) {
    for (int it = gtid; it < 32 * 4096 + 32 * 64; it += gthreads) {
        const bool isn = it >= 32 * 4096;
        const int sq = isn ? (it - 32 * 4096) >> 6 : it >> 12, e = isn ? (it - 32 * 4096) & 63 : it & 4095;
        const int bh = sq >> 1, dir = sq & 1;
        float2 v[NXC]; float tt[NXC], mm[NXC];
#pragma unroll
        for (int j = 0; j < NXC; ++j) { const int X = scanX(dir, j); const size_t li = (size_t)(bh * NXC + X) * 2 + dir;
            tt[j] = TOT[li]; mm[j] = MLOC[li];
            if (isn) { v[j].x = NLOC[li * 64 + e]; v[j].y = 0.f; } else v[j] = *(const float2*)(CLOC + li * 8192 + 2 * e); }
        float c0 = 0.f, c1 = 0.f, m = 0.f;
#pragma unroll
        for (int j = 0; j < NXC; ++j) {
            const int X = scanX(dir, j);
            if (X >= 2) {
                const size_t ci = (size_t)(bh * 32 + (X - 2)) * 2 + dir;
                if (isn) { NIN[ci * 64 + e] = c0; if (e == 0) MIN[ci] = m; }
                else CIN[ci * 4096 + e] = cvtpk(c0, c1);
            }
            const float mn = fmaxf(tt[j] + m, mm[j]), dec = __expf(tt[j] + m - mn), scl = __expf(mm[j] - mn);
            c0 = dec * c0 + scl * v[j].x; c1 = dec * c1 + scl * v[j].y;
            m = mn;
        }
    }
}

__device__ __forceinline__ void stepC_unit(const unsigned short* P16, const float* GATES, const float* bg, const unsigned short* CIN, const float* NIN, const float* MIN, const float* mng,
                                           unsigned short* MIX16, int bh, int c, char* lds) {
    const int tid = threadIdx.x, wave = __builtin_amdgcn_readfirstlane(tid >> 6), lane = tid & 63, r32 = lane & 31, hi = lane >> 5;
    const int b = bh >> 2, h = bh & 3, X = c + 2;
    LAS float* fa = (LAS float*)(lds + 98304);
    LAS float* cum = fa, *av = fa + 256, *pm = fa + 512, *wsr = fa + 768, *tot = fa + 1024, *scl = fa + 1040;
    LAS float* hs = (LAS float*)lds;
    const int dir = wave >> 2, tb = wave & 3;
    const int t = 32 * tb + r32;
    const size_t ci = (size_t)(bh * 32 + c) * 2 + dir;
    bf16x8 qr[4]; f32x4 nn[8];
    {
        const unsigned short* qp = P16 + (size_t)chunk_row(b, X, t) * 2304 + 672 + h * 64 + hi * 8;
        const float* np = NIN + ci * 64 + hi * 8;
#pragma unroll
        for (int ks = 0; ks < 4; ++ks) { qr[ks] = *reinterpret_cast<const bf16x8*>(qp + ks * 16); nn[2 * ks] = *(const f32x4*)(np + ks * 16); nn[2 * ks + 1] = *(const f32x4*)(np + ks * 16 + 4); }
    }
    const float min2 = MIN[ci] * L2E;
    bf16x8 stK[2], stV[4], stC[4];
#pragma unroll
    for (int j = 0; j < 2; ++j) { const int id = tid + 512 * j, row = id >> 3, ch = id & 7; stK[j] = *reinterpret_cast<const bf16x8*>(P16 + (size_t)chunk_row(b, X, row) * 2304 + 928 + h * 64 + ch * 8); }
#pragma unroll
    for (int j = 0; j < 4; ++j) { const int id = tid + 512 * j, row = id >> 4, ch = id & 15; stV[j] = *reinterpret_cast<const bf16x8*>(P16 + (size_t)chunk_row(b, X, row) * 2304 + 1184 + h * 128 + ch * 8); }
    gate_prep(GATES, bg, b, h, X, cum, av, pm, wsr, tot, wave, lane);
    asm volatile("" ::: "memory");
#pragma unroll
    for (int j = 0; j < 4; ++j) { const int id = tid + 512 * j, dd = id >> 10, row = (id >> 3) & 127, ch = id & 7;
        stC[j] = *reinterpret_cast<const bf16x8*>(CIN + ((size_t)(bh * 32 + c) * 2 + dd) * 8192 + row * 64 + ch * 8); }
#pragma unroll
    for (int j = 0; j < 2; ++j) { const int id = tid + 512 * j, row = id >> 3, ch = id & 7; *(bf16x8*)(lds + ML_KS(row, ch * 16)) = stK[j]; }
#pragma unroll
    for (int j = 0; j < 4; ++j) { const int id = tid + 512 * j, row = id >> 4, ch = id & 15; *(bf16x8*)(lds + 16384 + t_st<4>(row, ch * 8)) = stV[j]; }
#pragma unroll
    for (int j = 0; j < 4; ++j) { const int id = tid + 512 * j, dd = id >> 10, row = (id >> 3) & 127, ch = id & 7; *(bf16x8*)(lds + 65536 + dd * 16384 + ML_KS(row, ch * 16)) = stC[j]; }
    __syncthreads();
    const float el2 = fmaxf(min2, pm[dir * 128 + t] * L2E);
    const float wint = __builtin_amdgcn_exp2f(min2 - el2);
    float ndot = 0.f;
#pragma unroll
    for (int ks = 0; ks < 4; ++ks) { const u32x4 q4 = *reinterpret_cast<const u32x4*>(&qr[ks]); const f32x4 n0 = nn[2 * ks], n1 = nn[2 * ks + 1];
#pragma unroll
        for (int q = 0; q < 4; ++q) { const float lo = __uint_as_float(q4[q] << 16), hi2 = __uint_as_float(q4[q] & 0xffff0000u);
            const float nl = (q < 2) ? n0[2 * q] : n1[2 * q - 4], nh = (q < 2) ? n0[2 * q + 1] : n1[2 * q - 3];
            ndot = fmaf(lo, nl, ndot); ndot = fmaf(hi2, nh, ndot); } }
    f32x16 o[4] = {}; float den = 0.f;
    const int vb = (int)(uintptr_t)lds + 16384 + t_rd_base(lane);
    const char* Kl = lds;
#define ML_C_BLOCK(SB) do { if (dir ? (SB >= tb) : (SB <= tb)) { \
        f32x16 p = {}; \
        _Pragma("unroll") for (int ks = 0; ks < 4; ++ks) { const bf16x8 kf = *reinterpret_cast<const bf16x8*>(Kl + ML_KS(32 * SB + r32, (ks * 16 + hi * 8) * 2)); p = __builtin_amdgcn_mfma_f32_32x32x16_bf16(kf, qr[ks], p, 0, 0, 0); } \
        _Pragma("unroll") for (int g = 0; g < 4; ++g) { const f32x4 a4 = *(const LAS f32x4*)(av + dir * 128 + 32 * SB + 8 * g + 4 * hi); \
            _Pragma("unroll") for (int i = 0; i < 4; ++i) { const int sidx = 32 * SB + 8 * g + 4 * hi + i; const bool ok = dir ? (sidx >= t) : (sidx <= t); \
                const float f = __builtin_amdgcn_exp2f(a4[i] * L2E - el2) * 0.125f; p[4 * g + i] = ok ? p[4 * g + i] * f : 0.f; den += p[4 * g + i]; } } \
        bf16x8 pa0, pa1; \
        { u32x4 w = {cvtpk(p[0], p[1]), cvtpk(p[2], p[3]), cvtpk(p[4], p[5]), cvtpk(p[6], p[7])}; pa0 = *reinterpret_cast<bf16x8*>(&w); }        \
        { u32x4 w = {cvtpk(p[8], p[9]), cvtpk(p[10], p[11]), cvtpk(p[12], p[13]), cvtpk(p[14], p[15])}; pa1 = *reinterpret_cast<bf16x8*>(&w); } \
        ML_C_PV(0, SB, pa0, pa1); ML_C_PV(1, SB, pa0, pa1); ML_C_PV(2, SB, pa0, pa1); ML_C_PV(3, SB, pa0, pa1); } } while (0)
#define ML_C_PV(D0, SB, PA0, PA1) do { \
        const s16x4 l0 = tr_read<t_rd_off<4>(D0, 2 * SB, 0)>(vb), h0 = tr_read<t_rd_off<4>(D0, 2 * SB, 1)>(vb), l1 = tr_read<t_rd_off<4>(D0, 2 * SB + 1, 0)>(vb), h1 = tr_read<t_rd_off<4>(D0, 2 * SB + 1, 1)>(vb); \
        asm volatile("s_waitcnt lgkmcnt(0)" ::: "memory"); __builtin_amdgcn_sched_barrier(0); \
        o[D0] = __builtin_amdgcn_mfma_f32_32x32x16_bf16(PA0, ML_PK(l0, h0), o[D0], 0, 0, 0); \
        o[D0] = __builtin_amdgcn_mfma_f32_32x32x16_bf16(PA1, ML_PK(l1, h1), o[D0], 0, 0, 0); } while (0)
    ML_C_BLOCK(0); ML_C_BLOCK(1); ML_C_BLOCK(2); ML_C_BLOCK(3);
#undef ML_C_BLOCK
#undef ML_C_PV
    {
        bf16x8 qw[4];
#pragma unroll
        for (int ks = 0; ks < 4; ++ks) { const u32x4 q4 = *reinterpret_cast<const u32x4*>(&qr[ks]); u32x4 w4;
#pragma unroll
            for (int q = 0; q < 4; ++q) { const float lo = __uint_as_float(q4[q] << 16), hi2 = __uint_as_float(q4[q] & 0xffff0000u); w4[q] = cvtpk(lo * (0.125f * wint), hi2 * (0.125f * wint)); }
            qw[ks] = *reinterpret_cast<const bf16x8*>(&w4); }
        const char* Cl = lds + 65536 + dir * 16384;
#pragma unroll
        for (int d0 = 0; d0 < 4; ++d0)
#pragma unroll
            for (int ks = 0; ks < 4; ++ks) { const bf16x8 cf = *reinterpret_cast<const bf16x8*>(Cl + ML_KS(32 * d0 + r32, (ks * 16 + hi * 8) * 2)); o[d0] = __builtin_amdgcn_mfma_f32_32x32x16_bf16(qw[ks], cf, o[d0], 0, 0, 0); }
    }
    { auto rr = __builtin_amdgcn_permlane32_swap(__float_as_uint(den), __float_as_uint(den), false, false); den = __uint_as_float(rr[0]) + __uint_as_float(rr[1]); }
    { auto rr = __builtin_amdgcn_permlane32_swap(__float_as_uint(ndot), __float_as_uint(ndot), false, false); ndot = __uint_as_float(rr[0]) + __uint_as_float(rr[1]); }
    den += wint * 0.125f * ndot;
    const float sct = 1.f / fmaxf(fabsf(den), __builtin_amdgcn_exp2f(-cum[dir * 128 + t] * L2E - el2));
    if (hi == 0) scl[wave * 32 + r32] = sct;
    __syncthreads();
    if (dir == 1) {
#pragma unroll
        for (int r = 0; r < 16; ++r) { const float sc = scl[wave * 32 + crow(r, hi)];
#pragma unroll
            for (int d0 = 0; d0 < 4; ++d0) hs[(32 * tb + crow(r, hi)) * 128 + 32 * d0 + r32] = o[d0][r] * sc; }
    }
    __syncthreads();
    if (dir == 0) {
#pragma unroll
        for (int r = 0; r < 16; ++r) { const float sc = scl[wave * 32 + crow(r, hi)];
#pragma unroll
            for (int d0 = 0; d0 < 4; ++d0) hs[(32 * tb + crow(r, hi)) * 128 + 32 * d0 + r32] += o[d0][r] * sc; }
    }
    __syncthreads();
    {
        const int tt = tid >> 2, q4 = tid & 3;
        const size_t grow = (size_t)chunk_row(b, X, tt);
        const unsigned short* og = P16 + grow * 2304 + 1696 + h * 128 + 32 * q4;
        u32x4 og4[4];
#pragma unroll
        for (int j = 0; j < 4; ++j) og4[j] = *reinterpret_cast<const u32x4*>(og + 8 * j);
        f32x4 v[8]; float ss = 0.f;
#pragma unroll
        for (int j = 0; j < 8; ++j) { v[j] = *(const LAS f32x4*)(hs + tt * 128 + 32 * q4 + 4 * j); ss += (v[j][0] * v[j][0] + v[j][1] * v[j][1]) + (v[j][2] * v[j][2] + v[j][3] * v[j][3]); }
        ss += __shfl_xor(ss, 1); ss += __shfl_xor(ss, 2);
        const float rstd = rsqrtf(ss * (1.f / 128.f) + 1e-6f);
        const float* gn = mng + h * 128 + 32 * q4;
        unsigned short* dst = MIX16 + grow * 1024 + 512 + h * 128 + 32 * q4;
#pragma unroll
        for (int j = 0; j < 4; ++j) { const f32x4 g0 = *(const f32x4*)(gn + 8 * j), g1 = *(const f32x4*)(gn + 8 * j + 4); const f32x4 x0 = v[2 * j], x1 = v[2 * j + 1]; const u32x4 ow = og4[j];
            float r8[8];
#pragma unroll
            for (int e = 0; e < 4; ++e) { const float gl = __uint_as_float(ow[e] << 16), gh = __uint_as_float(ow[e] & 0xffff0000u);
                const float xa = (e < 2) ? x0[2 * e] : x1[2 * e - 4], xb = (e < 2) ? x0[2 * e + 1] : x1[2 * e - 3];
                const float ga = (e < 2) ? g0[2 * e] : g1[2 * e - 4], gb = (e < 2) ? g0[2 * e + 1] : g1[2 * e - 3];
                r8[2 * e] = xa * rstd * ga * __builtin_amdgcn_rcpf(1.f + __expf(-gl)); r8[2 * e + 1] = xb * rstd * gb * __builtin_amdgcn_rcpf(1.f + __expf(-gh)); }
            u32x4 w; w.x = cvtpk(r8[0], r8[1]); w.y = cvtpk(r8[2], r8[3]); w.z = cvtpk(r8[4], r8[5]); w.w = cvtpk(r8[6], r8[7]);
            *(u32x4*)(dst + 8 * j) = w; }
    }
    __syncthreads();
}
#undef ML_PK
#undef ML_KS
}


__device__ __forceinline__ unsigned pk4_fp8(float a, float b, float c, float d) { int w = __builtin_amdgcn_cvt_pk_fp8_f32(a, b, 0, false); w = __builtin_amdgcn_cvt_pk_fp8_f32(c, d, w, true); return (unsigned)w; }
template <class RowMap>
__device__ __forceinline__ void transpose_item8(const float* W, int K, int N, int nblk, unsigned char* WT, const RowMap& rowmap, LAS float* scr, int item, int lane) {
    const int kb = item / nblk, nb = item % nblk, k0 = 64 * kb, n0 = 32 * nb;
    const int ncol = n0 + (lane & 31);
    float tv[32];
#pragma unroll
    for (int i = 0; i < 32; ++i) { const int kk = 2 * i + (lane >> 5); tv[i] = __builtin_nontemporal_load(W + (size_t)(k0 + kk) * N + ncol) * 64.f; }
#pragma unroll
    for (int i = 0; i < 32; ++i) scr[(2 * i + (lane >> 5)) * 33 + (lane & 31)] = tv[i];
    asm volatile("s_waitcnt lgkmcnt(0)" ::: "memory");
    const int c = lane & 7;
    const int r0 = rowmap(n0);
#pragma unroll
    for (int j = 0; j < 4; ++j) { const int n = (lane >> 3) + 8 * j; const LAS float* sp = scr + (8 * c) * 33 + n;
        pg8::u32x2 o; o.x = pk4_fp8(sp[0 * 33], sp[1 * 33], sp[2 * 33], sp[3 * 33]); o.y = pk4_fp8(sp[4 * 33], sp[5 * 33], sp[6 * 33], sp[7 * 33]);
        __builtin_nontemporal_store(o, (pg8::u32x2*)(WT + (size_t)(r0 + n) * K + k0 + 8 * c)); }
    asm volatile("s_waitcnt lgkmcnt(0)" ::: "memory");
}

__device__ __forceinline__ void convert_chunk(const float* wgu, const float* wdn, unsigned short* WguT, unsigned short* WdnT, int which, int chunk, LAS float* scr, int wave, int lane) {
#pragma unroll 1
    for (int j = 0; j < 8; ++j) {
        const int it = chunk * 64 + wave * 8 + j;
#if MOE_FP8
        if (which == 0) { const int e = it >> 10, r = it & 1023;
            transpose_item8(wgu + (size_t)e * D * 2 * DFF, D, 2 * DFF, 2 * DFF / 32, (unsigned char*)WguT + (size_t)e * 2 * DFF * D,
                            [](int n0) { return n0 < DFF ? (n0 >> 7) * 256 + (n0 & 127) : ((n0 - DFF) >> 7) * 256 + 128 + ((n0 - DFF) & 127); }, scr, r, lane); }
        else { const int e = it >> 9, r = it & 511;
            transpose_item8(wdn + (size_t)e * DFF * D, DFF, D, D / 32, (unsigned char*)WdnT + (size_t)e * D * DFF, [](int n0) { return n0; }, scr, r, lane); }
#else
        if (which == 0) { const int e = it >> 10, r = it & 1023;
            transpose_item(wgu + (size_t)e * D * 2 * DFF, D, 2 * DFF, 2 * DFF / 32, WguT + (size_t)e * 2 * DFF * D,
                           [](int n0) { return n0 < DFF ? (n0 >> 7) * 256 + (n0 & 127) : ((n0 - DFF) >> 7) * 256 + 128 + ((n0 - DFF) & 127); }, scr, r, lane); }
        else { const int e = it >> 9, r = it & 511;
            transpose_item(wdn + (size_t)e * DFF * D, DFF, D, D / 32, WdnT + (size_t)e * D * DFF, [](int n0) { return n0; }, scr, r, lane); }
#endif
    }
}
__device__ __forceinline__ void pull_chunks(unsigned* qword, int first, int total, int maxc, const float* wgu, const float* wdn, unsigned short* WguT, unsigned short* WdnT, int which,
                                            unsigned char* lds_raw, int wave, int lane) {
    LAS int* bc = (LAS int*)(lds_raw + 131072 + 1024);
    LAS float* scr = (LAS float*)(lds_raw + wave * 16384);
    for (int n = 0; n < maxc; ++n) {
        __syncthreads();
        if (threadIdx.x == 0) bc[0] = first + (int)__hip_atomic_fetch_add(qword, 1u, __ATOMIC_RELAXED, __HIP_MEMORY_SCOPE_AGENT);
        __syncthreads();
        const int c = bc[0];
        if (c >= total) break;
        convert_chunk(wgu, wdn, WguT, WdnT, which, c, scr, wave, lane);
    }
    __syncthreads();
}

__device__ __forceinline__ int fresh_tid() { int t = (int)threadIdx.x; asm volatile("" : "+v"(t)); return t; }

#define DEF_PTRS \
    float* MOD = (float*)(ws + WS_MOD); \
    float* NLOC = (float*)(ws + WS_MLS); float* MLOC = (float*)(ws + WS_MLS + 512 * 1024); float* TOT = (float*)(ws + WS_MLS + 576 * 1024); float* NIN = (float*)(ws + WS_MLS + 1 * MiB); float* MIN_ = (float*)(ws + WS_MLS + 1536 * 1024); \
    float* CLOC = (float*)(ws + WS_CLOC); unsigned short* CIN = (unsigned short*)(ws + WS_CIN); \
    float* ROPEC = (float*)(ws + WS_ROPE); float* ROPES = ROPEC + S * 16; \
    int* TOPE = (int*)(ws + WS_TOPE); int* SLOT = (int*)(ws + WS_SLOT); int* LIST = (int*)(ws + WS_LIST); float* RGATE = (float*)(ws + WS_RGATE); \
    unsigned short* Hb16 = (unsigned short*)(ws + WS_H); unsigned short* WinT = (unsigned short*)(ws + WS_WINT); \
    unsigned short* Q16 = (unsigned short*)(ws + WS_Q); unsigned short* K16 = (unsigned short*)(ws + WS_KV); unsigned short* V16 = (unsigned short*)(ws + WS_KV + 32 * MiB); \
    unsigned short* X1 = (unsigned short*)(ws + WS_X1); unsigned short* H2 = (unsigned short*)(ws + WS_H2); \
    unsigned short* YG = (unsigned short*)(ws + WS_YG); unsigned short* ACT = (unsigned short*)(ws + WS_ACT); \
    unsigned short* WguT = (unsigned short*)(ws + WS_WGUT); unsigned short* WdnT = (unsigned short*)(ws + WS_WDNT); \
    unsigned short* WuqT = (unsigned short*)(ws + WS_WUQT); unsigned short* WukvT = (unsigned short*)(ws + WS_WUKVT); unsigned short* WoutT = (unsigned short*)(ws + WS_WOUTT); \
    float* GATES = (float*)(ws + WS_GATES); float* STAT = (float*)(ws + WS_STAT); float* STAT2 = (float*)(ws + WS_STAT2); \
    float* GM2 = (float*)(ws + WS_RSTD); unsigned short* RWH = (unsigned short*)(ws + WS_RSTD + 65536); unsigned short* RWL = (unsigned short*)(ws + WS_RSTD + 131072); unsigned short* MIX16 = (unsigned short*)(ws + WS_MIX16); \
    unsigned short* P16 = (unsigned short*)(ws + WS_P); \
    unsigned* CNT = ctl + CW_CNT; (void)CNT;
typedef const Params __attribute__((address_space(4))) KParams;
#define PHASE_ENV KParams* pk = kp; asm volatile("" : "+s"(pk)); unsigned char* ws = pk->ws; unsigned* ctl = (unsigned*)(ws + WS_CTL); (void)ctl; DEF_PTRS

constexpr int LDS_BYTES = 147456;
constexpr int N_PHASES = 12;

__global__ void __launch_bounds__(NT, 2) fwd_kernel(Params p) {
    extern __shared__ __attribute__((aligned(16))) unsigned char lds_raw[];
    float* lds = (float*)lds_raw;
    LAS unsigned* misc = (LAS unsigned*)(lds_raw + 131072 + 4096);
    const int tid = threadIdx.x, lane = tid & 63, wave = tid >> 6;
    const int bid = blockIdx.x, G = gridDim.x;
    KParams* kp = (KParams*)__builtin_amdgcn_kernarg_segment_ptr();
    unsigned* ctl = (unsigned*)(p.ws + WS_CTL);
    if (tid < 4) misc[tid] = 0u;
    __syncthreads();
    const bool single = (p.ph_hi - p.ph_lo) > 1;
    if (single) (void)xcd_barrier_post(ctl + CW_BAR, (volatile LAS unsigned*)misc);
#ifndef PH_MASK
#define PH_MASK 0xFFFF
#endif
#define IN(k) ((((PH_MASK) >> (k)) & 1) && p.ph_lo <= (k) && (k) < p.ph_hi)
#define GRID_BARRIER() do { KParams* pb_ = kp; asm volatile("" : "+s"(pb_)); XcdBarrier b_; b_.bar = (unsigned*)(pb_->ws + WS_CTL) + CW_BAR; b_.x = xb_xcc_id(); b_.st = (volatile LAS unsigned*)misc; xcd_barrier(b_); } while (0)
#define SEAM(k) do { if (IN(k) && IN((k) + 1)) GRID_BARRIER(); } while (0)
#define PH_BEGIN(k)
#define PH_END(k)
#define SEAM2(k) do { if (IN(k) && IN((k) + 2)) GRID_BARRIER(); } while (0)

    PH_BEGIN(0) if (IN(0)) {
        const int tid = fresh_tid(), lane = tid & 63, wave = tid >> 6; (void)lane; (void)wave;
        PHASE_ENV
        {
            const float* wmod = pk->in[I_WMOD]; const float* bmod = pk->in[I_BMOD];
            float* sil = lds;
            float* red = lds + 5 * 1024;
            for (int cg = bid; cg < 96; cg += G) {
                for (int e = tid; e < 5 * D; e += NT) { const int r = e >> 10, k = e & 1023; const float cv = (r < 4) ? pk->in[I_C][r * D + k] : pk->in[I_CCTX][k]; sil[e] = siluf_(cv); }
                __syncthreads();
                const int col = cg * 64 + (tid & 63), part = tid >> 6;
                float a0 = 0.f, a1 = 0.f, a2 = 0.f, a3 = 0.f, a4 = 0.f;
#pragma unroll 8
                for (int kk = 0; kk < 128; ++kk) { const int k = part * 128 + kk; const float w = wmod[(size_t)k * 6144 + col];
                    a0 = fmaf(sil[k], w, a0); a1 = fmaf(sil[1024 + k], w, a1); a2 = fmaf(sil[2048 + k], w, a2); a3 = fmaf(sil[3072 + k], w, a3); a4 = fmaf(sil[4096 + k], w, a4); }
                red[(part * 5 + 0) * 64 + (tid & 63)] = a0; red[(part * 5 + 1) * 64 + (tid & 63)] = a1; red[(part * 5 + 2) * 64 + (tid & 63)] = a2; red[(part * 5 + 3) * 64 + (tid & 63)] = a3; red[(part * 5 + 4) * 64 + (tid & 63)] = a4;
                __syncthreads();
                if (tid < 320) { const int r = tid >> 6, cc = tid & 63; float t = 0.f;
#pragma unroll
                    for (int pp = 0; pp < 8; ++pp) t += red[(pp * 5 + r) * 64 + cc];
                    MOD[r * 6144 + cg * 64 + cc] = t + bmod[cg * 64 + cc]; }
                __syncthreads();
            }
        }
        for (int e = bid * NT + tid; e < NE * D; e += G * NT) { const int ex = e >> 10, k = e & 1023; const float w = pk->in[I_RW][(size_t)k * NE + ex];
            const unsigned hi = pg8::cvt_pk_bf16(w, 0.f) & 0xffffu; const float lo = w - __uint_as_float(hi << 16);
            RWH[e] = (unsigned short)hi; RWL[e] = (unsigned short)(pg8::cvt_pk_bf16(lo, 0.f) & 0xffffu); }
        for (int e = bid * NT + tid; e < S * 16; e += G * NT) { float cs, sn; rope_angles(e >> 4, e & 15, cs, sn); ROPEC[e] = cs; ROPES[e] = sn; }
        {
            LAS float* scr = (LAS float*)(lds_raw + wave * 16384);
            const int gw = bid * 8 + wave, NGW = G * 8;
            for (int it = gw; it < (D / 64) * (PW / 32); it += NGW) transpose_item(pk->in[I_WIN], D, INW, PW / 32, WinT, [](int n0) { return n0; }, scr, it, lane);
            for (int it = gw; it < (QL / 64) * (768 / 32); it += NGW) transpose_item(pk->in[I_WUQ], QL, 768, 768 / 32, WuqT, [](int n0) { return n0; }, scr, it, lane, pk->in[I_QNG]);
            for (int it = gw; it < (KVL / 64) * (1024 / 32); it += NGW) transpose_item(pk->in[I_WUKV], KVL, 1024, 1024 / 32, WukvT, [](int n0) { return n0; }, scr, it, lane, pk->in[I_KVNG]);
            for (int it = gw; it < (D / 64) * (D / 32); it += NGW) transpose_item(pk->in[I_WOUT], D, D, D / 32, WoutT, [](int n0) { return n0; }, scr, it, lane);
            for (int c = G - 1 - bid; c < GU_STATIC; c += G) convert_chunk(pk->in[I_WGU], pk->in[I_WDN], WguT, WdnT, 0, c, scr, wave, lane);
        }
    }
    PH_END(0)
    SEAM(0);
    PH_BEGIN(1) if (IN(1)) {
        const int tid = fresh_tid(), lane = tid & 63, wave = tid >> 6; (void)lane; (void)wave;
        PHASE_ENV
        const float* g1n = pk->in[I_N1G];
        for (int e = bid * NT + tid; e < 4 * D; e += G * NT) GM2[e] = pk->in[I_N2G][e & 1023] * (1.f + MOD[(e >> 10) * 6144 + 4 * D + (e & 1023)]);
        for (int rp = bid * 8 + wave; rp < MT / 2; rp += G * 8) {
            const int r = 2 * rp;
            const float* src = (r < MX) ? pk->in[I_X] + (size_t)r * D : pk->in[I_CTX] + (size_t)(r - MX) * D;
            const int mb = (r < MX) ? r / S : 4;
            const float* sh = MOD + mb * 6144, *sc = sh + D;
            float4 va[4], vb[4]; float sa = 0.f, sb = 0.f;
#pragma unroll
            for (int j = 0; j < 4; ++j) { va[j] = *(const float4*)(src + j * 256 + lane * 4); vb[j] = *(const float4*)(src + D + j * 256 + lane * 4); }
#pragma unroll
            for (int j = 0; j < 4; ++j) { sa += (va[j].x * va[j].x + va[j].y * va[j].y) + (va[j].z * va[j].z + va[j].w * va[j].w); sb += (vb[j].x * vb[j].x + vb[j].y * vb[j].y) + (vb[j].z * vb[j].z + vb[j].w * vb[j].w); }
            const float ra = rsqrtf(wave_sum(sa) * (1.f / D) + EPS), rb2 = rsqrtf(wave_sum(sb) * (1.f / D) + EPS);
#pragma unroll
            for (int j = 0; j < 4; ++j) {
                const int c = j * 256 + lane * 4;
                const float4 gn = *(const float4*)(g1n + c), scv = *(const float4*)(sc + c), shv = *(const float4*)(sh + c);
                const float g0 = gn.x * (1.f + scv.x), g1 = gn.y * (1.f + scv.y), g2 = gn.z * (1.f + scv.z), g3 = gn.w * (1.f + scv.w);
                pg8::u32x2 w;
                w.x = pg8::cvt_pk_bf16(va[j].x * ra * g0 + shv.x, va[j].y * ra * g1 + shv.y); w.y = pg8::cvt_pk_bf16(va[j].z * ra * g2 + shv.z, va[j].w * ra * g3 + shv.w);
                *(pg8::u32x2*)(Hb16 + (size_t)r * D + c) = w;
                w.x = pg8::cvt_pk_bf16(vb[j].x * rb2 * g0 + shv.x, vb[j].y * rb2 * g1 + shv.y); w.y = pg8::cvt_pk_bf16(vb[j].z * rb2 * g2 + shv.z, vb[j].w * rb2 * g3 + shv.w);
                *(pg8::u32x2*)(Hb16 + (size_t)(r + 1) * D + c) = w;
            }
        }
    }
    PH_END(1)
    SEAM(1);
    PH_BEGIN(2) if (IN(2)) {
        const int tid = fresh_tid(), lane = tid & 63, wave = tid >> 6; (void)lane; (void)wave;
        PHASE_ENV
        pg8::PlainSched Sd; Sd.init(MT, PW, D, D, WinT, G, bid);
        pg8::EpiInproj E{P16, GATES, STAT, K16, ROPEC, ROPES};
        pg8::gemm_phase<pg8::EpiInproj, pg8::PlainSched, true>((LAS unsigned char*)lds_raw, Hb16, D, Sd, E);
        if ((Sd.nwg % G) != 0 && bid >= (Sd.nwg % G))
            pull_chunks(ctl + CW_QGU, GU_STATIC, GU_CHUNKS, 2, pk->in[I_WGU], pk->in[I_WDN], WguT, WdnT, 0, lds_raw, wave, lane);
    }
    PH_END(2)
    SEAM2(2);
    PH_BEGIN(4) if (IN(4)) {
        const int tid = fresh_tid(), lane = tid & 63, wave = tid >> 6; (void)lane; (void)wave;
        PHASE_ENV
#ifndef NO_QG
        { pg8::PlainSched Sd; Sd.init(MX, 768, QL, PW, WuqT, G, (bid + G - 16) % G);
          pg8::EpiQ E{Q16, STAT, ROPEC, ROPES};
          pg8::gemm_phase<pg8::EpiQ, pg8::PlainSched, true>((LAS unsigned char*)lds_raw, P16 + O_CQ, QL, Sd, E); }
#endif
#ifndef NO_KVG
        { pg8::PlainSched Sd; Sd.init(MT, 1024, KVL, PW, WukvT, G, bid);
          pg8::EpiKV E{K16, V16, STAT};
          pg8::gemm_phase<pg8::EpiKV, pg8::PlainSched, true>((LAS unsigned char*)lds_raw, P16 + O_CKV, KVL, Sd, E); }
#endif
        for (int u = (bid + 48) % G; u < 16 * ml::NXC; u += G) ml::stepA_unit(P16, GATES, pk->in[I_BG], u / ml::NXC, u % ml::NXC, CLOC, NLOC, MLOC, TOT, (char*)lds_raw);
    }
    PH_END(4)
    SEAM(4);
    PH_BEGIN(5) if (IN(5)) {
        const int tid = fresh_tid(), lane = tid & 63, wave = tid >> 6; (void)lane; (void)wave;
        PHASE_ENV
        ml::stepB(CLOC, NLOC, MLOC, TOT, (unsigned*)CIN, NIN, MIN_, bid * NT + tid, G * NT);
        {
            const int nun = NB * HA * (S / 256);
            for (int i = 0; i * G < nun; ++i) {
                int bh, qb;
                if (G == 256) { const int x = bid & 7, slot = bid >> 3; bh = i * 16 + x * 2 + (slot >> 4); qb = slot & 15; }
                else { const int u = i * G + bid; if (u >= nun) break; bh = u >> 4; qb = u & 15; }
                const int b = bh >> 3, h = bh & 7;
                att::attn_body(Q16 + (size_t)(b * S + qb * 256) * 768 + h * 96, K16 + (size_t)(b * SKV) * 768 + h * 96, V16 + (size_t)(b * SKV) * 512 + h * 64,
                               MIX16 + (size_t)(b * S + qb * 256) * D + h * 64, SKV, (char*)lds_raw);
            }
        }
    }
    PH_END(5)
    SEAM(5);
    PH_BEGIN(6) if (IN(6)) {
        const int tid = fresh_tid(), lane = tid & 63, wave = tid >> 6; (void)lane; (void)wave;
        PHASE_ENV
        for (int u = bid; u < 16 * 32; u += G) ml::stepC_unit(P16, GATES, pk->in[I_BG], CIN, NIN, MIN_, pk->in[I_MNG], MIX16, u >> 5, u & 31, (char*)lds_raw);
    }
    PH_END(6)
    SEAM(6);
    PH_BEGIN(7) if (IN(7)) {
        const int tid = fresh_tid(), lane = tid & 63, wave = tid >> 6; (void)lane; (void)wave;
        PHASE_ENV
        pg8::PlainSched Sd; Sd.init(MX, D, D, D, WoutT, G, bid);
        pg8::EpiResid E{X1, pk->in[I_X], MOD, STAT2};
        pg8::gemm_phase<pg8::EpiResid, pg8::PlainSched, true>((LAS unsigned char*)lds_raw, MIX16, D, Sd, E);
    }
    PH_END(7)
    SEAM(7);
    PH_BEGIN(8) if (IN(8)) {
        const int tid = fresh_tid(), lane = tid & 63, wave = tid >> 6; (void)lane; (void)wave;
        PHASE_ENV
        typedef short bf16x8v __attribute__((ext_vector_type(8)));
        typedef float f32x4v __attribute__((ext_vector_type(4)));
        float* LG = lds;
        LAS int* lcnt = (LAS int*)(lds_raw + 32768); LAS int* gbase = lcnt + 32;
        const float* rb = pk->in[I_RB];
        for (int base = bid * 64; base < MX; base += G * 64) {
            if (tid < 32) lcnt[tid] = 0;
            {
                const int bq0 = base / S; const float4 t4 = (tid < 256) ? *(const float4*)(GM2 + bq0 * D + 4 * tid) : *(const float4*)(MOD + bq0 * 6144 + 3 * D + 4 * (tid - 256));
                *(float4*)(lds + 10240 + 4 * tid) = t4; }
            __syncthreads();
            int te[4] = {0, 0, 0, 0}, rk[4] = {0, 0, 0, 0}; float tg[4] = {0.f, 0.f, 0.f, 0.f};
            {
                const int rt = wave & 3, kh = wave >> 2;
                const int r0 = base + 16 * rt, row = lane & 15, kg = lane >> 4, bq = r0 / S;
                float ss;
                { const float4 s0 = *(const float4*)(STAT2 + (size_t)(r0 + row) * 32 + kg * 8), s1 = *(const float4*)(STAT2 + (size_t)(r0 + row) * 32 + kg * 8 + 4);
                  ss = ((s0.x + s0.y) + (s0.z + s0.w)) + ((s1.x + s1.y) + (s1.z + s1.w)); ss += __shfl_xor(ss, 16); ss += __shfl_xor(ss, 32); }
                const float rstd = rsqrtf(ss * (1.f / D) + EPS);
                const int ko = kh * 512 + 8 * kg;
                const unsigned short* xr = X1 + (size_t)(r0 + row) * D + ko; const float* gmr = lds + 10240 + ko; const float* shr = lds + 10240 + 1024 + ko; (void)bq;
                unsigned short* hr = H2 + (size_t)(r0 + row) * D + ko; (void)hr;
                const unsigned short* wh0 = RWH + (size_t)row * D + ko, *wh1 = RWH + (size_t)(16 + row) * D + ko, *wl0 = RWL + (size_t)row * D + ko, *wl1 = RWL + (size_t)(16 + row) * D + ko;
                f32x4v acc0 = {0.f, 0.f, 0.f, 0.f}, acc1 = {0.f, 0.f, 0.f, 0.f};
#pragma unroll 8
                for (int st = 0; st < 16; ++st) {
                    const pg8::u32x4 xw = *(const pg8::u32x4*)(xr + 32 * st);
                    const float4 x0 = make_float4(__uint_as_float(xw[0] << 16), __uint_as_float(xw[0] & 0xffff0000u), __uint_as_float(xw[1] << 16), __uint_as_float(xw[1] & 0xffff0000u)), x1v = make_float4(__uint_as_float(xw[2] << 16), __uint_as_float(xw[2] & 0xffff0000u), __uint_as_float(xw[3] << 16), __uint_as_float(xw[3] & 0xffff0000u));
                    const float4 g0 = *(const float4*)(gmr + 32 * st), g1v = *(const float4*)(gmr + 32 * st + 4), h0 = *(const float4*)(shr + 32 * st), h1 = *(const float4*)(shr + 32 * st + 4);
                    float hv[8] = {x0.x * rstd * g0.x + h0.x, x0.y * rstd * g0.y + h0.y, x0.z * rstd * g0.z + h0.z, x0.w * rstd * g0.w + h0.w, x1v.x * rstd * g1v.x + h1.x, x1v.y * rstd * g1v.y + h1.y, x1v.z * rstd * g1v.z + h1.z, x1v.w * rstd * g1v.w + h1.w};
                    pg8::u32x4 hi4, lo4;
#pragma unroll
                    for (int q = 0; q < 4; ++q) { hi4[q] = pg8::cvt_pk_bf16(hv[2 * q], hv[2 * q + 1]);
                        lo4[q] = pg8::cvt_pk_bf16(hv[2 * q] - __uint_as_float(hi4[q] << 16), hv[2 * q + 1] - __uint_as_float(hi4[q] & 0xffff0000u)); }
#if MOE_FP8
                    { pg8::u32x2 h8; h8.x = pk4_fp8(hv[0], hv[1], hv[2], hv[3]); h8.y = pk4_fp8(hv[4], hv[5], hv[6], hv[7]); *(pg8::u32x2*)((unsigned char*)H2 + (size_t)(r0 + row) * D + ko + 32 * st) = h8; }
#else
                    *(pg8::u32x4*)(hr + 32 * st) = hi4;
#endif
                    const bf16x8v ah = *reinterpret_cast<const bf16x8v*>(&hi4), al = *reinterpret_cast<const bf16x8v*>(&lo4);
                    const bf16x8v bh0 = *reinterpret_cast<const bf16x8v*>(wh0 + 32 * st), bh1 = *reinterpret_cast<const bf16x8v*>(wh1 + 32 * st), bl0 = *reinterpret_cast<const bf16x8v*>(wl0 + 32 * st), bl1 = *reinterpret_cast<const bf16x8v*>(wl1 + 32 * st);
                    acc0 = __builtin_amdgcn_mfma_f32_16x16x32_bf16(ah, bh0, acc0, 0, 0, 0); acc0 = __builtin_amdgcn_mfma_f32_16x16x32_bf16(al, bh0, acc0, 0, 0, 0); acc0 = __builtin_amdgcn_mfma_f32_16x16x32_bf16(ah, bl0, acc0, 0, 0, 0);
                    acc1 = __builtin_amdgcn_mfma_f32_16x16x32_bf16(ah, bh1, acc1, 0, 0, 0); acc1 = __builtin_amdgcn_mfma_f32_16x16x32_bf16(al, bh1, acc1, 0, 0, 0); acc1 = __builtin_amdgcn_mfma_f32_16x16x32_bf16(ah, bl1, acc1, 0, 0, 0);
                }
                float* lgp = LG + kh * (64 * 33);
#pragma unroll
                for (int j = 0; j < 4; ++j) { lgp[(16 * rt + 4 * kg + j) * 33 + row] = acc0[j]; lgp[(16 * rt + 4 * kg + j) * 33 + 16 + row] = acc1[j]; }
            }
            __syncthreads();
            if (wave < 4 && lane < 16) {
                float* lr = LG + (16 * wave + lane) * 33; float tv[4];
                for (int e = 0; e < 32; ++e) lr[e] = (lr[e] + lr[64 * 33 + e]) + rb[e];
#pragma unroll
                for (int k = 0; k < 4; ++k) { float best = -3.0e38f; int bi = 0;
                    for (int e = 0; e < 32; ++e) { const float v = lr[e]; if (v > best) { best = v; bi = e; } }
                    te[k] = bi; tv[k] = best; lr[bi] = -3.0e38f; }
                const float e1 = __expf(tv[1] - tv[0]), e2 = __expf(tv[2] - tv[0]), e3 = __expf(tv[3] - tv[0]); const float inv = 1.f / (1.f + e1 + e2 + e3);
                tg[0] = inv; tg[1] = e1 * inv; tg[2] = e2 * inv; tg[3] = e3 * inv;
#pragma unroll
                for (int k = 0; k < 4; ++k) rk[k] = atomicAdd((int*)&lcnt[te[k]], 1);
            }
            __syncthreads();
            if (tid < 32) gbase[tid] = (int)atomicAdd(&CNT[tid], (unsigned)lcnt[tid]);
            __syncthreads();
            if (wave < 4 && lane < 16) { const int r = base + 16 * wave + lane;
#pragma unroll
                for (int k = 0; k < 4; ++k) { const int e = te[k], pos = gbase[e] + rk[k]; TOPE[r * 4 + k] = e; SLOT[r * 4 + k] = pos; LIST[e * MX + pos] = r; RGATE[e * MX + pos] = tg[k]; } }
            __syncthreads();
        }
    }
    if (IN(8)) { const int t2 = fresh_tid(); PHASE_ENV pull_chunks(ctl + CW_QGU, GU_STATIC, GU_CHUNKS, GU_CHUNKS, pk->in[I_WGU], pk->in[I_WDN], WguT, WdnT, 0, lds_raw, t2 >> 6, t2 & 63); }
    PH_END(8)
    SEAM(8);
    LAS int* mtp = (LAS int*)(lds_raw + 131072); LAS int* mro = mtp + 40; LAS int* mcn = mro + 40;
    if (IN(9) || IN(10) || IN(11)) {
        PHASE_ENV
        __syncthreads();
        if (tid < 64) {
            const int cnt = (tid < NE) ? (int)__hip_atomic_load(&CNT[tid & 31], __ATOMIC_RELAXED, __HIP_MEMORY_SCOPE_AGENT) : 0;
            const int tl = (cnt + 255) >> 8; int inc = tl;
#pragma unroll
            for (int o = 1; o < 64; o <<= 1) { const int y = __shfl_up(inc, o); if (tid >= o) inc += y; }
            if (tid < NE) { mcn[tid] = cnt; mtp[tid] = inc - tl; mro[tid] = (inc - tl) * 256; }
            if (tid == NE - 1) { mtp[NE] = inc; mro[NE] = inc * 256; }
        }
        __syncthreads();
    }
    PH_BEGIN(9) if (IN(9)) {
        const int tid = fresh_tid(), lane = tid & 63, wave = tid >> 6; (void)lane; (void)wave;
        PHASE_ENV
#if MOE_FP8
        pg8::MoeSched Sd{mtp, mro, mcn, DFF / 128, G, bid, D / 2, D / 2, 1, LIST, (const char*)WguT, (size_t)2 * DFF * D};
        pg8::EpiSwiglu E{ACT, pk->in[I_BGU]};
        pg8::gemm_phase<pg8::EpiSwiglu, pg8::MoeSched, true, true>((LAS unsigned char*)lds_raw, H2, D / 2, Sd, E);
#else
        pg8::MoeSched Sd{mtp, mro, mcn, DFF / 128, G, bid, D, D, 1, LIST, (const char*)WguT, (size_t)2 * DFF * D * 2};
        pg8::EpiSwiglu E{ACT, pk->in[I_BGU]};
        pg8::gemm_phase<pg8::EpiSwiglu, pg8::MoeSched, true>((LAS unsigned char*)lds_raw, H2, D, Sd, E);
#endif
        {
            const int nun = mtp[NE] * (DFF / 128); const int mine = (nun - bid + G - 1) / G, most = (nun + G - 1) / G;
            if (mine < most) pull_chunks(ctl + CW_QDN, 0, DN_CHUNKS, 3, pk->in[I_WGU], pk->in[I_WDN], WguT, WdnT, 1, lds_raw, wave, lane);
            pull_chunks(ctl + CW_QDN, 0, DN_CHUNKS, DN_CHUNKS, pk->in[I_WGU], pk->in[I_WDN], WguT, WdnT, 1, lds_raw, wave, lane);
        }
    }
    PH_END(9)
    SEAM(9);
    PH_BEGIN(10) if (IN(10)) {
        const int tid = fresh_tid(), lane = tid & 63, wave = tid >> 6; (void)lane; (void)wave;
        PHASE_ENV
#if MOE_FP8
        pg8::MoeSched Sd{mtp, mro, mcn, D / 256, G, bid, DFF / 2, DFF / 2, 0, LIST, (const char*)WdnT, (size_t)D * DFF};
        pg8::EpiDown E{YG, pk->in[I_BDN], RGATE, mro};
        pg8::gemm_phase<pg8::EpiDown, pg8::MoeSched, true, true>((LAS unsigned char*)lds_raw, ACT, DFF / 2, Sd, E);
#else
        pg8::MoeSched Sd{mtp, mro, mcn, D / 256, G, bid, DFF, DFF, 0, LIST, (const char*)WdnT, (size_t)D * DFF * 2};
        pg8::EpiDown E{YG, pk->in[I_BDN], RGATE, mro};
        pg8::gemm_phase<pg8::EpiDown, pg8::MoeSched, true>((LAS unsigned char*)lds_raw, ACT, DFF, Sd, E);
#endif
    }
    PH_END(10)
    SEAM(10);
    PH_BEGIN(11) if (IN(11)) {
        const int tid = fresh_tid(), lane = tid & 63, wave = tid >> 6; (void)lane; (void)wave;
        PHASE_ENV
        const float* fng = pk->in[I_FNG];
        for (int r = bid * 8 + wave; r < MX; r += G * 8) {
            const int mb = r / S; const float* g2 = MOD + mb * 6144 + 5 * D;
            float acc[16];
#pragma unroll
            for (int i = 0; i < 16; ++i) acc[i] = 0.f;
#pragma unroll
            for (int k = 0; k < 4; ++k) {
                const int e = TOPE[r * 4 + k]; const int row = mro[e] + SLOT[r * 4 + k];
                const unsigned short* yr = YG + (size_t)row * D;
#pragma unroll
                for (int j = 0; j < 4; ++j) { const pg8::u32x2 t = *(const pg8::u32x2*)(yr + j * 256 + lane * 4);
                    acc[4 * j] += __uint_as_float(t.x << 16); acc[4 * j + 1] += __uint_as_float(t.x & 0xffff0000u); acc[4 * j + 2] += __uint_as_float(t.y << 16); acc[4 * j + 3] += __uint_as_float(t.y & 0xffff0000u); }
            }
            float v[16]; float ss = 0.f;
#pragma unroll
            for (int j = 0; j < 4; ++j) { const pg8::u32x2 tw = *(const pg8::u32x2*)(X1 + (size_t)r * D + j * 256 + lane * 4); const float4 t = make_float4(__uint_as_float(tw.x << 16), __uint_as_float(tw.x & 0xffff0000u), __uint_as_float(tw.y << 16), __uint_as_float(tw.y & 0xffff0000u)); const int c = j * 256 + lane * 4;
                v[4 * j] = t.x + g2[c] * acc[4 * j]; v[4 * j + 1] = t.y + g2[c + 1] * acc[4 * j + 1]; v[4 * j + 2] = t.z + g2[c + 2] * acc[4 * j + 2]; v[4 * j + 3] = t.w + g2[c + 3] * acc[4 * j + 3];
                ss += v[4 * j] * v[4 * j] + v[4 * j + 1] * v[4 * j + 1] + v[4 * j + 2] * v[4 * j + 2] + v[4 * j + 3] * v[4 * j + 3]; }
            const float rstd = rsqrtf(wave_sum(ss) * (1.f / D) + EPS);
#pragma unroll
            for (int j = 0; j < 4; ++j) { const int c = j * 256 + lane * 4;
                *(float4*)(pk->out + (size_t)r * D + c) = make_float4(v[4 * j] * rstd * fng[c], v[4 * j + 1] * rstd * fng[c + 1], v[4 * j + 2] * rstd * fng[c + 2], v[4 * j + 3] * rstd * fng[c + 3]); }
        }
    }
    PH_END(11)
#undef IN
#undef SEAM
}

#ifndef PROBE_SPLIT_DUP
#define PROBE_SPLIT_DUP (-1)
#endif
#ifndef N_LAUNCH_SPLIT
#define N_LAUNCH_SPLIT 0
#endif

extern "C" void kernel_launch(void* const* d_in, const int* in_sizes, int n_in, void* d_out, int out_size, void* d_ws, size_t ws_size, hipStream_t stream) {
    static int grid = 0;
    if (grid == 0) {
        if (n_in != 23 || out_size != MX * D || ws_size < WS_END) { fprintf(stderr, "kernel_launch: unexpected shapes n_in %d out %d ws %zu (need %zu)\n", n_in, out_size, ws_size, (size_t)WS_END); grid = -1; return; }
        int dev = 0, cus = 0, per_cu = 0;
        hipGetDevice(&dev); hipDeviceGetAttribute(&cus, hipDeviceAttributeMultiprocessorCount, dev);
        if (hipFuncSetAttribute((const void*)fwd_kernel, hipFuncAttributeMaxDynamicSharedMemorySize, LDS_BYTES) != hipSuccess) { fprintf(stderr, "kernel_launch: hipFuncSetAttribute failed\n"); grid = -1; return; }
        hipOccupancyMaxActiveBlocksPerMultiprocessor(&per_cu, (const void*)fwd_kernel, NT, LDS_BYTES);
        if (per_cu < 1) fprintf(stderr, "kernel_launch: occupancy query says %d\n", per_cu);
        (void)hipGetLastError();
        grid = cus > 0 ? cus : 256;
    }
    if (grid < 0) return;
    hipMemsetAsync((char*)d_ws + WS_CTL, 0, CTL_BYTES, stream);
    Params p{};
    for (int i = 0; i < 23; ++i) p.in[i] = (const float*)d_in[i];
    p.out = (float*)d_out; p.ws = (unsigned char*)d_ws;
#if N_LAUNCH_SPLIT
    for (int k = 0; k < N_PHASES; ++k) {
        if (k == 3) continue;
        const int reps = (k == PROBE_SPLIT_DUP) ? 2 : 1;
        for (int r = 0; r < reps; ++r) {
            if (k == 8 && r == 1) hipMemsetAsync((char*)d_ws + WS_CTL, 0, CTL_BYTES, stream);
            p.ph_lo = k; p.ph_hi = k + 1; hipLaunchKernelGGL(fwd_kernel, dim3(grid), dim3(NT), LDS_BYTES, stream, p);
        }
    }
#else
    p.ph_lo = 0; p.ph_hi = N_PHASES;
    hipLaunchKernelGGL(fwd_kernel, dim3(grid), dim3(NT), LDS_BYTES, stream, p);
#endif
}
```

```cpp
#include <hip/hip_runtime.h>
#include <cstdio>
#include <cstdint>

#define LAS __attribute__((address_space(3)))

#define XB_TMO      128
#define XB_XCNT(j)  (256  + 64 * (j))
#define XB_XSUB(j)  (1280 + 64 * (j))
#define XB_XGEN(j)  (2304 + 64 * (j))
#define XB_TOP      3328
#define XB_TOPGEN   3392
#define XCD_BAR_WORDS 3456
#define XB_SPIN_CAP (1u << 22)

__device__ __forceinline__ unsigned xb_ld(unsigned* p)              { return __hip_atomic_load(p, __ATOMIC_RELAXED, __HIP_MEMORY_SCOPE_AGENT); }
__device__ __forceinline__ unsigned xb_add(unsigned* p, unsigned v) { return __hip_atomic_fetch_add(p, v, __ATOMIC_RELAXED, __HIP_MEMORY_SCOPE_AGENT); }
__device__ __forceinline__ unsigned xb_xcc_id() { return (unsigned)__builtin_amdgcn_s_getreg((3 << 11) | 20) & 0xFu; }
#define XB_SPIN(cond, bar) do { unsigned _sp = 0; while (cond) { __builtin_amdgcn_s_sleep(1); \
    if ((++_sp & 255u) == 0u) { if (xb_ld(&(bar)[XB_TMO])) break; if (_sp > XB_SPIN_CAP) { atomicAdd(&(bar)[XB_TMO], 1u); break; } } } } while (0)

struct XcdBarrier { unsigned* bar; unsigned x; volatile LAS unsigned* st; };

__device__ __forceinline__ XcdBarrier xcd_barrier_post(unsigned* bar, volatile LAS unsigned* st) {
    XcdBarrier b; b.bar = bar; b.x = xb_xcc_id(); b.st = st;
    if (threadIdx.x == 0) (void)xb_add(&bar[XB_XCNT(b.x)], 1u);
    return b;
}
__device__ __forceinline__ void xcd_barrier_complete(unsigned* bar, unsigned x, unsigned& nloc, unsigned& nx) {
    const unsigned G = gridDim.x * gridDim.y * gridDim.z;
    unsigned sum, cnt, mine, sp = 0u;
    for (;;) {
        sum = 0u; cnt = 0u; mine = 0u;
#pragma unroll
        for (unsigned j = 0; j < 16; ++j) { const unsigned c = xb_ld(&bar[XB_XCNT(j)]); sum += c; cnt += (c > 0u) ? 1u : 0u; mine = (j == x) ? c : mine; }
        if (sum == G) break;
        __builtin_amdgcn_s_sleep(1);
        if ((++sp & 255u) == 0u) { if (xb_ld(&bar[XB_TMO])) break; if (sp > XB_SPIN_CAP) { atomicAdd(&bar[XB_TMO], 1u); break; } }
    }
    nloc = mine > 0u ? mine : 1u; nx = cnt > 0u ? cnt : 1u;
}
__device__ __forceinline__ void xcd_barrier(const XcdBarrier& b) {
    asm volatile("s_waitcnt vmcnt(0)" ::: "memory");
    __syncthreads();
    if (threadIdx.x == 0) {
        unsigned* bar = b.bar;
        __builtin_amdgcn_s_waitcnt(0);
        unsigned nloc = b.st[0], nx = b.st[1];
        if (nloc == 0u) { xcd_barrier_complete(bar, b.x, nloc, nx); b.st[0] = nloc; b.st[1] = nx; }
        const unsigned old = xb_add(&bar[XB_XSUB(b.x)], 1u);
        const unsigned gen = old / nloc;
        if (old + 1u == (gen + 1u) * nloc) {
            __builtin_amdgcn_fence(__ATOMIC_RELEASE, "agent");
            asm volatile("s_waitcnt vmcnt(0)" ::: "memory");
            const unsigned og = xb_add(&bar[XB_TOP], 1u);
            const unsigned tg = og / nx;
            if (og + 1u == (tg + 1u) * nx) xb_add(&bar[XB_TOPGEN], 1u);
            else XB_SPIN(xb_ld(&bar[XB_TOPGEN]) == tg, bar);
            __builtin_amdgcn_fence(__ATOMIC_ACQUIRE, "agent");
            xb_add(&bar[XB_XGEN(b.x)], 1u);
            asm volatile("s_waitcnt vmcnt(0)" ::: "memory");
        } else {
            XB_SPIN(xb_ld(&bar[XB_XGEN(b.x)]) == gen, bar);
            __builtin_amdgcn_fence(__ATOMIC_ACQUIRE, "agent");
            asm volatile("s_waitcnt vmcnt(0)" ::: "memory");
        }
    }
    __syncthreads();
}

#ifndef MOE_FP8
#define MOE_FP8 1
#endif
constexpr int D = 1024, NB = 4, S = 4096, CTX = 256, SKV = S + CTX;
constexpr int MX = NB * S, MC = NB * CTX, MT = MX + MC;
constexpr int INW = 2224, PW = 2304;
constexpr int O_CQ = 0, O_CKV = 384, O_KR = 640, O_MQ = 672, O_MK = 928, O_MV = 1184, O_MO = 1696, O_G = 2208;
constexpr int QL = 384, KVL = 256, HA = 8, DN = 64, DR = 32, DQK = 96, DVH = 64;
constexpr int NH = 4, MDQK = 64, MDV = 128;
constexpr int NE = 32, TOPK = 4, DFF = 1024;
constexpr float EPS = 1e-6f;
constexpr int NT = 512;
constexpr int NSEQ = NB * NH * 2;
constexpr int RCAP = MX * TOPK + NE * 256;

constexpr size_t MiB = 1u << 20;
constexpr size_t WS_CTL = 0, CTL_BYTES = 128 * 1024;
constexpr size_t WS_MOD = 1 * MiB;
constexpr size_t WS_MLS = 2 * MiB;
constexpr size_t WS_ROPE = 5 * MiB;
constexpr size_t WS_STAT2 = 6 * MiB;
constexpr size_t WS_TOPE = 8 * MiB;
constexpr size_t WS_SLOT = 9 * MiB;
constexpr size_t WS_LIST = 10 * MiB;
constexpr size_t WS_RGATE = 12 * MiB;
constexpr size_t WS_H = 16 * MiB;
constexpr size_t WS_P = 52 * MiB;
constexpr size_t WS_ACT = WS_P;
constexpr size_t WS_Q = 206 * MiB;
constexpr size_t WS_KV = 254 * MiB;
constexpr size_t WS_CLOC = 322 * MiB;
constexpr size_t WS_CIN = 386 * MiB;
constexpr size_t WS_X1 = 450 * MiB;
constexpr size_t WS_H2 = 514 * MiB;
constexpr size_t WS_YG = 546 * MiB;
constexpr size_t WS_WGUT = 690 * MiB;
constexpr size_t WS_WDNT = 818 * MiB;
constexpr size_t WS_WINT = 882 * MiB;
constexpr size_t WS_WUQT = 887 * MiB;
constexpr size_t WS_WUKVT = 888 * MiB;
constexpr size_t WS_WOUTT = 889 * MiB;
constexpr size_t WS_GATES = 891 * MiB;
constexpr size_t WS_STAT = 893 * MiB;
constexpr size_t WS_RSTD = 895 * MiB;
constexpr size_t WS_MIX16 = 896 * MiB;
constexpr size_t WS_END = 928 * MiB;
static_assert((size_t)MT * PW * 2 <= 153 * MiB && (size_t)RCAP * DFF * 2 <= 144 * MiB, "map");

constexpr int CW_BAR = 4096;
constexpr int CW_CNT = 16384;
constexpr int CW_QGU = 16384 + 64, CW_QDN = 16384 + 128;
constexpr int GU_CHUNKS = 512, DN_CHUNKS = 256;
#ifndef GU_STATIC
#define GU_STATIC 400
#endif

struct Params {
    const float* in[23];
    float* out;
    unsigned char* ws;
    int ph_lo, ph_hi;
};
enum { I_X = 0, I_C, I_CTX, I_CCTX, I_WMOD, I_BMOD, I_N1G, I_WIN, I_BG, I_QNG, I_WUQ, I_KVNG, I_WUKV, I_MNG, I_WOUT, I_N2G, I_RW, I_RB, I_WGU, I_BGU, I_WDN, I_BDN, I_FNG };

__device__ __forceinline__ float wave_sum(float v) {
#pragma unroll
    for (int o = 1; o < 64; o <<= 1) v += __shfl_xor(v, o);
    return v;
}
__device__ __forceinline__ float bf2f(unsigned short v) { return __uint_as_float(((unsigned)v) << 16); }
__device__ __forceinline__ float sigmoidf_(float x) { return 1.f / (1.f + __expf(-x)); }
__device__ __forceinline__ float siluf_(float x) { return x / (1.f + expf(-x)); }
__device__ __forceinline__ float logsigmoidf_(float x) { return fminf(x, 0.f) - log1pf(expf(-fabsf(x))); }

__device__ __forceinline__ void rope_angles(int s, int j, float& cs, float& sn) {
    const int jj = j & 7; const float pos = (j < 8) ? (float)(s / 64) : (float)(s % 64);
    const float inv = powf(10000.f, -(float)jj / 8.f);
    const float ang = pos * inv; cs = cosf(ang); sn = sinf(ang);
}

namespace pg8 {
#define PG8_LAS __attribute__((address_space(3)))
typedef unsigned short bf16_t;
typedef short bf16x8 __attribute__((ext_vector_type(8)));
typedef float f32x4 __attribute__((ext_vector_type(4)));
typedef unsigned u32x4 __attribute__((ext_vector_type(4)));
typedef unsigned u32x2 __attribute__((ext_vector_type(2)));
constexpr int BM = 256, BK = 64, HALF = 128, HTB = HALF * BK * 2, STAGE_BYTES = 8 * HTB, NXCD = 8, WGM = 8;
__host__ __device__ __forceinline__ int lds_byte(int r, int c) { const int st = (r >> 4) * 2 + (c >> 5), rr = r & 15, cc = c & 31, ob = rr * 64 + cc * 2; return st * 1024 + (ob ^ (((ob >> 9) & 1) << 5)); }
__host__ __device__ __forceinline__ void stage_rc(int b, int& R, int& C) { const int st = b / 1024, sb = b % 1024, swz = sb ^ (((sb >> 9) & 1) << 5); R = (st >> 1) * 16 + swz / 64; C = (st & 1) * 32 + (swz % 64) / 2; }
__host__ __device__ __forceinline__ int perm32(int rho) { const int n = rho >> 4, i = rho & 15; return 8 * (i >> 2) + 4 * n + (i & 3); }
__device__ __forceinline__ unsigned cvt_pk_bf16(float lo, float hi) { unsigned r; asm volatile("v_cvt_pk_bf16_f32 %0, %1, %2" : "=v"(r) : "v"(lo), "v"(hi)); return r; }

struct Unit { int pm, pn, g, row0; };

struct PlainSched {
    int nM, nN, nwg, G, c, lda, K; const char* Bt;
    __device__ void init(int M, int N, int K_, int lda_, const void* Bt_, int G_, int c_) { nM = M / BM; nN = N / BM; nwg = nM * nN; G = G_; c = c_; lda = lda_; K = K_; Bt = (const char*)Bt_; }
    __device__ __forceinline__ bool next(int i, Unit& u) const {
        const long L = (long)i * G + c; if (L >= nwg) return false;
        int wgid = (int)L; { const int q = nwg / NXCD, r = nwg % NXCD, xcd = wgid % NXCD, off = wgid / NXCD; wgid = (xcd < r ? xcd * (q + 1) : r * (q + 1) + (xcd - r) * q) + off; }
        const int nig = WGM * nN, gid = wgid / nig, fm = gid * WGM, gsz = (nM - fm) < WGM ? (nM - fm) : WGM;
        u.pm = fm + ((wgid % nig) % gsz); u.pn = (wgid % nig) / gsz; u.g = 0; u.row0 = u.pm * BM; return true;
    }
    __device__ __forceinline__ unsigned a_rowoff(const Unit& u, int r) const { return (unsigned)(u.pm * BM + r) * (unsigned)(lda * 2); }
    __device__ __forceinline__ void rows4(const Unit& u, int R0, int R1, unsigned (&o)[4]) const { o[0] = a_rowoff(u, R0); o[1] = a_rowoff(u, R1); o[2] = a_rowoff(u, HALF + R0); o[3] = a_rowoff(u, HALF + R1); }
    __device__ __forceinline__ const char* b_base(const Unit& u) const { return Bt + (size_t)u.pn * BM * K * 2; }
};

template <class Epi, class Sched, bool ALIGN_EPI, bool F8 = false>
__device__ __forceinline__ void gemm_phase(PG8_LAS unsigned char* lds, const bf16_t* Aptr, const int K, const Sched& S, const Epi& E) {
    const int tid = threadIdx.x, wid = __builtin_amdgcn_readfirstlane(tid >> 6), lane = tid & 63, wr = wid >> 2, wc = wid & 3, fr = lane & 15, fq = lane >> 4;
    const int nt = K / BK;
    unsigned voffB[2];
#pragma unroll
    for (int i = 0; i < 2; ++i) { int R, C; stage_rc(tid * 16 + i * 8192, R, C); const int Rb = Epi::PERM ? ((R & ~31) + perm32(R & 31)) : R;
        voffB[i] = (unsigned)(Rb * K + C) * 2u; }
    const size_t kstep = (size_t)(BK * 2);
    const size_t hstepB = (size_t)HALF * K * 2;
    const unsigned ldsw = (unsigned)wid * 1024u;
    const int aoff = lds_byte(wr * 64 + fr, fq * 8), boff = lds_byte(wc * 32 + fr, fq * 8);
#define PG8_SA(b, h) (((b) * 2 + (h)) * HTB)
#define PG8_SB(b, h) ((4 + (b) * 2 + (h)) * HTB)
#define PG8_STAGE(bufoff, gbase, voff) do { _Pragma("unroll") for (int _i = 0; _i < 2; ++_i) \
        __builtin_amdgcn_global_load_lds((const unsigned*)((const char*)(gbase) + (voff)[_i]), (PG8_LAS unsigned*)(lds + (bufoff) + ldsw + _i * 8192), 16, 0, 0); } while (0)
#define PG8_LDA(dst, b, h) do { _Pragma("unroll") for (int m = 0; m < 4; ++m) _Pragma("unroll") for (int k = 0; k < 2; ++k) dst[m][k] = *(const PG8_LAS bf16x8*)(lds + PG8_SA(b, h) + aoff + m * 2048 + k * 1024); } while (0)
#define PG8_LDB(dst, b, h) do { _Pragma("unroll") for (int n = 0; n < 2; ++n) _Pragma("unroll") for (int k = 0; k < 2; ++k) dst[n][k] = *(const PG8_LAS bf16x8*)(lds + PG8_SB(b, h) + boff + n * 2048 + k * 1024); } while (0)
typedef int i32x4v __attribute__((ext_vector_type(4)));
typedef int i32x8v __attribute__((ext_vector_type(8)));
#define PG8_CAT(x0, x1) __builtin_shufflevector(__builtin_bit_cast(i32x4v, x0), __builtin_bit_cast(i32x4v, x1), 0, 1, 2, 3, 4, 5, 6, 7)
#define PG8_MMA(ai, bj, At, Bt) do { __builtin_amdgcn_s_setprio(1); \
        if constexpr (F8) { _Pragma("unroll") for (int m = 0; m < 4; ++m) _Pragma("unroll") for (int n = 0; n < 2; ++n) \
            acc[ai][bj][m][n] = __builtin_amdgcn_mfma_scale_f32_16x16x128_f8f6f4(PG8_CAT(Bt[n][0], Bt[n][1]), PG8_CAT(At[m][0], At[m][1]), acc[ai][bj][m][n], 0, 0, 0, 0x79797979, 0, 0x7f7f7f7f); } \
        else { _Pragma("unroll") for (int m = 0; m < 4; ++m) _Pragma("unroll") for (int n = 0; n < 2; ++n) _Pragma("unroll") for (int k = 0; k < 2; ++k) \
            acc[ai][bj][m][n] = __builtin_amdgcn_mfma_f32_16x16x32_bf16(Bt[n][k], At[m][k], acc[ai][bj][m][n], 0, 0, 0); } \
        __builtin_amdgcn_s_setprio(0); } while (0)
#define PG8_WAIT_V(n) asm volatile("s_waitcnt vmcnt(" #n ")" ::: "memory")
#define PG8_WAIT_L(n) asm volatile("s_waitcnt lgkmcnt(" #n ")" ::: "memory")
#define PG8_BAR __builtin_amdgcn_s_barrier()
#define PG8_SCHED __builtin_amdgcn_sched_barrier(0)
    Unit cur, nxt; int ui = 0;
    if (!S.next(0, cur)) return;
    f32x4 acc[2][2][4][2];
#pragma unroll
    for (int a = 0; a < 2; ++a)
#pragma unroll
        for (int b = 0; b < 2; ++b)
#pragma unroll
            for (int m = 0; m < 4; ++m)
#pragma unroll
                for (int n = 0; n < 2; ++n) acc[a][b][m][n] = (f32x4){0.f, 0.f, 0.f, 0.f};
    bf16x8 At[4][2], B0[2][2], B1[2][2];
    unsigned oA0[2], oA1[2];
    { int R0, C0, R1, C1; stage_rc(tid * 16, R0, C0); stage_rc(tid * 16 + 8192, R1, C1); unsigned o4[4]; S.rows4(cur, R0, R1, o4);
      oA0[0] = o4[0] + (unsigned)C0 * 2u; oA0[1] = o4[1] + (unsigned)C1 * 2u; oA1[0] = o4[2] + (unsigned)C0 * 2u; oA1[1] = o4[3] + (unsigned)C1 * 2u; }
    const char* const cA = (const char*)Aptr;
    const char* cB = S.b_base(cur);
    PG8_STAGE(PG8_SB(0, 0), cB, voffB); PG8_STAGE(PG8_SB(0, 1), cB + hstepB, voffB); PG8_STAGE(PG8_SA(0, 0), cA, oA0); PG8_STAGE(PG8_SA(0, 1), cA, oA1);
    if (wr == 1) PG8_BAR;
    PG8_WAIT_V(2); PG8_BAR;
    PG8_STAGE(PG8_SB(1, 0), cB + kstep, voffB); PG8_STAGE(PG8_SA(1, 0), cA + kstep, oA0); PG8_STAGE(PG8_SB(1, 1), cB + hstepB + kstep, voffB);
    PG8_WAIT_V(6); PG8_BAR;
    for (;;) {
        const bool has_next = S.next(ui + 1, nxt);
        const char* nB = has_next ? S.b_base(nxt) : cB;
        unsigned pre[4] = {0u, 0u, 0u, 0u};
        if (has_next) { int R0, C0, R1, C1; stage_rc((int)threadIdx.x * 16, R0, C0); stage_rc((int)threadIdx.x * 16 + 8192, R1, C1); S.rows4(nxt, R0, R1, pre);
            asm volatile("" : "+v"(pre[0]), "+v"(pre[1]), "+v"(pre[2]), "+v"(pre[3])); }
#pragma unroll 1
        for (int t = 0; t < nt; t += 2) {
            const bool last = (t == nt - 2);
            const char* a1 = cA + (size_t)(t + 1) * kstep;
            const char* a2 = last ? cA : cA + (size_t)(t + 2) * kstep; const char* b2 = last ? nB : cB + (size_t)(t + 2) * kstep;
            const char* a3 = a2 + kstep; const char* b3 = b2 + kstep;
            PG8_LDB(B0, 0, 0); PG8_LDB(B1, 0, 1); PG8_SCHED; PG8_LDA(At, 0, 0); PG8_STAGE(PG8_SA(1, 1), a1, oA1);
            if (last && has_next) {
                int R0, C0, R1, C1; stage_rc((int)threadIdx.x * 16, R0, C0); stage_rc((int)threadIdx.x * 16 + 8192, R1, C1);
                oA0[0] = pre[0] + (unsigned)C0 * 2u; oA0[1] = pre[1] + (unsigned)C1 * 2u; oA1[0] = pre[2] + (unsigned)C0 * 2u; oA1[1] = pre[3] + (unsigned)C1 * 2u;
            }
            PG8_WAIT_V(8); PG8_WAIT_L(0); PG8_BAR; PG8_MMA(0, 0, At, B0); PG8_MMA(0, 1, At, B1); PG8_BAR; PG8_SCHED;
            PG8_LDA(At, 0, 1); PG8_STAGE(PG8_SB(0, 0), b2, voffB); PG8_STAGE(PG8_SB(0, 1), b2 + hstepB, voffB); PG8_STAGE(PG8_SA(0, 0), a2, oA0);
            PG8_WAIT_V(8); PG8_WAIT_L(0); PG8_BAR; PG8_MMA(1, 0, At, B0); PG8_MMA(1, 1, At, B1); PG8_BAR; PG8_SCHED;
            PG8_LDB(B0, 1, 0); PG8_LDB(B1, 1, 1); PG8_SCHED; PG8_LDA(At, 1, 0); PG8_STAGE(PG8_SA(0, 1), a2, oA1);
            PG8_WAIT_V(8); PG8_WAIT_L(0); PG8_BAR; PG8_MMA(0, 0, At, B0); PG8_MMA(0, 1, At, B1); PG8_BAR; PG8_SCHED;
            PG8_LDA(At, 1, 1); PG8_STAGE(PG8_SB(1, 0), b3, voffB); PG8_STAGE(PG8_SB(1, 1), b3 + hstepB, voffB); PG8_STAGE(PG8_SA(1, 0), a3, oA0);
            PG8_WAIT_V(8); PG8_WAIT_L(0); PG8_BAR; PG8_MMA(1, 0, At, B0); PG8_MMA(1, 1, At, B1); PG8_BAR; PG8_SCHED;
        }
        if constexpr (ALIGN_EPI) { if (wr == 0) PG8_BAR; }
        E(acc, cur, wr, wc, fr, fq);
        if (!has_next) break;
#pragma unroll
        for (int a = 0; a < 2; ++a)
#pragma unroll
            for (int b = 0; b < 2; ++b)
#pragma unroll
                for (int m = 0; m < 4; ++m)
#pragma unroll
                    for (int n = 0; n < 2; ++n) acc[a][b][m][n] = (f32x4){0.f, 0.f, 0.f, 0.f};
        cur = nxt; cB = nB; ++ui;
        if constexpr (ALIGN_EPI) { if (wr == 1) PG8_BAR; }
    }
    PG8_WAIT_V(0);
    if constexpr (!ALIGN_EPI) { if (wr == 0) PG8_BAR; }
    PG8_BAR;
#undef PG8_SA
#undef PG8_SB
#undef PG8_STAGE
#undef PG8_LDA
#undef PG8_LDB
#undef PG8_MMA
#undef PG8_CAT
#undef PG8_WAIT_V
#undef PG8_WAIT_L
#undef PG8_BAR
#undef PG8_SCHED
}

struct MoeSched {
    const PG8_LAS int* tp; const PG8_LAS int* ro; const PG8_LAS int* cn; int nN, G, c, K, lda, gather; const int* list; const char* Bt; size_t bstride;
    __device__ __forceinline__ bool next(int i, Unit& u) const {
        const int nwg = tp[32] * nN; const long L = (long)i * G + c; if (L >= nwg) return false;
        int wgid = (int)L; { const int q = nwg / NXCD, r = nwg % NXCD, xcd = wgid % NXCD, off = wgid / NXCD; wgid = (xcd < r ? xcd * (q + 1) : r * (q + 1) + (xcd - r) * q) + off; }
        const int tile = wgid / nN;
        const int g = __popcll(__ballot(tp[threadIdx.x & 31] <= tile) & 0xffffffffull) - 1;
        const int ntm = tp[g + 1] - tp[g]; const int rem = wgid - tp[g] * nN;
        u.g = g; u.pm = rem % ntm; u.pn = rem / ntm; u.row0 = ro[g] + u.pm * BM; return true;
    }
    __device__ __forceinline__ unsigned a_rowoff(const Unit& u, int r) const {
        const int rr = u.pm * BM + r;
        if (gather) { const int tok = (rr < cn[u.g]) ? list[u.g * 16384 + rr] : 0; return (unsigned)tok * (unsigned)(lda * 2); }
        return (unsigned)(u.row0 + r) * (unsigned)(lda * 2);
    }
    __device__ __forceinline__ void rows4(const Unit& u, int R0, int R1, unsigned (&o)[4]) const {
        if (gather) { const int last = cn[u.g] - 1, b0 = u.pm * BM; const int* lp = list + u.g * 16384;
            const int t0 = lp[min(b0 + R0, last)], t1 = lp[min(b0 + R1, last)], t2 = lp[min(b0 + HALF + R0, last)], t3 = lp[min(b0 + HALF + R1, last)];
            o[0] = (unsigned)t0 * (unsigned)(lda * 2); o[1] = (unsigned)t1 * (unsigned)(lda * 2); o[2] = (unsigned)t2 * (unsigned)(lda * 2); o[3] = (unsigned)t3 * (unsigned)(lda * 2); }
        else { o[0] = a_rowoff(u, R0); o[1] = a_rowoff(u, R1); o[2] = a_rowoff(u, HALF + R0); o[3] = a_rowoff(u, HALF + R1); }
    }
    __device__ __forceinline__ const char* b_base(const Unit& u) const { return Bt + (size_t)u.g * bstride + (size_t)u.pn * BM * K * 2; }
};
struct EpiSwiglu {
    static constexpr bool PERM = true;
    bf16_t* O; const float* bias;
    __device__ __forceinline__ void operator()(const f32x4 (&acc)[2][2][4][2], const Unit& u, int wr, int wc, int fr, int fq) const {
        const int row0 = u.row0 + wr * 64 + fr, col0 = u.pn * 128 + wc * 32 + 8 * fq;
        const float* bg = bias + (size_t)u.g * 2048 + col0;
        f32x4 bgl[2], bln[2];
#pragma unroll
        for (int n = 0; n < 2; ++n) { bgl[n] = *(const f32x4*)(bg + 4 * n); bln[n] = *(const f32x4*)(bg + 1024 + 4 * n) + 1.0f; }
#pragma unroll
        for (int ai = 0; ai < 2; ++ai)
#pragma unroll
            for (int m = 0; m < 4; ++m) {
                float o[8];
#pragma unroll
                for (int n = 0; n < 2; ++n)
#pragma unroll
                    for (int jp = 0; jp < 2; ++jp) {
                        typedef float f32x2 __attribute__((ext_vector_type(2)));
                        f32x2 g = (f32x2){acc[ai][0][m][n][2 * jp], acc[ai][0][m][n][2 * jp + 1]} + (f32x2){bgl[n][2 * jp], bgl[n][2 * jp + 1]};
                        f32x2 l = (f32x2){acc[ai][1][m][n][2 * jp], acc[ai][1][m][n][2 * jp + 1]} + (f32x2){bln[n][2 * jp], bln[n][2 * jp + 1]};
                        g.x = fminf(g.x, 7.f); g.y = fminf(g.y, 7.f);
                        l.x = __builtin_amdgcn_fmed3f(l.x, -6.f, 8.f); l.y = __builtin_amdgcn_fmed3f(l.y, -6.f, 8.f);
                        const f32x2 t = g * (-1.702f * 1.4426950408889634f);
                        f32x2 d; d.x = __builtin_amdgcn_exp2f(t.x); d.y = __builtin_amdgcn_exp2f(t.y); d = d + 1.0f;
                        f32x2 r; r.x = __builtin_amdgcn_rcpf(d.x); r.y = __builtin_amdgcn_rcpf(d.y);
                        const f32x2 res = (g * r) * l;
                        o[4 * n + 2 * jp] = res.x; o[4 * n + 2 * jp + 1] = res.y;
                    }
#if MOE_FP8
                u32x2 w8; { int t0 = __builtin_amdgcn_cvt_pk_fp8_f32(o[0], o[1], 0, false); t0 = __builtin_amdgcn_cvt_pk_fp8_f32(o[2], o[3], t0, true); int t1 = __builtin_amdgcn_cvt_pk_fp8_f32(o[4], o[5], 0, false); t1 = __builtin_amdgcn_cvt_pk_fp8_f32(o[6], o[7], t1, true); w8.x = (unsigned)t0; w8.y = (unsigned)t1; }
                *(u32x2*)((unsigned char*)O + (size_t)(row0 + ai * HALF + m * 16) * 1024 + col0) = w8;
#else
                u32x4 w; w.x = cvt_pk_bf16(o[0], o[1]); w.y = cvt_pk_bf16(o[2], o[3]); w.z = cvt_pk_bf16(o[4], o[5]); w.w = cvt_pk_bf16(o[6], o[7]);
                *(u32x4*)(O + (size_t)(row0 + ai * HALF + m * 16) * 1024 + col0) = w;
#endif
            }
    }
};
struct EpiDown {
    static constexpr bool PERM = true;
    bf16_t* O; const float* bias; const float* rgate; const PG8_LAS int* ro;
    __device__ __forceinline__ void operator()(const f32x4 (&acc)[2][2][4][2], const Unit& u, int wr, int wc, int fr, int fq) const {
        const int row0 = u.row0 + wr * 64 + fr, col0 = u.pn * BM + wc * 32 + 8 * fq;
        const float* bd = bias + (size_t)u.g * 1024 + col0;
        const float* gt = rgate + (size_t)u.g * 16384 + (row0 - ro[u.g]);
        f32x4 bv[2][2];
#pragma unroll
        for (int bj = 0; bj < 2; ++bj)
#pragma unroll
            for (int n = 0; n < 2; ++n) bv[bj][n] = *(const f32x4*)(bd + bj * HALF + 4 * n);
        float gva[2][4];
#pragma unroll
        for (int ai = 0; ai < 2; ++ai)
#pragma unroll
            for (int m = 0; m < 4; ++m) gva[ai][m] = gt[ai * HALF + m * 16];
#pragma unroll
        for (int ai = 0; ai < 2; ++ai)
#pragma unroll
            for (int m = 0; m < 4; ++m) {
                const float gv = gva[ai][m];
                bf16_t* rowp = O + (size_t)(row0 + ai * HALF + m * 16) * 1024 + col0;
#pragma unroll
                for (int bj = 0; bj < 2; ++bj) { const f32x4 v0 = (acc[ai][bj][m][0] + bv[bj][0]) * gv, v1 = (acc[ai][bj][m][1] + bv[bj][1]) * gv;
                    u32x4 w; w.x = cvt_pk_bf16(v0[0], v0[1]); w.y = cvt_pk_bf16(v0[2], v0[3]); w.z = cvt_pk_bf16(v1[0], v1[1]); w.w = cvt_pk_bf16(v1[2], v1[3]);
                    *(u32x4*)(rowp + bj * HALF) = w; }
            }
    }
};
struct EpiInproj {
    static constexpr bool PERM = true;
    bf16_t* P; float* gates; float* stat; bf16_t* Kb; const float* cs; const float* sn;
    __device__ __forceinline__ void operator()(const f32x4 (&acc)[2][2][4][2], const Unit& u, int wr, int wc, int fr, int fq) const {
        const int row0 = u.row0 + wr * 64 + fr, colb = u.pn * BM + wc * 32 + 8 * fq;
#pragma unroll
        for (int ai = 0; ai < 2; ++ai)
#pragma unroll
            for (int m = 0; m < 4; ++m) { const int row = row0 + ai * HALF + m * 16;
#pragma unroll
                for (int bj = 0; bj < 2; ++bj) { const f32x4 v0 = acc[ai][bj][m][0], v1 = acc[ai][bj][m][1];
                    u32x4 w; w.x = cvt_pk_bf16(v0[0], v0[1]); w.y = cvt_pk_bf16(v0[2], v0[3]); w.z = cvt_pk_bf16(v1[0], v1[1]); w.w = cvt_pk_bf16(v1[2], v1[3]);
                    *(u32x4*)(P + (size_t)row * 2304 + colb + bj * HALF) = w;
                    if (u.pn <= 2) { float sq = (v0[0] * v0[0] + v0[1] * v0[1]) + (v0[2] * v0[2] + v0[3] * v0[3]) + (v1[0] * v1[0] + v1[1] * v1[1]) + (v1[2] * v1[2] + v1[3] * v1[3]);
                        sq += __shfl_xor(sq, 16); sq += __shfl_xor(sq, 32);
                        if (fq == 0) stat[(size_t)row * 24 + (u.pn * 2 + bj) * 4 + wc] = sq; }
                    if (u.pn == 8 && bj == 1 && wc == 1 && fq < 2) { *(f32x4*)(gates + (size_t)row * 16 + fq * 8) = v0; *(f32x4*)(gates + (size_t)row * 16 + fq * 8 + 4) = v1; }
                    if (u.pn == 2 && bj == 1 && wc == 0) {
                        f32x4 r0 = v0, r1 = v1;
                        f32x4 o0, o1;
#pragma unroll
                        for (int j = 0; j < 4; ++j) { o0[j] = __shfl_xor(v0[j], 32); o1[j] = __shfl_xor(v1[j], 32); }
                        int krow;
                        if (row < 16384) { const int pos = row & 4095; const int jb = 8 * (fq & 1);
                            const f32x4 c0 = *(const f32x4*)(cs + pos * 16 + jb), c1 = *(const f32x4*)(cs + pos * 16 + jb + 4), s0 = *(const f32x4*)(sn + pos * 16 + jb), s1 = *(const f32x4*)(sn + pos * 16 + jb + 4);
                            if (fq < 2) { r0 = v0 * c0 - o0 * s0; r1 = v1 * c1 - o1 * s1; } else { r0 = o0 * s0 + v0 * c0; r1 = o1 * s1 + v1 * c1; }
                            krow = (row >> 12) * 4352 + 256 + pos; }
                        else krow = ((row - 16384) >> 8) * 4352 + ((row - 16384) & 255);
                        u32x4 kw; kw.x = cvt_pk_bf16(r0[0], r0[1]); kw.y = cvt_pk_bf16(r0[2], r0[3]); kw.z = cvt_pk_bf16(r1[0], r1[1]); kw.w = cvt_pk_bf16(r1[2], r1[3]);
#pragma unroll
                        for (int hh = 0; hh < 8; ++hh) *(u32x4*)(Kb + (size_t)krow * 768 + hh * 96 + 64 + 8 * fq) = kw;
                    }
                } }
    }
};
struct EpiResid {
    static constexpr bool PERM = true;
    bf16_t* C; const float* X; const float* mod; float* stat2;
    __device__ __forceinline__ void operator()(const f32x4 (&acc)[2][2][4][2], const Unit& u, int wr, int wc, int fr, int fq) const {
        const int row0 = u.row0 + wr * 64 + fr, col0 = u.pn * BM + wc * 32 + 8 * fq;
        const float* g1 = mod + (size_t)(u.row0 / 4096) * 6144 + 2048 + col0;
        f32x4 gv[2][2];
#pragma unroll
        for (int bj = 0; bj < 2; ++bj)
#pragma unroll
            for (int n = 0; n < 2; ++n) gv[bj][n] = *(const f32x4*)(g1 + bj * HALF + 4 * n);
#pragma unroll
        for (int ai = 0; ai < 2; ++ai)
#pragma unroll
            for (int m = 0; m < 4; ++m) { const size_t off = (size_t)(row0 + ai * HALF + m * 16) * 1024 + col0;
#pragma unroll
                for (int bj = 0; bj < 2; ++bj) {
                    const f32x4 x0 = *(const f32x4*)(X + off + bj * HALF), x1 = *(const f32x4*)(X + off + bj * HALF + 4);
                    const f32x4 o0 = x0 + gv[bj][0] * acc[ai][bj][m][0], o1 = x1 + gv[bj][1] * acc[ai][bj][m][1];
                    u32x4 w; w.x = cvt_pk_bf16(o0[0], o0[1]); w.y = cvt_pk_bf16(o0[2], o0[3]); w.z = cvt_pk_bf16(o1[0], o1[1]); w.w = cvt_pk_bf16(o1[2], o1[3]);
                    *(u32x4*)(C + off + bj * HALF) = w;
                    float sq = ((o0[0] * o0[0] + o0[1] * o0[1]) + (o0[2] * o0[2] + o0[3] * o0[3])) + ((o1[0] * o1[0] + o1[1] * o1[1]) + (o1[2] * o1[2] + o1[3] * o1[3]));
                    sq += __shfl_xor(sq, 16); sq += __shfl_xor(sq, 32);
                    if (fq == 0) stat2[(size_t)(row0 + ai * HALF + m * 16) * 32 + (u.pn * 2 + bj) * 4 + wc] = sq; }
                if (m & 1) asm volatile("" ::: "memory"); }
    }
};
struct EpiQ {
    static constexpr bool PERM = false;
    bf16_t* Q; const float* stat; const float* cs; const float* sn;
    __device__ __forceinline__ void operator()(const f32x4 (&acc)[2][2][4][2], const Unit& u, int wr, int wc, int fr, int fq) const {
        const int row0 = u.row0 + wr * 64 + fr;
#pragma unroll
        for (int ai = 0; ai < 2; ++ai)
#pragma unroll
            for (int m = 0; m < 4; ++m) { const int row = row0 + ai * HALF + m * 16; const int pos = row & 4095;
                float sc; { const f32x4* sp = (const f32x4*)(stat + (size_t)row * 24); const f32x4 a0 = sp[0], a1 = sp[1], a2 = sp[2];
                    sc = rsqrtf((((a0[0] + a0[1]) + (a0[2] + a0[3])) + ((a1[0] + a1[1]) + (a1[2] + a1[3])) + ((a2[0] + a2[1]) + (a2[2] + a2[3]))) * (1.f / 384.f) + 1e-6f) * 0.14724445f; }
                const f32x4 cv = *(const f32x4*)(cs + pos * 16 + 4 * fq), sv = *(const f32x4*)(sn + pos * 16 + 4 * fq);
#pragma unroll
                for (int bj = 0; bj < 2; ++bj) { const int c32 = u.pn * BM + bj * HALF + wc * 32; const bool rope = ((c32 % 96) == 64);
                    f32x4 v0 = acc[ai][bj][m][0], v1 = acc[ai][bj][m][1];
                    if (rope) { const f32x4 a = v0 * cv - v1 * sv, b = v0 * sv + v1 * cv; v0 = a; v1 = b; }
                    v0 = v0 * sc; v1 = v1 * sc;
                    u32x2 w0, w1; w0.x = cvt_pk_bf16(v0[0], v0[1]); w0.y = cvt_pk_bf16(v0[2], v0[3]); w1.x = cvt_pk_bf16(v1[0], v1[1]); w1.y = cvt_pk_bf16(v1[2], v1[3]);
                    bf16_t* dst = Q + (size_t)row * 768 + c32 + 4 * fq;
                    *(u32x2*)dst = w0; *(u32x2*)(dst + 16) = w1; }
                asm volatile("" ::: "memory"); }
    }
};
struct EpiKV {
    static constexpr bool PERM = true;
    bf16_t* K; bf16_t* V; const float* stat;
    __device__ __forceinline__ void operator()(const f32x4 (&acc)[2][2][4][2], const Unit& u, int wr, int wc, int fr, int fq) const {
        const int row0 = u.row0 + wr * 64 + fr;
#pragma unroll
        for (int ai = 0; ai < 2; ++ai)
#pragma unroll
            for (int m = 0; m < 4; ++m) { const int row = row0 + ai * HALF + m * 16;
                float sc; { const f32x4* sp = (const f32x4*)(stat + (size_t)row * 24); const f32x4 a3 = sp[3], a4 = sp[4];
                    sc = rsqrtf((((a3[0] + a3[1]) + (a3[2] + a3[3])) + ((a4[0] + a4[1]) + (a4[2] + a4[3]))) * (1.f / 256.f) + 1e-6f); }
                const int krow = (row < 16384) ? ((row >> 12) * 4352 + 256 + (row & 4095)) : (((row - 16384) >> 8) * 4352 + ((row - 16384) & 255));
#pragma unroll
                for (int bj = 0; bj < 2; ++bj) { const int head = 2 * u.pn + bj; const f32x4 v0 = acc[ai][bj][m][0] * sc, v1 = acc[ai][bj][m][1] * sc;
                    u32x4 w; w.x = cvt_pk_bf16(v0[0], v0[1]); w.y = cvt_pk_bf16(v0[2], v0[3]); w.z = cvt_pk_bf16(v1[0], v1[1]); w.w = cvt_pk_bf16(v1[2], v1[3]);
                    if (wc < 2) *(u32x4*)(K + (size_t)krow * 768 + head * 96 + wc * 32 + 8 * fq) = w;
                    else *(u32x4*)(V + (size_t)krow * 512 + head * 64 + (wc - 2) * 32 + 8 * fq) = w; }
                asm volatile("" ::: "memory"); }
    }
};
}

template <class RowMap>
__device__ __forceinline__ void transpose_item(const float* W, int K, int N, int nblk, unsigned short* WT, const RowMap& rowmap, LAS float* scr, int item, int lane, const float* kscale = nullptr) {
    const int kb = item / nblk, nb = item % nblk, k0 = 64 * kb, n0 = 32 * nb;
    const int ncol = n0 + (lane & 31);
    float tv[32];
#pragma unroll
    for (int i = 0; i < 32; ++i) { const int kk = 2 * i + (lane >> 5); tv[i] = (ncol < N) ? __builtin_nontemporal_load(W + (size_t)(k0 + kk) * N + ncol) : 0.f; }
    if (kscale) {
#pragma unroll
        for (int i = 0; i < 32; ++i) tv[i] *= kscale[k0 + 2 * i + (lane >> 5)]; }
#pragma unroll
    for (int i = 0; i < 32; ++i) scr[(2 * i + (lane >> 5)) * 33 + (lane & 31)] = tv[i];
    asm volatile("s_waitcnt lgkmcnt(0)" ::: "memory");
    const int c = lane & 7;
    const int r0 = rowmap(n0);
#pragma unroll
    for (int j = 0; j < 4; ++j) { const int n = (lane >> 3) + 8 * j; const LAS float* sp = scr + (8 * c) * 33 + n;
        pg8::u32x4 o; o.x = pg8::cvt_pk_bf16(sp[0 * 33], sp[1 * 33]); o.y = pg8::cvt_pk_bf16(sp[2 * 33], sp[3 * 33]); o.z = pg8::cvt_pk_bf16(sp[4 * 33], sp[5 * 33]); o.w = pg8::cvt_pk_bf16(sp[6 * 33], sp[7 * 33]);
        __builtin_nontemporal_store(o, (pg8::u32x4*)(WT + (size_t)(r0 + n) * K + k0 + 8 * c)); }
    asm volatile("s_waitcnt lgkmcnt(0)" ::: "memory");
}


namespace att {
using bf16x8 = __attribute__((ext_vector_type(8))) short;
using s16x4  = __attribute__((ext_vector_type(4))) short;
using f32x16 = __attribute__((ext_vector_type(16))) float;
using u32x4  = __attribute__((ext_vector_type(4))) unsigned;
constexpr int NW = 8, QBLK = 32, KVBLK = 64;
constexpr float SCALE = 0.10206207261596577f;
constexpr float THR = 8.f;
constexpr int LDQ = 768, LDK = 768, LDV = 512, LDO = 1024;
constexpr int SHM_V = KVBLK * 64 * 2, SHM_K = KVBLK * 256;
constexpr int SHM_ATTN = 3 * SHM_V + 3 * SHM_K + NW * 64 * 4;
#define KSWZ(row, colB) ((row) * 256 + ((colB) ^ (((row) & 7) << 4)))
#define SBAR() __builtin_amdgcn_sched_barrier(0)
__device__ __forceinline__ int crow(int r, int hi) { return (r & 3) + 8 * (r >> 2) + 4 * hi; }
__device__ __forceinline__ unsigned cvtpk(float lo, float hi) { unsigned r; asm volatile("v_cvt_pk_bf16_f32 %0, %1, %2" : "=v"(r) : "v"(lo), "v"(hi)); return r; }

constexpr float THR2 = THR * 1.4426950408889634f;
__device__ __forceinline__ void partialSM(f32x16& p0, f32x16& p1, float& m_run, float& alpha) {
  float pmax = p0[0]; for (int r = 1; r < 16; ++r) pmax = fmaxf(pmax, p0[r]); for (int r = 0; r < 16; ++r) pmax = fmaxf(pmax, p1[r]);
  { auto rr = __builtin_amdgcn_permlane32_swap(__float_as_uint(pmax), __float_as_uint(pmax), false, false);
    pmax = fmaxf(__uint_as_float(rr[0]), __uint_as_float(rr[1])); }
  if (__builtin_expect(__all(fabsf(pmax) <= THR2), 1)) { alpha = 1.f; }
  else { m_run += pmax; alpha = __builtin_amdgcn_exp2f(-pmax);
    for (int r = 0; r < 16; ++r) p0[r] -= pmax; for (int r = 0; r < 16; ++r) p1[r] -= pmax; }
  for (int r = 0; r < 16; ++r) p0[r] = __builtin_amdgcn_exp2f(p0[r]);
}
__device__ __forceinline__ void finishSM(f32x16& p0, f32x16& p1, float alpha, float& l_reg, bf16x8& pa0, bf16x8& pa1, bf16x8& pa2, bf16x8& pa3) {
  for (int r = 0; r < 16; ++r) p1[r] = __builtin_amdgcn_exp2f(p1[r]);
  float ps = 0; for (int r = 0; r < 16; ++r) ps += p0[r]; for (int r = 0; r < 16; ++r) ps += p1[r];
  { auto rr = __builtin_amdgcn_permlane32_swap(__float_as_uint(ps), __float_as_uint(ps), false, false);
    ps = __uint_as_float(rr[0]) + __uint_as_float(rr[1]); }
  l_reg = l_reg * alpha + ps;
#define PK4(P, BASE, OUT) do { u32x4 w = {cvtpk(P[BASE + 0], P[BASE + 1]), cvtpk(P[BASE + 2], P[BASE + 3]), cvtpk(P[BASE + 4], P[BASE + 5]), cvtpk(P[BASE + 6], P[BASE + 7])}; OUT = *reinterpret_cast<bf16x8*>(&w); } while (0)
  PK4(p0, 0, pa0); PK4(p0, 8, pa1); PK4(p1, 0, pa2); PK4(p1, 8, pa3);
#undef PK4
}
__device__ __forceinline__ void qkt(f32x16& p0, f32x16& p1, const char* Ks, const bf16x8* qr, int r32, int hi, float m_run) {
#pragma unroll
  for (int r = 0; r < 16; ++r) { p0[r] = -m_run; p1[r] = -m_run; }
#pragma unroll
  for (int d0 = 0; d0 < 6; ++d0) { int cb = (d0 * 16 + hi * 8) * 2;
    bf16x8 b0 = *reinterpret_cast<const bf16x8*>(Ks + KSWZ(r32, cb));
    bf16x8 b1 = *reinterpret_cast<const bf16x8*>(Ks + KSWZ(32 + r32, cb));
    p0 = __builtin_amdgcn_mfma_f32_32x32x16_bf16(b0, qr[d0], p0, 0, 0, 0);
    p1 = __builtin_amdgcn_mfma_f32_32x32x16_bf16(b1, qr[d0], p1, 0, 0, 0); }
}
__device__ __forceinline__ int v_st(int k, int c) { const int kk = k; return ((kk >> 3) * 2 + (c >> 5)) * 512 + ((kk & 7) * 32 + (c & 31)) * 2; }
__device__ __forceinline__ int v_rd_base(int lane) { return ((lane & 3) << 3) | (((lane >> 2) & 3) << 6) | (((lane >> 4) & 1) << 5) | (((lane >> 5) & 1) << 8); }
constexpr int v_rd_off(int d0, int ks, int half) { return d0 * 512 + ks * 2048 + half * 1024; }
template <int OFF> __device__ __forceinline__ s16x4 tr_read(int vb) {
  s16x4 r; asm volatile("ds_read_b64_tr_b16 %0, %1 offset:%2" : "=&v"(r) : "v"(vb), "i"(OFF) : "memory"); return r;
}
template <int D0> __device__ __forceinline__ void pv_one(f32x16& od, int vb, bf16x8 pa0, bf16x8 pa1, bf16x8 pa2, bf16x8 pa3) {
  const s16x4 l0 = tr_read<v_rd_off(D0, 0, 0)>(vb), h0 = tr_read<v_rd_off(D0, 0, 1)>(vb), l1 = tr_read<v_rd_off(D0, 1, 0)>(vb), h1 = tr_read<v_rd_off(D0, 1, 1)>(vb);
  const s16x4 l2 = tr_read<v_rd_off(D0, 2, 0)>(vb), h2 = tr_read<v_rd_off(D0, 2, 1)>(vb), l3 = tr_read<v_rd_off(D0, 3, 0)>(vb), h3 = tr_read<v_rd_off(D0, 3, 1)>(vb);
  asm volatile("s_waitcnt lgkmcnt(0)" ::: "memory"); SBAR();
#define PK(L, H) (bf16x8){L[0], L[1], L[2], L[3], H[0], H[1], H[2], H[3]}
  od = __builtin_amdgcn_mfma_f32_32x32x16_bf16(pa0, PK(l0, h0), od, 0, 0, 0);
  od = __builtin_amdgcn_mfma_f32_32x32x16_bf16(pa1, PK(l1, h1), od, 0, 0, 0);
  od = __builtin_amdgcn_mfma_f32_32x32x16_bf16(pa2, PK(l2, h2), od, 0, 0, 0);
  od = __builtin_amdgcn_mfma_f32_32x32x16_bf16(pa3, PK(l3, h3), od, 0, 0, 0);
#undef PK
}
__device__ __forceinline__ void pv_d0(f32x16* o, int vb, bf16x8 pa0, bf16x8 pa1, bf16x8 pa2, bf16x8 pa3) {
  const s16x4 a0 = tr_read<v_rd_off(0, 0, 0)>(vb), a1 = tr_read<v_rd_off(0, 0, 1)>(vb), a2 = tr_read<v_rd_off(0, 1, 0)>(vb), a3 = tr_read<v_rd_off(0, 1, 1)>(vb);
  const s16x4 a4 = tr_read<v_rd_off(0, 2, 0)>(vb), a5 = tr_read<v_rd_off(0, 2, 1)>(vb), a6 = tr_read<v_rd_off(0, 3, 0)>(vb), a7 = tr_read<v_rd_off(0, 3, 1)>(vb);
  const s16x4 c0 = tr_read<v_rd_off(1, 0, 0)>(vb), c1 = tr_read<v_rd_off(1, 0, 1)>(vb), c2 = tr_read<v_rd_off(1, 1, 0)>(vb), c3 = tr_read<v_rd_off(1, 1, 1)>(vb);
  const s16x4 c4 = tr_read<v_rd_off(1, 2, 0)>(vb), c5 = tr_read<v_rd_off(1, 2, 1)>(vb), c6 = tr_read<v_rd_off(1, 3, 0)>(vb), c7 = tr_read<v_rd_off(1, 3, 1)>(vb);
  asm volatile("s_waitcnt lgkmcnt(0)" ::: "memory"); SBAR();
#define PK(L, H) (bf16x8){L[0], L[1], L[2], L[3], H[0], H[1], H[2], H[3]}
  o[0] = __builtin_amdgcn_mfma_f32_32x32x16_bf16(pa0, PK(a0, a1), o[0], 0, 0, 0); o[1] = __builtin_amdgcn_mfma_f32_32x32x16_bf16(pa0, PK(c0, c1), o[1], 0, 0, 0);
  o[0] = __builtin_amdgcn_mfma_f32_32x32x16_bf16(pa1, PK(a2, a3), o[0], 0, 0, 0); o[1] = __builtin_amdgcn_mfma_f32_32x32x16_bf16(pa1, PK(c2, c3), o[1], 0, 0, 0);
  o[0] = __builtin_amdgcn_mfma_f32_32x32x16_bf16(pa2, PK(a4, a5), o[0], 0, 0, 0); o[1] = __builtin_amdgcn_mfma_f32_32x32x16_bf16(pa2, PK(c4, c5), o[1], 0, 0, 0);
  o[0] = __builtin_amdgcn_mfma_f32_32x32x16_bf16(pa3, PK(a6, a7), o[0], 0, 0, 0); o[1] = __builtin_amdgcn_mfma_f32_32x32x16_bf16(pa3, PK(c6, c7), o[1], 0, 0, 0);
#undef PK
}
__device__ __forceinline__ void attn_body(const unsigned short* __restrict__ Qb, const unsigned short* __restrict__ Kh, const unsigned short* __restrict__ Vh,
                                          unsigned short* __restrict__ Ob, int seq, char* lds) {
  const int tid = threadIdx.x, wid = tid >> 6, lane = tid & 63, r32 = lane & 31, hi = lane >> 5;
  char* V_lds = lds; char* K_lds = lds + 3 * SHM_V;
  float* ws = (float*)(lds + 3 * SHM_V + 3 * SHM_K) + wid * 64; float* li_l = ws; float* al_l = ws + 32;
  float m_run = 0.f, l_reg = 0; f32x16 o[2] = {}; bf16x8 qr[6];
  const unsigned short* Qw = Qb + (long)(wid * QBLK + r32) * LDQ + hi * 8;
#pragma unroll
  for (int d0 = 0; d0 < 6; ++d0) qr[d0] = *reinterpret_cast<const bf16x8*>(Qw + d0 * 16);
  const int vr = tid >> 3, vc = (tid & 7) * 8, vst = v_st(vr, vc);
  const int k0r = tid / 12, k0c = tid % 12, id1 = 512 + (tid & 255), k1r = id1 / 12, k1c = id1 % 12;
  const int kst0 = KSWZ(k0r, k0c * 16), kst1 = KSWZ(k1r, k1c * 16);
  const long vg = (long)vr * LDV + vc, kg0 = (long)k0r * LDK + k0c * 8, kg1 = (long)k1r * LDK + k1c * 8;
  const int vb0 = (int)(uintptr_t)V_lds + v_rd_base(lane);
  struct { bf16x8 vs, ks0, ks1; } sr_[2];
#define SLOAD(i, kk0) do { sr_[i].vs = *reinterpret_cast<const bf16x8*>(Vh + (long)(kk0) * LDV + vg); \
    sr_[i].ks0 = *reinterpret_cast<const bf16x8*>(Kh + (long)(kk0) * LDK + kg0); sr_[i].ks1 = *reinterpret_cast<const bf16x8*>(Kh + (long)(kk0) * LDK + kg1); } while (0)
#define SWRITE(b, i) do { *(bf16x8*)(V_lds + (b) * SHM_V + vst) = sr_[i].vs; \
    *(bf16x8*)(K_lds + (b) * SHM_K + kst0) = sr_[i].ks0; *(bf16x8*)(K_lds + (b) * SHM_K + kst1) = sr_[i].ks1; } while (0)
#define SWAIT() asm volatile("s_waitcnt vmcnt(3)" ::: "memory")
#define RESC(a) do { if (__any((a) < 1.f)) { if (hi == 0) al_l[r32] = (a); asm volatile("s_waitcnt lgkmcnt(0)" ::: "memory"); \
    for (int d = 0; d < 2; ++d) for (int r = 0; r < 16; ++r) o[d][r] *= al_l[crow(r, hi)]; } } while (0)
  f32x16 pA0, pA1, pB0, pB1; float alA, alB; bf16x8 pa0, pa1, pa2, pa3; const int NT = seq / KVBLK;
  constexpr int SE = 0, SO = 1;
  SLOAD(SE, 0); asm volatile("s_waitcnt vmcnt(0)" ::: "memory"); SWRITE(0, SE); __syncthreads();
  qkt(pA0, pA1, K_lds, qr, r32, hi, m_run); partialSM(pA0, pA1, m_run, alA);
  SLOAD(SO, KVBLK); if (2 < NT) SLOAD(SE, 2 * KVBLK);
  SWAIT(); SWRITE(1, SO); __syncthreads();
  int b0 = 0, b1 = 1, b2 = 2;
  for (int j = 1; j + 1 < NT; j += 2) {
    SBAR(); qkt(pB0, pB1, K_lds + b1 * SHM_K, qr, r32, hi, m_run);
    finishSM(pA0, pA1, alA, l_reg, pa0, pa1, pa2, pa3); SBAR();
    SLOAD(SO, (j + 2) * KVBLK); SBAR();
    pv_d0(o, vb0 + b0 * SHM_V, pa0, pa1, pa2, pa3); partialSM(pB0, pB1, m_run, alB);
    SWAIT(); SWRITE(b2, SE);
    RESC(alB); __syncthreads();
    SBAR(); qkt(pA0, pA1, K_lds + b2 * SHM_K, qr, r32, hi, m_run);
    finishSM(pB0, pB1, alB, l_reg, pa0, pa1, pa2, pa3); SBAR();
    if (j + 3 < NT) SLOAD(SE, (j + 3) * KVBLK); SBAR();
    pv_d0(o, vb0 + b1 * SHM_V, pa0, pa1, pa2, pa3); partialSM(pA0, pA1, m_run, alA);
    SWAIT(); SWRITE(b0, SO);
    RESC(alA); __syncthreads();
    { const int t0 = b0; b0 = b2; b2 = b1; b1 = t0; }
  }
  SBAR(); qkt(pB0, pB1, K_lds + b1 * SHM_K, qr, r32, hi, m_run);
  finishSM(pA0, pA1, alA, l_reg, pa0, pa1, pa2, pa3); SBAR();
  pv_d0(o, vb0 + b0 * SHM_V, pa0, pa1, pa2, pa3); partialSM(pB0, pB1, m_run, alB);
  RESC(alB);
  finishSM(pB0, pB1, alB, l_reg, pa0, pa1, pa2, pa3); SBAR();
  pv_d0(o, vb0 + b1 * SHM_V, pa0, pa1, pa2, pa3);
  if (hi == 0) li_l[r32] = l_reg; asm volatile("s_waitcnt lgkmcnt(0)" ::: "memory");
  float rli[16];
#pragma unroll
  for (int r = 0; r < 16; ++r) rli[r] = __builtin_amdgcn_rcpf(li_l[crow(r, hi)]);
  unsigned short* Ow = Ob + (long)(wid * QBLK) * LDO;
#pragma unroll
  for (int r = 0; r < 16; ++r) { int orow = crow(r, hi);
#pragma unroll
    for (int d0 = 0; d0 < 2; ++d0) Ow[(long)orow * LDO + d0 * 32 + r32] = (unsigned short)(cvtpk(o[d0][r] * rli[r], 0.f) & 0xffffu); }
  __syncthreads();
#undef SLOAD
#undef SWRITE
#undef SWAIT
#undef RESC
}
#undef KSWZ
#undef SBAR
}


namespace ml {
using bf16x8 = __attribute__((ext_vector_type(8))) short;
using s16x4  = __attribute__((ext_vector_type(4))) short;
using f32x16 = __attribute__((ext_vector_type(16))) float;
using f32x4  = __attribute__((ext_vector_type(4))) float;
using u32x4  = __attribute__((ext_vector_type(4))) unsigned;
constexpr float L2E = 1.4426950408889634f;
constexpr int NXC = 34;
__device__ __forceinline__ int crow(int r, int hi) { return (r & 3) + 8 * (r >> 2) + 4 * hi; }
__device__ __forceinline__ unsigned cvtpk(float lo, float hi) { unsigned r; asm volatile("v_cvt_pk_bf16_f32 %0, %1, %2" : "=v"(r) : "v"(lo), "v"(hi)); return r; }
template <int NC> __device__ __forceinline__ int t_st(int k, int c) { const int kk = k; return ((kk >> 3) * NC + (c >> 5)) * 512 + ((kk & 7) * 32 + (c & 31)) * 2; }
__device__ __forceinline__ int t_rd_base(int lane) { return ((lane & 3) << 3) | (((lane >> 2) & 3) << 6) | (((lane >> 4) & 1) << 5) | (((lane >> 5) & 1) << 8); }
template <int NC> constexpr int t_rd_off(int d0, int ks, int half) { return d0 * 512 + ks * (NC * 1024) + half * (NC * 512); }
template <int OFF> __device__ __forceinline__ s16x4 tr_read(int vb) { s16x4 r; asm volatile("ds_read_b64_tr_b16 %0, %1 offset:%2" : "=&v"(r) : "v"(vb), "i"(OFF) : "memory"); return r; }
#define ML_PK(L, H) (bf16x8){L[0], L[1], L[2], L[3], H[0], H[1], H[2], H[3]}
#define ML_KS(row, colB) ((row) * 128 + ((colB) ^ (((row) & 7) << 4)))
__device__ __forceinline__ int chunk_row(int b, int X, int i) { return X < 2 ? (16384 + b * 256 + X * 128 + i) : (b * 4096 + (X - 2) * 128 + i); }
__device__ __forceinline__ float lsig(float x) { return fminf(x, 0.f) - __logf(1.f + __expf(-fabsf(x))); }

__device__ __forceinline__ void gate_prep(const float* GATES, const float* bg, int b, int h, int X, LAS float* cum, LAS float* av, LAS float* pm, LAS float* wsr, LAS float* tot, int wave, int lane) {
    if (wave < 2) {
        const int dir = wave;
        const int e0 = dir ? (127 - 2 * lane) : (2 * lane), e1 = dir ? (126 - 2 * lane) : (2 * lane + 1);
        const int r0 = chunk_row(b, X, e0), r1 = chunk_row(b, X, e1);
        const float bi = bg[(2 * dir) * 4 + h], bf = bg[(2 * dir + 1) * 4 + h];
        const float li0 = GATES[(size_t)r0 * 16 + (2 * dir) * 4 + h] + bi, li1 = GATES[(size_t)r1 * 16 + (2 * dir) * 4 + h] + bi;
        const float x0 = lsig(GATES[(size_t)r0 * 16 + (2 * dir + 1) * 4 + h] + bf), x1 = lsig(GATES[(size_t)r1 * 16 + (2 * dir + 1) * 4 + h] + bf);
        float sc = x0 + x1;
#pragma unroll
        for (int o = 1; o < 64; o <<= 1) { const float y = __shfl_up(sc, o); if (lane >= o) sc += y; }
        const float c1 = sc, c0 = sc - x1; const float total = __shfl(sc, 63);
        const float a0 = li0 - c0, a1 = li1 - c1;
        float mx = fmaxf(a0, a1);
#pragma unroll
        for (int o = 1; o < 64; o <<= 1) { const float y = __shfl_up(mx, o); if (lane >= o) mx = fmaxf(mx, y); }
        float prev = __shfl_up(mx, 1); if (lane == 0) prev = -3.0e38f;
        cum[dir * 128 + e0] = c0; cum[dir * 128 + e1] = c1; av[dir * 128 + e0] = a0; av[dir * 128 + e1] = a1;
        pm[dir * 128 + e0] = fmaxf(prev, a0); pm[dir * 128 + e1] = mx;
        wsr[dir * 128 + e0] = total - c0 + li0; wsr[dir * 128 + e1] = total - c1 + li1;
        if (lane == 0) tot[dir] = total;
    }
}

__device__ __forceinline__ void stepA_unit(const unsigned short* P16, const float* GATES, const float* bg, int bh, int X, float* CLOC, float* NLOC, float* MLOC, float* TOT, char* lds) {
    const int tid = threadIdx.x, wave = __builtin_amdgcn_readfirstlane(tid >> 6), lane = tid & 63, r32 = lane & 31, hi = lane >> 5;
    const int b = bh >> 2, h = bh & 3;
    LAS float* fa = (LAS float*)(lds + 65536);
    LAS float* cum = fa, *av = fa + 256, *pm = fa + 512, *wsr = fa + 768, *tot = fa + 1024, *wl = fa + 1040, *npart = fa + 1312;
    bf16x8 stV[4]; u32x4 stK[2];
#pragma unroll
    for (int j = 0; j < 4; ++j) { const int id = tid + 512 * j, row = id >> 4, ch = id & 15; stV[j] = *reinterpret_cast<const bf16x8*>(P16 + (size_t)chunk_row(b, X, row) * 2304 + 1184 + h * 128 + ch * 8); }
#pragma unroll
    for (int j = 0; j < 2; ++j) { const int id = tid + 512 * j, row = id >> 3, ch = id & 7; stK[j] = *reinterpret_cast<const u32x4*>(P16 + (size_t)chunk_row(b, X, row) * 2304 + 928 + h * 64 + ch * 8); }
    gate_prep(GATES, bg, b, h, X, cum, av, pm, wsr, tot, wave, lane);
#pragma unroll
    for (int j = 0; j < 4; ++j) { const int id = tid + 512 * j, row = id >> 4, ch = id & 15; *(bf16x8*)(lds + t_st<4>(row, ch * 8)) = stV[j]; }
    __syncthreads();
    if (wave < 2) {
        const int dir = wave; const float w0 = wsr[dir * 128 + lane], w1 = wsr[dir * 128 + 64 + lane];
        float mx = fmaxf(w0, w1);
#pragma unroll
        for (int o = 1; o < 64; o <<= 1) mx = fmaxf(mx, __shfl_xor(mx, o));
        wl[dir * 128 + lane] = __expf(w0 - mx); wl[dir * 128 + 64 + lane] = __expf(w1 - mx);
        if (lane == 0) { MLOC[(bh * NXC + X) * 2 + dir] = mx; TOT[(bh * NXC + X) * 2 + dir] = tot[dir]; }
    }
    __syncthreads();
#pragma unroll
    for (int j = 0; j < 2; ++j) { const int id = tid + 512 * j, row = id >> 3, ch = id & 7;
        const u32x4 kv = stK[j];
        const float wf = wl[row], wb = wl[128 + row];
        u32x4 of, ob;
#pragma unroll
        for (int q = 0; q < 4; ++q) { const float lo = __uint_as_float(kv[q] << 16), hi2 = __uint_as_float(kv[q] & 0xffff0000u); of[q] = cvtpk(lo * wf, hi2 * wf); ob[q] = cvtpk(lo * wb, hi2 * wb); }
        *(u32x4*)(lds + 32768 + t_st<2>(row, ch * 8)) = of; *(u32x4*)(lds + 49152 + t_st<2>(row, ch * 8)) = ob; }
    __syncthreads();
    {
        const int dir = wave >> 2, mb = wave & 3;
        const int vb = (int)(uintptr_t)lds + t_rd_base(lane) + mb * 512;
        const int kb = (int)(uintptr_t)lds + 32768 + dir * 16384 + t_rd_base(lane);
        f32x16 acc0 = {}, acc1 = {};
#define ML_A_STEP(KS) do { \
        const s16x4 vl = tr_read<t_rd_off<4>(0, KS, 0)>(vb), vh = tr_read<t_rd_off<4>(0, KS, 1)>(vb); \
        const s16x4 k0l = tr_read<t_rd_off<2>(0, KS, 0)>(kb), k0h = tr_read<t_rd_off<2>(0, KS, 1)>(kb), k1l = tr_read<t_rd_off<2>(1, KS, 0)>(kb), k1h = tr_read<t_rd_off<2>(1, KS, 1)>(kb); \
        asm volatile("s_waitcnt lgkmcnt(0)" ::: "memory"); __builtin_amdgcn_sched_barrier(0); \
        acc0 = __builtin_amdgcn_mfma_f32_32x32x16_bf16(ML_PK(vl, vh), ML_PK(k0l, k0h), acc0, 0, 0, 0); \
        acc1 = __builtin_amdgcn_mfma_f32_32x32x16_bf16(ML_PK(vl, vh), ML_PK(k1l, k1h), acc1, 0, 0, 0); } while (0)
        ML_A_STEP(0); ML_A_STEP(1); ML_A_STEP(2); ML_A_STEP(3); ML_A_STEP(4); ML_A_STEP(5); ML_A_STEP(6); ML_A_STEP(7);
#undef ML_A_STEP
        float* dst = CLOC + ((size_t)(bh * NXC + X) * 2 + dir) * 8192;
#pragma unroll
        for (int r = 0; r < 16; ++r) { const int dv = 32 * mb + crow(r, hi); dst[dv * 64 + r32] = acc0[r]; dst[dv * 64 + 32 + r32] = acc1[r]; }
    }
    {
        const int dir = tid >> 8, part = (tid >> 6) & 3, d = tid & 63; float a = 0.f;
        const char* img = lds + 32768 + dir * 16384;
#pragma unroll 8
        for (int i = 0; i < 32; ++i) { const int row = part * 32 + i; a += bf2f(*(const unsigned short*)(img + t_st<2>(row, d))); }
        npart[(dir * 4 + part) * 64 + d] = a;
    }
    __syncthreads();
    if (tid < 128) { const int dir = tid >> 6, d = tid & 63; NLOC[((size_t)(bh * NXC + X) * 2 + dir) * 64 + d] = (npart[(dir * 4 + 0) * 64 + d] + npart[(dir * 4 + 1) * 64 + d]) + (npart[(dir * 4 + 2) * 64 + d] + npart[(dir * 4 + 3) * 64 + d]); }
    __syncthreads();
}

__device__ __forceinline__ int scanX(int dir, int j) { return dir ? (j == 0 ? 1 : (j == 1 ? 0 : 35 - j)) : j; }
__device__ __forceinline__ void stepB(const float* CLOC, const float* NLOC, const float* MLOC, const float* TOT, unsigned* CIN, float* NIN, float* MIN, int gtid, int gthreads) {
    for (int it = gtid; it < 32 * 4096 + 32 * 64; it += gthreads) {
        const bool isn = it >= 32 * 4096;
        const int sq = isn ? (it - 32 * 4096) >> 6 : it >> 12, e = isn ? (it - 32 * 4096) & 63 : it & 4095;
        const int bh = sq >> 1, dir = sq & 1;
        float2 v[NXC]; float tt[NXC], mm[NXC];
#pragma unroll
        for (int j = 0; j < NXC; ++j) { const int X = scanX(dir, j); const size_t li = (size_t)(bh * NXC + X) * 2 + dir;
            tt[j] = TOT[li]; mm[j] = MLOC[li];
            if (isn) { v[j].x = NLOC[li * 64 + e]; v[j].y = 0.f; } else v[j] = *(const float2*)(CLOC + li * 8192 + 2 * e); }
        float c0 = 0.f, c1 = 0.f, m = 0.f;
#pragma unroll
        for (int j = 0; j < NXC; ++j) {
            const int X = scanX(dir, j);
            if (X >= 2) {
                const size_t ci = (size_t)(bh * 32 + (X - 2)) * 2 + dir;
                if (isn) { NIN[ci * 64 + e] = c0; if (e == 0) MIN[ci] = m; }
                else CIN[ci * 4096 + e] = cvtpk(c0, c1);
            }
            const float mn = fmaxf(tt[j] + m, mm[j]), dec = __expf(tt[j] + m - mn), scl = __expf(mm[j] - mn);
            c0 = dec * c0 + scl * v[j].x; c1 = dec * c1 + scl * v[j].y;
            m = mn;
        }
    }
}

__device__ __forceinline__ void stepC_unit(const unsigned short* P16, const float* GATES, const float* bg, const unsigned short* CIN, const float* NIN, const float* MIN, const float* mng,
                                           unsigned short* MIX16, int bh, int c, char* lds) {
    const int tid = threadIdx.x, wave = __builtin_amdgcn_readfirstlane(tid >> 6), lane = tid & 63, r32 = lane & 31, hi = lane >> 5;
    const int b = bh >> 2, h = bh & 3, X = c + 2;
    LAS float* fa = (LAS float*)(lds + 98304);
    LAS float* cum = fa, *av = fa + 256, *pm = fa + 512, *wsr = fa + 768, *tot = fa + 1024, *scl = fa + 1040;
    LAS float* hs = (LAS float*)lds;
    const int dir = wave >> 2, tb = wave & 3;
    const int t = 32 * tb + r32;
    const size_t ci = (size_t)(bh * 32 + c) * 2 + dir;
    bf16x8 qr[4]; f32x4 nn[8];
    {
        const unsigned short* qp = P16 + (size_t)chunk_row(b, X, t) * 2304 + 672 + h * 64 + hi * 8;
        const float* np = NIN + ci * 64 + hi * 8;
#pragma unroll
        for (int ks = 0; ks < 4; ++ks) { qr[ks] = *reinterpret_cast<const bf16x8*>(qp + ks * 16); nn[2 * ks] = *(const f32x4*)(np + ks * 16); nn[2 * ks + 1] = *(const f32x4*)(np + ks * 16 + 4); }
    }
    const float min2 = MIN[ci] * L2E;
    bf16x8 stK[2], stV[4], stC[4];
#pragma unroll
    for (int j = 0; j < 2; ++j) { const int id = tid + 512 * j, row = id >> 3, ch = id & 7; stK[j] = *reinterpret_cast<const bf16x8*>(P16 + (size_t)chunk_row(b, X, row) * 2304 + 928 + h * 64 + ch * 8); }
#pragma unroll
    for (int j = 0; j < 4; ++j) { const int id = tid + 512 * j, row = id >> 4, ch = id & 15; stV[j] = *reinterpret_cast<const bf16x8*>(P16 + (size_t)chunk_row(b, X, row) * 2304 + 1184 + h * 128 + ch * 8); }
    gate_prep(GATES, bg, b, h, X, cum, av, pm, wsr, tot, wave, lane);
    asm volatile("" ::: "memory");
#pragma unroll
    for (int j = 0; j < 4; ++j) { const int id = tid + 512 * j, dd = id >> 10, row = (id >> 3) & 127, ch = id & 7;
        stC[j] = *reinterpret_cast<const bf16x8*>(CIN + ((size_t)(bh * 32 + c) * 2 + dd) * 8192 + row * 64 + ch * 8); }
#pragma unroll
    for (int j = 0; j < 2; ++j) { const int id = tid + 512 * j, row = id >> 3, ch = id & 7; *(bf16x8*)(lds + ML_KS(row, ch * 16)) = stK[j]; }
#pragma unroll
    for (int j = 0; j < 4; ++j) { const int id = tid + 512 * j, row = id >> 4, ch = id & 15; *(bf16x8*)(lds + 16384 + t_st<4>(row, ch * 8)) = stV[j]; }
#pragma unroll
    for (int j = 0; j < 4; ++j) { const int id = tid + 512 * j, dd = id >> 10, row = (id >> 3) & 127, ch = id & 7; *(bf16x8*)(lds + 65536 + dd * 16384 + ML_KS(row, ch * 16)) = stC[j]; }
    __syncthreads();
    const float el2 = fmaxf(min2, pm[dir * 128 + t] * L2E);
    const float wint = __builtin_amdgcn_exp2f(min2 - el2);
    float ndot = 0.f;
#pragma unroll
    for (int ks = 0; ks < 4; ++ks) { const u32x4 q4 = *reinterpret_cast<const u32x4*>(&qr[ks]); const f32x4 n0 = nn[2 * ks], n1 = nn[2 * ks + 1];
#pragma unroll
        for (int q = 0; q < 4; ++q) { const float lo = __uint_as_float(q4[q] << 16), hi2 = __uint_as_float(q4[q] & 0xffff0000u);
            const float nl = (q < 2) ? n0[2 * q] : n1[2 * q - 4], nh = (q < 2) ? n0[2 * q + 1] : n1[2 * q - 3];
            ndot = fmaf(lo, nl, ndot); ndot = fmaf(hi2, nh, ndot); } }
    f32x16 o[4] = {}; float den = 0.f;
    const int vb = (int)(uintptr_t)lds + 16384 + t_rd_base(lane);
    const char* Kl = lds;
#define ML_C_BLOCK(SB) do { if (dir ? (SB >= tb) : (SB <= tb)) { \
        f32x16 p = {}; \
        _Pragma("unroll") for (int ks = 0; ks < 4; ++ks) { const bf16x8 kf = *reinterpret_cast<const bf16x8*>(Kl + ML_KS(32 * SB + r32, (ks * 16 + hi * 8) * 2)); p = __builtin_amdgcn_mfma_f32_32x32x16_bf16(kf, qr[ks], p, 0, 0, 0); } \
        _Pragma("unroll") for (int g = 0; g < 4; ++g) { const f32x4 a4 = *(const LAS f32x4*)(av + dir * 128 + 32 * SB + 8 * g + 4 * hi); \
            _Pragma("unroll") for (int i = 0; i < 4; ++i) { const int sidx = 32 * SB + 8 * g + 4 * hi + i; const bool ok = dir ? (sidx >= t) : (sidx <= t); \
                const float f = __builtin_amdgcn_exp2f(a4[i] * L2E - el2) * 0.125f; p[4 * g + i] = ok ? p[4 * g + i] * f : 0.f; den += p[4 * g + i]; } } \
        bf16x8 pa0, pa1; \
        { u32x4 w = {cvtpk(p[0], p[1]), cvtpk(p[2], p[3]), cvtpk(p[4], p[5]), cvtpk(p[6], p[7])}; pa0 = *reinterpret_cast<bf16x8*>(&w); }        \
        { u32x4 w = {cvtpk(p[8], p[9]), cvtpk(p[10], p[11]), cvtpk(p[12], p[13]), cvtpk(p[14], p[15])}; pa1 = *reinterpret_cast<bf16x8*>(&w); } \
        ML_C_PV(0, SB, pa0, pa1); ML_C_PV(1, SB, pa0, pa1); ML_C_PV(2, SB, pa0, pa1); ML_C_PV(3, SB, pa0, pa1); } } while (0)
#define ML_C_PV(D0, SB, PA0, PA1) do { \
        const s16x4 l0 = tr_read<t_rd_off<4>(D0, 2 * SB, 0)>(vb), h0 = tr_read<t_rd_off<4>(D0, 2 * SB, 1)>(vb), l1 = tr_read<t_rd_off<4>(D0, 2 * SB + 1, 0)>(vb), h1 = tr_read<t_rd_off<4>(D0, 2 * SB + 1, 1)>(vb); \
        asm volatile("s_waitcnt lgkmcnt(0)" ::: "memory"); __builtin_amdgcn_sched_barrier(0); \
        o[D0] = __builtin_amdgcn_mfma_f32_32x32x16_bf16(PA0, ML_PK(l0, h0), o[D0], 0, 0, 0); \
        o[D0] = __builtin_amdgcn_mfma_f32_32x32x16_bf16(PA1, ML_PK(l1, h1), o[D0], 0, 0, 0); } while (0)
    ML_C_BLOCK(0); ML_C_BLOCK(1); ML_C_BLOCK(2); ML_C_BLOCK(3);
#undef ML_C_BLOCK
#undef ML_C_PV
    {
        bf16x8 qw[4];
#pragma unroll
        for (int ks = 0; ks < 4; ++ks) { const u32x4 q4 = *reinterpret_cast<const u32x4*>(&qr[ks]); u32x4 w4;
#pragma unroll
            for (int q = 0; q < 4; ++q) { const float lo = __uint_as_float(q4[q] << 16), hi2 = __uint_as_float(q4[q] & 0xffff0000u); w4[q] = cvtpk(lo * (0.125f * wint), hi2 * (0.125f * wint)); }
            qw[ks] = *reinterpret_cast<const bf16x8*>(&w4); }
        const char* Cl = lds + 65536 + dir * 16384;
#pragma unroll
        for (int d0 = 0; d0 < 4; ++d0)
#pragma unroll
            for (int ks = 0; ks < 4; ++ks) { const bf16x8 cf = *reinterpret_cast<const bf16x8*>(Cl + ML_KS(32 * d0 + r32, (ks * 16 + hi * 8) * 2)); o[d0] = __builtin_amdgcn_mfma_f32_32x32x16_bf16(qw[ks], cf, o[d0], 0, 0, 0); }
    }
    { auto rr = __builtin_amdgcn_permlane32_swap(__float_as_uint(den), __float_as_uint(den), false, false); den = __uint_as_float(rr[0]) + __uint_as_float(rr[1]); }
    { auto rr = __builtin_amdgcn_permlane32_swap(__float_as_uint(ndot), __float_as_uint(ndot), false, false); ndot = __uint_as_float(rr[0]) + __uint_as_float(rr[1]); }
    den += wint * 0.125f * ndot;
    const float sct = 1.f / fmaxf(fabsf(den), __builtin_amdgcn_exp2f(-cum[dir * 128 + t] * L2E - el2));
    if (hi == 0) scl[wave * 32 + r32] = sct;
    __syncthreads();
    if (dir == 1) {
#pragma unroll
        for (int r = 0; r < 16; ++r) { const float sc = scl[wave * 32 + crow(r, hi)];
#pragma unroll
            for (int d0 = 0; d0 < 4; ++d0) hs[(32 * tb + crow(r, hi)) * 128 + 32 * d0 + r32] = o[d0][r] * sc; }
    }
    __syncthreads();
    if (dir == 0) {
#pragma unroll
        for (int r = 0; r < 16; ++r) { const float sc = scl[wave * 32 + crow(r, hi)];
#pragma unroll
            for (int d0 = 0; d0 < 4; ++d0) hs[(32 * tb + crow(r, hi)) * 128 + 32 * d0 + r32] += o[d0][r] * sc; }
    }
    __syncthreads();
    {
        const int tt = tid >> 2, q4 = tid & 3;
        const size_t grow = (size_t)chunk_row(b, X, tt);
        const unsigned short* og = P16 + grow * 2304 + 1696 + h * 128 + 32 * q4;
        u32x4 og4[4];
#pragma unroll
        for (int j = 0; j < 4; ++j) og4[j] = *reinterpret_cast<const u32x4*>(og + 8 * j);
        f32x4 v[8]; float ss = 0.f;
#pragma unroll
        for (int j = 0; j < 8; ++j) { v[j] = *(const LAS f32x4*)(hs + tt * 128 + 32 * q4 + 4 * j); ss += (v[j][0] * v[j][0] + v[j][1] * v[j][1]) + (v[j][2] * v[j][2] + v[j][3] * v[j][3]); }
        ss += __shfl_xor(ss, 1); ss += __shfl_xor(ss, 2);
        const float rstd = rsqrtf(ss * (1.f / 128.f) + 1e-6f);
        const float* gn = mng + h * 128 + 32 * q4;
        unsigned short* dst = MIX16 + grow * 1024 + 512 + h * 128 + 32 * q4;
#pragma unroll
        for (int j = 0; j < 4; ++j) { const f32x4 g0 = *(const f32x4*)(gn + 8 * j), g1 = *(const f32x4*)(gn + 8 * j + 4); const f32x4 x0 = v[2 * j], x1 = v[2 * j + 1]; const u32x4 ow = og4[j];
            float r8[8];
#pragma unroll
            for (int e = 0; e < 4; ++e) { const float gl = __uint_as_float(ow[e] << 16), gh = __uint_as_float(ow[e] & 0xffff0000u);
                const float xa = (e < 2) ? x0[2 * e] : x1[2 * e - 4], xb = (e < 2) ? x0[2 * e + 1] : x1[2 * e - 3];
                const float ga = (e < 2) ? g0[2 * e] : g1[2 * e - 4], gb = (e < 2) ? g0[2 * e + 1] : g1[2 * e - 3];
                r8[2 * e] = xa * rstd * ga * __builtin_amdgcn_rcpf(1.f + __expf(-gl)); r8[2 * e + 1] = xb * rstd * gb * __builtin_amdgcn_rcpf(1.f + __expf(-gh)); }
            u32x4 w; w.x = cvtpk(r8[0], r8[1]); w.y = cvtpk(r8[2], r8[3]); w.z = cvtpk(r8[4], r8[5]); w.w = cvtpk(r8[6], r8[7]);
            *(u32x4*)(dst + 8 * j) = w; }
    }
    __syncthreads();
}
#undef ML_PK
#undef ML_KS
}


__device__ __forceinline__ unsigned pk4_fp8(float a, float b, float c, float d) { int w = __builtin_amdgcn_cvt_pk_fp8_f32(a, b, 0, false); w = __builtin_amdgcn_cvt_pk_fp8_f32(c, d, w, true); return (unsigned)w; }
template <class RowMap>
__device__ __forceinline__ void transpose_item8(const float* W, int K, int N, int nblk, unsigned char* WT, const RowMap& rowmap, LAS float* scr, int item, int lane) {
    const int kb = item / nblk, nb = item % nblk, k0 = 64 * kb, n0 = 32 * nb;
    const int ncol = n0 + (lane & 31);
    float tv[32];
#pragma unroll
    for (int i = 0; i < 32; ++i) { const int kk = 2 * i + (lane >> 5); tv[i] = __builtin_nontemporal_load(W + (size_t)(k0 + kk) * N + ncol) * 64.f; }
#pragma unroll
    for (int i = 0; i < 32; ++i) scr[(2 * i + (lane >> 5)) * 33 + (lane & 31)] = tv[i];
    asm volatile("s_waitcnt lgkmcnt(0)" ::: "memory");
    const int c = lane & 7;
    const int r0 = rowmap(n0);
#pragma unroll
    for (int j = 0; j < 4; ++j) { const int n = (lane >> 3) + 8 * j; const LAS float* sp = scr + (8 * c) * 33 + n;
        pg8::u32x2 o; o.x = pk4_fp8(sp[0 * 33], sp[1 * 33], sp[2 * 33], sp[3 * 33]); o.y = pk4_fp8(sp[4 * 33], sp[5 * 33], sp[6 * 33], sp[7 * 33]);
        __builtin_nontemporal_store(o, (pg8::u32x2*)(WT + (size_t)(r0 + n) * K + k0 + 8 * c)); }
    asm volatile("s_waitcnt lgkmcnt(0)" ::: "memory");
}

__device__ __forceinline__ void convert_chunk(const float* wgu, const float* wdn, unsigned short* WguT, unsigned short* WdnT, int which, int chunk, LAS float* scr, int wave, int lane) {
#pragma unroll 1
    for (int j = 0; j < 8; ++j) {
        const int it = chunk * 64 + wave * 8 + j;
#if MOE_FP8
        if (which == 0) { const int e = it >> 10, r = it & 1023;
            transpose_item8(wgu + (size_t)e * D * 2 * DFF, D, 2 * DFF, 2 * DFF / 32, (unsigned char*)WguT + (size_t)e * 2 * DFF * D,
                            [](int n0) { return n0 < DFF ? (n0 >> 7) * 256 + (n0 & 127) : ((n0 - DFF) >> 7) * 256 + 128 + ((n0 - DFF) & 127); }, scr, r, lane); }
        else { const int e = it >> 9, r = it & 511;
            transpose_item8(wdn + (size_t)e * DFF * D, DFF, D, D / 32, (unsigned char*)WdnT + (size_t)e * D * DFF, [](int n0) { return n0; }, scr, r, lane); }
#else
        if (which == 0) { const int e = it >> 10, r = it & 1023;
            transpose_item(wgu + (size_t)e * D * 2 * DFF, D, 2 * DFF, 2 * DFF / 32, WguT + (size_t)e * 2 * DFF * D,
                           [](int n0) { return n0 < DFF ? (n0 >> 7) * 256 + (n0 & 127) : ((n0 - DFF) >> 7) * 256 + 128 + ((n0 - DFF) & 127); }, scr, r, lane); }
        else { const int e = it >> 9, r = it & 511;
            transpose_item(wdn + (size_t)e * DFF * D, DFF, D, D / 32, WdnT + (size_t)e * D * DFF, [](int n0) { return n0; }, scr, r, lane); }
#endif
    }
}
__device__ __forceinline__ void pull_chunks(unsigned* qword, int first, int total, int maxc, const float* wgu, const float* wdn, unsigned short* WguT, unsigned short* WdnT, int which,
                                            unsigned char* lds_raw, int wave, int lane) {
    LAS int* bc = (LAS int*)(lds_raw + 131072 + 1024);
    LAS float* scr = (LAS float*)(lds_raw + wave * 16384);
    for (int n = 0; n < maxc; ++n) {
        __syncthreads();
        if (threadIdx.x == 0) bc[0] = first + (int)__hip_atomic_fetch_add(qword, 1u, __ATOMIC_RELAXED, __HIP_MEMORY_SCOPE_AGENT);
        __syncthreads();
        const int c = bc[0];
        if (c >= total) break;
        convert_chunk(wgu, wdn, WguT, WdnT, which, c, scr, wave, lane);
    }
    __syncthreads();
}

__device__ __forceinline__ int fresh_tid() { int t = (int)threadIdx.x; asm volatile("" : "+v"(t)); return t; }

#define DEF_PTRS \
    float* MOD = (float*)(ws + WS_MOD); \
    float* NLOC = (float*)(ws + WS_MLS); float* MLOC = (float*)(ws + WS_MLS + 512 * 1024); float* TOT = (float*)(ws + WS_MLS + 576 * 1024); float* NIN = (float*)(ws + WS_MLS + 1 * MiB); float* MIN_ = (float*)(ws + WS_MLS + 1536 * 1024); \
    float* CLOC = (float*)(ws + WS_CLOC); unsigned short* CIN = (unsigned short*)(ws + WS_CIN); \
    float* ROPEC = (float*)(ws + WS_ROPE); float* ROPES = ROPEC + S * 16; \
    int* TOPE = (int*)(ws + WS_TOPE); int* SLOT = (int*)(ws + WS_SLOT); int* LIST = (int*)(ws + WS_LIST); float* RGATE = (float*)(ws + WS_RGATE); \
    unsigned short* Hb16 = (unsigned short*)(ws + WS_H); unsigned short* WinT = (unsigned short*)(ws + WS_WINT); \
    unsigned short* Q16 = (unsigned short*)(ws + WS_Q); unsigned short* K16 = (unsigned short*)(ws + WS_KV); unsigned short* V16 = (unsigned short*)(ws + WS_KV + 32 * MiB); \
    unsigned short* X1 = (unsigned short*)(ws + WS_X1); unsigned short* H2 = (unsigned short*)(ws + WS_H2); \
    unsigned short* YG = (unsigned short*)(ws + WS_YG); unsigned short* ACT = (unsigned short*)(ws + WS_ACT); \
    unsigned short* WguT = (unsigned short*)(ws + WS_WGUT); unsigned short* WdnT = (unsigned short*)(ws + WS_WDNT); \
    unsigned short* WuqT = (unsigned short*)(ws + WS_WUQT); unsigned short* WukvT = (unsigned short*)(ws + WS_WUKVT); unsigned short* WoutT = (unsigned short*)(ws + WS_WOUTT); \
    float* GATES = (float*)(ws + WS_GATES); float* STAT = (float*)(ws + WS_STAT); float* STAT2 = (float*)(ws + WS_STAT2); \
    float* GM2 = (float*)(ws + WS_RSTD); unsigned short* RWH = (unsigned short*)(ws + WS_RSTD + 65536); unsigned short* RWL = (unsigned short*)(ws + WS_RSTD + 131072); unsigned short* MIX16 = (unsigned short*)(ws + WS_MIX16); \
    unsigned short* P16 = (unsigned short*)(ws + WS_P); \
    unsigned* CNT = ctl + CW_CNT; (void)CNT;
typedef const Params __attribute__((address_space(4))) KParams;
#define PHASE_ENV KParams* pk = kp; asm volatile("" : "+s"(pk)); unsigned char* ws = pk->ws; unsigned* ctl = (unsigned*)(ws + WS_CTL); (void)ctl; DEF_PTRS

constexpr int LDS_BYTES = 147456;
constexpr int N_PHASES = 12;

__global__ void __launch_bounds__(NT, 2) fwd_kernel(Params p) {
    extern __shared__ __attribute__((aligned(16))) unsigned char lds_raw[];
    float* lds = (float*)lds_raw;
    LAS unsigned* misc = (LAS unsigned*)(lds_raw + 131072 + 4096);
    const int tid = threadIdx.x, lane = tid & 63, wave = tid >> 6;
    const int bid = blockIdx.x, G = gridDim.x;
    KParams* kp = (KParams*)__builtin_amdgcn_kernarg_segment_ptr();
    unsigned* ctl = (unsigned*)(p.ws + WS_CTL);
    if (tid < 4) misc[tid] = 0u;
    __syncthreads();
    const bool single = (p.ph_hi - p.ph_lo) > 1;
    if (single) (void)xcd_barrier_post(ctl + CW_BAR, (volatile LAS unsigned*)misc);
#ifndef PH_MASK
#define PH_MASK 0xFFFF
#endif
#define IN(k) ((((PH_MASK) >> (k)) & 1) && p.ph_lo <= (k) && (k) < p.ph_hi)
#define GRID_BARRIER() do { KParams* pb_ = kp; asm volatile("" : "+s"(pb_)); XcdBarrier b_; b_.bar = (unsigned*)(pb_->ws + WS_CTL) + CW_BAR; b_.x = xb_xcc_id(); b_.st = (volatile LAS unsigned*)misc; xcd_barrier(b_); } while (0)
#define SEAM(k) do { if (IN(k) && IN((k) + 1)) GRID_BARRIER(); } while (0)
#define PH_BEGIN(k)
#define PH_END(k)
#define SEAM2(k) do { if (IN(k) && IN((k) + 2)) GRID_BARRIER(); } while (0)

    PH_BEGIN(0) if (IN(0)) {
        const int tid = fresh_tid(), lane = tid & 63, wave = tid >> 6; (void)lane; (void)wave;
        PHASE_ENV
        {
            const float* wmod = pk->in[I_WMOD]; const float* bmod = pk->in[I_BMOD];
            float* sil = lds;
            float* red = lds + 5 * 1024;
            for (int cg = bid; cg < 96; cg += G) {
                for (int e = tid; e < 5 * D; e += NT) { const int r = e >> 10, k = e & 1023; const float cv = (r < 4) ? pk->in[I_C][r * D + k] : pk->in[I_CCTX][k]; sil[e] = siluf_(cv); }
                __syncthreads();
                const int col = cg * 64 + (tid & 63), part = tid >> 6;
                float a0 = 0.f, a1 = 0.f, a2 = 0.f, a3 = 0.f, a4 = 0.f;
#pragma unroll 8
                for (int kk = 0; kk < 128; ++kk) { const int k = part * 128 + kk; const float w = wmod[(size_t)k * 6144 + col];
                    a0 = fmaf(sil[k], w, a0); a1 = fmaf(sil[1024 + k], w, a1); a2 = fmaf(sil[2048 + k], w, a2); a3 = fmaf(sil[3072 + k], w, a3); a4 = fmaf(sil[4096 + k], w, a4); }
                red[(part * 5 + 0) * 64 + (tid & 63)] = a0; red[(part * 5 + 1) * 64 + (tid & 63)] = a1; red[(part * 5 + 2) * 64 + (tid & 63)] = a2; red[(part * 5 + 3) * 64 + (tid & 63)] = a3; red[(part * 5 + 4) * 64 + (tid & 63)] = a4;
                __syncthreads();
                if (tid < 320) { const int r = tid >> 6, cc = tid & 63; float t = 0.f;
#pragma unroll
                    for (int pp = 0; pp < 8; ++pp) t += red[(pp * 5 + r) * 64 + cc];
                    MOD[r * 6144 + cg * 64 + cc] = t + bmod[cg * 64 + cc]; }
                __syncthreads();
            }
        }
        for (int e = bid * NT + tid; e < NE * D; e += G * NT) { const int ex = e >> 10, k = e & 1023; const float w = pk->in[I_RW][(size_t)k * NE + ex];
            const unsigned hi = pg8::cvt_pk_bf16(w, 0.f) & 0xffffu; const float lo = w - __uint_as_float(hi << 16);
            RWH[e] = (unsigned short)hi; RWL[e] = (unsigned short)(pg8::cvt_pk_bf16(lo, 0.f) & 0xffffu); }
        for (int e = bid * NT + tid; e < S * 16; e += G * NT) { float cs, sn; rope_angles(e >> 4, e & 15, cs, sn); ROPEC[e] = cs; ROPES[e] = sn; }
        {
            LAS float* scr = (LAS float*)(lds_raw + wave * 16384);
            const int gw = bid * 8 + wave, NGW = G * 8;
            for (int it = gw; it < (D / 64) * (PW / 32); it += NGW) transpose_item(pk->in[I_WIN], D, INW, PW / 32, WinT, [](int n0) { return n0; }, scr, it, lane);
            for (int it = gw; it < (QL / 64) * (768 / 32); it += NGW) transpose_item(pk->in[I_WUQ], QL, 768, 768 / 32, WuqT, [](int n0) { return n0; }, scr, it, lane, pk->in[I_QNG]);
            for (int it = gw; it < (KVL / 64) * (1024 / 32); it += NGW) transpose_item(pk->in[I_WUKV], KVL, 1024, 1024 / 32, WukvT, [](int n0) { return n0; }, scr, it, lane, pk->in[I_KVNG]);
            for (int it = gw; it < (D / 64) * (D / 32); it += NGW) transpose_item(pk->in[I_WOUT], D, D, D / 32, WoutT, [](int n0) { return n0; }, scr, it, lane);
            for (int c = G - 1 - bid; c < GU_STATIC; c += G) convert_chunk(pk->in[I_WGU], pk->in[I_WDN], WguT, WdnT, 0, c, scr, wave, lane);
        }
    }
    PH_END(0)
    SEAM(0);
    PH_BEGIN(1) if (IN(1)) {
        const int tid = fresh_tid(), lane = tid & 63, wave = tid >> 6; (void)lane; (void)wave;
        PHASE_ENV
        const float* g1n = pk->in[I_N1G];
        for (int e = bid * NT + tid; e < 4 * D; e += G * NT) GM2[e] = pk->in[I_N2G][e & 1023] * (1.f + MOD[(e >> 10) * 6144 + 4 * D + (e & 1023)]);
        for (int rp = bid * 8 + wave; rp < MT / 2; rp += G * 8) {
            const int r = 2 * rp;
            const float* src = (r < MX) ? pk->in[I_X] + (size_t)r * D : pk->in[I_CTX] + (size_t)(r - MX) * D;
            const int mb = (r < MX) ? r / S : 4;
            const float* sh = MOD + mb * 6144, *sc = sh + D;
            float4 va[4], vb[4]; float sa = 0.f, sb = 0.f;
#pragma unroll
            for (int j = 0; j < 4; ++j) { va[j] = *(const float4*)(src + j * 256 + lane * 4); vb[j] = *(const float4*)(src + D + j * 256 + lane * 4); }
#pragma unroll
            for (int j = 0; j < 4; ++j) { sa += (va[j].x * va[j].x + va[j].y * va[j].y) + (va[j].z * va[j].z + va[j].w * va[j].w); sb += (vb[j].x * vb[j].x + vb[j].y * vb[j].y) + (vb[j].z * vb[j].z + vb[j].w * vb[j].w); }
            const float ra = rsqrtf(wave_sum(sa) * (1.f / D) + EPS), rb2 = rsqrtf(wave_sum(sb) * (1.f / D) + EPS);
#pragma unroll
            for (int j = 0; j < 4; ++j) {
                const int c = j * 256 + lane * 4;
                const float4 gn = *(const float4*)(g1n + c), scv = *(const float4*)(sc + c), shv = *(const float4*)(sh + c);
                const float g0 = gn.x * (1.f + scv.x), g1 = gn.y * (1.f + scv.y), g2 = gn.z * (1.f + scv.z), g3 = gn.w * (1.f + scv.w);
                pg8::u32x2 w;
                w.x = pg8::cvt_pk_bf16(va[j].x * ra * g0 + shv.x, va[j].y * ra * g1 + shv.y); w.y = pg8::cvt_pk_bf16(va[j].z * ra * g2 + shv.z, va[j].w * ra * g3 + shv.w);
                *(pg8::u32x2*)(Hb16 + (size_t)r * D + c) = w;
                w.x = pg8::cvt_pk_bf16(vb[j].x * rb2 * g0 + shv.x, vb[j].y * rb2 * g1 + shv.y); w.y = pg8::cvt_pk_bf16(vb[j].z * rb2 * g2 + shv.z, vb[j].w * rb2 * g3 + shv.w);
                *(pg8::u32x2*)(Hb16 + (size_t)(r + 1) * D + c) = w;
            }
        }
    }
    PH_END(1)
    SEAM(1);
    PH_BEGIN(2) if (IN(2)) {
        const int tid = fresh_tid(), lane = tid & 63, wave = tid >> 6; (void)lane; (void)wave;
        PHASE_ENV
        pg8::PlainSched Sd; Sd.init(MT, PW, D, D, WinT, G, bid);
        pg8::EpiInproj E{P16, GATES, STAT, K16, ROPEC, ROPES};
        pg8::gemm_phase<pg8::EpiInproj, pg8::PlainSched, true>((LAS unsigned char*)lds_raw, Hb16, D, Sd, E);
        if ((Sd.nwg % G) != 0 && bid >= (Sd.nwg % G))
            pull_chunks(ctl + CW_QGU, GU_STATIC, GU_CHUNKS, 2, pk->in[I_WGU], pk->in[I_WDN], WguT, WdnT, 0, lds_raw, wave, lane);
    }
    PH_END(2)
    SEAM2(2);
    PH_BEGIN(4) if (IN(4)) {
        const int tid = fresh_tid(), lane = tid & 63, wave = tid >> 6; (void)lane; (void)wave;
        PHASE_ENV
#ifndef NO_QG
        { pg8::PlainSched Sd; Sd.init(MX, 768, QL, PW, WuqT, G, (bid + G - 16) % G);
          pg8::EpiQ E{Q16, STAT, ROPEC, ROPES};
          pg8::gemm_phase<pg8::EpiQ, pg8::PlainSched, true>((LAS unsigned char*)lds_raw, P16 + O_CQ, QL, Sd, E); }
#endif
#ifndef NO_KVG
        { pg8::PlainSched Sd; Sd.init(MT, 1024, KVL, PW, WukvT, G, bid);
          pg8::EpiKV E{K16, V16, STAT};
          pg8::gemm_phase<pg8::EpiKV, pg8::PlainSched, true>((LAS unsigned char*)lds_raw, P16 + O_CKV, KVL, Sd, E); }
#endif
        for (int u = (bid + 48) % G; u < 16 * ml::NXC; u += G) ml::stepA_unit(P16, GATES, pk->in[I_BG], u / ml::NXC, u % ml::NXC, CLOC, NLOC, MLOC, TOT, (char*)lds_raw);
    }
    PH_END(4)
    SEAM(4);
    PH_BEGIN(5) if (IN(5)) {
        const int tid = fresh_tid(), lane = tid & 63, wave = tid >> 6; (void)lane; (void)wave;
        PHASE_ENV
        ml::stepB(CLOC, NLOC, MLOC, TOT, (unsigned*)CIN, NIN, MIN_, bid * NT + tid, G * NT);
        {
            const int nun = NB * HA * (S / 256);
            for (int i = 0; i * G < nun; ++i) {
                int bh, qb;
                if (G == 256) { const int x = bid & 7, slot = bid >> 3; bh = i * 16 + x * 2 + (slot >> 4); qb = slot & 15; }
                else { const int u = i * G + bid; if (u >= nun) break; bh = u >> 4; qb = u & 15; }
                const int b = bh >> 3, h = bh & 7;
                att::attn_body(Q16 + (size_t)(b * S + qb * 256) * 768 + h * 96, K16 + (size_t)(b * SKV) * 768 + h * 96, V16 + (size_t)(b * SKV) * 512 + h * 64,
                               MIX16 + (size_t)(b * S + qb * 256) * D + h * 64, SKV, (char*)lds_raw);
            }
        }
    }
    PH_END(5)
    SEAM(5);
    PH_BEGIN(6) if (IN(6)) {
        const int tid = fresh_tid(), lane = tid & 63, wave = tid >> 6; (void)lane; (void)wave;
        PHASE_ENV
        for (int u = bid; u < 16 * 32; u += G) ml::stepC_unit(P16, GATES, pk->in[I_BG], CIN, NIN, MIN_, pk->in[I_MNG], MIX16, u >> 5, u & 31, (char*)lds_raw);
    }
    PH_END(6)
    SEAM(6);
    PH_BEGIN(7) if (IN(7)) {
        const int tid = fresh_tid(), lane = tid & 63, wave = tid >> 6; (void)lane; (void)wave;
        PHASE_ENV
        pg8::PlainSched Sd; Sd.init(MX, D, D, D, WoutT, G, bid);
        pg8::EpiResid E{X1, pk->in[I_X], MOD, STAT2};
        pg8::gemm_phase<pg8::EpiResid, pg8::PlainSched, true>((LAS unsigned char*)lds_raw, MIX16, D, Sd, E);
    }
    PH_END(7)
    SEAM(7);
    PH_BEGIN(8) if (IN(8)) {
        const int tid = fresh_tid(), lane = tid & 63, wave = tid >> 6; (void)lane; (void)wave;
        PHASE_ENV
        typedef short bf16x8v __attribute__((ext_vector_type(8)));
        typedef float f32x4v __attribute__((ext_vector_type(4)));
        float* LG = lds;
        LAS int* lcnt = (LAS int*)(lds_raw + 32768); LAS int* gbase = lcnt + 32;
        const float* rb = pk->in[I_RB];
        for (int base = bid * 64; base < MX; base += G * 64) {
            if (tid < 32) lcnt[tid] = 0;
            {
                const int bq0 = base / S; const float4 t4 = (tid < 256) ? *(const float4*)(GM2 + bq0 * D + 4 * tid) : *(const float4*)(MOD + bq0 * 6144 + 3 * D + 4 * (tid - 256));
                *(float4*)(lds + 10240 + 4 * tid) = t4; }
            __syncthreads();
            int te[4] = {0, 0, 0, 0}, rk[4] = {0, 0, 0, 0}; float tg[4] = {0.f, 0.f, 0.f, 0.f};
            {
                const int rt = wave & 3, kh = wave >> 2;
                const int r0 = base + 16 * rt, row = lane & 15, kg = lane >> 4, bq = r0 / S;
                float ss;
                { const float4 s0 = *(const float4*)(STAT2 + (size_t)(r0 + row) * 32 + kg * 8), s1 = *(const float4*)(STAT2 + (size_t)(r0 + row) * 32 + kg * 8 + 4);
                  ss = ((s0.x + s0.y) + (s0.z + s0.w)) + ((s1.x + s1.y) + (s1.z + s1.w)); ss += __shfl_xor(ss, 16); ss += __shfl_xor(ss, 32); }
                const float rstd = rsqrtf(ss * (1.f / D) + EPS);
                const int ko = kh * 512 + 8 * kg;
                const unsigned short* xr = X1 + (size_t)(r0 + row) * D + ko; const float* gmr = lds + 10240 + ko; const float* shr = lds + 10240 + 1024 + ko; (void)bq;
                unsigned short* hr = H2 + (size_t)(r0 + row) * D + ko; (void)hr;
                const unsigned short* wh0 = RWH + (size_t)row * D + ko, *wh1 = RWH + (size_t)(16 + row) * D + ko, *wl0 = RWL + (size_t)row * D + ko, *wl1 = RWL + (size_t)(16 + row) * D + ko;
                f32x4v acc0 = {0.f, 0.f, 0.f, 0.f}, acc1 = {0.f, 0.f, 0.f, 0.f};
#pragma unroll 8
                for (int st = 0; st < 16; ++st) {
                    const pg8::u32x4 xw = *(const pg8::u32x4*)(xr + 32 * st);
                    const float4 x0 = make_float4(__uint_as_float(xw[0] << 16), __uint_as_float(xw[0] & 0xffff0000u), __uint_as_float(xw[1] << 16), __uint_as_float(xw[1] & 0xffff0000u)), x1v = make_float4(__uint_as_float(xw[2] << 16), __uint_as_float(xw[2] & 0xffff0000u), __uint_as_float(xw[3] << 16), __uint_as_float(xw[3] & 0xffff0000u));
                    const float4 g0 = *(const float4*)(gmr + 32 * st), g1v = *(const float4*)(gmr + 32 * st + 4), h0 = *(const float4*)(shr + 32 * st), h1 = *(const float4*)(shr + 32 * st + 4);
                    float hv[8] = {x0.x * rstd * g0.x + h0.x, x0.y * rstd * g0.y + h0.y, x0.z * rstd * g0.z + h0.z, x0.w * rstd * g0.w + h0.w, x1v.x * rstd * g1v.x + h1.x, x1v.y * rstd * g1v.y + h1.y, x1v.z * rstd * g1v.z + h1.z, x1v.w * rstd * g1v.w + h1.w};
                    pg8::u32x4 hi4, lo4;
#pragma unroll
                    for (int q = 0; q < 4; ++q) { hi4[q] = pg8::cvt_pk_bf16(hv[2 * q], hv[2 * q + 1]);
                        lo4[q] = pg8::cvt_pk_bf16(hv[2 * q] - __uint_as_float(hi4[q] << 16), hv[2 * q + 1] - __uint_as_float(hi4[q] & 0xffff0000u)); }
#if MOE_FP8
                    { pg8::u32x2 h8; h8.x = pk4_fp8(hv[0], hv[1], hv[2], hv[3]); h8.y = pk4_fp8(hv[4], hv[5], hv[6], hv[7]); *(pg8::u32x2*)((unsigned char*)H2 + (size_t)(r0 + row) * D + ko + 32 * st) = h8; }
#else
                    *(pg8::u32x4*)(hr + 32 * st) = hi4;
#endif
                    const bf16x8v ah = *reinterpret_cast<const bf16x8v*>(&hi4), al = *reinterpret_cast<const bf16x8v*>(&lo4);
                    const bf16x8v bh0 = *reinterpret_cast<const bf16x8v*>(wh0 + 32 * st), bh1 = *reinterpret_cast<const bf16x8v*>(wh1 + 32 * st), bl0 = *reinterpret_cast<const bf16x8v*>(wl0 + 32 * st), bl1 = *reinterpret_cast<const bf16x8v*>(wl1 + 32 * st);
                    acc0 = __builtin_amdgcn_mfma_f32_16x16x32_bf16(ah, bh0, acc0, 0, 0, 0); acc0 = __builtin_amdgcn_mfma_f32_16x16x32_bf16(al, bh0, acc0, 0, 0, 0); acc0 = __builtin_amdgcn_mfma_f32_16x16x32_bf16(ah, bl0, acc0, 0, 0, 0);
                    acc1 = __builtin_amdgcn_mfma_f32_16x16x32_bf16(ah, bh1, acc1, 0, 0, 0); acc1 = __builtin_amdgcn_mfma_f32_16x16x32_bf16(al, bh1, acc1, 0, 0, 0); acc1 = __builtin_amdgcn_mfma_f32_16x16x32_bf16(ah, bl1, acc1, 0, 0, 0);
                }
                float* lgp = LG + kh * (64 * 33);
#pragma unroll
                for (int j = 0; j < 4; ++j) { lgp[(16 * rt + 4 * kg + j) * 33 + row] = acc0[j]; lgp[(16 * rt + 4 * kg + j) * 33 + 16 + row] = acc1[j]; }
            }
            __syncthreads();
            if (wave < 4 && lane < 16) {
                float* lr = LG + (16 * wave + lane) * 33; float tv[4];
                for (int e = 0; e < 32; ++e) lr[e] = (lr[e] + lr[64 * 33 + e]) + rb[e];
#pragma unroll
                for (int k = 0; k < 4; ++k) { float best = -3.0e38f; int bi = 0;
                    for (int e = 0; e < 32; ++e) { const float v = lr[e]; if (v > best) { best = v; bi = e; } }
                    te[k] = bi; tv[k] = best; lr[bi] = -3.0e38f; }
                const float e1 = __expf(tv[1] - tv[0]), e2 = __expf(tv[2] - tv[0]), e3 = __expf(tv[3] - tv[0]); const float inv = 1.f / (1.f + e1 + e2 + e3);
                tg[0] = inv; tg[1] = e1 * inv; tg[2] = e2 * inv; tg[3] = e3 * inv;
#pragma unroll
                for (int k = 0; k < 4; ++k) rk[k] = atomicAdd((int*)&lcnt[te[k]], 1);
            }
            __syncthreads();
            if (tid < 32) gbase[tid] = (int)atomicAdd(&CNT[tid], (unsigned)lcnt[tid]);
            __syncthreads();
            if (wave < 4 && lane < 16) { const int r = base + 16 * wave + lane;
#pragma unroll
                for (int k = 0; k < 4; ++k) { const int e = te[k], pos = gbase[e] + rk[k]; TOPE[r * 4 + k] = e; SLOT[r * 4 + k] = pos; LIST[e * MX + pos] = r; RGATE[e * MX + pos] = tg[k]; } }
            __syncthreads();
        }
    }
    if (IN(8)) { const int t2 = fresh_tid(); PHASE_ENV pull_chunks(ctl + CW_QGU, GU_STATIC, GU_CHUNKS, GU_CHUNKS, pk->in[I_WGU], pk->in[I_WDN], WguT, WdnT, 0, lds_raw, t2 >> 6, t2 & 63); }
    PH_END(8)
    SEAM(8);
    LAS int* mtp = (LAS int*)(lds_raw + 131072); LAS int* mro = mtp + 40; LAS int* mcn = mro + 40;
    if (IN(9) || IN(10) || IN(11)) {
        PHASE_ENV
        __syncthreads();
        if (tid < 64) {
            const int cnt = (tid < NE) ? (int)__hip_atomic_load(&CNT[tid & 31], __ATOMIC_RELAXED, __HIP_MEMORY_SCOPE_AGENT) : 0;
            const int tl = (cnt + 255) >> 8; int inc = tl;
#pragma unroll
            for (int o = 1; o < 64; o <<= 1) { const int y = __shfl_up(inc, o); if (tid >= o) inc += y; }
            if (tid < NE) { mcn[tid] = cnt; mtp[tid] = inc - tl; mro[tid] = (inc - tl) * 256; }
            if (tid == NE - 1) { mtp[NE] = inc; mro[NE] = inc * 256; }
        }
        __syncthreads();
    }
    PH_BEGIN(9) if (IN(9)) {
        const int tid = fresh_tid(), lane = tid & 63, wave = tid >> 6; (void)lane; (void)wave;
        PHASE_ENV
#if MOE_FP8
        pg8::MoeSched Sd{mtp, mro, mcn, DFF / 128, G, bid, D / 2, D / 2, 1, LIST, (const char*)WguT, (size_t)2 * DFF * D};
        pg8::EpiSwiglu E{ACT, pk->in[I_BGU]};
        pg8::gemm_phase<pg8::EpiSwiglu, pg8::MoeSched, true, true>((LAS unsigned char*)lds_raw, H2, D / 2, Sd, E);
#else
        pg8::MoeSched Sd{mtp, mro, mcn, DFF / 128, G, bid, D, D, 1, LIST, (const char*)WguT, (size_t)2 * DFF * D * 2};
        pg8::EpiSwiglu E{ACT, pk->in[I_BGU]};
        pg8::gemm_phase<pg8::EpiSwiglu, pg8::MoeSched, true>((LAS unsigned char*)lds_raw, H2, D, Sd, E);
#endif
        {
            const int nun = mtp[NE] * (DFF / 128); const int mine = (nun - bid + G - 1) / G, most = (nun + G - 1) / G;
            if (mine < most) pull_chunks(ctl + CW_QDN, 0, DN_CHUNKS, 3, pk->in[I_WGU], pk->in[I_WDN], WguT, WdnT, 1, lds_raw, wave, lane);
            pull_chunks(ctl + CW_QDN, 0, DN_CHUNKS, DN_CHUNKS, pk->in[I_WGU], pk->in[I_WDN], WguT, WdnT, 1, lds_raw, wave, lane);
        }
    }
    PH_END(9)
    SEAM(9);
    PH_BEGIN(10) if (IN(10)) {
        const int tid = fresh_tid(), lane = tid & 63, wave = tid >> 6; (void)lane; (void)wave;
        PHASE_ENV
#if MOE_FP8
        pg8::MoeSched Sd{mtp, mro, mcn, D / 256, G, bid, DFF / 2, DFF / 2, 0, LIST, (const char*)WdnT, (size_t)D * DFF};
        pg8::EpiDown E{YG, pk->in[I_BDN], RGATE, mro};
        pg8::gemm_phase<pg8::EpiDown, pg8::MoeSched, true, true>((LAS unsigned char*)lds_raw, ACT, DFF / 2, Sd, E);
#else
        pg8::MoeSched Sd{mtp, mro, mcn, D / 256, G, bid, DFF, DFF, 0, LIST, (const char*)WdnT, (size_t)D * DFF * 2};
        pg8::EpiDown E{YG, pk->in[I_BDN], RGATE, mro};
        pg8::gemm_phase<pg8::EpiDown, pg8::MoeSched, true>((LAS unsigned char*)lds_raw, ACT, DFF, Sd, E);
#endif
    }
    PH_END(10)
    SEAM(10);
    PH_BEGIN(11) if (IN(11)) {
        const int tid = fresh_tid(), lane = tid & 63, wave = tid >> 6; (void)lane; (void)wave;
        PHASE_ENV
        const float* fng = pk->in[I_FNG];
        for (int r = bid * 8 + wave; r < MX; r += G * 8) {
            const int mb = r / S; const float* g2 = MOD + mb * 6144 + 5 * D;
            float acc[16];
#pragma unroll
            for (int i = 0; i < 16; ++i) acc[i] = 0.f;
#pragma unroll
            for (int k = 0; k < 4; ++k) {
                const int e = TOPE[r * 4 + k]; const int row = mro[e] + SLOT[r * 4 + k];
                const unsigned short* yr = YG + (size_t)row * D;
#pragma unroll
                for (int j = 0; j < 4; ++j) { const pg8::u32x2 t = *(const pg8::u32x2*)(yr + j * 256 + lane * 4);
                    acc[4 * j] += __uint_as_float(t.x << 16); acc[4 * j + 1] += __uint_as_float(t.x & 0xffff0000u); acc[4 * j + 2] += __uint_as_float(t.y << 16); acc[4 * j + 3] += __uint_as_float(t.y & 0xffff0000u); }
            }
            float v[16]; float ss = 0.f;
#pragma unroll
            for (int j = 0; j < 4; ++j) { const pg8::u32x2 tw = *(const pg8::u32x2*)(X1 + (size_t)r * D + j * 256 + lane * 4); const float4 t = make_float4(__uint_as_float(tw.x << 16), __uint_as_float(tw.x & 0xffff0000u), __uint_as_float(tw.y << 16), __uint_as_float(tw.y & 0xffff0000u)); const int c = j * 256 + lane * 4;
                v[4 * j] = t.x + g2[c] * acc[4 * j]; v[4 * j + 1] = t.y + g2[c + 1] * acc[4 * j + 1]; v[4 * j + 2] = t.z + g2[c + 2] * acc[4 * j + 2]; v[4 * j + 3] = t.w + g2[c + 3] * acc[4 * j + 3];
                ss += v[4 * j] * v[4 * j] + v[4 * j + 1] * v[4 * j + 1] + v[4 * j + 2] * v[4 * j + 2] + v[4 * j + 3] * v[4 * j + 3]; }
            const float rstd = rsqrtf(wave_sum(ss) * (1.f / D) + EPS);
#pragma unroll
            for (int j = 0; j < 4; ++j) { const int c = j * 256 + lane * 4;
                *(float4*)(pk->out + (size_t)r * D + c) = make_float4(v[4 * j] * rstd * fng[c], v[4 * j + 1] * rstd * fng[c + 1], v[4 * j + 2] * rstd * fng[c + 2], v[4 * j + 3] * rstd * fng[c + 3]); }
        }
    }
    PH_END(11)
#undef IN
#undef SEAM
}

#ifndef PROBE_SPLIT_DUP
#define PROBE_SPLIT_DUP (-1)
#endif
#ifndef N_LAUNCH_SPLIT
#define N_LAUNCH_SPLIT 0
#endif

extern "C" void kernel_launch(void* const* d_in, const int* in_sizes, int n_in, void* d_out, int out_size, void* d_ws, size_t ws_size, hipStream_t stream) {
    static int grid = 0;
    if (grid == 0) {
        if (n_in != 23 || out_size != MX * D || ws_size < WS_END) { fprintf(stderr, "kernel_launch: unexpected shapes n_in %d out %d ws %zu (need %zu)\n", n_in, out_size, ws_size, (size_t)WS_END); grid = -1; return; }
        int dev = 0, cus = 0, per_cu = 0;
        hipGetDevice(&dev); hipDeviceGetAttribute(&cus, hipDeviceAttributeMultiprocessorCount, dev);
        if (hipFuncSetAttribute((const void*)fwd_kernel, hipFuncAttributeMaxDynamicSharedMemorySize, LDS_BYTES) != hipSuccess) { fprintf(stderr, "kernel_launch: hipFuncSetAttribute failed\n"); grid = -1; return; }
        hipOccupancyMaxActiveBlocksPerMultiprocessor(&per_cu, (const void*)fwd_kernel, NT, LDS_BYTES);
        if (per_cu < 1) fprintf(stderr, "kernel_launch: occupancy query says %d\n", per_cu);
        (void)hipGetLastError();
        grid = cus > 0 ? cus : 256;
    }
    if (grid < 0) return;
    hipMemsetAsync((char*)d_ws + WS_CTL, 0, CTL_BYTES, stream);
    Params p{};
    for (int i = 0; i < 23; ++i) p.in[i] = (const float*)d_in[i];
    p.out = (float*)d_out; p.ws = (unsigned char*)d_ws;
#if N_LAUNCH_SPLIT
    for (int k = 0; k < N_PHASES; ++k) {
        if (k == 3) continue;
        const int reps = (k == PROBE_SPLIT_DUP) ? 2 : 1;
        for (int r = 0; r < reps; ++r) {
            if (k == 8 && r == 1) hipMemsetAsync((char*)d_ws + WS_CTL, 0, CTL_BYTES, stream);
            p.ph_lo = k; p.ph_hi = k + 1; hipLaunchKernelGGL(fwd_kernel, dim3(grid), dim3(NT), LDS_BYTES, stream, p);
        }
    }
#else
    p.ph_lo = 0; p.ph_hi = N_PHASES;
    hipLaunchKernelGGL(fwd_kernel, dim3(grid), dim3(NT), LDS_BYTES, stream, p);
#endif
}
```
